# Optimizing an MI355X kernel written in HIP

```python
import jax, jax.numpy as jnp
from jax import lax
import numpy as np

D_MODEL = 1024
BATCH = 32
SEQ = 2048
DEPTH = 1

HGRN_HEADS = 4
HGRN_DK = 128
HGRN_DV = 128
HGRN_WIDTH = HGRN_HEADS * HGRN_DK
CHUNK = 64
CONV_WIDTH = 512
CONV_K = 3
N_EXPERTS = 32
TOP_K = 4
D_FF = 1024
SWIGLU_LIMIT = 7.0
SWIGLU_ALPHA = 1.702
MOE_BLOCK = 128
EPS = 1e-6
IN_SIZES = (HGRN_WIDTH, HGRN_WIDTH, HGRN_WIDTH, HGRN_WIDTH, CONV_WIDTH, CONV_WIDTH, CONV_WIDTH, D_MODEL, D_MODEL)
IN_COLS = 4 * HGRN_WIDTH + 3 * CONV_WIDTH + 2 * D_MODEL

kernel_name = "hgrn2_shortconv_gated_moe_adaln"


def rms_norm(x, w):
    xf = x.astype(jnp.float32)
    y = xf * lax.rsqrt(jnp.mean(xf * xf, axis=-1, keepdims=True) + EPS)
    return (y * w.astype(jnp.float32)).astype(x.dtype)


def split_points():
    return [int(v) for v in np.cumsum(IN_SIZES)[:-1]]


def hgrn2_lower_bound(lb_table, layer):
    p = jax.nn.softmax(lb_table.astype(jnp.float32), axis=0)
    return jnp.cumsum(p, axis=0)[layer]


def hgrn2_mixer(q, f_pre, v, g_out, lb, norm_w):
    dt = q.dtype
    bsz, s_len, _ = q.shape
    n_chunks = s_len // CHUNK
    log_f = jnp.logaddexp(jnp.log(lb), jnp.log1p(-lb) + jax.nn.log_sigmoid(f_pre.astype(jnp.float32)))
    k = -jnp.expm1(log_f)

    def to_chunks(t, d):
        return t.astype(jnp.float32).reshape(bsz, n_chunks, CHUNK, HGRN_HEADS, d).transpose(1, 0, 3, 2, 4)

    qc, kc, gc = to_chunks(q, HGRN_DK), to_chunks(k, HGRN_DK), to_chunks(log_f, HGRN_DK)
    vc = to_chunks(v, HGRN_DV)
    causal = jnp.tril(jnp.ones((CHUNK, CHUNK), dtype=bool))[None, None, :, :, None]

    def step(state, inp):
        q_c, k_c, v_c, g_c = inp
        b = jnp.cumsum(g_c, axis=2)
        o_inter = jnp.einsum('bhtk,bhkv->bhtv', q_c * jnp.exp(b), state)
        diff = b[:, :, :, None, :] - b[:, :, None, :, :]
        decay = jnp.exp(jnp.where(causal, diff, -jnp.inf))
        scores = jnp.einsum('bhtsk,bhsk->bhts', q_c[:, :, :, None, :] * decay, k_c)
        o = o_inter + jnp.einsum('bhts,bhsv->bhtv', scores, v_c)
        b_last = b[:, :, -1:, :]
        state = jnp.exp(b_last[:, :, 0, :])[..., None] * state + jnp.einsum('bhsk,bhsv->bhkv', k_c * jnp.exp(b_last - b), v_c)
        return state, o

    state0 = jnp.zeros((bsz, HGRN_HEADS, HGRN_DK, HGRN_DV), jnp.float32)
    _, o = lax.scan(step, state0, (qc, kc, vc, gc))
    o = o.transpose(1, 0, 3, 2, 4).reshape(bsz, s_len, HGRN_HEADS, HGRN_DV)
    o = o * lax.rsqrt(jnp.mean(o * o, axis=-1, keepdims=True) + EPS) * norm_w.astype(jnp.float32)
    g = g_out.astype(jnp.float32).reshape(bsz, s_len, HGRN_HEADS, HGRN_DV)
    o = o * jax.nn.silu(g)
    return o.reshape(bsz, s_len, HGRN_WIDTH).astype(dt)


def short_conv_mixer(b_gate, c_gate, h, conv_w):
    u = c_gate * h
    rhs = conv_w.astype(u.dtype)[:, None, :]
    y = lax.conv_general_dilated(u, rhs, window_strides=(1,), padding=((CONV_K - 1, 0),),
                                 dimension_numbers=('NWC', 'WIO', 'NWC'), feature_group_count=CONV_WIDTH)
    return b_gate * y


def moe_ffn(u, w_router, b_router, w1, b1, w2, b2):
    bsz, s_len, d = u.shape
    n_tok = bsz * s_len
    n_assign = n_tok * TOP_K
    n_blocks = n_assign // MOE_BLOCK + N_EXPERTS
    n_rows = n_blocks * MOE_BLOCK
    xt = u.reshape(n_tok, d)
    logits = (xt @ w_router + b_router).astype(jnp.float32)
    top_vals, top_idx = lax.top_k(logits, TOP_K)
    probs = jax.nn.softmax(top_vals, axis=-1)
    flat_e = top_idx.reshape(n_assign).astype(jnp.int32)
    order = jnp.argsort(flat_e)
    e_sorted = flat_e[order]
    tok_sorted = (order // TOP_K).astype(jnp.int32)
    w_sorted = probs.reshape(n_assign)[order]
    sizes = jnp.bincount(flat_e, length=N_EXPERTS).astype(jnp.int32)
    padded = (sizes + MOE_BLOCK - 1) // MOE_BLOCK * MOE_BLOCK
    start = jnp.cumsum(sizes) - sizes
    pad_end = jnp.cumsum(padded)
    pad_start = pad_end - padded
    dest = pad_start[e_sorted] + jnp.arange(n_assign, dtype=jnp.int32) - start[e_sorted]
    row_tok = jnp.full((n_rows,), n_tok, jnp.int32).at[dest].set(tok_sorted)
    row_w = jnp.zeros((n_rows,), jnp.float32).at[dest].set(w_sorted)
    block_start = jnp.arange(n_blocks, dtype=jnp.int32) * MOE_BLOCK
    block_e = jnp.minimum(jnp.searchsorted(pad_end, block_start, side='right'), N_EXPERTS - 1).astype(jnp.int32)
    x_pad = jnp.concatenate([xt, jnp.zeros((1, d), xt.dtype)], axis=0)

    def expert_block(args):
        toks, e = args
        hs = x_pad[toks]
        hid = hs @ w1[e] + b1[e]
        glu, lin = jnp.split(hid, 2, axis=-1)
        glu = jnp.minimum(glu, SWIGLU_LIMIT)
        lin = jnp.clip(lin, -SWIGLU_LIMIT, SWIGLU_LIMIT)
        act = glu * jax.nn.sigmoid(SWIGLU_ALPHA * glu) * (lin + 1.0)
        return act @ w2[e] + b2[e]

    out = lax.map(expert_block, (row_tok.reshape(n_blocks, MOE_BLOCK), block_e))
    out = out.reshape(n_rows, d) * row_w[:, None].astype(out.dtype)
    y = jnp.zeros((n_tok + 1, d), out.dtype).at[row_tok].add(out)[:n_tok]
    return y.reshape(bsz, s_len, d)


def setup_inputs(seed: int = 0) -> dict:
    key = jax.random.key(seed)
    ks = jax.random.split(key, 20)
    nrm = jax.random.normal
    f32 = jnp.float32
    D = D_MODEL
    return {
        "x": nrm(ks[0], (BATCH, SEQ, D), f32),
        "c": nrm(ks[1], (BATCH, D), f32),
        "w_ada": nrm(ks[2], (DEPTH, D, 6 * D), f32) * D ** -0.5,
        "b_ada": nrm(ks[3], (DEPTH, 6 * D), f32) * 0.02,
        "norm_mix_w": 1.0 + 0.02 * nrm(ks[4], (DEPTH, D), f32),
        "w_in": nrm(ks[5], (DEPTH, D, IN_COLS), f32) * D ** -0.5,
        "hgrn_lower_bounds": nrm(ks[6], (DEPTH + 1, HGRN_WIDTH), f32) * 0.5,
        "hgrn_norm_w": 1.0 + 0.02 * nrm(ks[7], (DEPTH, HGRN_DV), f32),
        "conv_w": nrm(ks[8], (DEPTH, CONV_K, CONV_WIDTH), f32) * CONV_K ** -0.5,
        "w_hgrn_out": nrm(ks[9], (DEPTH, HGRN_WIDTH, D), f32) * HGRN_WIDTH ** -0.5,
        "w_conv_out": nrm(ks[10], (DEPTH, CONV_WIDTH, D), f32) * CONV_WIDTH ** -0.5,
        "w_mix_out": nrm(ks[11], (DEPTH, D, D), f32) * D ** -0.5,
        "norm_ffn_w": 1.0 + 0.02 * nrm(ks[12], (DEPTH, D), f32),
        "w_router": nrm(ks[13], (DEPTH, D, N_EXPERTS), f32) * D ** -0.5,
        "b_router": nrm(ks[14], (DEPTH, N_EXPERTS), f32) * 0.01,
        "w1": nrm(ks[15], (DEPTH, N_EXPERTS, D, 2 * D_FF), f32) * D ** -0.5,
        "b1": nrm(ks[16], (DEPTH, N_EXPERTS, 2 * D_FF), f32) * 0.01,
        "w2": nrm(ks[17], (DEPTH, N_EXPERTS, D_FF, D), f32) * D_FF ** -0.5,
        "b2": nrm(ks[18], (DEPTH, N_EXPERTS, D), f32) * 0.01,
        "norm_final_w": 1.0 + 0.02 * nrm(ks[19], (D,), f32),
    }


def reference(x, c, w_ada, b_ada, norm_mix_w, w_in, hgrn_lower_bounds, hgrn_norm_w, conv_w,
              w_hgrn_out, w_conv_out, w_mix_out, norm_ffn_w, w_router, b_router, w1, b1, w2, b2,
              norm_final_w):
    bsz, s_len, d = x.shape
    silu_c = jax.nn.silu(c)
    cuts = split_points()
    h = x
    for layer in range(DEPTH):
        mod = (silu_c @ w_ada[layer] + b_ada[layer]).reshape(bsz, 6, 1, d)
        shift_m, scale_m, gate_m = mod[:, 0], mod[:, 1], mod[:, 2]
        shift_f, scale_f, gate_f = mod[:, 3], mod[:, 4], mod[:, 5]

        u = rms_norm(h, norm_mix_w[layer]) * (1.0 + scale_m) + shift_m
        proj = u @ w_in[layer]
        q, f_pre, i_v, g_o, cb, cc, ch, ga, gb = jnp.split(proj, cuts, axis=-1)
        lb = hgrn2_lower_bound(hgrn_lower_bounds, layer)
        y_a = hgrn2_mixer(q, f_pre, i_v, g_o, lb, hgrn_norm_w[layer]) @ w_hgrn_out[layer]
        y_b = short_conv_mixer(cb, cc, ch, conv_w[layer]) @ w_conv_out[layer]
        merged = jax.nn.sigmoid(ga) * y_a + jax.nn.sigmoid(gb) * y_b
        h = h + gate_m * (merged @ w_mix_out[layer])

        u = rms_norm(h, norm_ffn_w[layer]) * (1.0 + scale_f) + shift_f
        h = h + gate_f * moe_ffn(u, w_router[layer], b_router[layer], w1[layer], b1[layer], w2[layer], b2[layer])
    return rms_norm(h, norm_final_w)
```

```cpp
#include <hip/hip_runtime.h>
#include <cstdio>
#include <cstdint>

#ifndef MK_PROBE
#define MK_PROBE 0
#endif
#ifndef MK_ONE_LAUNCH
#define MK_ONE_LAUNCH 0
#endif

#define LAS __attribute__((address_space(3)))
#define GAS __attribute__((address_space(1)))
typedef unsigned short bf16_t;
typedef short bf16x8 __attribute__((ext_vector_type(8)));
typedef float f32x4 __attribute__((ext_vector_type(4)));
typedef float f32x2 __attribute__((ext_vector_type(2)));
typedef unsigned u32x4 __attribute__((ext_vector_type(4)));
typedef unsigned u32x2 __attribute__((ext_vector_type(2)));

constexpr int D = 1024, BATCH = 32, SEQ = 2048, NTOK = BATCH * SEQ;
constexpr int HW = 512, NHEAD = 4, DK = 128, CHUNK = 64, NCHUNK = SEQ / CHUNK;
constexpr int INC = 5632, PROJ_LD = 3584, GATE_LD = 2048;
constexpr int NE = 32, TOPK = 4, DFF = 1024, NASSIGN = NTOK * TOPK;
constexpr int MAXTILES = NASSIGN / 256 + NE;
constexpr int MAXROWS = MAXTILES * 256;
constexpr float EPS = 1e-6f, SW_LIMIT = 7.0f, SW_ALPHA = 1.702f;
constexpr int NWAVES = 8, NTHREADS = 512;
constexpr int NPHASE = 11;

constexpr size_t MiB = 1u << 20;
constexpr size_t WS_CTL = 0, CTL_ZERO_BYTES = 65536;
constexpr size_t WS_MOD = 1 * MiB;
constexpr size_t WS_LB = WS_MOD + 32 * 6144 * 4;
constexpr size_t WS_WIN = 2 * MiB;
constexpr size_t WS_WHG = 13 * MiB, WS_WCV = 14 * MiB, WS_WMIX = 15 * MiB;
constexpr size_t WS_W2 = 18 * MiB;
constexpr size_t WS_W1 = 82 * MiB;
constexpr size_t WS_U = 210 * MiB;
constexpr size_t WS_PROJ = 338 * MiB;
constexpr size_t WS_O = 786 * MiB;
constexpr size_t WS_CV = 850 * MiB;
constexpr size_t WS_H = 338 * MiB;
constexpr size_t WS_ACT = 466 * MiB;
constexpr size_t WS_TOPI = 994 * MiB, WS_TOPP = 995 * MiB, WS_POS = 996 * MiB;
constexpr size_t WS_RTOK = 997 * MiB, WS_RSLOT = 997 * MiB + 1081344 + 0, WS_RW = WS_RSLOT + 1081344;
constexpr size_t WS_YO23 = 82 * MiB;
constexpr size_t WS_END = 1001 * MiB;
static_assert(WS_RW + 1081344 <= WS_END && MAXROWS * 4 == 1081344, "tables");
static_assert(WS_ACT + (size_t)MAXROWS * 1024 * 2 <= WS_TOPI, "act");
constexpr int CW_TMO = 0, CW_BAR = 4096, CW_CNT = 8192;

constexpr int LDS_BYTES = 163840;
constexpr int MISC_OFF = LDS_BYTES - 256;
constexpr int TBL_OFF = 131072;
constexpr int STASH_OFF = TBL_OFF + 8192;

#define LDS_WAIT() asm volatile("s_waitcnt lgkmcnt(0)" ::: "memory")
#define VM_WAIT() asm volatile("s_waitcnt vmcnt(0)" ::: "memory")
typedef __bf16 bf16x2_t __attribute__((ext_vector_type(2)));
__device__ __forceinline__ unsigned cvt_pk_bf16(float lo, float hi) { const f32x2 v = {lo, hi}; const bf16x2_t b = __builtin_convertvector(v, bf16x2_t); return __builtin_bit_cast(unsigned, b); }
__device__ __forceinline__ float bf_lo(unsigned u) { return __uint_as_float(u << 16); }
__device__ __forceinline__ float bf_hi(unsigned u) { return __uint_as_float(u & 0xffff0000u); }
__device__ __forceinline__ float bf1(bf16_t u) { return __uint_as_float(((unsigned)u) << 16); }
__device__ __forceinline__ float fast_rcp(float x) { return __builtin_amdgcn_rcpf(x); }
__device__ __forceinline__ float fast_exp(float x) { return __builtin_amdgcn_exp2f(x * 1.44269504089f); }
__device__ __forceinline__ float fast_log(float x) { return __builtin_amdgcn_logf(x) * 0.69314718056f; }
__device__ __forceinline__ float sigmoidf_(float x) { return fast_rcp(1.0f + fast_exp(-x)); }
__device__ __forceinline__ float wave_sum(float v) {
#pragma unroll
    for (int o = 1; o < 64; o <<= 1) v += __shfl_xor(v, o);
    return v;
}

#define XB_TMO      128
#define XB_XCNT(j)  (256  + 64 * (j))
#define XB_XSUB(j)  (1280 + 64 * (j))
#define XB_XGEN(j)  (2304 + 64 * (j))
#define XB_TOP      3328
#define XB_TOPGEN   3392
#define XCD_BAR_WORDS 3456
#define XB_SPIN_CAP (1u << 20)
__device__ __forceinline__ unsigned xb_ld(unsigned* p)              { return __hip_atomic_load(p, __ATOMIC_RELAXED, __HIP_MEMORY_SCOPE_AGENT); }
__device__ __forceinline__ unsigned xb_add(unsigned* p, unsigned v) { return __hip_atomic_fetch_add(p, v, __ATOMIC_RELAXED, __HIP_MEMORY_SCOPE_AGENT); }
__device__ __forceinline__ unsigned xb_xcc_id() { return (unsigned)__builtin_amdgcn_s_getreg((3 << 11) | 20) & 0xFu; }
#define XB_SPIN(cond, bar) do { unsigned _sp = 0; while (cond) { __builtin_amdgcn_s_sleep(1); \
    if ((++_sp & 255u) == 0u) { if (xb_ld(&(bar)[XB_TMO])) break; if (_sp > XB_SPIN_CAP) { atomicAdd(&(bar)[XB_TMO], 1u); break; } } } } while (0)
struct XcdBarrier { unsigned* bar; unsigned x; volatile LAS unsigned* st; };
__device__ __forceinline__ XcdBarrier xcd_barrier_post(unsigned* bar, volatile LAS unsigned* st) {
    XcdBarrier b; b.bar = bar; b.x = xb_xcc_id(); b.st = st;
    if (threadIdx.x == 0) (void)xb_add(&bar[XB_XCNT(b.x)], 1u);
    return b;
}
__device__ __forceinline__ void xcd_barrier_complete(unsigned* bar, unsigned x, unsigned& nloc, unsigned& nx) {
    const unsigned G = gridDim.x * gridDim.y * gridDim.z;
    unsigned sum, cnt, mine, sp = 0u;
    for (;;) {
        sum = 0u; cnt = 0u; mine = 0u;
#pragma unroll
        for (unsigned j = 0; j < 16; ++j) { const unsigned c = xb_ld(&bar[XB_XCNT(j)]); sum += c; cnt += (c > 0u) ? 1u : 0u; mine = (j == x) ? c : mine; }
        if (sum == G) break;
        __builtin_amdgcn_s_sleep(1);
        if ((++sp & 255u) == 0u) { if (xb_ld(&bar[XB_TMO])) break; if (sp > XB_SPIN_CAP) { atomicAdd(&bar[XB_TMO], 1u); break; } }
    }
    nloc = mine > 0u ? mine : 1u; nx = cnt > 0u ? cnt : 1u;
}
__device__ __forceinline__ void xcd_barrier(const XcdBarrier& b) {
    asm volatile("s_waitcnt vmcnt(0)" ::: "memory");
    __syncthreads();
    if (threadIdx.x == 0) {
        unsigned* bar = b.bar;
        __builtin_amdgcn_s_waitcnt(0);
        unsigned nloc = b.st[0], nx = b.st[1];
        if (nloc == 0u) { xcd_barrier_complete(bar, b.x, nloc, nx); b.st[0] = nloc; b.st[1] = nx; }
        const unsigned old = xb_add(&bar[XB_XSUB(b.x)], 1u);
        const unsigned gen = old / nloc;
        if (old + 1u == (gen + 1u) * nloc) {
            __builtin_amdgcn_fence(__ATOMIC_RELEASE, "agent");
            asm volatile("s_waitcnt vmcnt(0)" ::: "memory");
            const unsigned og = xb_add(&bar[XB_TOP], 1u);
            const unsigned tg = og / nx;
            if (og + 1u == (tg + 1u) * nx) xb_add(&bar[XB_TOPGEN], 1u);
            else XB_SPIN(xb_ld(&bar[XB_TOPGEN]) == tg, bar);
            __builtin_amdgcn_fence(__ATOMIC_ACQUIRE, "agent");
            xb_add(&bar[XB_XGEN(b.x)], 1u);
            asm volatile("s_waitcnt vmcnt(0)" ::: "memory");
        } else {
            XB_SPIN(xb_ld(&bar[XB_XGEN(b.x)]) == gen, bar);
            __builtin_amdgcn_fence(__ATOMIC_ACQUIRE, "agent");
            asm volatile("s_waitcnt vmcnt(0)" ::: "memory");
        }
    }
    __syncthreads();
}

namespace gm {
constexpr int BM = 256, BK = 64, HALF = 128, HTB = HALF * BK * 2, STAGE_BYTES = 8 * HTB, NXCD = 8, WGM = 8;
__device__ __forceinline__ int lds_byte(int r, int c) { const int st = (r >> 4) * 2 + (c >> 5), rr = r & 15, cc = c & 31, ob = rr * 64 + cc * 2; return st * 1024 + (ob ^ (((ob >> 9) & 1) << 5)); }
__device__ __forceinline__ void stage_rc(int b, int& R, int& C) { const int st = b / 1024, sb = b % 1024, swz = sb ^ (((sb >> 9) & 1) << 5); R = (st >> 1) * 16 + swz / 64; C = (st & 1) * 32 + (swz % 64) / 2; }
__device__ __forceinline__ int perm32(int rho) { const int n = rho >> 4, i = rho & 15; return 8 * (i >> 2) + 4 * n + (i & 3); }

struct Unit { int pm, pn, e, sub; };

__device__ __forceinline__ bool tile_order(int nM, int nN, long L, int& pm, int& pn) {
    const int nwg = nM * nN; if (L >= nwg) return false;
    int wgid = (int)L; { const int q = nwg / NXCD, r = nwg % NXCD, xcd = wgid % NXCD, off = wgid / NXCD; wgid = (xcd < r ? xcd * (q + 1) : r * (q + 1) + (xcd - r) * q) + off; }
    const int nig = WGM * nN, gid = wgid / nig, fm = gid * WGM, gsz = (nM - fm) < WGM ? (nM - fm) : WGM;
    pm = fm + ((wgid % nig) % gsz); pn = (wgid % nig) / gsz; return true;
}
struct DenseOrder {
    int nM, nN, G, c, nsub;
    __device__ __forceinline__ bool next(int i, Unit& u) const { const int ti = i / nsub; u.sub = i - ti * nsub; u.e = 0; return tile_order(nM, nN, (long)ti * G + c, u.pm, u.pn); }
};
struct MoeOrder {
    int nM, nN, G, c; const LAS int* tile_e;
    __device__ __forceinline__ bool next(int i, Unit& u) const { u.sub = 0; if (!tile_order(nM, nN, (long)i * G + c, u.pm, u.pn)) return false; u.e = tile_e[u.pm]; return true; }
};
struct DenseA { int K; unsigned sub_stride;
    __device__ __forceinline__ void offsets(const Unit& u, int tid, unsigned (&o)[2][2]) const {
#pragma unroll
        for (int i = 0; i < 2; ++i) { int R, C; stage_rc(tid * 16 + i * 8192, R, C);
#pragma unroll
            for (int h = 0; h < 2; ++h) o[h][i] = (unsigned)(((u.pm * BM + h * HALF + R) * K + C) * 2) + (unsigned)u.sub * sub_stride; } } };
struct GatherA { int K; const int* row_tok;
    __device__ __forceinline__ void offsets(const Unit& u, int tid, unsigned (&o)[2][2]) const {
#pragma unroll
        for (int i = 0; i < 2; ++i) { int R, C; stage_rc(tid * 16 + i * 8192, R, C);
#pragma unroll
            for (int h = 0; h < 2; ++h) { const int tok = row_tok[u.pm * BM + h * HALF + R]; o[h][i] = (unsigned)((tok * K + C) * 2); } } } };

template <class Epi, class Sched, class AMap>
__device__ __forceinline__ void gemm_phase(int wave_sg, LAS unsigned char* lds, const char* Abase, const char* Bbase, int K, int Nb, unsigned b_sub_stride, const Sched& S, const Epi& E, const AMap& AM) {
    int lane = (int)__builtin_amdgcn_mbcnt_hi(~0u, __builtin_amdgcn_mbcnt_lo(~0u, 0u)); asm volatile("" : "+v"(lane));
    const int wid = wave_sg, tid = wid * 64 + lane, wr = wid >> 2, wc = wid & 3, fr = lane & 15, fq = lane >> 4;
    const int nt = K / BK;
    unsigned voffB[2];
#pragma unroll
    for (int i = 0; i < 2; ++i) { int R, C; stage_rc(tid * 16 + i * 8192, R, C); const int Rb = (R & ~31) + perm32(R & 31); voffB[i] = (unsigned)(Rb * K + C) * 2u; }
    const size_t kstep = (size_t)(BK * 2);
    const size_t hstep = (size_t)HALF * K * 2;
    const unsigned ldsw = (unsigned)wid * 1024u;
    const int aoff = lds_byte(wr * 64 + fr, fq * 8), boff = lds_byte(wc * 32 + fr, fq * 8);
#define G_SA(b, h) (((b) * 2 + (h)) * HTB)
#define G_SB(b, h) ((4 + (b) * 2 + (h)) * HTB)
#define G_STAGE(bufoff, gbase, voff) do { _Pragma("unroll") for (int _i = 0; _i < 2; ++_i) \
        __builtin_amdgcn_global_load_lds((const unsigned*)((const char*)(gbase) + (voff)[_i]), (LAS unsigned*)(lds + (bufoff) + ldsw + _i * 8192), 16, 0, 0); } while (0)
#define G_LDA(dst, b, h) do { _Pragma("unroll") for (int m = 0; m < 4; ++m) _Pragma("unroll") for (int k = 0; k < 2; ++k) dst[m][k] = *(const LAS bf16x8*)(lds + G_SA(b, h) + aoff + m * 2048 + k * 1024); } while (0)
#define G_LDB(dst, b, h) do { _Pragma("unroll") for (int n = 0; n < 2; ++n) _Pragma("unroll") for (int k = 0; k < 2; ++k) dst[n][k] = *(const LAS bf16x8*)(lds + G_SB(b, h) + boff + n * 2048 + k * 1024); } while (0)
#define G_MMA(ai, bj, At, Bt) do { __builtin_amdgcn_s_setprio(1); _Pragma("unroll") for (int m = 0; m < 4; ++m) _Pragma("unroll") for (int n = 0; n < 2; ++n) _Pragma("unroll") for (int k = 0; k < 2; ++k) \
        acc[ai][bj][m][n] = __builtin_amdgcn_mfma_f32_16x16x32_bf16(Bt[n][k], At[m][k], acc[ai][bj][m][n], 0, 0, 0); __builtin_amdgcn_s_setprio(0); } while (0)
#define G_WAIT_V(n) asm volatile("s_waitcnt vmcnt(" #n ")" ::: "memory")
#define G_WAIT_L(n) asm volatile("s_waitcnt lgkmcnt(" #n ")" ::: "memory")
#define G_BAR __builtin_amdgcn_s_barrier()
#define G_SCHED __builtin_amdgcn_sched_barrier(0)
    Unit cur, nxt; int ui = 0;
    if (!S.next(0, cur)) return;
    f32x4 acc[2][2][4][2];
#pragma unroll
    for (int a = 0; a < 2; ++a)
#pragma unroll
        for (int b = 0; b < 2; ++b)
#pragma unroll
            for (int m = 0; m < 4; ++m)
#pragma unroll
                for (int n = 0; n < 2; ++n) acc[a][b][m][n] = (f32x4){0.f, 0.f, 0.f, 0.f};
    bf16x8 At[4][2], B0[2][2], B1[2][2];
    unsigned rA[2][2];
    AM.offsets(cur, tid, rA);
    LAS u32x4* stash = (LAS u32x4*)(lds + STASH_OFF) + tid;
    const char* cB = Bbase + ((size_t)cur.e * Nb + (size_t)cur.pn * BM) * K * 2 + (size_t)cur.sub * b_sub_stride;
    G_STAGE(G_SB(0, 0), cB, voffB); G_STAGE(G_SB(0, 1), cB + hstep, voffB); G_STAGE(G_SA(0, 0), Abase, rA[0]); G_STAGE(G_SA(0, 1), Abase, rA[1]);
    if (wr == 1) G_BAR;
    G_WAIT_V(2); G_BAR;
    G_STAGE(G_SB(1, 0), cB + kstep, voffB); G_STAGE(G_SA(1, 0), Abase + kstep, rA[0]); G_STAGE(G_SB(1, 1), cB + hstep + kstep, voffB);
    G_WAIT_V(6); G_BAR;
    const int t_pre = nt >= 4 ? nt - 4 : 0;
    for (;;) {
        const bool has_next = S.next(ui + 1, nxt);
        const char* nB = has_next ? Bbase + ((size_t)nxt.e * Nb + (size_t)nxt.pn * BM) * K * 2 + (size_t)nxt.sub * b_sub_stride : cB;
        for (int t = 0; t < nt; t += 2) {
            const bool last = (t == nt - 2);
            if (t == t_pre && has_next) { unsigned rn[2][2]; AM.offsets(nxt, tid, rn); *stash = (u32x4){rn[0][0], rn[0][1], rn[1][0], rn[1][1]}; }
            const char* b2 = last ? nB : cB + (size_t)(t + 2) * kstep; const char* b3 = b2 + kstep;
            G_LDB(B0, 0, 0); G_LDB(B1, 0, 1); G_SCHED; G_LDA(At, 0, 0); G_STAGE(G_SA(1, 1), Abase + (size_t)(t + 1) * kstep, rA[1]);
            G_WAIT_V(8); G_WAIT_L(0); G_BAR; G_MMA(0, 0, At, B0); G_MMA(0, 1, At, B1); G_BAR; G_SCHED;
            if (last && has_next) { const u32x4 rn = *stash; rA[0][0] = rn.x; rA[0][1] = rn.y; rA[1][0] = rn.z; rA[1][1] = rn.w; }
            const char* a2 = Abase + (last ? (size_t)0 : (size_t)(t + 2) * kstep);
            G_LDA(At, 0, 1); G_STAGE(G_SB(0, 0), b2, voffB); G_STAGE(G_SB(0, 1), b2 + hstep, voffB); G_STAGE(G_SA(0, 0), a2, rA[0]);
            G_WAIT_V(8); G_WAIT_L(0); G_BAR; G_MMA(1, 0, At, B0); G_MMA(1, 1, At, B1); G_BAR; G_SCHED;
            G_LDB(B0, 1, 0); G_LDB(B1, 1, 1); G_SCHED; G_LDA(At, 1, 0); G_STAGE(G_SA(0, 1), a2, rA[1]);
            G_WAIT_V(8); G_WAIT_L(0); G_BAR; G_MMA(0, 0, At, B0); G_MMA(0, 1, At, B1); G_BAR; G_SCHED;
            G_LDA(At, 1, 1); G_STAGE(G_SB(1, 0), b3, voffB); G_STAGE(G_SB(1, 1), b3 + hstep, voffB); G_STAGE(G_SA(1, 0), a2 + kstep, rA[0]);
            G_WAIT_V(8); G_WAIT_L(0); G_BAR; G_MMA(1, 0, At, B0); G_MMA(1, 1, At, B1); G_BAR; G_SCHED;
        }
        if (wr == 0) G_BAR;
        E(acc, cur, wr, wc, fr, fq);
        if (!has_next) break;
        if (!E.keep(cur)) {
#pragma unroll
            for (int a = 0; a < 2; ++a)
#pragma unroll
                for (int b = 0; b < 2; ++b)
#pragma unroll
                    for (int m = 0; m < 4; ++m)
#pragma unroll
                        for (int n = 0; n < 2; ++n) acc[a][b][m][n] = (f32x4){0.f, 0.f, 0.f, 0.f};
        }
        cur = nxt; cB = nB; ++ui;
        if (wr == 1) G_BAR;
    }
    G_WAIT_V(0);
    G_BAR;
#undef G_SA
#undef G_SB
#undef G_STAGE
#undef G_LDA
#undef G_LDB
#undef G_MMA
#undef G_WAIT_V
#undef G_WAIT_L
#undef G_BAR
#undef G_SCHED
}

__device__ __forceinline__ u32x4 pack8(const f32x4& v0, const f32x4& v1) { u32x4 w; w.x = cvt_pk_bf16(v0[0], v0[1]); w.y = cvt_pk_bf16(v0[2], v0[3]); w.z = cvt_pk_bf16(v1[0], v1[1]); w.w = cvt_pk_bf16(v1[2], v1[3]); return w; }
__device__ __forceinline__ void unpack8(const u32x4& w, f32x4& v0, f32x4& v1) { v0 = (f32x4){bf_lo(w.x), bf_hi(w.x), bf_lo(w.y), bf_hi(w.y)}; v1 = (f32x4){bf_lo(w.z), bf_hi(w.z), bf_lo(w.w), bf_hi(w.w)}; }

struct EpiProj {
    bf16_t* proj; bf16_t* gates; const float* lb;
    __device__ __forceinline__ bool keep(const Unit&) const { return false; }
    __device__ __forceinline__ void operator()(f32x4 (&acc)[2][2][4][2], const Unit& u, int wr, int wc, int fr, int fq) const {
        const int row0 = u.pm * BM + wr * 64 + fr, pn = u.pn;
        bf16_t* base; int ldc, colt, kind;
        if (pn < 14) { base = proj; ldc = PROJ_LD; colt = pn * BM; kind = (pn == 2 || pn == 3) ? 1 : 0; } else { base = gates; ldc = GATE_LD; colt = (pn - 14) * BM; kind = 2; }
        const int col0 = colt + wc * 32 + 8 * fq;
        f32x4 lbv[2][2];
        if (kind == 1) {
#pragma unroll
            for (int bj = 0; bj < 2; ++bj) { const float* lp = lb + (pn - 2) * BM + bj * HALF + wc * 32 + 8 * fq; lbv[bj][0] = *(const f32x4*)lp; lbv[bj][1] = *(const f32x4*)(lp + 4); }
        }
#pragma unroll
        for (int ai = 0; ai < 2; ++ai)
#pragma unroll
            for (int m = 0; m < 4; ++m) { bf16_t* rowp = base + (size_t)(row0 + ai * HALF + m * 16) * ldc + col0;
#pragma unroll
                for (int bj = 0; bj < 2; ++bj) { f32x4 v0 = acc[ai][bj][m][0], v1 = acc[ai][bj][m][1];
                    if (kind == 1) {
#pragma unroll
                        for (int j = 0; j < 4; ++j) { const float l0 = lbv[bj][0][j], l1 = lbv[bj][1][j];
                            v0[j] = fast_log(l0 + (1.0f - l0) * sigmoidf_(v0[j])); v1[j] = fast_log(l1 + (1.0f - l1) * sigmoidf_(v1[j])); }
                    } else if (kind == 2) {
#pragma unroll
                        for (int j = 0; j < 4; ++j) { v0[j] = sigmoidf_(v0[j]); v1[j] = sigmoidf_(v1[j]); }
                    }
                    *(u32x4*)(rowp + bj * HALF) = pack8(v0, v1); } }
    }
};
struct EpiMerge {
    const bf16_t* gates; bf16_t* out;
    __device__ __forceinline__ bool keep(const Unit& u) const { return u.sub == 0; }
    __device__ __forceinline__ void operator()(f32x4 (&acc)[2][2][4][2], const Unit& u, int wr, int wc, int fr, int fq) const {
        const int row0 = u.pm * BM + wr * 64 + fr, col0 = u.pn * BM + wc * 32 + 8 * fq;
#pragma unroll
        for (int ai = 0; ai < 2; ++ai)
#pragma unroll
            for (int m = 0; m < 4; ++m) { const size_t r = (size_t)(row0 + ai * HALF + m * 16); const bf16_t* gp = gates + r * GATE_LD + col0;
#pragma unroll
                for (int bj = 0; bj < 2; ++bj) {
                    f32x4 b0, b1; unpack8(*(const u32x4*)(gp + 1024 + bj * HALF), b0, b1);
                    if (u.sub == 0) { f32x4 a0, a1; unpack8(*(const u32x4*)(gp + bj * HALF), a0, a1);
#pragma unroll
                        for (int j = 0; j < 4; ++j) { acc[ai][bj][m][0][j] *= a0[j] * fast_rcp(fmaxf(b0[j], 1e-30f)); acc[ai][bj][m][1][j] *= a1[j] * fast_rcp(fmaxf(b1[j], 1e-30f)); }
                    } else {
                        *(u32x4*)(out + r * D + col0 + bj * HALF) = pack8(acc[ai][bj][m][0] * b0, acc[ai][bj][m][1] * b1);
                    } } }
    }
};
struct EpiMix {
    const float* x; const float* mod; bf16_t* h;
    __device__ __forceinline__ bool keep(const Unit&) const { return false; }
    __device__ __forceinline__ void operator()(f32x4 (&acc)[2][2][4][2], const Unit& u, int wr, int wc, int fr, int fq) const {
        const int row0 = u.pm * BM + wr * 64 + fr, col0 = u.pn * BM + wc * 32 + 8 * fq, b = u.pm >> 3;
        f32x4 g[2][2];
#pragma unroll
        for (int bj = 0; bj < 2; ++bj) { const float* gp = mod + (size_t)b * 6144 + 2048 + col0 + bj * HALF; g[bj][0] = *(const f32x4*)gp; g[bj][1] = *(const f32x4*)(gp + 4); }
#pragma unroll
        for (int ai = 0; ai < 2; ++ai)
#pragma unroll
            for (int m = 0; m < 4; ++m) { const size_t r = (size_t)(row0 + ai * HALF + m * 16);
#pragma unroll
                for (int bj = 0; bj < 2; ++bj) { const float* xp = x + r * D + col0 + bj * HALF; const f32x4 x0 = *(const f32x4*)xp, x1 = *(const f32x4*)(xp + 4);
                    *(u32x4*)(h + r * D + col0 + bj * HALF) = pack8(x0 + g[bj][0] * acc[ai][bj][m][0], x1 + g[bj][1] * acc[ai][bj][m][1]); }
                asm volatile("" ::: "memory"); }
    }
};
struct EpiSwiglu {
    const float* b1; bf16_t* act;
    __device__ __forceinline__ bool keep(const Unit&) const { return false; }
    __device__ __forceinline__ void operator()(f32x4 (&acc)[2][2][4][2], const Unit& u, int wr, int wc, int fr, int fq) const {
        const int row0 = u.pm * BM + wr * 64 + fr, hc0 = u.pn * HALF + wc * 32 + 8 * fq;
        const float* bp = b1 + (size_t)u.e * 2048 + hc0;
        const f32x4 bg0 = *(const f32x4*)bp, bg1 = *(const f32x4*)(bp + 4), bl0 = *(const f32x4*)(bp + 1024), bl1 = *(const f32x4*)(bp + 1028);
#pragma unroll
        for (int ai = 0; ai < 2; ++ai)
#pragma unroll
            for (int m = 0; m < 4; ++m) { const size_t r = (size_t)(row0 + ai * HALF + m * 16);
                f32x4 o0, o1;
#pragma unroll
                for (int j = 0; j < 4; ++j) {
                    float gl = fminf(acc[ai][0][m][0][j] + bg0[j], SW_LIMIT), li = fminf(fmaxf(acc[ai][1][m][0][j] + bl0[j], -SW_LIMIT), SW_LIMIT);
                    o0[j] = gl * sigmoidf_(SW_ALPHA * gl) * (li + 1.0f);
                    gl = fminf(acc[ai][0][m][1][j] + bg1[j], SW_LIMIT); li = fminf(fmaxf(acc[ai][1][m][1][j] + bl1[j], -SW_LIMIT), SW_LIMIT);
                    o1[j] = gl * sigmoidf_(SW_ALPHA * gl) * (li + 1.0f); }
                *(u32x4*)(act + r * DFF + hc0) = pack8(o0, o1); }
    }
};
struct EpiMoeOut {
    const float* b2; const int* rslot; const float* rw; bf16_t* yo01; bf16_t* yo23;
    __device__ __forceinline__ bool keep(const Unit&) const { return false; }
    __device__ __forceinline__ void operator()(f32x4 (&acc)[2][2][4][2], const Unit& u, int wr, int wc, int fr, int fq) const {
        const int row0 = u.pm * BM + wr * 64 + fr, col0 = u.pn * BM + wc * 32 + 8 * fq;
        f32x4 bv[2][2];
#pragma unroll
        for (int bj = 0; bj < 2; ++bj) { const float* bp = b2 + (size_t)u.e * D + col0 + bj * HALF; bv[bj][0] = *(const f32x4*)bp; bv[bj][1] = *(const f32x4*)(bp + 4); }
#pragma unroll
        for (int ai = 0; ai < 2; ++ai)
#pragma unroll
            for (int m = 0; m < 4; ++m) { const int r = row0 + ai * HALF + m * 16; const int slot = rslot[r]; const float w = rw[r];
                if (slot >= 0) { const int tok = slot >> 2, j = slot & 3;
                    bf16_t* dst = (j < 2 ? yo01 + (size_t)tok * 2048 + (size_t)j * 1024 : yo23 + (size_t)tok * 2048 + (size_t)(j - 2) * 1024) + col0;
#pragma unroll
                    for (int bj = 0; bj < 2; ++bj) *(u32x4*)(dst + bj * HALF) = pack8((acc[ai][bj][m][0] + bv[bj][0]) * w, (acc[ai][bj][m][1] + bv[bj][1]) * w); } }
    }
};
}

struct Args { const float* in[20]; float* out; unsigned char* ws; int ph_lo, ph_hi; };

__device__ __forceinline__ void transpose_item(const float* W, int N, bf16_t* WT, int ldwt, int k0, int n0, int dst_row0, LAS float* scr, int lane) {
    const int ks = lane >> 4, n4 = (lane & 15) * 4;
    f32x4 v[16];
#pragma unroll
    for (int i = 0; i < 16; ++i) v[i] = *(const f32x4*)(W + (size_t)(k0 + 4 * i + ks) * N + n0 + n4);
#pragma unroll
    for (int i = 0; i < 16; ++i) { LAS float* s = scr + (4 * i + ks) * 65 + n4; s[0] = v[i][0]; s[1] = v[i][1]; s[2] = v[i][2]; s[3] = v[i][3]; }
    LDS_WAIT(); asm volatile("" ::: "memory");
    const int kc = lane & 7;
#pragma unroll
    for (int p = 0; p < 8; ++p) { const int n = (lane >> 3) + 8 * p; const LAS float* s = scr + (8 * kc) * 65 + n;
        u32x4 o; o.x = cvt_pk_bf16(s[0], s[65]); o.y = cvt_pk_bf16(s[2 * 65], s[3 * 65]); o.z = cvt_pk_bf16(s[4 * 65], s[5 * 65]); o.w = cvt_pk_bf16(s[6 * 65], s[7 * 65]);
        *(u32x4*)(WT + (size_t)(dst_row0 + n) * ldwt + k0 + 8 * kc) = o; }
    LDS_WAIT(); asm volatile("" ::: "memory");
}

__global__ void __launch_bounds__(NTHREADS, 2) fwd_kernel(Args args) {
    extern __shared__ __attribute__((aligned(16))) unsigned char lds_raw[];
    LAS unsigned char* lds = (LAS unsigned char*)lds_raw;
    volatile LAS unsigned* MISC = (volatile LAS unsigned*)(lds + MISC_OFF);
    const int G = gridDim.x, bid = blockIdx.x;
    const int wave_sg = __builtin_amdgcn_readfirstlane((int)threadIdx.x >> 6);
#define PHASE_IDS() int lane = (int)__builtin_amdgcn_mbcnt_hi(~0u, __builtin_amdgcn_mbcnt_lo(~0u, 0u)); asm volatile("" : "+v"(lane)); const int wave = wave_sg; const int tid = wave * 64 + lane; const int gw = bid * NWAVES + wave, NGW = G * NWAVES; (void)lane; (void)wave; (void)gw; (void)NGW
#define CAS __attribute__((address_space(4)))
#define PHASE_ARGS() const CAS Args* ap = (const CAS Args*)__builtin_amdgcn_kernarg_segment_ptr(); asm volatile("" : "+s"(ap)); unsigned char* const ws = ap->ws; unsigned* const ctl = (unsigned*)(ws + WS_CTL); (void)ctl
#define ARG(i) (ap->in[i])
#define WSP(T, off) ((T*)(ws + (off)))
    enum { I_X = 0, I_C, I_WADA, I_BADA, I_NMIX, I_WIN, I_LBT, I_HGNW, I_CONVW, I_WHG, I_WCV, I_WMIX, I_NFFN, I_WR, I_BR, I_W1, I_B1, I_W2, I_B2, I_NFIN };
    { PHASE_IDS(); for (int u = tid; u < 64; u += NTHREADS) MISC[u] = 0u; }
    __syncthreads();
    XcdBarrier bar; bar.bar = nullptr; bar.x = 0; bar.st = nullptr;
#if MK_ONE_LAUNCH
    { PHASE_ARGS(); bar = xcd_barrier_post(ctl + CW_BAR, MISC + 8); }
#define GRID_BAR() xcd_barrier(bar)
#else
#define GRID_BAR() do { } while (0)
#endif
    const int lo = args.ph_lo, hi = args.ph_hi;
#ifndef PH_MASK
#define PH_MASK 0x7ff
#endif
#define IN(k) (((PH_MASK >> (k)) & 1) && lo <= (k) && (k) < hi)
#define BOTH(k) (IN(k) && IN((k) + 1))

    if (IN(0)) { PHASE_IDS(); PHASE_ARGS();
        const float* cvec = ARG(I_C); const float* w_ada = ARG(I_WADA); const float* b_ada = ARG(I_BADA); const float* lbtab = ARG(I_LBT);
        const float* w_in = ARG(I_WIN); const float* w_hg = ARG(I_WHG); const float* w_cv = ARG(I_WCV); const float* w_mix = ARG(I_WMIX); const float* w1 = ARG(I_W1); const float* w2 = ARG(I_W2);
        float* MOD = WSP(float, WS_MOD); float* LB = WSP(float, WS_LB);
        bf16_t* Win_t = WSP(bf16_t, WS_WIN); bf16_t* Whg_t = WSP(bf16_t, WS_WHG); bf16_t* Wcv_t = WSP(bf16_t, WS_WCV); bf16_t* Wmix_t = WSP(bf16_t, WS_WMIX); bf16_t* W1_t = WSP(bf16_t, WS_W1); bf16_t* W2_t = WSP(bf16_t, WS_W2);
        LAS float* scr = (LAS float*)(lds + wave * 16640);
        for (int it = gw; it < 384; it += NGW) {
            const int n0 = it * 16, cl = lane & 15, kq = lane >> 4;
            float acc[32];
#pragma unroll
            for (int b = 0; b < 32; ++b) acc[b] = 0.f;
            for (int ch = 0; ch < 16; ++ch) {
                { const int b = lane >> 1, part = lane & 1;
#pragma unroll
                    for (int q = 0; q < 4; ++q) {
                        const float* cp = cvec + (size_t)b * D + q * 256 + ch * 16 + part * 8;
                        const f32x4 c0 = *(const f32x4*)cp, c1 = *(const f32x4*)(cp + 4);
#pragma unroll
                        for (int j = 0; j < 4; ++j) { scr[(q * 16 + part * 8 + j) * 32 + b] = c0[j] * sigmoidf_(c0[j]); scr[(q * 16 + part * 8 + 4 + j) * 32 + b] = c1[j] * sigmoidf_(c1[j]); }
                    } }
                float wv[16];
#pragma unroll
                for (int kk = 0; kk < 16; ++kk) wv[kk] = w_ada[(size_t)(kq * 256 + ch * 16 + kk) * 6144 + n0 + cl];
                LDS_WAIT(); asm volatile("" ::: "memory");
#pragma unroll
                for (int kk = 0; kk < 16; ++kk) {
                    const LAS f32x4* sp = (const LAS f32x4*)(scr + (kq * 16 + kk) * 32);
#pragma unroll
                    for (int b4 = 0; b4 < 8; ++b4) { const f32x4 s = sp[b4]; acc[4 * b4] += wv[kk] * s[0]; acc[4 * b4 + 1] += wv[kk] * s[1]; acc[4 * b4 + 2] += wv[kk] * s[2]; acc[4 * b4 + 3] += wv[kk] * s[3]; }
                }
                LDS_WAIT(); asm volatile("" ::: "memory");
            }
            const float bias = b_ada[n0 + cl];
#pragma unroll
            for (int b = 0; b < 32; ++b) { float v = acc[b]; v += __shfl_xor(v, 16); v += __shfl_xor(v, 32); if (kq == 0) MOD[(size_t)b * 6144 + n0 + cl] = v + bias; }
        }
        if (bid == (G > 1 ? 1 : 0)) { const int k = tid; const float l0 = lbtab[k], l1 = lbtab[HW + k]; LB[k] = fast_rcp(1.0f + fast_exp(l1 - l0)); }
        {
            constexpr int I_IN = 16 * 88, I_HG = 8 * 16, I_CV = 8 * 16, I_MIX = 16 * 16, I_W1 = 32 * 16 * 32, I_W2 = 32 * 16 * 16;
            constexpr int NITEMS = I_IN + I_HG + I_CV + I_MIX + I_W1 + I_W2;
            for (int it = gw; it < NITEMS; it += NGW) {
                int r = it;
                if (r < I_IN) { const int kb = r / 88, nb = r % 88; transpose_item(w_in, INC, Win_t, D, kb * 64, nb * 64, nb * 64, scr, lane); continue; } r -= I_IN;
                if (r < I_HG) { const int kb = r / 16, nb = r % 16; transpose_item(w_hg, D, Whg_t, HW, kb * 64, nb * 64, nb * 64, scr, lane); continue; } r -= I_HG;
                if (r < I_CV) { const int kb = r / 16, nb = r % 16; transpose_item(w_cv, D, Wcv_t, HW, kb * 64, nb * 64, nb * 64, scr, lane); continue; } r -= I_CV;
                if (r < I_MIX) { const int kb = r / 16, nb = r % 16; transpose_item(w_mix, D, Wmix_t, D, kb * 64, nb * 64, nb * 64, scr, lane); continue; } r -= I_MIX;
                if (r < I_W1) { const int e = r / 512, q = r % 512, kb = q / 32, nb = q % 32;
                    const int pn = nb >> 2, wi = (nb & 3) * 64; const int src = wi < 128 ? pn * 128 + wi : 1024 + pn * 128 + (wi - 128);
                    transpose_item(w1 + (size_t)e * D * 2048, 2048, W1_t + (size_t)e * 2048 * D, D, kb * 64, src, nb * 64, scr, lane); continue; } r -= I_W1;
                { const int e = r / 256, q = r % 256, kb = q / 16, nb = q % 16;
                    transpose_item(w2 + (size_t)e * DFF * D, D, W2_t + (size_t)e * D * DFF, DFF, kb * 64, nb * 64, nb * 64, scr, lane); }
            }
        }
        if (BOTH(0)) GRID_BAR();
    }

    if (IN(1)) { PHASE_IDS(); PHASE_ARGS();
        const float* x = ARG(I_X); const float* norm_mix_w = ARG(I_NMIX); const float* MOD = WSP(float, WS_MOD); bf16_t* U = WSP(bf16_t, WS_U);
        for (int m0 = gw * 32; m0 < NTOK; m0 += NGW * 32) {
            const int b = m0 >> 11;
            f32x4 A[4], Sh[4];
#pragma unroll
            for (int j = 0; j < 4; ++j) { const int k = 4 * lane + 256 * j; const f32x4 w = *(const f32x4*)(norm_mix_w + k), sc = *(const f32x4*)(MOD + (size_t)b * 6144 + 1024 + k);
                A[j] = w * (sc + 1.0f); Sh[j] = *(const f32x4*)(MOD + (size_t)b * 6144 + k); }
            for (int r = 0; r < 32; ++r) {
                const float* xr = x + (size_t)(m0 + r) * D; f32x4 v[4]; float s = 0.f;
#pragma unroll
                for (int j = 0; j < 4; ++j) { v[j] = *(const f32x4*)(xr + 4 * lane + 256 * j); s += (v[j][0] * v[j][0] + v[j][1] * v[j][1]) + (v[j][2] * v[j][2] + v[j][3] * v[j][3]); }
                const float rs = __builtin_amdgcn_rsqf(wave_sum(s) * (1.0f / D) + EPS);
                bf16_t* ur = U + (size_t)(m0 + r) * D;
#pragma unroll
                for (int j = 0; j < 4; ++j) { const f32x4 o = v[j] * rs * A[j] + Sh[j]; u32x2 w; w.x = cvt_pk_bf16(o[0], o[1]); w.y = cvt_pk_bf16(o[2], o[3]); *(u32x2*)(ur + 4 * lane + 256 * j) = w; }
            }
        }
        if (BOTH(1)) GRID_BAR();
    }

    if (IN(2)) { PHASE_ARGS();
        gm::DenseOrder S{NTOK / 256, INC / 256, G, bid, 1}; gm::DenseA AM{D, 0u}; gm::EpiProj E{WSP(bf16_t, WS_PROJ), (bf16_t*)ap->out, WSP(float, WS_LB)};
        gm::gemm_phase(wave_sg, lds, (const char*)WSP(bf16_t, WS_U), (const char*)WSP(bf16_t, WS_WIN), D, 0, 0u, S, E, AM);
        if (BOTH(2)) GRID_BAR();
    }

    if (IN(3)) { PHASE_IDS(); PHASE_ARGS();
        const float* hg_norm_w = ARG(I_HGNW); const float* conv_w = ARG(I_CONVW); const bf16_t* PROJ = WSP(bf16_t, WS_PROJ); bf16_t* OB = WSP(bf16_t, WS_O); bf16_t* CVB = WSP(bf16_t, WS_CV);
        const int nchainblk = (G >= 256) ? 128 : (G >= 2 ? G / 2 : 1);
        if (bid < nchainblk) {
            constexpr int LDQ = 136, LDT = 72;
            LAS bf16_t* QT = (LAS bf16_t*)(lds);
            LAS bf16_t* KT = QT + 64 * LDQ;
            LAS bf16_t* QB = KT + 64 * LDQ;
            LAS bf16_t* KBT = QB + 64 * LDQ;
            LAS bf16_t* VT = KBT + 128 * LDT;
            LAS bf16_t* PM = VT + 128 * LDT;
            LAS bf16_t* ST = PM + 64 * LDT;
            LAS bf16_t* OS = ST + 128 * LDQ;
            LAS float* SEG = (LAS float*)(OS + 64 * LDQ);
            LAS float* DEC = SEG + 8 * 128;
            const int fr = lane & 15, fq = lane >> 4, w = wave;
            for (int chain = bid; chain < BATCH * NHEAD; chain += nchainblk) {
                const int b = chain >> 2, h = chain & 3;
                __syncthreads();
                for (int i = tid; i < 128 * LDQ / 2; i += NTHREADS) ((LAS unsigned*)ST)[i] = 0u;
                f32x4 Sacc[8];
#pragma unroll
                for (int i = 0; i < 8; ++i) Sacc[i] = (f32x4){0.f, 0.f, 0.f, 0.f};
                const int ot = tid >> 3, ocg = tid & 7;
                f32x4 nwv[4];
#pragma unroll
                for (int q = 0; q < 2; ++q) { nwv[2 * q] = *(const f32x4*)(hg_norm_w + q * 64 + 8 * ocg); nwv[2 * q + 1] = *(const f32x4*)(hg_norm_w + q * 64 + 8 * ocg + 4); }
                const bf16_t* pbase = PROJ + (size_t)(b * SEQ) * PROJ_LD + h * DK;
                unsigned rq[8], rl[8], rv[8];
#pragma unroll
                for (int r = 0; r < 8; ++r) { const bf16_t* p = pbase + (size_t)(8 * w + r) * PROJ_LD + 2 * lane; rq[r] = *(const unsigned*)p; rl[r] = *(const unsigned*)(p + 512); rv[r] = *(const unsigned*)(p + 1024); }
                for (int c = 0; c < NCHUNK; ++c) {
                    const int m0 = c * CHUNK;
                    float cs0[8], cs1[8]; { float a0 = 0.f, a1 = 0.f;
#pragma unroll
                        for (int r = 0; r < 8; ++r) { a0 += bf_lo(rl[r]); a1 += bf_hi(rl[r]); cs0[r] = a0; cs1[r] = a1; }
                        *(LAS f32x2*)(SEG + w * 128 + 2 * lane) = (f32x2){a0, a1}; }
                    LDS_WAIT(); __syncthreads();
                    float pre0 = 0.f, pre1 = 0.f, bm0 = 0.f, bm1 = 0.f, bl0 = 0.f, bl1 = 0.f;
#pragma unroll
                    for (int s = 0; s < 8; ++s) { const f32x2 t2 = *(const LAS f32x2*)(SEG + s * 128 + 2 * lane); if (s < w) { pre0 += t2[0]; pre1 += t2[1]; } if (s < 4) { bm0 += t2[0]; bm1 += t2[1]; } bl0 += t2[0]; bl1 += t2[1]; }
                    const float em0 = fast_exp(fmaxf(bm0, -80.f)), em1 = fast_exp(fmaxf(bm1, -80.f));
                    const float el0 = fast_exp(fmaxf(bl0 - bm0, -80.f)), el1 = fast_exp(fmaxf(bl1 - bm1, -80.f));
                    if (w == 0) *(LAS f32x2*)(DEC + 2 * lane) = (f32x2){fast_exp(fmaxf(bl0, -80.f)), fast_exp(fmaxf(bl1, -80.f))};
                    unsigned kb0[4], kb1[4], vt0[4], vt1[4];
#pragma unroll
                    for (int r = 0; r < 8; ++r) {
                        const int t = 8 * w + r;
                        const float lf0 = bf_lo(rl[r]), lf1 = bf_hi(rl[r]);
                        const float d0 = fminf(fmaxf(pre0 + cs0[r] - bm0, -80.f), 80.f), d1 = fminf(fmaxf(pre1 + cs1[r] - bm1, -80.f), 80.f);
                        const float e0 = fast_exp(d0), e1 = fast_exp(d1), i0 = fast_exp(-d0), i1 = fast_exp(-d1);
                        const float kk0 = 1.0f - fast_exp(lf0), kk1 = 1.0f - fast_exp(lf1);
                        const float qt0 = bf_lo(rq[r]) * e0, qt1 = bf_hi(rq[r]) * e1, kt0 = kk0 * i0, kt1 = kk1 * i1;
                        *(LAS unsigned*)(QT + t * LDQ + 2 * lane) = cvt_pk_bf16(qt0, qt1);
                        *(LAS unsigned*)(KT + t * LDQ + 2 * lane) = cvt_pk_bf16(kt0, kt1);
                        *(LAS unsigned*)(QB + t * LDQ + 2 * lane) = cvt_pk_bf16(qt0 * em0, qt1 * em1);
                        const unsigned kbp = cvt_pk_bf16(kt0 * el0, kt1 * el1);
                        if (r & 1) { kb0[r >> 1] |= (kbp << 16); kb1[r >> 1] |= (kbp & 0xffff0000u); vt0[r >> 1] |= (rv[r] << 16); vt1[r >> 1] |= (rv[r] & 0xffff0000u); }
                        else { kb0[r >> 1] = kbp & 0xffffu; kb1[r >> 1] = kbp >> 16; vt0[r >> 1] = rv[r] & 0xffffu; vt1[r >> 1] = rv[r] >> 16; }
                    }
                    *(LAS u32x4*)(KBT + (2 * lane) * LDT + 8 * w) = (u32x4){kb0[0], kb0[1], kb0[2], kb0[3]};
                    *(LAS u32x4*)(KBT + (2 * lane + 1) * LDT + 8 * w) = (u32x4){kb1[0], kb1[1], kb1[2], kb1[3]};
                    *(LAS u32x4*)(VT + (2 * lane) * LDT + 8 * w) = (u32x4){vt0[0], vt0[1], vt0[2], vt0[3]};
                    *(LAS u32x4*)(VT + (2 * lane + 1) * LDT + 8 * w) = (u32x4){vt1[0], vt1[1], vt1[2], vt1[3]};
                    LDS_WAIT(); __syncthreads();
                    u32x4 gg[2];
                    { const bf16_t* gp = pbase + (size_t)(m0 + ot) * PROJ_LD + 1536 + 8 * ocg; gg[0] = *(const u32x4*)gp; gg[1] = *(const u32x4*)(gp + 64); }
                    if (c + 1 < NCHUNK) {
#pragma unroll
                        for (int r = 0; r < 8; ++r) { const bf16_t* p = pbase + (size_t)(m0 + CHUNK + 8 * w + r) * PROJ_LD + 2 * lane; rq[r] = *(const unsigned*)p; rl[r] = *(const unsigned*)(p + 512); rv[r] = *(const unsigned*)(p + 1024); }
                    }
#pragma unroll
                    for (int x2 = 0; x2 < 2; ++x2) { const int id = 2 * w + x2, si = id >> 2, ti = id & 3;
                        f32x4 sc = (f32x4){0.f, 0.f, 0.f, 0.f};
                        if (si <= ti) {
#pragma unroll
                            for (int ks = 0; ks < 4; ++ks) { const bf16x8 a = *(const LAS bf16x8*)(KT + (16 * si + fr) * LDQ + 32 * ks + 8 * fq), bb = *(const LAS bf16x8*)(QT + (16 * ti + fr) * LDQ + 32 * ks + 8 * fq);
                                sc = __builtin_amdgcn_mfma_f32_16x16x32_bf16(a, bb, sc, 0, 0, 0); }
                            const int t = 16 * ti + fr, s0 = 16 * si + 4 * fq;
#pragma unroll
                            for (int j = 0; j < 4; ++j) sc[j] = (s0 + j <= t) ? sc[j] : 0.f;
                        }
                        *(LAS u32x2*)(PM + (16 * ti + fr) * LDT + 16 * si + 4 * fq) = (u32x2){cvt_pk_bf16(sc[0], sc[1]), cvt_pk_bf16(sc[2], sc[3])};
                    }
                    f32x4 oacc[4];
                    { bf16x8 sa[4];
#pragma unroll
                        for (int ks = 0; ks < 4; ++ks) sa[ks] = *(const LAS bf16x8*)(ST + (16 * w + fr) * LDQ + 32 * ks + 8 * fq);
#pragma unroll
                        for (int ti = 0; ti < 4; ++ti) { oacc[ti] = (f32x4){0.f, 0.f, 0.f, 0.f};
#pragma unroll
                            for (int ks = 0; ks < 4; ++ks) { const bf16x8 bb = *(const LAS bf16x8*)(QB + (16 * ti + fr) * LDQ + 32 * ks + 8 * fq); oacc[ti] = __builtin_amdgcn_mfma_f32_16x16x32_bf16(sa[ks], bb, oacc[ti], 0, 0, 0); } } }
                    LDS_WAIT(); __syncthreads();
                    { bf16x8 va[2];
#pragma unroll
                        for (int ks = 0; ks < 2; ++ks) va[ks] = *(const LAS bf16x8*)(VT + (16 * w + fr) * LDT + 32 * ks + 8 * fq);
#pragma unroll
                        for (int ti = 0; ti < 4; ++ti)
#pragma unroll
                            for (int ks = 0; ks < 2; ++ks) { const bf16x8 bb = *(const LAS bf16x8*)(PM + (16 * ti + fr) * LDT + 32 * ks + 8 * fq); oacc[ti] = __builtin_amdgcn_mfma_f32_16x16x32_bf16(va[ks], bb, oacc[ti], 0, 0, 0); }
#pragma unroll
                        for (int i = 0; i < 8; ++i) { const f32x4 dv = *(const LAS f32x4*)(DEC + 16 * i + 4 * fq); Sacc[i] = Sacc[i] * dv;
#pragma unroll
                            for (int ks = 0; ks < 2; ++ks) { const bf16x8 a = *(const LAS bf16x8*)(KBT + (16 * i + fr) * LDT + 32 * ks + 8 * fq); Sacc[i] = __builtin_amdgcn_mfma_f32_16x16x32_bf16(a, va[ks], Sacc[i], 0, 0, 0); } } }
#pragma unroll
                    for (int ti = 0; ti < 4; ++ti) *(LAS u32x2*)(OS + (16 * ti + fr) * LDQ + 16 * w + 4 * fq) = (u32x2){cvt_pk_bf16(oacc[ti][0], oacc[ti][1]), cvt_pk_bf16(oacc[ti][2], oacc[ti][3])};
#pragma unroll
                    for (int i = 0; i < 8; ++i) *(LAS u32x2*)(ST + (16 * w + fr) * LDQ + 16 * i + 4 * fq) = (u32x2){cvt_pk_bf16(Sacc[i][0], Sacc[i][1]), cvt_pk_bf16(Sacc[i][2], Sacc[i][3])};
                    LDS_WAIT(); __syncthreads();
                    { f32x4 o[4]; const u32x4 ow0 = *(const LAS u32x4*)(OS + ot * LDQ + 8 * ocg), ow1 = *(const LAS u32x4*)(OS + ot * LDQ + 64 + 8 * ocg); gm::unpack8(ow0, o[0], o[1]); gm::unpack8(ow1, o[2], o[3]);
                        float ss = 0.f;
#pragma unroll
                        for (int q = 0; q < 4; ++q) ss += (o[q][0] * o[q][0] + o[q][1] * o[q][1]) + (o[q][2] * o[q][2] + o[q][3] * o[q][3]);
                        ss += __shfl_xor(ss, 1); ss += __shfl_xor(ss, 2); ss += __shfl_xor(ss, 4);
                        const float rn = __builtin_amdgcn_rsqf(ss * (1.0f / 128.0f) + EPS);
                        bf16_t* op = OB + (size_t)(b * SEQ + m0 + ot) * HW + h * DK + 8 * ocg;
#pragma unroll
                        for (int q = 0; q < 2; ++q) { f32x4 g0, g1; gm::unpack8(gg[q], g0, g1);
#pragma unroll
                            for (int j = 0; j < 4; ++j) { g0[j] = g0[j] * sigmoidf_(g0[j]); g1[j] = g1[j] * sigmoidf_(g1[j]); }
                            *(u32x4*)(op + 64 * q) = gm::pack8(o[2 * q] * rn * nwv[2 * q] * g0, o[2 * q + 1] * rn * nwv[2 * q + 1] * g1); } }
                }
            }
        } else {
            const int nconv = G - nchainblk;
            f32x4 cw[3][2];
#pragma unroll
            for (int j = 0; j < 3; ++j) { cw[j][0] = *(const f32x4*)(conv_w + j * 512 + 8 * lane); cw[j][1] = *(const f32x4*)(conv_w + j * 512 + 8 * lane + 4); }
            for (int it = bid - nchainblk; it < BATCH * 8; it += nconv) {
                const int b = it >> 3, t0 = (it & 7) * 256 + wave * 32;
                const bf16_t* pb = PROJ + (size_t)(b * SEQ) * PROJ_LD + 2048 + 8 * lane;
                f32x4 p1[2], p2[2];
#pragma unroll
                for (int q = 0; q < 2; ++q) { p1[q] = (f32x4){0.f, 0.f, 0.f, 0.f}; p2[q] = p1[q]; }
                if (t0 > 0) {
                    f32x4 a0, a1, c0, c1;
                    gm::unpack8(*(const u32x4*)(pb + (size_t)(t0 - 2) * PROJ_LD + 512), a0, a1); gm::unpack8(*(const u32x4*)(pb + (size_t)(t0 - 2) * PROJ_LD + 1024), c0, c1); p2[0] = a0 * c0; p2[1] = a1 * c1;
                    gm::unpack8(*(const u32x4*)(pb + (size_t)(t0 - 1) * PROJ_LD + 512), a0, a1); gm::unpack8(*(const u32x4*)(pb + (size_t)(t0 - 1) * PROJ_LD + 1024), c0, c1); p1[0] = a0 * c0; p1[1] = a1 * c1;
                }
                for (int r = 0; r < 32; ++r) { const size_t ro = (size_t)(t0 + r) * PROJ_LD;
                    f32x4 a0, a1, c0, c1, g0, g1;
                    gm::unpack8(*(const u32x4*)(pb + ro + 512), a0, a1); gm::unpack8(*(const u32x4*)(pb + ro + 1024), c0, c1); gm::unpack8(*(const u32x4*)(pb + ro), g0, g1);
                    const f32x4 q0 = a0 * c0, q1 = a1 * c1;
                    const f32x4 y0 = g0 * (cw[0][0] * p2[0] + cw[1][0] * p1[0] + cw[2][0] * q0), y1 = g1 * (cw[0][1] * p2[1] + cw[1][1] * p1[1] + cw[2][1] * q1);
                    *(u32x4*)(CVB + (size_t)(b * SEQ + t0 + r) * HW + 8 * lane) = gm::pack8(y0, y1);
                    p2[0] = p1[0]; p2[1] = p1[1]; p1[0] = q0; p1[1] = q1; }
            }
        }
        if (BOTH(3)) GRID_BAR();
    }

    if (IN(4)) { PHASE_ARGS();
        gm::DenseOrder S{NTOK / 256, D / 256, G, bid, 2}; gm::DenseA AM{HW, (unsigned)(WS_CV - WS_O)}; gm::EpiMerge E{(const bf16_t*)ap->out, WSP(bf16_t, WS_U)};
        gm::gemm_phase(wave_sg, lds, (const char*)WSP(bf16_t, WS_O), (const char*)WSP(bf16_t, WS_WHG), HW, 0, (unsigned)(WS_WCV - WS_WHG), S, E, AM);
        if (BOTH(4)) GRID_BAR();
    }

    if (IN(5)) { PHASE_ARGS();
        gm::DenseOrder S{NTOK / 256, D / 256, G, bid, 1}; gm::DenseA AM{D, 0u}; gm::EpiMix E{ARG(I_X), WSP(float, WS_MOD), WSP(bf16_t, WS_H)};
        gm::gemm_phase(wave_sg, lds, (const char*)WSP(bf16_t, WS_U), (const char*)WSP(bf16_t, WS_WMIX), D, 0, 0u, S, E, AM);
        if (BOTH(5)) GRID_BAR();
    }

    if (IN(6)) { PHASE_IDS(); PHASE_ARGS();
        const float* norm_ffn_w = ARG(I_NFFN); const float* w_router = ARG(I_WR); const float* b_router = ARG(I_BR); const float* MOD = WSP(float, WS_MOD);
        const bf16_t* HB = WSP(bf16_t, WS_H); bf16_t* U = WSP(bf16_t, WS_U); int* TOPI = WSP(int, WS_TOPI); float* TOPP = WSP(float, WS_TOPP); int* POS = WSP(int, WS_POS);
        LAS float* WRT = (LAS float*)lds;
        LAS unsigned* LCNT = (LAS unsigned*)(lds + 131072);
        LAS unsigned* LBASE = LCNT + 32;
        LAS unsigned* LASS = LCNT + 64;
        for (int i = tid; i < 32 * 1024; i += NTHREADS) { const int e = i >> 10, k = i & 1023; WRT[i] = w_router[(size_t)k * NE + e]; }
        for (int tb = bid; tb < NTOK / 256; tb += G) {
            if (tid < 32) LCNT[tid] = 0u;
            LDS_WAIT(); __syncthreads();
            const int b = (tb * 256) >> 11;
            f32x4 A[4], Sh[4];
#pragma unroll
            for (int j = 0; j < 4; ++j) { const int k = 4 * lane + 256 * j; const f32x4 w = *(const f32x4*)(norm_ffn_w + k), sc = *(const f32x4*)(MOD + (size_t)b * 6144 + 4096 + k);
                A[j] = w * (sc + 1.0f); Sh[j] = *(const f32x4*)(MOD + (size_t)b * 6144 + 3072 + k); }
            const int myexp = ((lane >> 5) & 1) * 16 + ((lane >> 4) & 1) * 8 + ((lane >> 3) & 1) * 4 + ((lane >> 2) & 1) * 2 + ((lane >> 1) & 1);
            const float mybr = b_router[myexp];
            for (int p = 0; p < 16; ++p) {
                const int ltok = wave * 32 + 2 * p, tok = tb * 256 + ltok;
                f32x4 uu[2][4];
#pragma unroll
                for (int xx = 0; xx < 2; ++xx) {
                    const bf16_t* hr = HB + (size_t)(tok + xx) * D; float s = 0.f;
#pragma unroll
                    for (int j = 0; j < 4; ++j) { const u32x2 w = *(const u32x2*)(hr + 4 * lane + 256 * j); uu[xx][j] = (f32x4){bf_lo(w.x), bf_hi(w.x), bf_lo(w.y), bf_hi(w.y)};
                        s += (uu[xx][j][0] * uu[xx][j][0] + uu[xx][j][1] * uu[xx][j][1]) + (uu[xx][j][2] * uu[xx][j][2] + uu[xx][j][3] * uu[xx][j][3]); }
                    const float rs = __builtin_amdgcn_rsqf(wave_sum(s) * (1.0f / D) + EPS);
                    bf16_t* ur = U + (size_t)(tok + xx) * D;
#pragma unroll
                    for (int j = 0; j < 4; ++j) { uu[xx][j] = uu[xx][j] * rs * A[j] + Sh[j]; u32x2 w; w.x = cvt_pk_bf16(uu[xx][j][0], uu[xx][j][1]); w.y = cvt_pk_bf16(uu[xx][j][2], uu[xx][j][3]); *(u32x2*)(ur + 4 * lane + 256 * j) = w; }
                }
                float a0[32], a1[32];
#pragma unroll
                for (int e = 0; e < 32; ++e) { float s0 = 0.f, s1 = 0.f;
#pragma unroll
                    for (int j = 0; j < 4; ++j) { const f32x4 w = *(const LAS f32x4*)(WRT + e * 1024 + 4 * lane + 256 * j);
                        s0 += (w[0] * uu[0][j][0] + w[1] * uu[0][j][1]) + (w[2] * uu[0][j][2] + w[3] * uu[0][j][3]);
                        s1 += (w[0] * uu[1][j][0] + w[1] * uu[1][j][1]) + (w[2] * uu[1][j][2] + w[3] * uu[1][j][3]); }
                    a0[e] = s0; a1[e] = s1; }
#define TR_STEP(arr, mask, n) do { const bool sel = (lane & (mask)) != 0; _Pragma("unroll") for (int i = 0; i < (n); ++i) { const float keep = sel ? arr[(n) + i] : arr[i], send = sel ? arr[i] : arr[(n) + i]; arr[i] = keep + __shfl_xor(send, (mask)); } } while (0)
                TR_STEP(a0, 32, 16); TR_STEP(a0, 16, 8); TR_STEP(a0, 8, 4); TR_STEP(a0, 4, 2); TR_STEP(a0, 2, 1); a0[0] += __shfl_xor(a0[0], 1);
                TR_STEP(a1, 32, 16); TR_STEP(a1, 16, 8); TR_STEP(a1, 8, 4); TR_STEP(a1, 4, 2); TR_STEP(a1, 2, 1); a1[0] += __shfl_xor(a1[0], 1);
#pragma unroll
                for (int xx = 0; xx < 2; ++xx) {
                    float val = (xx == 0 ? a0[0] : a1[0]) + mybr;
                    float tv[4]; int tix[4];
#pragma unroll
                    for (int r = 0; r < 4; ++r) { float bv = val; int bi = myexp;
#pragma unroll
                        for (int o = 1; o < 64; o <<= 1) { const float ov = __shfl_xor(bv, o); const int oi = __shfl_xor(bi, o); if (ov > bv || (ov == bv && oi < bi)) { bv = ov; bi = oi; } }
                        tv[r] = bv; tix[r] = bi; if (myexp == bi) val = -3.0e38f; }
                    const float e1 = fast_exp(tv[1] - tv[0]), e2 = fast_exp(tv[2] - tv[0]), e3 = fast_exp(tv[3] - tv[0]); const float inv = fast_rcp(1.0f + e1 + e2 + e3);
                    if (lane < 4) { const int e = lane == 0 ? tix[0] : lane == 1 ? tix[1] : lane == 2 ? tix[2] : tix[3]; const float pr = (lane == 0 ? 1.0f : lane == 1 ? e1 : lane == 2 ? e2 : e3) * inv;
                        TOPI[(size_t)(tok + xx) * 4 + lane] = e; TOPP[(size_t)(tok + xx) * 4 + lane] = pr;
                        const unsigned rank = __hip_atomic_fetch_add(LCNT + e, 1u, __ATOMIC_RELAXED, __HIP_MEMORY_SCOPE_WORKGROUP); LASS[(ltok + xx) * 4 + lane] = ((unsigned)e << 16) | rank; }
                }
            }
            LDS_WAIT(); __syncthreads();
            if (tid < 32) LBASE[tid] = atomicAdd(ctl + CW_CNT + 64 * tid, (unsigned)LCNT[tid]);
            LDS_WAIT(); __syncthreads();
            for (int i = tid; i < 1024; i += NTHREADS) { const unsigned v = LASS[i]; POS[(size_t)tb * 1024 + i] = (int)(LBASE[v >> 16] + (v & 0xffffu)); }
            __syncthreads();
        }
        if (BOTH(6)) GRID_BAR();
    }

    LAS int* PADSTART = (LAS int*)(lds + TBL_OFF); LAS int* TILE_E = PADSTART + 64;
    int ntiles = 0;
    {
        if (lo <= 9 && hi > 7) { PHASE_IDS(); PHASE_ARGS();
            __syncthreads();
            if (tid == 0) { int acc = 0; for (int e = 0; e < NE; ++e) { PADSTART[e] = acc; const int cnt = (int)__hip_atomic_load(ctl + CW_CNT + 64 * e, __ATOMIC_RELAXED, __HIP_MEMORY_SCOPE_AGENT); const int nt_e = (cnt + 255) >> 8; for (int t = 0; t < nt_e; ++t) TILE_E[(acc >> 8) + t] = e; acc += nt_e << 8; } PADSTART[NE] = acc; }
            LDS_WAIT(); __syncthreads();
            ntiles = PADSTART[NE] >> 8;
        }
    }

    if (IN(7)) { PHASE_IDS(); PHASE_ARGS();
        const int* TOPI = WSP(int, WS_TOPI); const float* TOPP = WSP(float, WS_TOPP); const int* POS = WSP(int, WS_POS); int* RTOK = WSP(int, WS_RTOK); int* RSLOT = WSP(int, WS_RSLOT); float* RW = WSP(float, WS_RW);
        for (int i = bid * NTHREADS + tid; i < NASSIGN; i += G * NTHREADS) { const int e = TOPI[i]; const int row = PADSTART[e] + POS[i]; RTOK[row] = i >> 2; RSLOT[row] = i; RW[row] = TOPP[i]; }
        for (int e = bid; e < NE; e += G) { const int cnt = (int)__hip_atomic_load(ctl + CW_CNT + 64 * e, __ATOMIC_RELAXED, __HIP_MEMORY_SCOPE_AGENT);
            for (int r = PADSTART[e] + cnt + tid; r < PADSTART[e + 1]; r += NTHREADS) { RTOK[r] = 0; RSLOT[r] = -1; RW[r] = 0.f; } }
        if (BOTH(7)) GRID_BAR();
    }

    if (IN(8)) { PHASE_ARGS();
        gm::MoeOrder S{ntiles, 2048 / 256, G, bid, TILE_E}; gm::GatherA AM{D, WSP(int, WS_RTOK)}; gm::EpiSwiglu E{ARG(I_B1), WSP(bf16_t, WS_ACT)};
        gm::gemm_phase(wave_sg, lds, (const char*)WSP(bf16_t, WS_U), (const char*)WSP(bf16_t, WS_W1), D, 2048, 0u, S, E, AM);
        if (BOTH(8)) GRID_BAR();
    }

    if (IN(9)) { PHASE_ARGS();
        gm::MoeOrder S{ntiles, D / 256, G, bid, TILE_E}; gm::DenseA AM{DFF, 0u}; gm::EpiMoeOut E{ARG(I_B2), WSP(int, WS_RSLOT), WSP(float, WS_RW), (bf16_t*)ap->out, WSP(bf16_t, WS_YO23)};
        gm::gemm_phase(wave_sg, lds, (const char*)WSP(bf16_t, WS_ACT), (const char*)WSP(bf16_t, WS_W2), DFF, D, 0u, S, E, AM);
        if (BOTH(9)) GRID_BAR();
    }

#if MK_PROBE
    if (lo == 100) { PHASE_IDS(); PHASE_ARGS();
        float* out = ap->out;
        const bf16_t* src = MK_PROBE == 1 ? WSP(bf16_t, WS_U) : MK_PROBE == 3 ? WSP(bf16_t, WS_O) : MK_PROBE == 4 ? WSP(bf16_t, WS_U) : MK_PROBE == 5 ? WSP(bf16_t, WS_H) : WSP(bf16_t, WS_U);
        for (size_t i = (size_t)bid * NTHREADS + tid; i < (size_t)NTOK * D; i += (size_t)G * NTHREADS) {
            float v;
            if (MK_PROBE == 3) { const size_t t = i >> 10, c = i & 1023; v = bf1(c < 512 ? src[t * 512 + c] : WSP(bf16_t, WS_CV)[t * 512 + (c - 512)]); }
            else if (MK_PROBE == 2) { const size_t t = i >> 10, c = i & 1023; const bf16_t* P = WSP(bf16_t, WS_PROJ) + t * PROJ_LD; v = bf1(P[c]) + bf1(P[c + 1024]) + bf1(P[c + 2048]) + (c < 512 ? bf1(P[c + 3072]) : 0.f); }
            else if (MK_PROBE == 6) { const size_t t = i >> 10, c = i & 1023; v = bf1(src[i]) + (c < 4 ? (float)WSP(int, WS_TOPI)[t * 4 + c] : c < 8 ? WSP(float, WS_TOPP)[t * 4 + (c - 4)] : 0.f); }
            else v = bf1(src[i]);
            out[i] = v; }
    }
#endif
    if (IN(10)) { PHASE_IDS(); PHASE_ARGS();
        const float* norm_final_w = ARG(I_NFIN); const float* MOD = WSP(float, WS_MOD); const bf16_t* HB = WSP(bf16_t, WS_H); const bf16_t* YO01 = (const bf16_t*)ap->out; const bf16_t* YO23 = WSP(bf16_t, WS_YO23); float* out = ap->out;
        for (int m0 = gw * 32; m0 < NTOK; m0 += NGW * 32) {
            const int b = m0 >> 11;
            f32x4 gf[4], nf[4];
#pragma unroll
            for (int j = 0; j < 4; ++j) { const int k = 4 * lane + 256 * j; gf[j] = *(const f32x4*)(MOD + (size_t)b * 6144 + 5120 + k); nf[j] = *(const f32x4*)(norm_final_w + k); }
            for (int r = 0; r < 32; ++r) {
                const size_t tok = (size_t)(m0 + r);
                const bf16_t* hr = HB + tok * D; const bf16_t* y0 = YO01 + tok * 2048; const bf16_t* y2 = YO23 + tok * 2048;
                f32x4 v[4]; float s = 0.f;
#pragma unroll
                for (int j = 0; j < 4; ++j) { const int k = 4 * lane + 256 * j;
                    const u32x2 hw = *(const u32x2*)(hr + k), ya = *(const u32x2*)(y0 + k), yb = *(const u32x2*)(y0 + 1024 + k), yc = *(const u32x2*)(y2 + k), yd = *(const u32x2*)(y2 + 1024 + k);
                    f32x4 y = (f32x4){bf_lo(ya.x), bf_hi(ya.x), bf_lo(ya.y), bf_hi(ya.y)};
                    y += (f32x4){bf_lo(yb.x), bf_hi(yb.x), bf_lo(yb.y), bf_hi(yb.y)}; y += (f32x4){bf_lo(yc.x), bf_hi(yc.x), bf_lo(yc.y), bf_hi(yc.y)}; y += (f32x4){bf_lo(yd.x), bf_hi(yd.x), bf_lo(yd.y), bf_hi(yd.y)};
                    v[j] = (f32x4){bf_lo(hw.x), bf_hi(hw.x), bf_lo(hw.y), bf_hi(hw.y)} + gf[j] * y;
                    s += (v[j][0] * v[j][0] + v[j][1] * v[j][1]) + (v[j][2] * v[j][2] + v[j][3] * v[j][3]); }
                const float rs = __builtin_amdgcn_rsqf(wave_sum(s) * (1.0f / D) + EPS);
                float* orow = out + tok * D;
#pragma unroll
                for (int j = 0; j < 4; ++j) *(f32x4*)(orow + 4 * lane + 256 * j) = v[j] * rs * nf[j];
            }
        }
    }
#undef IN
#undef BOTH
}

extern "C" void kernel_launch(void* const* d_in, const int* in_sizes, int n_in, void* d_out, int out_size, void* d_ws, size_t ws_size, hipStream_t stream) {
    static int grid = 0;
    if (grid == 0) {
        if (n_in != 20 || out_size != NTOK * D || ws_size < WS_END) { fprintf(stderr, "kernel_launch: unexpected shapes (n_in %d out %d ws %zu)\n", n_in, out_size, ws_size); grid = -1; return; }
        if (hipFuncSetAttribute((const void*)fwd_kernel, hipFuncAttributeMaxDynamicSharedMemorySize, LDS_BYTES) != hipSuccess) { fprintf(stderr, "kernel_launch: hipFuncSetAttribute failed\n"); grid = -1; return; }
        int dev = 0, cus = 0, per_cu = 0;
        (void)hipGetDevice(&dev); (void)hipDeviceGetAttribute(&cus, hipDeviceAttributeMultiprocessorCount, dev);
        if (hipOccupancyMaxActiveBlocksPerMultiprocessor(&per_cu, (const void*)fwd_kernel, NTHREADS, LDS_BYTES) != hipSuccess || per_cu < 1) fprintf(stderr, "kernel_launch: occupancy query says %d\n", per_cu);
        (void)hipGetLastError();
        grid = cus > 0 ? cus : 256;
    }
    if (grid < 0) return;
    (void)hipMemsetAsync((char*)d_ws + WS_CTL, 0, CTL_ZERO_BYTES, stream);
    Args a{};
    for (int i = 0; i < 20; ++i) a.in[i] = (const float*)d_in[i];
    a.out = (float*)d_out; a.ws = (unsigned char*)d_ws;
#if MK_ONE_LAUNCH
    a.ph_lo = 0; a.ph_hi = NPHASE;
    hipLaunchKernelGGL(fwd_kernel, dim3(grid), dim3(NTHREADS), LDS_BYTES, stream, a);
#else
#if MK_PROBE
    for (int p = 0; p <= MK_PROBE; ++p) { a.ph_lo = p; a.ph_hi = p + 1; hipLaunchKernelGGL(fwd_kernel, dim3(grid), dim3(NTHREADS), LDS_BYTES, stream, a); }
    a.ph_lo = 100; a.ph_hi = 101; hipLaunchKernelGGL(fwd_kernel, dim3(grid), dim3(NTHREADS), LDS_BYTES, stream, a);
#else
    for (int p = 0; p < NPHASE; ++p) { a.ph_lo = p; a.ph_hi = p + 1; hipLaunchKernelGGL(fwd_kernel, dim3(grid), dim3(NTHREADS), LDS_BYTES, stream, a); }
#endif
#endif
}
```

```cpp
#include <hip/hip_runtime.h>
#include <cstdio>
#include <cstdint>

#ifndef MK_PROBE
#define MK_PROBE 0
#endif
#ifndef MK_ONE_LAUNCH
#define MK_ONE_LAUNCH 1
#endif

#define LAS __attribute__((address_space(3)))
#define GAS __attribute__((address_space(1)))
typedef unsigned short bf16_t;
typedef short bf16x8 __attribute__((ext_vector_type(8)));
typedef float f32x4 __attribute__((ext_vector_type(4)));
typedef float f32x2 __attribute__((ext_vector_type(2)));
typedef unsigned u32x4 __attribute__((ext_vector_type(4)));
typedef unsigned u32x2 __attribute__((ext_vector_type(2)));

constexpr int D = 1024, BATCH = 32, SEQ = 2048, NTOK = BATCH * SEQ;
constexpr int HW = 512, NHEAD = 4, DK = 128, CHUNK = 64, NCHUNK = SEQ / CHUNK;
constexpr int INC = 5632, PROJ_LD = 3584, GATE_LD = 2048;
constexpr int NE = 32, TOPK = 4, DFF = 1024, NASSIGN = NTOK * TOPK;
constexpr int MAXTILES = NASSIGN / 256 + NE;
constexpr int MAXROWS = MAXTILES * 256;
constexpr float EPS = 1e-6f, SW_LIMIT = 7.0f, SW_ALPHA = 1.702f;
constexpr int NWAVES = 8, NTHREADS = 512;
constexpr int NPHASE = 11;

constexpr size_t MiB = 1u << 20;
constexpr size_t WS_CTL = 0, CTL_ZERO_BYTES = 65536;
constexpr size_t WS_MOD = 1 * MiB;
constexpr size_t WS_LB = WS_MOD + 32 * 6144 * 4;
constexpr size_t WS_WIN = 2 * MiB;
constexpr size_t WS_WHG = 13 * MiB, WS_WCV = 14 * MiB, WS_WMIX = 15 * MiB;
constexpr size_t WS_W2 = 18 * MiB;
constexpr size_t WS_W1 = 82 * MiB;
constexpr size_t WS_U = 210 * MiB;
constexpr size_t WS_PROJ = 338 * MiB;
constexpr size_t WS_O = 786 * MiB;
constexpr size_t WS_CV = 850 * MiB;
constexpr size_t WS_H = 338 * MiB;
constexpr size_t WS_ACT = 466 * MiB;
constexpr size_t WS_TOPI = 994 * MiB, WS_TOPP = 995 * MiB, WS_POS = 996 * MiB;
constexpr size_t WS_RTOK = 997 * MiB, WS_RSLOT = 997 * MiB + 1081344 + 0, WS_RW = WS_RSLOT + 1081344;
constexpr size_t WS_YO23 = 82 * MiB;
constexpr size_t WS_END = 1001 * MiB;
static_assert(WS_RW + 1081344 <= WS_END && MAXROWS * 4 == 1081344, "tables");
static_assert(WS_ACT + (size_t)MAXROWS * 1024 * 2 <= WS_TOPI, "act");
constexpr int CW_TMO = 0, CW_BAR = 4096, CW_CNT = 8192;

constexpr int LDS_BYTES = 163840;
constexpr int MISC_OFF = LDS_BYTES - 256;
constexpr int TBL_OFF = 131072;
constexpr int STASH_OFF = TBL_OFF + 8192;

#define LDS_WAIT() asm volatile("s_waitcnt lgkmcnt(0)" ::: "memory")
#define VM_WAIT() asm volatile("s_waitcnt vmcnt(0)" ::: "memory")
typedef __bf16 bf16x2_t __attribute__((ext_vector_type(2)));
__device__ __forceinline__ unsigned cvt_pk_bf16(float lo, float hi) { const f32x2 v = {lo, hi}; const bf16x2_t b = __builtin_convertvector(v, bf16x2_t); return __builtin_bit_cast(unsigned, b); }
__device__ __forceinline__ float bf_lo(unsigned u) { return __uint_as_float(u << 16); }
__device__ __forceinline__ float bf_hi(unsigned u) { return __uint_as_float(u & 0xffff0000u); }
__device__ __forceinline__ float bf1(bf16_t u) { return __uint_as_float(((unsigned)u) << 16); }
__device__ __forceinline__ float fast_rcp(float x) { return __builtin_amdgcn_rcpf(x); }
__device__ __forceinline__ float fast_exp(float x) { return __builtin_amdgcn_exp2f(x * 1.44269504089f); }
__device__ __forceinline__ float fast_log(float x) { return __builtin_amdgcn_logf(x) * 0.69314718056f; }
__device__ __forceinline__ float sigmoidf_(float x) { return fast_rcp(1.0f + fast_exp(-x)); }
__device__ __forceinline__ float wave_sum(float v) {
#pragma unroll
    for (int o = 1; o < 64; o <<= 1) v += __shfl_xor(v, o);
    return v;
}

#define XB_TMO      128
#define XB_XCNT(j)  (256  + 64 * (j))
#define XB_XSUB(j)  (1280 + 64 * (j))
#define XB_XGEN(j)  (2304 + 64 * (j))
#define XB_TOP      3328
#define XB_TOPGEN   3392
#define XCD_BAR_WORDS 3456
#define XB_SPIN_CAP (1u << 20)
__device__ __forceinline__ unsigned xb_ld(unsigned* p)              { return __hip_atomic_load(p, __ATOMIC_RELAXED, __HIP_MEMORY_SCOPE_AGENT); }
__device__ __forceinline__ unsigned xb_add(unsigned* p, unsigned v) { return __hip_atomic_fetch_add(p, v, __ATOMIC_RELAXED, __HIP_MEMORY_SCOPE_AGENT); }
__device__ __forceinline__ unsigned xb_xcc_id() { return (unsigned)__builtin_amdgcn_s_getreg((3 << 11) | 20) & 0xFu; }
#define XB_SPIN(cond, bar) do { unsigned _sp = 0; while (cond) { __builtin_amdgcn_s_sleep(1); \
    if ((++_sp & 255u) == 0u) { if (xb_ld(&(bar)[XB_TMO])) break; if (_sp > XB_SPIN_CAP) { atomicAdd(&(bar)[XB_TMO], 1u); break; } } } } while (0)
struct XcdBarrier { unsigned* bar; unsigned x; volatile LAS unsigned* st; };
__device__ __forceinline__ XcdBarrier xcd_barrier_post(unsigned* bar, volatile LAS unsigned* st) {
    XcdBarrier b; b.bar = bar; b.x = xb_xcc_id(); b.st = st;
    if (threadIdx.x == 0) (void)xb_add(&bar[XB_XCNT(b.x)], 1u);
    return b;
}
__device__ __forceinline__ void xcd_barrier_complete(unsigned* bar, unsigned x, unsigned& nloc, unsigned& nx) {
    const unsigned G = gridDim.x * gridDim.y * gridDim.z;
    unsigned sum, cnt, mine, sp = 0u;
    for (;;) {
        sum = 0u; cnt = 0u; mine = 0u;
#pragma unroll
        for (unsigned j = 0; j < 16; ++j) { const unsigned c = xb_ld(&bar[XB_XCNT(j)]); sum += c; cnt += (c > 0u) ? 1u : 0u; mine = (j == x) ? c : mine; }
        if (sum == G) break;
        __builtin_amdgcn_s_sleep(1);
        if ((++sp & 255u) == 0u) { if (xb_ld(&bar[XB_TMO])) break; if (sp > XB_SPIN_CAP) { atomicAdd(&bar[XB_TMO], 1u); break; } }
    }
    nloc = mine > 0u ? mine : 1u; nx = cnt > 0u ? cnt : 1u;
}
__device__ __forceinline__ void xcd_barrier(const XcdBarrier& b) {
    asm volatile("s_waitcnt vmcnt(0)" ::: "memory");
    __syncthreads();
    if (threadIdx.x == 0) {
        unsigned* bar = b.bar;
        __builtin_amdgcn_s_waitcnt(0);
        unsigned nloc = b.st[0], nx = b.st[1];
        if (nloc == 0u) { xcd_barrier_complete(bar, b.x, nloc, nx); b.st[0] = nloc; b.st[1] = nx; }
        const unsigned old = xb_add(&bar[XB_XSUB(b.x)], 1u);
        const unsigned gen = old / nloc;
        if (old + 1u == (gen + 1u) * nloc) {
            __builtin_amdgcn_fence(__ATOMIC_RELEASE, "agent");
            asm volatile("s_waitcnt vmcnt(0)" ::: "memory");
            const unsigned og = xb_add(&bar[XB_TOP], 1u);
            const unsigned tg = og / nx;
            if (og + 1u == (tg + 1u) * nx) xb_add(&bar[XB_TOPGEN], 1u);
            else XB_SPIN(xb_ld(&bar[XB_TOPGEN]) == tg, bar);
            __builtin_amdgcn_fence(__ATOMIC_ACQUIRE, "agent");
            xb_add(&bar[XB_XGEN(b.x)], 1u);
            asm volatile("s_waitcnt vmcnt(0)" ::: "memory");
        } else {
            XB_SPIN(xb_ld(&bar[XB_XGEN(b.x)]) == gen, bar);
            __builtin_amdgcn_fence(__ATOMIC_ACQUIRE, "agent");
            asm volatile("s_waitcnt vmcnt(0)" ::: "memory");
        }
    }
    __syncthreads();
}

namespace gm {
constexpr int BM = 256, BK = 64, HALF = 128, HTB = HALF * BK * 2, STAGE_BYTES = 8 * HTB, NXCD = 8, WGM = 8;
__device__ __forceinline__ int lds_byte(int r, int c) { const int st = (r >> 4) * 2 + (c >> 5), rr = r & 15, cc = c & 31, ob = rr * 64 + cc * 2; return st * 1024 + (ob ^ (((ob >> 9) & 1) << 5)); }
__device__ __forceinline__ void stage_rc(int b, int& R, int& C) { const int st = b / 1024, sb = b % 1024, swz = sb ^ (((sb >> 9) & 1) << 5); R = (st >> 1) * 16 + swz / 64; C = (st & 1) * 32 + (swz % 64) / 2; }
__device__ __forceinline__ int perm32(int rho) { const int n = rho >> 4, i = rho & 15; return 8 * (i >> 2) + 4 * n + (i & 3); }

struct Unit { int pm, pn, e, sub; };

__device__ __forceinline__ bool tile_order(int nM, int nN, long L, int& pm, int& pn) {
    const int nwg = nM * nN; if (L >= nwg) return false;
    int wgid = (int)L; { const int q = nwg / NXCD, r = nwg % NXCD, xcd = wgid % NXCD, off = wgid / NXCD; wgid = (xcd < r ? xcd * (q + 1) : r * (q + 1) + (xcd - r) * q) + off; }
    const int nig = WGM * nN, gid = wgid / nig, fm = gid * WGM, gsz = (nM - fm) < WGM ? (nM - fm) : WGM;
    pm = fm + ((wgid % nig) % gsz); pn = (wgid % nig) / gsz; return true;
}
struct DenseOrder {
    int nM, nN, G, c, nsub;
    __device__ __forceinline__ bool next(int i, Unit& u) const { const int ti = i / nsub; u.sub = i - ti * nsub; u.e = 0; return tile_order(nM, nN, (long)ti * G + c, u.pm, u.pn); }
};
struct MoeOrder {
    int nM, nN, G, c; const LAS int* tile_e;
    __device__ __forceinline__ bool next(int i, Unit& u) const { u.sub = 0; if (!tile_order(nM, nN, (long)i * G + c, u.pm, u.pn)) return false; u.e = tile_e[u.pm]; return true; }
};
struct DenseA { int K; unsigned sub_stride;
    __device__ __forceinline__ void offsets(const Unit& u, int tid, unsigned (&o)[2][2]) const {
#pragma unroll
        for (int i = 0; i < 2; ++i) { int R, C; stage_rc(tid * 16 + i * 8192, R, C);
#pragma unroll
            for (int h = 0; h < 2; ++h) o[h][i] = (unsigned)(((u.pm * BM + h * HALF + R) * K + C) * 2) + (unsigned)u.sub * sub_stride; } } };
struct GatherA { int K; const int* row_tok;
    __device__ __forceinline__ void offsets(const Unit& u, int tid, unsigned (&o)[2][2]) const {
#pragma unroll
        for (int i = 0; i < 2; ++i) { int R, C; stage_rc(tid * 16 + i * 8192, R, C);
#pragma unroll
            for (int h = 0; h < 2; ++h) { const int tok = row_tok[u.pm * BM + h * HALF + R]; o[h][i] = (unsigned)((tok * K + C) * 2); } } } };

template <class Epi, class Sched, class AMap>
__device__ __forceinline__ void gemm_phase(int wave_sg, LAS unsigned char* lds, const char* Abase, const char* Bbase, int K, int Nb, unsigned b_sub_stride, const Sched& S, const Epi& E, const AMap& AM) {
    int lane = (int)__builtin_amdgcn_mbcnt_hi(~0u, __builtin_amdgcn_mbcnt_lo(~0u, 0u)); asm volatile("" : "+v"(lane));
    const int wid = wave_sg, tid = wid * 64 + lane, wr = wid >> 2, wc = wid & 3, fr = lane & 15, fq = lane >> 4;
    const int nt = K / BK;
    unsigned voffB[2];
#pragma unroll
    for (int i = 0; i < 2; ++i) { int R, C; stage_rc(tid * 16 + i * 8192, R, C); const int Rb = (R & ~31) + perm32(R & 31); voffB[i] = (unsigned)(Rb * K + C) * 2u; }
    const size_t kstep = (size_t)(BK * 2);
    const size_t hstep = (size_t)HALF * K * 2;
    const unsigned ldsw = (unsigned)wid * 1024u;
    const int aoff = lds_byte(wr * 64 + fr, fq * 8), boff = lds_byte(wc * 32 + fr, fq * 8);
#define G_SA(b, h) (((b) * 2 + (h)) * HTB)
#define G_SB(b, h) ((4 + (b) * 2 + (h)) * HTB)
#define G_STAGE(bufoff, gbase, voff) do { _Pragma("unroll") for (int _i = 0; _i < 2; ++_i) \
        __builtin_amdgcn_global_load_lds((const unsigned*)((const char*)(gbase) + (voff)[_i]), (LAS unsigned*)(lds + (bufoff) + ldsw + _i * 8192), 16, 0, 0); } while (0)
#define G_LDA(dst, b, h) do { _Pragma("unroll") for (int m = 0; m < 4; ++m) _Pragma("unroll") for (int k = 0; k < 2; ++k) dst[m][k] = *(const LAS bf16x8*)(lds + G_SA(b, h) + aoff + m * 2048 + k * 1024); } while (0)
#define G_LDB(dst, b, h) do { _Pragma("unroll") for (int n = 0; n < 2; ++n) _Pragma("unroll") for (int k = 0; k < 2; ++k) dst[n][k] = *(const LAS bf16x8*)(lds + G_SB(b, h) + boff + n * 2048 + k * 1024); } while (0)
#define G_MMA(ai, bj, At, Bt) do { __builtin_amdgcn_s_setprio(1); _Pragma("unroll") for (int m = 0; m < 4; ++m) _Pragma("unroll") for (int n = 0; n < 2; ++n) _Pragma("unroll") for (int k = 0; k < 2; ++k) \
        acc[ai][bj][m][n] = __builtin_amdgcn_mfma_f32_16x16x32_bf16(Bt[n][k], At[m][k], acc[ai][bj][m][n], 0, 0, 0); __builtin_amdgcn_s_setprio(0); } while (0)
#define G_WAIT_V(n) asm volatile("s_waitcnt vmcnt(" #n ")" ::: "memory")
#define G_WAIT_L(n) asm volatile("s_waitcnt lgkmcnt(" #n ")" ::: "memory")
#define G_BAR __builtin_amdgcn_s_barrier()
#define G_SCHED __builtin_amdgcn_sched_barrier(0)
    Unit cur, nxt; int ui = 0;
    if (!S.next(0, cur)) return;
    f32x4 acc[2][2][4][2];
#pragma unroll
    for (int a = 0; a < 2; ++a)
#pragma unroll
        for (int b = 0; b < 2; ++b)
#pragma unroll
            for (int m = 0; m < 4; ++m)
#pragma unroll
                for (int n = 0; n < 2; ++n) acc[a][b][m][n] = (f32x4){0.f, 0.f, 0.f, 0.f};
    bf16x8 At[4][2], B0[2][2], B1[2][2];
    unsigned rA[2][2];
    AM.offsets(cur, tid, rA);
    LAS u32x4* stash = (LAS u32x4*)(lds + STASH_OFF) + tid;
    const char* cB = Bbase + ((size_t)cur.e * Nb + (size_t)cur.pn * BM) * K * 2 + (size_t)cur.sub * b_sub_stride;
    G_STAGE(G_SB(0, 0), cB, voffB); G_STAGE(G_SB(0, 1), cB + hstep, voffB); G_STAGE(G_SA(0, 0), Abase, rA[0]); G_STAGE(G_SA(0, 1), Abase, rA[1]);
    if (wr == 1) G_BAR;
    G_WAIT_V(2); G_BAR;
    G_STAGE(G_SB(1, 0), cB + kstep, voffB); G_STAGE(G_SA(1, 0), Abase + kstep, rA[0]); G_STAGE(G_SB(1, 1), cB + hstep + kstep, voffB);
    G_WAIT_V(6); G_BAR;
    const int t_pre = nt >= 4 ? nt - 4 : 0;
    for (;;) {
        const bool has_next = S.next(ui + 1, nxt);
        const char* nB = has_next ? Bbase + ((size_t)nxt.e * Nb + (size_t)nxt.pn * BM) * K * 2 + (size_t)nxt.sub * b_sub_stride : cB;
        for (int t = 0; t < nt; t += 2) {
            const bool last = (t == nt - 2);
            if (t == t_pre && has_next) { unsigned rn[2][2]; AM.offsets(nxt, tid, rn); *stash = (u32x4){rn[0][0], rn[0][1], rn[1][0], rn[1][1]}; }
            const char* b2 = last ? nB : cB + (size_t)(t + 2) * kstep; const char* b3 = b2 + kstep;
            G_LDB(B0, 0, 0); G_LDB(B1, 0, 1); G_SCHED; G_LDA(At, 0, 0); G_STAGE(G_SA(1, 1), Abase + (size_t)(t + 1) * kstep, rA[1]);
            G_WAIT_V(8); G_WAIT_L(0); G_BAR; G_MMA(0, 0, At, B0); G_MMA(0, 1, At, B1); G_BAR; G_SCHED;
            if (last && has_next) { const u32x4 rn = *stash; rA[0][0] = rn.x; rA[0][1] = rn.y; rA[1][0] = rn.z; rA[1][1] = rn.w; }
            const char* a2 = Abase + (last ? (size_t)0 : (size_t)(t + 2) * kstep);
            G_LDA(At, 0, 1); G_STAGE(G_SB(0, 0), b2, voffB); G_STAGE(G_SB(0, 1), b2 + hstep, voffB); G_STAGE(G_SA(0, 0), a2, rA[0]);
            G_WAIT_V(8); G_WAIT_L(0); G_BAR; G_MMA(1, 0, At, B0); G_MMA(1, 1, At, B1); G_BAR; G_SCHED;
            G_LDB(B0, 1, 0); G_LDB(B1, 1, 1); G_SCHED; G_LDA(At, 1, 0); G_STAGE(G_SA(0, 1), a2, rA[1]);
            G_WAIT_V(8); G_WAIT_L(0); G_BAR; G_MMA(0, 0, At, B0); G_MMA(0, 1, At, B1); G_BAR; G_SCHED;
            G_LDA(At, 1, 1); G_STAGE(G_SB(1, 0), b3, voffB); G_STAGE(G_SB(1, 1), b3 + hstep, voffB); G_STAGE(G_SA(1, 0), a2 + kstep, rA[0]);
            G_WAIT_V(8); G_WAIT_L(0); G_BAR; G_MMA(1, 0, At, B0); G_MMA(1, 1, At, B1); G_BAR; G_SCHED;
        }
        if (wr == 0) G_BAR;
        E(acc, cur, wr, wc, fr, fq);
        if (!has_next) break;
        if (!E.keep(cur)) {
#pragma unroll
            for (int a = 0; a < 2; ++a)
#pragma unroll
                for (int b = 0; b < 2; ++b)
#pragma unroll
                    for (int m = 0; m < 4; ++m)
#pragma unroll
                        for (int n = 0; n < 2; ++n) acc[a][b][m][n] = (f32x4){0.f, 0.f, 0.f, 0.f};
        }
        cur = nxt; cB = nB; ++ui;
        if (wr == 1) G_BAR;
    }
    G_WAIT_V(0);
    G_BAR;
#undef G_SA
#undef G_SB
#undef G_STAGE
#undef G_LDA
#undef G_LDB
#undef G_MMA
#undef G_WAIT_V
#undef G_WAIT_L
#undef G_BAR
#undef G_SCHED
}

__device__ __forceinline__ u32x4 pack8(const f32x4& v0, const f32x4& v1) { u32x4 w; w.x = cvt_pk_bf16(v0[0], v0[1]); w.y = cvt_pk_bf16(v0[2], v0[3]); w.z = cvt_pk_bf16(v1[0], v1[1]); w.w = cvt_pk_bf16(v1[2], v1[3]); return w; }
__device__ __forceinline__ void unpack8(const u32x4& w, f32x4& v0, f32x4& v1) { v0 = (f32x4){bf_lo(w.x), bf_hi(w.x), bf_lo(w.y), bf_hi(w.y)}; v1 = (f32x4){bf_lo(w.z), bf_hi(w.z), bf_lo(w.w), bf_hi(w.w)}; }

struct EpiProj {
    bf16_t* proj; bf16_t* gates; const float* lb;
    __device__ __forceinline__ bool keep(const Unit&) const { return false; }
    __device__ __forceinline__ void operator()(f32x4 (&acc)[2][2][4][2], const Unit& u, int wr, int wc, int fr, int fq) const {
        const int row0 = u.pm * BM + wr * 64 + fr, pn = u.pn;
        bf16_t* base; int ldc, colt, kind;
        if (pn < 14) { base = proj; ldc = PROJ_LD; colt = pn * BM; kind = (pn == 2 || pn == 3) ? 1 : 0; } else { base = gates; ldc = GATE_LD; colt = (pn - 14) * BM; kind = 2; }
        const int col0 = colt + wc * 32 + 8 * fq;
        f32x4 lbv[2][2];
        if (kind == 1) {
#pragma unroll
            for (int bj = 0; bj < 2; ++bj) { const float* lp = lb + (pn - 2) * BM + bj * HALF + wc * 32 + 8 * fq; lbv[bj][0] = *(const f32x4*)lp; lbv[bj][1] = *(const f32x4*)(lp + 4); }
        }
#pragma unroll
        for (int ai = 0; ai < 2; ++ai)
#pragma unroll
            for (int m = 0; m < 4; ++m) { bf16_t* rowp = base + (size_t)(row0 + ai * HALF + m * 16) * ldc + col0;
#pragma unroll
                for (int bj = 0; bj < 2; ++bj) { f32x4 v0 = acc[ai][bj][m][0], v1 = acc[ai][bj][m][1];
                    if (kind == 1) {
#pragma unroll
                        for (int j = 0; j < 4; ++j) { const float l0 = lbv[bj][0][j], l1 = lbv[bj][1][j];
                            v0[j] = fast_log(l0 + (1.0f - l0) * sigmoidf_(v0[j])); v1[j] = fast_log(l1 + (1.0f - l1) * sigmoidf_(v1[j])); }
                    } else if (kind == 2) {
#pragma unroll
                        for (int j = 0; j < 4; ++j) { v0[j] = sigmoidf_(v0[j]); v1[j] = sigmoidf_(v1[j]); }
                    }
                    *(u32x4*)(rowp + bj * HALF) = pack8(v0, v1); } }
    }
};
struct EpiMerge {
    const bf16_t* gates; bf16_t* out;
    __device__ __forceinline__ bool keep(const Unit& u) const { return u.sub == 0; }
    __device__ __forceinline__ void operator()(f32x4 (&acc)[2][2][4][2], const Unit& u, int wr, int wc, int fr, int fq) const {
        const int row0 = u.pm * BM + wr * 64 + fr, col0 = u.pn * BM + wc * 32 + 8 * fq;
#pragma unroll
        for (int ai = 0; ai < 2; ++ai)
#pragma unroll
            for (int m = 0; m < 4; ++m) { const size_t r = (size_t)(row0 + ai * HALF + m * 16); const bf16_t* gp = gates + r * GATE_LD + col0;
#pragma unroll
                for (int bj = 0; bj < 2; ++bj) {
                    f32x4 b0, b1; unpack8(*(const u32x4*)(gp + 1024 + bj * HALF), b0, b1);
                    if (u.sub == 0) { f32x4 a0, a1; unpack8(*(const u32x4*)(gp + bj * HALF), a0, a1);
#pragma unroll
                        for (int j = 0; j < 4; ++j) { acc[ai][bj][m][0][j] *= a0[j] * fast_rcp(fmaxf(b0[j], 1e-30f)); acc[ai][bj][m][1][j] *= a1[j] * fast_rcp(fmaxf(b1[j], 1e-30f)); }
                    } else {
                        *(u32x4*)(out + r * D + col0 + bj * HALF) = pack8(acc[ai][bj][m][0] * b0, acc[ai][bj][m][1] * b1);
                    } } }
    }
};
struct EpiMix {
    const float* x; const float* mod; bf16_t* h;
    __device__ __forceinline__ bool keep(const Unit&) const { return false; }
    __device__ __forceinline__ void operator()(f32x4 (&acc)[2][2][4][2], const Unit& u, int wr, int wc, int fr, int fq) const {
        const int row0 = u.pm * BM + wr * 64 + fr, col0 = u.pn * BM + wc * 32 + 8 * fq, b = u.pm >> 3;
        f32x4 g[2][2];
#pragma unroll
        for (int bj = 0; bj < 2; ++bj) { const float* gp = mod + (size_t)b * 6144 + 2048 + col0 + bj * HALF; g[bj][0] = *(const f32x4*)gp; g[bj][1] = *(const f32x4*)(gp + 4); }
#pragma unroll
        for (int ai = 0; ai < 2; ++ai)
#pragma unroll
            for (int m = 0; m < 4; ++m) { const size_t r = (size_t)(row0 + ai * HALF + m * 16);
#pragma unroll
                for (int bj = 0; bj < 2; ++bj) { const float* xp = x + r * D + col0 + bj * HALF; const f32x4 x0 = *(const f32x4*)xp, x1 = *(const f32x4*)(xp + 4);
                    *(u32x4*)(h + r * D + col0 + bj * HALF) = pack8(x0 + g[bj][0] * acc[ai][bj][m][0], x1 + g[bj][1] * acc[ai][bj][m][1]); }
                asm volatile("" ::: "memory"); }
    }
};
struct EpiSwiglu {
    const float* b1; bf16_t* act;
    __device__ __forceinline__ bool keep(const Unit&) const { return false; }
    __device__ __forceinline__ void operator()(f32x4 (&acc)[2][2][4][2], const Unit& u, int wr, int wc, int fr, int fq) const {
        const int row0 = u.pm * BM + wr * 64 + fr, hc0 = u.pn * HALF + wc * 32 + 8 * fq;
        const float* bp = b1 + (size_t)u.e * 2048 + hc0;
        const f32x4 bg0 = *(const f32x4*)bp, bg1 = *(const f32x4*)(bp + 4), bl0 = *(const f32x4*)(bp + 1024), bl1 = *(const f32x4*)(bp + 1028);
#pragma unroll
        for (int ai = 0; ai < 2; ++ai)
#pragma unroll
            for (int m = 0; m < 4; ++m) { const size_t r = (size_t)(row0 + ai * HALF + m * 16);
                f32x4 o0, o1;
#pragma unroll
                for (int j = 0; j < 4; ++j) {
                    float gl = fminf(acc[ai][0][m][0][j] + bg0[j], SW_LIMIT), li = fminf(fmaxf(acc[ai][1][m][0][j] + bl0[j], -SW_LIMIT), SW_LIMIT);
                    o0[j] = gl * sigmoidf_(SW_ALPHA * gl) * (li + 1.0f);
                    gl = fminf(acc[ai][0][m][1][j] + bg1[j], SW_LIMIT); li = fminf(fmaxf(acc[ai][1][m][1][j] + bl1[j], -SW_LIMIT), SW_LIMIT);
                    o1[j] = gl * sigmoidf_(SW_ALPHA * gl) * (li + 1.0f); }
                *(u32x4*)(act + r * DFF + hc0) = pack8(o0, o1); }
    }
};
struct EpiMoeOut {
    const float* b2; const int* rslot; const float* rw; bf16_t* yo01; bf16_t* yo23;
    __device__ __forceinline__ bool keep(const Unit&) const { return false; }
    __device__ __forceinline__ void operator()(f32x4 (&acc)[2][2][4][2], const Unit& u, int wr, int wc, int fr, int fq) const {
        const int row0 = u.pm * BM + wr * 64 + fr, col0 = u.pn * BM + wc * 32 + 8 * fq;
        f32x4 bv[2][2];
#pragma unroll
        for (int bj = 0; bj < 2; ++bj) { const float* bp = b2 + (size_t)u.e * D + col0 + bj * HALF; bv[bj][0] = *(const f32x4*)bp; bv[bj][1] = *(const f32x4*)(bp + 4); }
#pragma unroll
        for (int ai = 0; ai < 2; ++ai)
#pragma unroll
            for (int m = 0; m < 4; ++m) { const int r = row0 + ai * HALF + m * 16; const int slot = rslot[r]; const float w = rw[r];
                if (slot >= 0) { const int tok = slot >> 2, j = slot & 3;
                    bf16_t* dst = (j < 2 ? yo01 + (size_t)tok * 2048 + (size_t)j * 1024 : yo23 + (size_t)tok * 2048 + (size_t)(j - 2) * 1024) + col0;
#pragma unroll
                    for (int bj = 0; bj < 2; ++bj) *(u32x4*)(dst + bj * HALF) = pack8((acc[ai][bj][m][0] + bv[bj][0]) * w, (acc[ai][bj][m][1] + bv[bj][1]) * w); } }
    }
};
}

struct Args { const float* in[20]; float* out; unsigned char* ws; int ph_lo, ph_hi; };

__device__ __forceinline__ void transpose_item(const float* W, int N, bf16_t* WT, int ldwt, int k0, int n0, int dst_row0, LAS float* scr, int lane) {
    const int ks = lane >> 4, n4 = (lane & 15) * 4;
    f32x4 v[16];
#pragma unroll
    for (int i = 0; i < 16; ++i) v[i] = *(const f32x4*)(W + (size_t)(k0 + 4 * i + ks) * N + n0 + n4);
#pragma unroll
    for (int i = 0; i < 16; ++i) { LAS float* s = scr + (4 * i + ks) * 65 + n4; s[0] = v[i][0]; s[1] = v[i][1]; s[2] = v[i][2]; s[3] = v[i][3]; }
    LDS_WAIT(); asm volatile("" ::: "memory");
    const int kc = lane & 7;
#pragma unroll
    for (int p = 0; p < 8; ++p) { const int n = (lane >> 3) + 8 * p; const LAS float* s = scr + (8 * kc) * 65 + n;
        u32x4 o; o.x = cvt_pk_bf16(s[0], s[65]); o.y = cvt_pk_bf16(s[2 * 65], s[3 * 65]); o.z = cvt_pk_bf16(s[4 * 65], s[5 * 65]); o.w = cvt_pk_bf16(s[6 * 65], s[7 * 65]);
        *(u32x4*)(WT + (size_t)(dst_row0 + n) * ldwt + k0 + 8 * kc) = o; }
    LDS_WAIT(); asm volatile("" ::: "memory");
}

__global__ void __launch_bounds__(NTHREADS, 2) fwd_kernel(Args args) {
    extern __shared__ __attribute__((aligned(16))) unsigned char lds_raw[];
    LAS unsigned char* lds = (LAS unsigned char*)lds_raw;
    volatile LAS unsigned* MISC = (volatile LAS unsigned*)(lds + MISC_OFF);
    const int G = gridDim.x, bid = blockIdx.x;
    const int wave_sg = __builtin_amdgcn_readfirstlane((int)threadIdx.x >> 6);
#define PHASE_IDS() int lane = (int)__builtin_amdgcn_mbcnt_hi(~0u, __builtin_amdgcn_mbcnt_lo(~0u, 0u)); asm volatile("" : "+v"(lane)); const int wave = wave_sg; const int tid = wave * 64 + lane; const int gw = bid * NWAVES + wave, NGW = G * NWAVES; (void)lane; (void)wave; (void)gw; (void)NGW
#define CAS __attribute__((address_space(4)))
#define PHASE_ARGS() const CAS Args* ap = (const CAS Args*)__builtin_amdgcn_kernarg_segment_ptr(); asm volatile("" : "+s"(ap)); unsigned char* const ws = ap->ws; unsigned* const ctl = (unsigned*)(ws + WS_CTL); (void)ctl
#define ARG(i) (ap->in[i])
#define WSP(T, off) ((T*)(ws + (off)))
    enum { I_X = 0, I_C, I_WADA, I_BADA, I_NMIX, I_WIN, I_LBT, I_HGNW, I_CONVW, I_WHG, I_WCV, I_WMIX, I_NFFN, I_WR, I_BR, I_W1, I_B1, I_W2, I_B2, I_NFIN };
    { PHASE_IDS(); for (int u = tid; u < 64; u += NTHREADS) MISC[u] = 0u; }
    __syncthreads();
    XcdBarrier bar; bar.bar = nullptr; bar.x = 0; bar.st = nullptr;
#if MK_ONE_LAUNCH
    { PHASE_ARGS(); bar = xcd_barrier_post(ctl + CW_BAR, MISC + 8); }
#define GRID_BAR() xcd_barrier(bar)
#else
#define GRID_BAR() do { } while (0)
#endif
    const int lo = args.ph_lo, hi = args.ph_hi;
#ifndef PH_MASK
#define PH_MASK 0x7ff
#endif
#define IN(k) (((PH_MASK >> (k)) & 1) && lo <= (k) && (k) < hi)
#define BOTH(k) (IN(k) && IN((k) + 1))

    if (IN(0)) { PHASE_IDS(); PHASE_ARGS();
        const float* cvec = ARG(I_C); const float* w_ada = ARG(I_WADA); const float* b_ada = ARG(I_BADA); const float* lbtab = ARG(I_LBT);
        const float* w_in = ARG(I_WIN); const float* w_hg = ARG(I_WHG); const float* w_cv = ARG(I_WCV); const float* w_mix = ARG(I_WMIX); const float* w1 = ARG(I_W1); const float* w2 = ARG(I_W2);
        float* MOD = WSP(float, WS_MOD); float* LB = WSP(float, WS_LB);
        bf16_t* Win_t = WSP(bf16_t, WS_WIN); bf16_t* Whg_t = WSP(bf16_t, WS_WHG); bf16_t* Wcv_t = WSP(bf16_t, WS_WCV); bf16_t* Wmix_t = WSP(bf16_t, WS_WMIX); bf16_t* W1_t = WSP(bf16_t, WS_W1); bf16_t* W2_t = WSP(bf16_t, WS_W2);
        LAS float* scr = (LAS float*)(lds + wave * 16640);
        for (int it = gw; it < 384; it += NGW) {
            const int n0 = it * 16, cl = lane & 15, kq = lane >> 4;
            float acc[32];
#pragma unroll
            for (int b = 0; b < 32; ++b) acc[b] = 0.f;
            for (int ch = 0; ch < 16; ++ch) {
                { const int b = lane >> 1, part = lane & 1;
#pragma unroll
                    for (int q = 0; q < 4; ++q) {
                        const float* cp = cvec + (size_t)b * D + q * 256 + ch * 16 + part * 8;
                        const f32x4 c0 = *(const f32x4*)cp, c1 = *(const f32x4*)(cp + 4);
#pragma unroll
                        for (int j = 0; j < 4; ++j) { scr[(q * 16 + part * 8 + j) * 32 + b] = c0[j] * sigmoidf_(c0[j]); scr[(q * 16 + part * 8 + 4 + j) * 32 + b] = c1[j] * sigmoidf_(c1[j]); }
                    } }
                float wv[16];
#pragma unroll
                for (int kk = 0; kk < 16; ++kk) wv[kk] = w_ada[(size_t)(kq * 256 + ch * 16 + kk) * 6144 + n0 + cl];
                LDS_WAIT(); asm volatile("" ::: "memory");
#pragma unroll
                for (int kk = 0; kk < 16; ++kk) {
                    const LAS f32x4* sp = (const LAS f32x4*)(scr + (kq * 16 + kk) * 32);
#pragma unroll
                    for (int b4 = 0; b4 < 8; ++b4) { const f32x4 s = sp[b4]; acc[4 * b4] += wv[kk] * s[0]; acc[4 * b4 + 1] += wv[kk] * s[1]; acc[4 * b4 + 2] += wv[kk] * s[2]; acc[4 * b4 + 3] += wv[kk] * s[3]; }
                }
                LDS_WAIT(); asm volatile("" ::: "memory");
            }
            const float bias = b_ada[n0 + cl];
#pragma unroll
            for (int b = 0; b < 32; ++b) { float v = acc[b]; v += __shfl_xor(v, 16); v += __shfl_xor(v, 32); if (kq == 0) MOD[(size_t)b * 6144 + n0 + cl] = v + bias; }
        }
        if (bid == (G > 1 ? 1 : 0)) { const int k = tid; const float l0 = lbtab[k], l1 = lbtab[HW + k]; LB[k] = fast_rcp(1.0f + fast_exp(l1 - l0)); }
        {
            constexpr int I_IN = 16 * 88, I_HG = 8 * 16, I_CV = 8 * 16, I_MIX = 16 * 16, I_W1 = 32 * 16 * 32, I_W2 = 32 * 16 * 16;
            constexpr int NITEMS = I_IN + I_HG + I_CV + I_MIX + I_W1 + I_W2;
            for (int it = gw; it < NITEMS; it += NGW) {
                int r = it;
                if (r < I_IN) { const int kb = r / 88, nb = r % 88; transpose_item(w_in, INC, Win_t, D, kb * 64, nb * 64, nb * 64, scr, lane); continue; } r -= I_IN;
                if (r < I_HG) { const int kb = r / 16, nb = r % 16; transpose_item(w_hg, D, Whg_t, HW, kb * 64, nb * 64, nb * 64, scr, lane); continue; } r -= I_HG;
                if (r < I_CV) { const int kb = r / 16, nb = r % 16; transpose_item(w_cv, D, Wcv_t, HW, kb * 64, nb * 64, nb * 64, scr, lane); continue; } r -= I_CV;
                if (r < I_MIX) { const int kb = r / 16, nb = r % 16; transpose_item(w_mix, D, Wmix_t, D, kb * 64, nb * 64, nb * 64, scr, lane); continue; } r -= I_MIX;
                if (r < I_W1) { const int e = r / 512, q = r % 512, kb = q / 32, nb = q % 32;
                    const int pn = nb >> 2, wi = (nb & 3) * 64; const int src = wi < 128 ? pn * 128 + wi : 1024 + pn * 128 + (wi - 128);
                    transpose_item(w1 + (size_t)e * D * 2048, 2048, W1_t + (size_t)e * 2048 * D, D, kb * 64, src, nb * 64, scr, lane); continue; } r -= I_W1;
                { const int e = r / 256, q = r % 256, kb = q / 16, nb = q % 16;
                    transpose_item(w2 + (size_t)e * DFF * D, D, W2_t + (size_t)e * D * DFF, DFF, kb * 64, nb * 64, nb * 64, scr, lane); }
            }
        }
        if (BOTH(0)) GRID_BAR();
    }

    if (IN(1)) { PHASE_IDS(); PHASE_ARGS();
        const float* x = ARG(I_X); const float* norm_mix_w = ARG(I_NMIX); const float* MOD = WSP(float, WS_MOD); bf16_t* U = WSP(bf16_t, WS_U);
        for (int m0 = gw * 32; m0 < NTOK; m0 += NGW * 32) {
            const int b = m0 >> 11;
            f32x4 A[4], Sh[4];
#pragma unroll
            for (int j = 0; j < 4; ++j) { const int k = 4 * lane + 256 * j; const f32x4 w = *(const f32x4*)(norm_mix_w + k), sc = *(const f32x4*)(MOD + (size_t)b * 6144 + 1024 + k);
                A[j] = w * (sc + 1.0f); Sh[j] = *(const f32x4*)(MOD + (size_t)b * 6144 + k); }
            for (int r = 0; r < 32; ++r) {
                const float* xr = x + (size_t)(m0 + r) * D; f32x4 v[4]; float s = 0.f;
#pragma unroll
                for (int j = 0; j < 4; ++j) { v[j] = *(const f32x4*)(xr + 4 * lane + 256 * j); s += (v[j][0] * v[j][0] + v[j][1] * v[j][1]) + (v[j][2] * v[j][2] + v[j][3] * v[j][3]); }
                const float rs = __builtin_amdgcn_rsqf(wave_sum(s) * (1.0f / D) + EPS);
                bf16_t* ur = U + (size_t)(m0 + r) * D;
#pragma unroll
                for (int j = 0; j < 4; ++j) { const f32x4 o = v[j] * rs * A[j] + Sh[j]; u32x2 w; w.x = cvt_pk_bf16(o[0], o[1]); w.y = cvt_pk_bf16(o[2], o[3]); *(u32x2*)(ur + 4 * lane + 256 * j) = w; }
            }
        }
        if (BOTH(1)) GRID_BAR();
    }

    if (IN(2)) { PHASE_ARGS();
        gm::DenseOrder S{NTOK / 256, INC / 256, G, bid, 1}; gm::DenseA AM{D, 0u}; gm::EpiProj E{WSP(bf16_t, WS_PROJ), (bf16_t*)ap->out, WSP(float, WS_LB)};
        gm::gemm_phase(wave_sg, lds, (const char*)WSP(bf16_t, WS_U), (const char*)WSP(bf16_t, WS_WIN), D, 0, 0u, S, E, AM);
        if (BOTH(2)) GRID_BAR();
    }

    if (IN(3)) { PHASE_IDS(); PHASE_ARGS();
        const float* hg_norm_w = ARG(I_HGNW); const float* conv_w = ARG(I_CONVW); const bf16_t* PROJ = WSP(bf16_t, WS_PROJ); bf16_t* OB = WSP(bf16_t, WS_O); bf16_t* CVB = WSP(bf16_t, WS_CV);
        const int nchainblk = (G >= 256) ? 128 : (G >= 2 ? G / 2 : 1);
        if (bid < nchainblk) {
            constexpr int LDQ = 136, LDT = 72;
            LAS bf16_t* QT = (LAS bf16_t*)(lds);
            LAS bf16_t* KT = QT + 64 * LDQ;
            LAS bf16_t* QB = KT + 64 * LDQ;
            LAS bf16_t* KBT = QB + 64 * LDQ;
            LAS bf16_t* VT = KBT + 128 * LDT;
            LAS bf16_t* PM = VT + 128 * LDT;
            LAS bf16_t* ST = PM + 64 * LDT;
            LAS bf16_t* OS = ST + 128 * LDQ;
            LAS float* SEG = (LAS float*)(OS + 64 * LDQ);
            LAS float* DEC = SEG + 8 * 128;
            const int fr = lane & 15, fq = lane >> 4, w = wave;
            for (int chain = bid; chain < BATCH * NHEAD; chain += nchainblk) {
                const int b = chain >> 2, h = chain & 3;
                __syncthreads();
                for (int i = tid; i < 128 * LDQ / 2; i += NTHREADS) ((LAS unsigned*)ST)[i] = 0u;
                f32x4 Sacc[8];
#pragma unroll
                for (int i = 0; i < 8; ++i) Sacc[i] = (f32x4){0.f, 0.f, 0.f, 0.f};
                const int ot = tid >> 3, ocg = tid & 7;
                f32x4 nwv[4];
#pragma unroll
                for (int q = 0; q < 2; ++q) { nwv[2 * q] = *(const f32x4*)(hg_norm_w + q * 64 + 8 * ocg); nwv[2 * q + 1] = *(const f32x4*)(hg_norm_w + q * 64 + 8 * ocg + 4); }
                const bf16_t* pbase = PROJ + (size_t)(b * SEQ) * PROJ_LD + h * DK;
                unsigned rq[8], rl[8], rv[8];
#pragma unroll
                for (int r = 0; r < 8; ++r) { const bf16_t* p = pbase + (size_t)(8 * w + r) * PROJ_LD + 2 * lane; rq[r] = *(const unsigned*)p; rl[r] = *(const unsigned*)(p + 512); rv[r] = *(const unsigned*)(p + 1024); }
                for (int c = 0; c < NCHUNK; ++c) {
                    const int m0 = c * CHUNK;
                    float cs0[8], cs1[8]; { float a0 = 0.f, a1 = 0.f;
#pragma unroll
                        for (int r = 0; r < 8; ++r) { a0 += bf_lo(rl[r]); a1 += bf_hi(rl[r]); cs0[r] = a0; cs1[r] = a1; }
                        *(LAS f32x2*)(SEG + w * 128 + 2 * lane) = (f32x2){a0, a1}; }
                    LDS_WAIT(); __syncthreads();
                    float pre0 = 0.f, pre1 = 0.f, bm0 = 0.f, bm1 = 0.f, bl0 = 0.f, bl1 = 0.f;
#pragma unroll
                    for (int s = 0; s < 8; ++s) { const f32x2 t2 = *(const LAS f32x2*)(SEG + s * 128 + 2 * lane); if (s < w) { pre0 += t2[0]; pre1 += t2[1]; } if (s < 4) { bm0 += t2[0]; bm1 += t2[1]; } bl0 += t2[0]; bl1 += t2[1]; }
                    const float em0 = fast_exp(fmaxf(bm0, -80.f)), em1 = fast_exp(fmaxf(bm1, -80.f));
                    const float el0 = fast_exp(fmaxf(bl0 - bm0, -80.f)), el1 = fast_exp(fmaxf(bl1 - bm1, -80.f));
                    if (w == 0) *(LAS f32x2*)(DEC + 2 * lane) = (f32x2){fast_exp(fmaxf(bl0, -80.f)), fast_exp(fmaxf(bl1, -80.f))};
                    unsigned kb0[4], kb1[4], vt0[4], vt1[4];
#pragma unroll
                    for (int r = 0; r < 8; ++r) {
                        const int t = 8 * w + r;
                        const float lf0 = bf_lo(rl[r]), lf1 = bf_hi(rl[r]);
                        const float d0 = fminf(fmaxf(pre0 + cs0[r] - bm0, -80.f), 80.f), d1 = fminf(fmaxf(pre1 + cs1[r] - bm1, -80.f), 80.f);
                        const float e0 = fast_exp(d0), e1 = fast_exp(d1), i0 = fast_exp(-d0), i1 = fast_exp(-d1);
                        const float kk0 = 1.0f - fast_exp(lf0), kk1 = 1.0f - fast_exp(lf1);
                        const float qt0 = bf_lo(rq[r]) * e0, qt1 = bf_hi(rq[r]) * e1, kt0 = kk0 * i0, kt1 = kk1 * i1;
                        *(LAS unsigned*)(QT + t * LDQ + 2 * lane) = cvt_pk_bf16(qt0, qt1);
                        *(LAS unsigned*)(KT + t * LDQ + 2 * lane) = cvt_pk_bf16(kt0, kt1);
                        *(LAS unsigned*)(QB + t * LDQ + 2 * lane) = cvt_pk_bf16(qt0 * em0, qt1 * em1);
                        const unsigned kbp = cvt_pk_bf16(kt0 * el0, kt1 * el1);
                        if (r & 1) { kb0[r >> 1] |= (kbp << 16); kb1[r >> 1] |= (kbp & 0xffff0000u); vt0[r >> 1] |= (rv[r] << 16); vt1[r >> 1] |= (rv[r] & 0xffff0000u); }
                        else { kb0[r >> 1] = kbp & 0xffffu; kb1[r >> 1] = kbp >> 16; vt0[r >> 1] = rv[r] & 0xffffu; vt1[r >> 1] = rv[r] >> 16; }
                    }
                    *(LAS u32x4*)(KBT + (2 * lane) * LDT + 8 * w) = (u32x4){kb0[0], kb0[1], kb0[2], kb0[3]};
                    *(LAS u32x4*)(KBT + (2 * lane + 1) * LDT + 8 * w) = (u32x4){kb1[0], kb1[1], kb1[2], kb1[3]};
                    *(LAS u32x4*)(VT + (2 * lane) * LDT + 8 * w) = (u32x4){vt0[0], vt0[1], vt0[2], vt0[3]};
                    *(LAS u32x4*)(VT + (2 * lane + 1) * LDT + 8 * w) = (u32x4){vt1[0], vt1[1], vt1[2], vt1[3]};
                    LDS_WAIT(); __syncthreads();
                    u32x4 gg[2];
                    { const bf16_t* gp = pbase + (size_t)(m0 + ot) * PROJ_LD + 1536 + 8 * ocg; gg[0] = *(const u32x4*)gp; gg[1] = *(const u32x4*)(gp + 64); }
                    if (c + 1 < NCHUNK) {
#pragma unroll
                        for (int r = 0; r < 8; ++r) { const bf16_t* p = pbase + (size_t)(m0 + CHUNK + 8 * w + r) * PROJ_LD + 2 * lane; rq[r] = *(const unsigned*)p; rl[r] = *(const unsigned*)(p + 512); rv[r] = *(const unsigned*)(p + 1024); }
                    }
#pragma unroll
                    for (int x2 = 0; x2 < 2; ++x2) { const int id = 2 * w + x2, si = id >> 2, ti = id & 3;
                        f32x4 sc = (f32x4){0.f, 0.f, 0.f, 0.f};
                        if (si <= ti) {
#pragma unroll
                            for (int ks = 0; ks < 4; ++ks) { const bf16x8 a = *(const LAS bf16x8*)(KT + (16 * si + fr) * LDQ + 32 * ks + 8 * fq), bb = *(const LAS bf16x8*)(QT + (16 * ti + fr) * LDQ + 32 * ks + 8 * fq);
                                sc = __builtin_amdgcn_mfma_f32_16x16x32_bf16(a, bb, sc, 0, 0, 0); }
                            const int t = 16 * ti + fr, s0 = 16 * si + 4 * fq;
#pragma unroll
                            for (int j = 0; j < 4; ++j) sc[j] = (s0 + j <= t) ? sc[j] : 0.f;
                        }
                        *(LAS u32x2*)(PM + (16 * ti + fr) * LDT + 16 * si + 4 * fq) = (u32x2){cvt_pk_bf16(sc[0], sc[1]), cvt_pk_bf16(sc[2], sc[3])};
                    }
                    f32x4 oacc[4];
                    { bf16x8 sa[4];
#pragma unroll
                        for (int ks = 0; ks < 4; ++ks) sa[ks] = *(const LAS bf16x8*)(ST + (16 * w + fr) * LDQ + 32 * ks + 8 * fq);
#pragma unroll
                        for (int ti = 0; ti < 4; ++ti) { oacc[ti] = (f32x4){0.f, 0.f, 0.f, 0.f};
#pragma unroll
                            for (int ks = 0; ks < 4; ++ks) { const bf16x8 bb = *(const LAS bf16x8*)(QB + (16 * ti + fr) * LDQ + 32 * ks + 8 * fq); oacc[ti] = __builtin_amdgcn_mfma_f32_16x16x32_bf16(sa[ks], bb, oacc[ti], 0, 0, 0); } } }
                    LDS_WAIT(); __syncthreads();
                    { bf16x8 va[2];
#pragma unroll
                        for (int ks = 0; ks < 2; ++ks) va[ks] = *(const LAS bf16x8*)(VT + (16 * w + fr) * LDT + 32 * ks + 8 * fq);
#pragma unroll
                        for (int ti = 0; ti < 4; ++ti)
#pragma unroll
                            for (int ks = 0; ks < 2; ++ks) { const bf16x8 bb = *(const LAS bf16x8*)(PM + (16 * ti + fr) * LDT + 32 * ks + 8 * fq); oacc[ti] = __builtin_amdgcn_mfma_f32_16x16x32_bf16(va[ks], bb, oacc[ti], 0, 0, 0); }
#pragma unroll
                        for (int i = 0; i < 8; ++i) { const f32x4 dv = *(const LAS f32x4*)(DEC + 16 * i + 4 * fq); Sacc[i] = Sacc[i] * dv;
#pragma unroll
                            for (int ks = 0; ks < 2; ++ks) { const bf16x8 a = *(const LAS bf16x8*)(KBT + (16 * i + fr) * LDT + 32 * ks + 8 * fq); Sacc[i] = __builtin_amdgcn_mfma_f32_16x16x32_bf16(a, va[ks], Sacc[i], 0, 0, 0); } } }
#pragma unroll
                    for (int ti = 0; ti < 4; ++ti) *(LAS u32x2*)(OS + (16 * ti + fr) * LDQ + 16 * w + 4 * fq) = (u32x2){cvt_pk_bf16(oacc[ti][0], oacc[ti][1]), cvt_pk_bf16(oacc[ti][2], oacc[ti][3])};
#pragma unroll
                    for (int i = 0; i < 8; ++i) *(LAS u32x2*)(ST + (16 * w + fr) * LDQ + 16 * i + 4 * fq) = (u32x2){cvt_pk_bf16(Sacc[i][0], Sacc[i][1]), cvt_pk_bf16(Sacc[i][2], Sacc[i][3])};
                    LDS_WAIT(); __syncthreads();
                    { f32x4 o[4]; const u32x4 ow0 = *(const LAS u32x4*)(OS + ot * LDQ + 8 * ocg), ow1 = *(const LAS u32x4*)(OS + ot * LDQ + 64 + 8 * ocg); gm::unpack8(ow0, o[0], o[1]); gm::unpack8(ow1, o[2], o[3]);
                        float ss = 0.f;
#pragma unroll
                        for (int q = 0; q < 4; ++q) ss += (o[q][0] * o[q][0] + o[q][1] * o[q][1]) + (o[q][2] * o[q][2] + o[q][3] * o[q][3]);
                        ss += __shfl_xor(ss, 1); ss += __shfl_xor(ss, 2); ss += __shfl_xor(ss, 4);
                        const float rn = __builtin_amdgcn_rsqf(ss * (1.0f / 128.0f) + EPS);
                        bf16_t* op = OB + (size_t)(b * SEQ + m0 + ot) * HW + h * DK + 8 * ocg;
#pragma unroll
                        for (int q = 0; q < 2; ++q) { f32x4 g0, g1; gm::unpack8(gg[q], g0, g1);
#pragma unroll
                            for (int j = 0; j < 4; ++j) { g0[j] = g0[j] * sigmoidf_(g0[j]); g1[j] = g1[j] * sigmoidf_(g1[j]); }
                            *(u32x4*)(op + 64 * q) = gm::pack8(o[2 * q] * rn * nwv[2 * q] * g0, o[2 * q + 1] * rn * nwv[2 * q + 1] * g1); } }
                }
            }
        } else {
            const int nconv = G - nchainblk;
            f32x4 cw[3][2];
#pragma unroll
            for (int j = 0; j < 3; ++j) { cw[j][0] = *(const f32x4*)(conv_w + j * 512 + 8 * lane); cw[j][1] = *(const f32x4*)(conv_w + j * 512 + 8 * lane + 4); }
            for (int it = bid - nchainblk; it < BATCH * 8; it += nconv) {
                const int b = it >> 3, t0 = (it & 7) * 256 + wave * 32;
                const bf16_t* pb = PROJ + (size_t)(b * SEQ) * PROJ_LD + 2048 + 8 * lane;
                f32x4 p1[2], p2[2];
#pragma unroll
                for (int q = 0; q < 2; ++q) { p1[q] = (f32x4){0.f, 0.f, 0.f, 0.f}; p2[q] = p1[q]; }
                if (t0 > 0) {
                    f32x4 a0, a1, c0, c1;
                    gm::unpack8(*(const u32x4*)(pb + (size_t)(t0 - 2) * PROJ_LD + 512), a0, a1); gm::unpack8(*(const u32x4*)(pb + (size_t)(t0 - 2) * PROJ_LD + 1024), c0, c1); p2[0] = a0 * c0; p2[1] = a1 * c1;
                    gm::unpack8(*(const u32x4*)(pb + (size_t)(t0 - 1) * PROJ_LD + 512), a0, a1); gm::unpack8(*(const u32x4*)(pb + (size_t)(t0 - 1) * PROJ_LD + 1024), c0, c1); p1[0] = a0 * c0; p1[1] = a1 * c1;
                }
                for (int r = 0; r < 32; ++r) { const size_t ro = (size_t)(t0 + r) * PROJ_LD;
                    f32x4 a0, a1, c0, c1, g0, g1;
                    gm::unpack8(*(const u32x4*)(pb + ro + 512), a0, a1); gm::unpack8(*(const u32x4*)(pb + ro + 1024), c0, c1); gm::unpack8(*(const u32x4*)(pb + ro), g0, g1);
                    const f32x4 q0 = a0 * c0, q1 = a1 * c1;
                    const f32x4 y0 = g0 * (cw[0][0] * p2[0] + cw[1][0] * p1[0] + cw[2][0] * q0), y1 = g1 * (cw[0][1] * p2[1] + cw[1][1] * p1[1] + cw[2][1] * q1);
                    *(u32x4*)(CVB + (size_t)(b * SEQ + t0 + r) * HW + 8 * lane) = gm::pack8(y0, y1);
                    p2[0] = p1[0]; p2[1] = p1[1]; p1[0] = q0; p1[1] = q1; }
            }
        }
        if (BOTH(3)) GRID_BAR();
    }

    if (IN(4)) { PHASE_ARGS();
        gm::DenseOrder S{NTOK / 256, D / 256, G, bid, 2}; gm::DenseA AM{HW, (unsigned)(WS_CV - WS_O)}; gm::EpiMerge E{(const bf16_t*)ap->out, WSP(bf16_t, WS_U)};
        gm::gemm_phase(wave_sg, lds, (const char*)WSP(bf16_t, WS_O), (const char*)WSP(bf16_t, WS_WHG), HW, 0, (unsigned)(WS_WCV - WS_WHG), S, E, AM);
        if (BOTH(4)) GRID_BAR();
    }

    if (IN(5)) { PHASE_ARGS();
        gm::DenseOrder S{NTOK / 256, D / 256, G, bid, 1}; gm::DenseA AM{D, 0u}; gm::EpiMix E{ARG(I_X), WSP(float, WS_MOD), WSP(bf16_t, WS_H)};
        gm::gemm_phase(wave_sg, lds, (const char*)WSP(bf16_t, WS_U), (const char*)WSP(bf16_t, WS_WMIX), D, 0, 0u, S, E, AM);
        if (BOTH(5)) GRID_BAR();
    }

    if (IN(6)) { PHASE_IDS(); PHASE_ARGS();
        const float* norm_ffn_w = ARG(I_NFFN); const float* w_router = ARG(I_WR); const float* b_router = ARG(I_BR); const float* MOD = WSP(float, WS_MOD);
        const bf16_t* HB = WSP(bf16_t, WS_H); bf16_t* U = WSP(bf16_t, WS_U); int* TOPI = WSP(int, WS_TOPI); float* TOPP = WSP(float, WS_TOPP); int* POS = WSP(int, WS_POS);
        LAS float* WRT = (LAS float*)lds;
        LAS unsigned* LCNT = (LAS unsigned*)(lds + 131072);
        LAS unsigned* LBASE = LCNT + 32;
        LAS unsigned* LASS = LCNT + 64;
        for (int i = tid; i < 32 * 1024; i += NTHREADS) { const int e = i >> 10, k = i & 1023; WRT[i] = w_router[(size_t)k * NE + e]; }
        for (int tb = bid; tb < NTOK / 256; tb += G) {
            if (tid < 32) LCNT[tid] = 0u;
            LDS_WAIT(); __syncthreads();
            const int b = (tb * 256) >> 11;
            f32x4 A[4], Sh[4];
#pragma unroll
            for (int j = 0; j < 4; ++j) { const int k = 4 * lane + 256 * j; const f32x4 w = *(const f32x4*)(norm_ffn_w + k), sc = *(const f32x4*)(MOD + (size_t)b * 6144 + 4096 + k);
                A[j] = w * (sc + 1.0f); Sh[j] = *(const f32x4*)(MOD + (size_t)b * 6144 + 3072 + k); }
            const int myexp = ((lane >> 5) & 1) * 16 + ((lane >> 4) & 1) * 8 + ((lane >> 3) & 1) * 4 + ((lane >> 2) & 1) * 2 + ((lane >> 1) & 1);
            const float mybr = b_router[myexp];
            for (int p = 0; p < 16; ++p) {
                const int ltok = wave * 32 + 2 * p, tok = tb * 256 + ltok;
                f32x4 uu[2][4];
#pragma unroll
                for (int xx = 0; xx < 2; ++xx) {
                    const bf16_t* hr = HB + (size_t)(tok + xx) * D; float s = 0.f;
#pragma unroll
                    for (int j = 0; j < 4; ++j) { const u32x2 w = *(const u32x2*)(hr + 4 * lane + 256 * j); uu[xx][j] = (f32x4){bf_lo(w.x), bf_hi(w.x), bf_lo(w.y), bf_hi(w.y)};
                        s += (uu[xx][j][0] * uu[xx][j][0] + uu[xx][j][1] * uu[xx][j][1]) + (uu[xx][j][2] * uu[xx][j][2] + uu[xx][j][3] * uu[xx][j][3]); }
                    const float rs = __builtin_amdgcn_rsqf(wave_sum(s) * (1.0f / D) + EPS);
                    bf16_t* ur = U + (size_t)(tok + xx) * D;
#pragma unroll
                    for (int j = 0; j < 4; ++j) { uu[xx][j] = uu[xx][j] * rs * A[j] + Sh[j]; u32x2 w; w.x = cvt_pk_bf16(uu[xx][j][0], uu[xx][j][1]); w.y = cvt_pk_bf16(uu[xx][j][2], uu[xx][j][3]); *(u32x2*)(ur + 4 * lane + 256 * j) = w; }
                }
                float a0[32], a1[32];
#pragma unroll
                for (int e = 0; e < 32; ++e) { float s0 = 0.f, s1 = 0.f;
#pragma unroll
                    for (int j = 0; j < 4; ++j) { const f32x4 w = *(const LAS f32x4*)(WRT + e * 1024 + 4 * lane + 256 * j);
                        s0 += (w[0] * uu[0][j][0] + w[1] * uu[0][j][1]) + (w[2] * uu[0][j][2] + w[3] * uu[0][j][3]);
                        s1 += (w[0] * uu[1][j][0] + w[1] * uu[1][j][1]) + (w[2] * uu[1][j][2] + w[3] * uu[1][j][3]); }
                    a0[e] = s0; a1[e] = s1; }
#define TR_STEP(arr, mask, n) do { const bool sel = (lane & (mask)) != 0; _Pragma("unroll") for (int i = 0; i < (n); ++i) { const float keep = sel ? arr[(n) + i] : arr[i], send = sel ? arr[i] : arr[(n) + i]; arr[i] = keep + __shfl_xor(send, (mask)); } } while (0)
                TR_STEP(a0, 32, 16); TR_STEP(a0, 16, 8); TR_STEP(a0, 8, 4); TR_STEP(a0, 4, 2); TR_STEP(a0, 2, 1); a0[0] += __shfl_xor(a0[0], 1);
                TR_STEP(a1, 32, 16); TR_STEP(a1, 16, 8); TR_STEP(a1, 8, 4); TR_STEP(a1, 4, 2); TR_STEP(a1, 2, 1); a1[0] += __shfl_xor(a1[0], 1);
#pragma unroll
                for (int xx = 0; xx < 2; ++xx) {
                    float val = (xx == 0 ? a0[0] : a1[0]) + mybr;
                    float tv[4]; int tix[4];
#pragma unroll
                    for (int r = 0; r < 4; ++r) { float bv = val; int bi = myexp;
#pragma unroll
                        for (int o = 1; o < 64; o <<= 1) { const float ov = __shfl_xor(bv, o); const int oi = __shfl_xor(bi, o); if (ov > bv || (ov == bv && oi < bi)) { bv = ov; bi = oi; } }
                        tv[r] = bv; tix[r] = bi; if (myexp == bi) val = -3.0e38f; }
                    const float e1 = fast_exp(tv[1] - tv[0]), e2 = fast_exp(tv[2] - tv[0]), e3 = fast_exp(tv[3] - tv[0]); const float inv = fast_rcp(1.0f + e1 + e2 + e3);
                    if (lane < 4) { const int e = lane == 0 ? tix[0] : lane == 1 ? tix[1] : lane == 2 ? tix[2] : tix[3]; const float pr = (lane == 0 ? 1.0f : lane == 1 ? e1 : lane == 2 ? e2 : e3) * inv;
                        TOPI[(size_t)(tok + xx) * 4 + lane] = e; TOPP[(size_t)(tok + xx) * 4 + lane] = pr;
                        const unsigned rank = __hip_atomic_fetch_add(LCNT + e, 1u, __ATOMIC_RELAXED, __HIP_MEMORY_SCOPE_WORKGROUP); LASS[(ltok + xx) * 4 + lane] = ((unsigned)e << 16) | rank; }
                }
            }
            LDS_WAIT(); __syncthreads();
            if (tid < 32) LBASE[tid] = atomicAdd(ctl + CW_CNT + 64 * tid, (unsigned)LCNT[tid]);
            LDS_WAIT(); __syncthreads();
            for (int i = tid; i < 1024; i += NTHREADS) { const unsigned v = LASS[i]; POS[(size_t)tb * 1024 + i] = (int)(LBASE[v >> 16] + (v & 0xffffu)); }
            __syncthreads();
        }
        if (BOTH(6)) GRID_BAR();
    }

    LAS int* PADSTART = (LAS int*)(lds + TBL_OFF); LAS int* TILE_E = PADSTART + 64;
    int ntiles = 0;
    {
        if (lo <= 9 && hi > 7) { PHASE_IDS(); PHASE_ARGS();
            __syncthreads();
            if (tid == 0) { int acc = 0; for (int e = 0; e < NE; ++e) { PADSTART[e] = acc; const int cnt = (int)__hip_atomic_load(ctl + CW_CNT + 64 * e, __ATOMIC_RELAXED, __HIP_MEMORY_SCOPE_AGENT); const int nt_e = (cnt + 255) >> 8; for (int t = 0; t < nt_e; ++t) TILE_E[(acc >> 8) + t] = e; acc += nt_e << 8; } PADSTART[NE] = acc; }
            LDS_WAIT(); __syncthreads();
            ntiles = PADSTART[NE] >> 8;
        }
    }

    if (IN(7)) { PHASE_IDS(); PHASE_ARGS();
        const int* TOPI = WSP(int, WS_TOPI); const float* TOPP = WSP(float, WS_TOPP); const int* POS = WSP(int, WS_POS); int* RTOK = WSP(int, WS_RTOK); int* RSLOT = WSP(int, WS_RSLOT); float* RW = WSP(float, WS_RW);
        for (int i = bid * NTHREADS + tid; i < NASSIGN; i += G * NTHREADS) { const int e = TOPI[i]; const int row = PADSTART[e] + POS[i]; RTOK[row] = i >> 2; RSLOT[row] = i; RW[row] = TOPP[i]; }
        for (int e = bid; e < NE; e += G) { const int cnt = (int)__hip_atomic_load(ctl + CW_CNT + 64 * e, __ATOMIC_RELAXED, __HIP_MEMORY_SCOPE_AGENT);
            for (int r = PADSTART[e] + cnt + tid; r < PADSTART[e + 1]; r += NTHREADS) { RTOK[r] = 0; RSLOT[r] = -1; RW[r] = 0.f; } }
        if (BOTH(7)) GRID_BAR();
    }

    if (IN(8)) { PHASE_ARGS();
        gm::MoeOrder S{ntiles, 2048 / 256, G, bid, TILE_E}; gm::GatherA AM{D, WSP(int, WS_RTOK)}; gm::EpiSwiglu E{ARG(I_B1), WSP(bf16_t, WS_ACT)};
        gm::gemm_phase(wave_sg, lds, (const char*)WSP(bf16_t, WS_U), (const char*)WSP(bf16_t, WS_W1), D, 2048, 0u, S, E, AM);
        if (BOTH(8)) GRID_BAR();
    }

    if (IN(9)) { PHASE_ARGS();
        gm::MoeOrder S{ntiles, D / 256, G, bid, TILE_E}; gm::DenseA AM{DFF, 0u}; gm::EpiMoeOut E{ARG(I_B2), WSP(int, WS_RSLOT), WSP(float, WS_RW), (bf16_t*)ap->out, WSP(bf16_t, WS_YO23)};
        gm::gemm_phase(wave_sg, lds, (const char*)WSP(bf16_t, WS_ACT), (const char*)WSP(bf16_t, WS_W2), DFF, D, 0u, S, E, AM);
        if (BOTH(9)) GRID_BAR();
    }

#if MK_PROBE
    if (lo == 100) { PHASE_IDS(); PHASE_ARGS();
        float* out = ap->out;
        const bf16_t* src = MK_PROBE == 1 ? WSP(bf16_t, WS_U) : MK_PROBE == 3 ? WSP(bf16_t, WS_O) : MK_PROBE == 4 ? WSP(bf16_t, WS_U) : MK_PROBE == 5 ? WSP(bf16_t, WS_H) : WSP(bf16_t, WS_U);
        for (size_t i = (size_t)bid * NTHREADS + tid; i < (size_t)NTOK * D; i += (size_t)G * NTHREADS) {
            float v;
            if (MK_PROBE == 3) { const size_t t = i >> 10, c = i & 1023; v = bf1(c < 512 ? src[t * 512 + c] : WSP(bf16_t, WS_CV)[t * 512 + (c - 512)]); }
            else if (MK_PROBE == 2) { const size_t t = i >> 10, c = i & 1023; const bf16_t* P = WSP(bf16_t, WS_PROJ) + t * PROJ_LD; v = bf1(P[c]) + bf1(P[c + 1024]) + bf1(P[c + 2048]) + (c < 512 ? bf1(P[c + 3072]) : 0.f); }
            else if (MK_PROBE == 6) { const size_t t = i >> 10, c = i & 1023; v = bf1(src[i]) + (c < 4 ? (float)WSP(int, WS_TOPI)[t * 4 + c] : c < 8 ? WSP(float, WS_TOPP)[t * 4 + (c - 4)] : 0.f); }
            else v = bf1(src[i]);
            out[i] = v; }
    }
#endif
    if (IN(10)) { PHASE_IDS(); PHASE_ARGS();
        const float* norm_final_w = ARG(I_NFIN); const float* MOD = WSP(float, WS_MOD); const bf16_t* HB = WSP(bf16_t, WS_H); const bf16_t* YO01 = (const bf16_t*)ap->out; const bf16_t* YO23 = WSP(bf16_t, WS_YO23); float* out = ap->out;
        for (int m0 = gw * 32; m0 < NTOK; m0 += NGW * 32) {
            const int b = m0 >> 11;
            f32x4 gf[4], nf[4];
#pragma unroll
            for (int j = 0; j < 4; ++j) { const int k = 4 * lane + 256 * j; gf[j] = *(const f32x4*)(MOD + (size_t)b * 6144 + 5120 + k); nf[j] = *(const f32x4*)(norm_final_w + k); }
            for (int r = 0; r < 32; ++r) {
                const size_t tok = (size_t)(m0 + r);
                const bf16_t* hr = HB + tok * D; const bf16_t* y0 = YO01 + tok * 2048; const bf16_t* y2 = YO23 + tok * 2048;
                f32x4 v[4]; float s = 0.f;
#pragma unroll
                for (int j = 0; j < 4; ++j) { const int k = 4 * lane + 256 * j;
                    const u32x2 hw = *(const u32x2*)(hr + k), ya = *(const u32x2*)(y0 + k), yb = *(const u32x2*)(y0 + 1024 + k), yc = *(const u32x2*)(y2 + k), yd = *(const u32x2*)(y2 + 1024 + k);
                    f32x4 y = (f32x4){bf_lo(ya.x), bf_hi(ya.x), bf_lo(ya.y), bf_hi(ya.y)};
                    y += (f32x4){bf_lo(yb.x), bf_hi(yb.x), bf_lo(yb.y), bf_hi(yb.y)}; y += (f32x4){bf_lo(yc.x), bf_hi(yc.x), bf_lo(yc.y), bf_hi(yc.y)}; y += (f32x4){bf_lo(yd.x), bf_hi(yd.x), bf_lo(yd.y), bf_hi(yd.y)};
                    v[j] = (f32x4){bf_lo(hw.x), bf_hi(hw.x), bf_lo(hw.y), bf_hi(hw.y)} + gf[j] * y;
                    s += (v[j][0] * v[j][0] + v[j][1] * v[j][1]) + (v[j][2] * v[j][2] + v[j][3] * v[j][3]); }
                const float rs = __builtin_amdgcn_rsqf(wave_sum(s) * (1.0f / D) + EPS);
                float* orow = out + tok * D;
#pragma unroll
                for (int j = 0; j < 4; ++j) *(f32x4*)(orow + 4 * lane + 256 * j) = v[j] * rs * nf[j];
            }
        }
    }
#undef IN
#undef BOTH
}

extern "C" void kernel_launch(void* const* d_in, const int* in_sizes, int n_in, void* d_out, int out_size, void* d_ws, size_t ws_size, hipStream_t stream) {
    static int grid = 0;
    if (grid == 0) {
        if (n_in != 20 || out_size != NTOK * D || ws_size < WS_END) { fprintf(stderr, "kernel_launch: unexpected shapes (n_in %d out %d ws %zu)\n", n_in, out_size, ws_size); grid = -1; return; }
        if (hipFuncSetAttribute((const void*)fwd_kernel, hipFuncAttributeMaxDynamicSharedMemorySize, LDS_BYTES) != hipSuccess) { fprintf(stderr, "kernel_launch: hipFuncSetAttribute failed\n"); grid = -1; return; }
        int dev = 0, cus = 0, per_cu = 0;
        (void)hipGetDevice(&dev); (void)hipDeviceGetAttribute(&cus, hipDeviceAttributeMultiprocessorCount, dev);
        if (hipOccupancyMaxActiveBlocksPerMultiprocessor(&per_cu, (const void*)fwd_kernel, NTHREADS, LDS_BYTES) != hipSuccess || per_cu < 1) fprintf(stderr, "kernel_launch: occupancy query says %d\n", per_cu);
        (void)hipGetLastError();
        grid = cus > 0 ? cus : 256;
    }
    if (grid < 0) return;
    (void)hipMemsetAsync((char*)d_ws + WS_CTL, 0, CTL_ZERO_BYTES, stream);
    Args a{};
    for (int i = 0; i < 20; ++i) a.in[i] = (const float*)d_in[i];
    a.out = (float*)d_out; a.ws = (unsigned char*)d_ws;
#if MK_ONE_LAUNCH
    a.ph_lo = 0; a.ph_hi = NPHASE;
    hipLaunchKernelGGL(fwd_kernel, dim3(grid), dim3(NTHREADS), LDS_BYTES, stream, a);
#else
#if MK_PROBE
    for (int p = 0; p <= MK_PROBE; ++p) { a.ph_lo = p; a.ph_hi = p + 1; hipLaunchKernelGGL(fwd_kernel, dim3(grid), dim3(NTHREADS), LDS_BYTES, stream, a); }
    a.ph_lo = 100; a.ph_hi = 101; hipLaunchKernelGGL(fwd_kernel, dim3(grid), dim3(NTHREADS), LDS_BYTES, stream, a);
#else
    for (int p = 0; p < NPHASE; ++p) { a.ph_lo = p; a.ph_hi = p + 1; hipLaunchKernelGGL(fwd_kernel, dim3(grid), dim3(NTHREADS), LDS_BYTES, stream, a); }
#endif
#endif
}
```

```cpp
#include <hip/hip_runtime.h>
#include <cstdio>
#include <cstdint>

#ifndef MK_PROBE
#define MK_PROBE 0
#endif
#ifndef MK_REPEAT
#define MK_REPEAT 0
#endif
#ifndef MK_FP8TEST
#define MK_FP8TEST 0
#endif
#ifndef MK_ONE_LAUNCH
#define MK_ONE_LAUNCH 1
#endif

#define LAS __attribute__((address_space(3)))
#define GAS __attribute__((address_space(1)))
typedef unsigned short bf16_t;
typedef short bf16x8 __attribute__((ext_vector_type(8)));
typedef float f32x4 __attribute__((ext_vector_type(4)));
typedef float f32x2 __attribute__((ext_vector_type(2)));
typedef unsigned u32x4 __attribute__((ext_vector_type(4)));
typedef unsigned u32x2 __attribute__((ext_vector_type(2)));
typedef int v8i __attribute__((ext_vector_type(8)));

constexpr int D = 1024, BATCH = 32, SEQ = 2048, NTOK = BATCH * SEQ;
constexpr int HW = 512, NHEAD = 4, DK = 128, CHUNK = 64, NCHUNK = SEQ / CHUNK;
constexpr int INC = 5632, PROJ_LD = 3584, GATE_LD = 2048;
constexpr int NE = 32, TOPK = 4, DFF = 1024, NASSIGN = NTOK * TOPK;
constexpr int MAXTILES = NASSIGN / 256 + NE;
constexpr int MAXROWS = MAXTILES * 256;
constexpr float EPS = 1e-6f, SW_LIMIT = 7.0f, SW_ALPHA = 1.702f;
constexpr int NWAVES = 8, NTHREADS = 512;
constexpr int NPHASE = 11;

constexpr size_t MiB = 1u << 20;
constexpr size_t WS_CTL = 0, CTL_ZERO_BYTES = 65536;
constexpr size_t WS_MOD = 1 * MiB;
constexpr size_t WS_LB = WS_MOD + 32 * 6144 * 4;
constexpr size_t WS_WIN = 2 * MiB;
constexpr size_t WS_WHG = 13 * MiB, WS_WCV = 14 * MiB, WS_WMIX = 15 * MiB;
constexpr size_t WS_W2 = 18 * MiB;
constexpr size_t WS_W1 = 50 * MiB;
constexpr size_t WS_U2Q = 114 * MiB;
constexpr size_t WS_U = 210 * MiB;
constexpr size_t WS_PROJ = 338 * MiB;
constexpr size_t WS_O = 786 * MiB;
constexpr size_t WS_CV = 850 * MiB;
constexpr size_t WS_H = 338 * MiB;
constexpr size_t WS_ACT = 466 * MiB;
constexpr size_t WS_TOPI = 994 * MiB, WS_TOPP = 995 * MiB, WS_POS = 996 * MiB;
constexpr size_t WS_RTOK = 997 * MiB, WS_RSLOT = 997 * MiB + 1081344 + 0, WS_RW = WS_RSLOT + 1081344;
constexpr size_t WS_YO23 = 730 * MiB;
constexpr size_t WS_END = 1001 * MiB;
static_assert(WS_RW + 1081344 <= WS_END && MAXROWS * 4 == 1081344, "tables");
static_assert(WS_ACT + (size_t)MAXROWS * 1024 <= WS_YO23 && WS_YO23 + 256 * MiB <= WS_TOPI, "act");
constexpr int CW_TMO = 0, CW_BAR = 4096, CW_CNT = 8192;

constexpr int LDS_BYTES = 163840;
constexpr int MISC_OFF = LDS_BYTES - 256;
constexpr int TBL_OFF = 131072;
constexpr int STASH_OFF = TBL_OFF + 8192;

#define LDS_WAIT() asm volatile("s_waitcnt lgkmcnt(0)" ::: "memory")
#define VM_WAIT() asm volatile("s_waitcnt vmcnt(0)" ::: "memory")
typedef __bf16 bf16x2_t __attribute__((ext_vector_type(2)));
__device__ __forceinline__ unsigned cvt_pk_bf16(float lo, float hi) { const f32x2 v = {lo, hi}; const bf16x2_t b = __builtin_convertvector(v, bf16x2_t); return __builtin_bit_cast(unsigned, b); }
__device__ __forceinline__ unsigned pk4_fp8(float a, float b, float c, float d) {
    a = fminf(fmaxf(a, -448.f), 448.f); b = fminf(fmaxf(b, -448.f), 448.f); c = fminf(fmaxf(c, -448.f), 448.f); d = fminf(fmaxf(d, -448.f), 448.f);
    int w = __builtin_amdgcn_cvt_pk_fp8_f32(a, b, 0, false); w = __builtin_amdgcn_cvt_pk_fp8_f32(c, d, w, true); return (unsigned)w; }
__device__ __forceinline__ float bf_lo(unsigned u) { return __uint_as_float(u << 16); }
__device__ __forceinline__ float bf_hi(unsigned u) { return __uint_as_float(u & 0xffff0000u); }
__device__ __forceinline__ float bf1(bf16_t u) { return __uint_as_float(((unsigned)u) << 16); }
__device__ __forceinline__ float fast_rcp(float x) { return __builtin_amdgcn_rcpf(x); }
__device__ __forceinline__ float fast_exp(float x) { return __builtin_amdgcn_exp2f(x * 1.44269504089f); }
__device__ __forceinline__ float fast_log(float x) { return __builtin_amdgcn_logf(x) * 0.69314718056f; }
__device__ __forceinline__ float sigmoidf_(float x) { return fast_rcp(1.0f + fast_exp(-x)); }
__device__ __forceinline__ float wave_sum(float v) {
#pragma unroll
    for (int o = 1; o < 64; o <<= 1) v += __shfl_xor(v, o);
    return v;
}

#define XB_TMO      128
#define XB_XCNT(j)  (256  + 64 * (j))
#define XB_XSUB(j)  (1280 + 64 * (j))
#define XB_XGEN(j)  (2304 + 64 * (j))
#define XB_TOP      3328
#define XB_TOPGEN   3392
#define XCD_BAR_WORDS 3456
#define XB_SPIN_CAP (1u << 20)
__device__ __forceinline__ unsigned xb_ld(unsigned* p)              { return __hip_atomic_load(p, __ATOMIC_RELAXED, __HIP_MEMORY_SCOPE_AGENT); }
__device__ __forceinline__ unsigned xb_add(unsigned* p, unsigned v) { return __hip_atomic_fetch_add(p, v, __ATOMIC_RELAXED, __HIP_MEMORY_SCOPE_AGENT); }
__device__ __forceinline__ unsigned xb_xcc_id() { return (unsigned)__builtin_amdgcn_s_getreg((3 << 11) | 20) & 0xFu; }
#define XB_SPIN(cond, bar) do { unsigned _sp = 0; while (cond) { __builtin_amdgcn_s_sleep(1); \
    if ((++_sp & 255u) == 0u) { if (xb_ld(&(bar)[XB_TMO])) break; if (_sp > XB_SPIN_CAP) { atomicAdd(&(bar)[XB_TMO], 1u); break; } } } } while (0)
struct XcdBarrier { unsigned* bar; unsigned x; volatile LAS unsigned* st; };
__device__ __forceinline__ XcdBarrier xcd_barrier_post(unsigned* bar, volatile LAS unsigned* st) {
    XcdBarrier b; b.bar = bar; b.x = xb_xcc_id(); b.st = st;
    if (threadIdx.x == 0) (void)xb_add(&bar[XB_XCNT(b.x)], 1u);
    return b;
}
__device__ __forceinline__ void xcd_barrier_complete(unsigned* bar, unsigned x, unsigned& nloc, unsigned& nx) {
    const unsigned G = gridDim.x * gridDim.y * gridDim.z;
    unsigned sum, cnt, mine, sp = 0u;
    for (;;) {
        sum = 0u; cnt = 0u; mine = 0u;
#pragma unroll
        for (unsigned j = 0; j < 16; ++j) { const unsigned c = xb_ld(&bar[XB_XCNT(j)]); sum += c; cnt += (c > 0u) ? 1u : 0u; mine = (j == x) ? c : mine; }
        if (sum == G) break;
        __builtin_amdgcn_s_sleep(1);
        if ((++sp & 255u) == 0u) { if (xb_ld(&bar[XB_TMO])) break; if (sp > XB_SPIN_CAP) { atomicAdd(&bar[XB_TMO], 1u); break; } }
    }
    nloc = mine > 0u ? mine : 1u; nx = cnt > 0u ? cnt : 1u;
}
__device__ __forceinline__ void xcd_barrier(const XcdBarrier& b) {
    asm volatile("s_waitcnt vmcnt(0)" ::: "memory");
    __syncthreads();
    if (threadIdx.x == 0) {
        unsigned* bar = b.bar;
        __builtin_amdgcn_s_waitcnt(0);
        unsigned nloc = b.st[0], nx = b.st[1];
        if (nloc == 0u) { xcd_barrier_complete(bar, b.x, nloc, nx); b.st[0] = nloc; b.st[1] = nx; }
        const unsigned old = xb_add(&bar[XB_XSUB(b.x)], 1u);
        const unsigned gen = old / nloc;
        if (old + 1u == (gen + 1u) * nloc) {
            __builtin_amdgcn_fence(__ATOMIC_RELEASE, "agent");
            asm volatile("s_waitcnt vmcnt(0)" ::: "memory");
            const unsigned og = xb_add(&bar[XB_TOP], 1u);
            const unsigned tg = og / nx;
            if (og + 1u == (tg + 1u) * nx) xb_add(&bar[XB_TOPGEN], 1u);
            else XB_SPIN(xb_ld(&bar[XB_TOPGEN]) == tg, bar);
            __builtin_amdgcn_fence(__ATOMIC_ACQUIRE, "agent");
            xb_add(&bar[XB_XGEN(b.x)], 1u);
            asm volatile("s_waitcnt vmcnt(0)" ::: "memory");
        } else {
            XB_SPIN(xb_ld(&bar[XB_XGEN(b.x)]) == gen, bar);
            __builtin_amdgcn_fence(__ATOMIC_ACQUIRE, "agent");
            asm volatile("s_waitcnt vmcnt(0)" ::: "memory");
        }
    }
    __syncthreads();
}

namespace gm {
constexpr int BM = 256, BK = 64, HALF = 128, HTB = HALF * BK * 2, STAGE_BYTES = 8 * HTB, NXCD = 8, WGM = 8;
__device__ __forceinline__ int lds_byte(int r, int c) { const int st = (r >> 4) * 2 + (c >> 5), rr = r & 15, cc = c & 31, ob = rr * 64 + cc * 2; return st * 1024 + (ob ^ (((ob >> 9) & 1) << 5)); }
__device__ __forceinline__ void stage_rc(int b, int& R, int& C) { const int st = b / 1024, sb = b % 1024, swz = sb ^ (((sb >> 9) & 1) << 5); R = (st >> 1) * 16 + swz / 64; C = (st & 1) * 32 + (swz % 64) / 2; }
__device__ __forceinline__ int perm32(int rho) { const int n = rho >> 4, i = rho & 15; return 8 * (i >> 2) + 4 * n + (i & 3); }

struct Unit { int pm, pn, e, sub; };

__device__ __forceinline__ bool tile_order(int nM, int nN, long L, int& pm, int& pn) {
    const int nwg = nM * nN; if (L >= nwg) return false;
    int wgid = (int)L; { const int q = nwg / NXCD, r = nwg % NXCD, xcd = wgid % NXCD, off = wgid / NXCD; wgid = (xcd < r ? xcd * (q + 1) : r * (q + 1) + (xcd - r) * q) + off; }
    const int nig = WGM * nN, gid = wgid / nig, fm = gid * WGM, gsz = (nM - fm) < WGM ? (nM - fm) : WGM;
    pm = fm + ((wgid % nig) % gsz); pn = (wgid % nig) / gsz; return true;
}
struct DenseOrder {
    int nM, nN, G, c, nsub;
    __device__ __forceinline__ bool next(int i, Unit& u) const { const int ti = i / nsub; u.sub = i - ti * nsub; u.e = 0; return tile_order(nM, nN, (long)ti * G + c, u.pm, u.pn); }
};
struct MoeOrder {
    int nM, nN, G, c; const LAS int* tile_e;
    __device__ __forceinline__ bool next(int i, Unit& u) const { u.sub = 0; if (!tile_order(nM, nN, (long)i * G + c, u.pm, u.pn)) return false; u.e = tile_e[u.pm]; return true; }
};
struct DenseA { int K; unsigned sub_stride; int ES;
    __device__ __forceinline__ void offsets(const Unit& u, int tid, unsigned (&o)[2][2]) const {
#pragma unroll
        for (int i = 0; i < 2; ++i) { int R, C; stage_rc(tid * 16 + i * 8192, R, C);
#pragma unroll
            for (int h = 0; h < 2; ++h) o[h][i] = (unsigned)((u.pm * BM + h * HALF + R) * K * ES + C * 2) + (unsigned)u.sub * sub_stride; } } };
struct GatherA { int K; const int* row_tok; int ES;
    __device__ __forceinline__ void offsets(const Unit& u, int tid, unsigned (&o)[2][2]) const {
#pragma unroll
        for (int i = 0; i < 2; ++i) { int R, C; stage_rc(tid * 16 + i * 8192, R, C);
#pragma unroll
            for (int h = 0; h < 2; ++h) { const int tok = row_tok[u.pm * BM + h * HALF + R]; o[h][i] = (unsigned)(tok * K * ES + C * 2); } } } };

template <bool FP8, class Epi, class Sched, class AMap>
__device__ __forceinline__ void gemm_phase(int wave_sg, LAS unsigned char* lds, const char* Abase, const char* Bbase, int K, int Nb, unsigned b_sub_stride, const Sched& S, const Epi& E, const AMap& AM) {
    int lane; asm volatile("v_mbcnt_lo_u32_b32 %0, -1, 0\n\tv_mbcnt_hi_u32_b32 %0, -1, %0" : "=v"(lane));
    const int wid = wave_sg, tid = wid * 64 + lane, wr = wid >> 2, wc = wid & 3, fr = lane & 15, fq = lane >> 4;
    constexpr int ES = FP8 ? 1 : 2;
    const int nt = K * ES / (BK * 2);
    unsigned voffB[2];
#pragma unroll
    for (int i = 0; i < 2; ++i) { int R, C; stage_rc(tid * 16 + i * 8192, R, C); const int Rb = (R & ~31) + perm32(R & 31); voffB[i] = (unsigned)(Rb * K * ES + C * 2); }
    const size_t kstep = (size_t)(BK * 2);
    const size_t hstep = (size_t)HALF * K * ES;
    const unsigned ldsw = (unsigned)wid * 1024u;
    const int aoff = FP8 ? lds_byte(wr * 64 + fr, fq * 16) : lds_byte(wr * 64 + fr, fq * 8), boff = FP8 ? lds_byte(wc * 32 + fr, fq * 16) : lds_byte(wc * 32 + fr, fq * 8);
#define G_SA(b, h) (((b) * 2 + (h)) * HTB)
#define G_SB(b, h) ((4 + (b) * 2 + (h)) * HTB)
#define G_STAGE(bufoff, gbase, voff) do { _Pragma("unroll") for (int _i = 0; _i < 2; ++_i) \
        __builtin_amdgcn_global_load_lds((const unsigned*)((const char*)(gbase) + (voff)[_i]), (LAS unsigned*)(lds + (bufoff) + ldsw + _i * 8192), 16, 0, 0); } while (0)
#define G_LDA(dst, b, h) do { _Pragma("unroll") for (int m = 0; m < 4; ++m) _Pragma("unroll") for (int k = 0; k < 2; ++k) dst[m][k] = *(const LAS bf16x8*)(lds + G_SA(b, h) + aoff + m * 2048 + k * 1024); } while (0)
#define G_LDB(dst, b, h) do { _Pragma("unroll") for (int n = 0; n < 2; ++n) _Pragma("unroll") for (int k = 0; k < 2; ++k) dst[n][k] = *(const LAS bf16x8*)(lds + G_SB(b, h) + boff + n * 2048 + k * 1024); } while (0)
#define G_MMA(ai, bj, At, Bt) do { __builtin_amdgcn_s_setprio(1); _Pragma("unroll") for (int m = 0; m < 4; ++m) _Pragma("unroll") for (int n = 0; n < 2; ++n) _Pragma("unroll") for (int k = 0; k < 2; ++k) \
        acc[ai][bj][m][n] = __builtin_amdgcn_mfma_f32_16x16x32_bf16(Bt[n][k], At[m][k], acc[ai][bj][m][n], 0, 0, 0); __builtin_amdgcn_s_setprio(0); } while (0)
#define G_LD8(dst, off) do { const u32x4 _l = *(const LAS u32x4*)(lds + (off)), _h = *(const LAS u32x4*)(lds + (off) + 16); dst = (v8i){(int)_l.x, (int)_l.y, (int)_l.z, (int)_l.w, (int)_h.x, (int)_h.y, (int)_h.z, (int)_h.w}; } while (0)
#define G_LDA8(dst, b, h) do { _Pragma("unroll") for (int m = 0; m < 4; ++m) G_LD8(dst[m], G_SA(b, h) + aoff + m * 2048); } while (0)
#define G_LDB8(dst, b, h) do { _Pragma("unroll") for (int n = 0; n < 2; ++n) G_LD8(dst[n], G_SB(b, h) + boff + n * 2048); } while (0)
#define G_MMA8(ai, bj, At, Bt) do { __builtin_amdgcn_s_setprio(1); _Pragma("unroll") for (int m = 0; m < 4; ++m) _Pragma("unroll") for (int n = 0; n < 2; ++n) \
        acc[ai][bj][m][n] = __builtin_amdgcn_mfma_scale_f32_16x16x128_f8f6f4(Bt[n], At[m], acc[ai][bj][m][n], 0, 0, 0, 0x7F7F7F7F, 0, 0x7F7F7F7F); __builtin_amdgcn_s_setprio(0); } while (0)
#define G_WAIT_V(n) asm volatile("s_waitcnt vmcnt(" #n ")" ::: "memory")
#define G_WAIT_L(n) asm volatile("s_waitcnt lgkmcnt(" #n ")" ::: "memory")
#define G_BAR __builtin_amdgcn_s_barrier()
#define G_SCHED __builtin_amdgcn_sched_barrier(0)
    Unit cur, nxt; int ui = 0;
    if (!S.next(0, cur)) return;
    f32x4 acc[2][2][4][2];
#pragma unroll
    for (int a = 0; a < 2; ++a)
#pragma unroll
        for (int b = 0; b < 2; ++b)
#pragma unroll
            for (int m = 0; m < 4; ++m)
#pragma unroll
                for (int n = 0; n < 2; ++n) acc[a][b][m][n] = (f32x4){0.f, 0.f, 0.f, 0.f};
    bf16x8 At[4][2], B0[2][2], B1[2][2];
    v8i At8[4], B08[2], B18[2];
    unsigned rA[2][2];
    AM.offsets(cur, tid, rA);
    LAS u32x4* stash = (LAS u32x4*)(lds + STASH_OFF) + tid;
    const char* cB = Bbase + ((size_t)cur.e * Nb + (size_t)cur.pn * BM) * K * ES + (size_t)cur.sub * b_sub_stride;
    G_STAGE(G_SB(0, 0), cB, voffB); G_STAGE(G_SB(0, 1), cB + hstep, voffB); G_STAGE(G_SA(0, 0), Abase, rA[0]); G_STAGE(G_SA(0, 1), Abase, rA[1]);
    if (wr == 1) G_BAR;
    G_WAIT_V(2); G_BAR;
    G_STAGE(G_SB(1, 0), cB + kstep, voffB); G_STAGE(G_SA(1, 0), Abase + kstep, rA[0]); G_STAGE(G_SB(1, 1), cB + hstep + kstep, voffB);
    G_WAIT_V(6); G_BAR;
    const int t_pre = nt >= 4 ? nt - 4 : 0;
    for (;;) {
        const bool has_next = S.next(ui + 1, nxt);
        const char* nB = has_next ? Bbase + ((size_t)nxt.e * Nb + (size_t)nxt.pn * BM) * K * ES + (size_t)nxt.sub * b_sub_stride : cB;
#pragma nounroll
        for (int t = 0; t < nt; t += 2) {
            const bool last = (t == nt - 2);
            if (t == t_pre && has_next) { unsigned rn[2][2]; AM.offsets(nxt, tid, rn); *stash = (u32x4){rn[0][0], rn[0][1], rn[1][0], rn[1][1]}; }
            const char* b2 = last ? nB : cB + (size_t)(t + 2) * kstep; const char* b3 = b2 + kstep;
            if constexpr (FP8) { G_LDB8(B08, 0, 0); G_LDB8(B18, 0, 1); G_SCHED; G_LDA8(At8, 0, 0); } else { G_LDB(B0, 0, 0); G_LDB(B1, 0, 1); G_SCHED; G_LDA(At, 0, 0); }
            G_STAGE(G_SA(1, 1), Abase + (size_t)(t + 1) * kstep, rA[1]);
            G_WAIT_V(8); G_WAIT_L(0); G_BAR;
            if constexpr (FP8) { G_MMA8(0, 0, At8, B08); G_MMA8(0, 1, At8, B18); } else { G_MMA(0, 0, At, B0); G_MMA(0, 1, At, B1); }
            G_BAR; G_SCHED;
            if (last && has_next) { const u32x4 rn = *stash; rA[0][0] = rn.x; rA[0][1] = rn.y; rA[1][0] = rn.z; rA[1][1] = rn.w; }
            const char* a2 = Abase + (last ? (size_t)0 : (size_t)(t + 2) * kstep);
            if constexpr (FP8) { G_LDA8(At8, 0, 1); } else { G_LDA(At, 0, 1); }
            G_STAGE(G_SB(0, 0), b2, voffB); G_STAGE(G_SB(0, 1), b2 + hstep, voffB); G_STAGE(G_SA(0, 0), a2, rA[0]);
            G_WAIT_V(8); G_WAIT_L(0); G_BAR;
            if constexpr (FP8) { G_MMA8(1, 0, At8, B08); G_MMA8(1, 1, At8, B18); } else { G_MMA(1, 0, At, B0); G_MMA(1, 1, At, B1); }
            G_BAR; G_SCHED;
            if constexpr (FP8) { G_LDB8(B08, 1, 0); G_LDB8(B18, 1, 1); G_SCHED; G_LDA8(At8, 1, 0); } else { G_LDB(B0, 1, 0); G_LDB(B1, 1, 1); G_SCHED; G_LDA(At, 1, 0); }
            G_STAGE(G_SA(0, 1), a2, rA[1]);
            G_WAIT_V(8); G_WAIT_L(0); G_BAR;
            if constexpr (FP8) { G_MMA8(0, 0, At8, B08); G_MMA8(0, 1, At8, B18); } else { G_MMA(0, 0, At, B0); G_MMA(0, 1, At, B1); }
            G_BAR; G_SCHED;
            if constexpr (FP8) { G_LDA8(At8, 1, 1); } else { G_LDA(At, 1, 1); }
            G_STAGE(G_SB(1, 0), b3, voffB); G_STAGE(G_SB(1, 1), b3 + hstep, voffB); G_STAGE(G_SA(1, 0), a2 + kstep, rA[0]);
            G_WAIT_V(8); G_WAIT_L(0); G_BAR;
            if constexpr (FP8) { G_MMA8(1, 0, At8, B08); G_MMA8(1, 1, At8, B18); } else { G_MMA(1, 0, At, B0); G_MMA(1, 1, At, B1); }
            G_BAR; G_SCHED;
        }
        if (wr == 0) G_BAR;
        E(acc, cur, wr, wc, fr, fq);
        if (!has_next) break;
        if (!E.keep(cur)) {
#pragma unroll
            for (int a = 0; a < 2; ++a)
#pragma unroll
                for (int b = 0; b < 2; ++b)
#pragma unroll
                    for (int m = 0; m < 4; ++m)
#pragma unroll
                        for (int n = 0; n < 2; ++n) acc[a][b][m][n] = (f32x4){0.f, 0.f, 0.f, 0.f};
        }
        cur = nxt; cB = nB; ++ui;
        if (wr == 1) G_BAR;
    }
    G_WAIT_V(0);
    G_BAR;
#undef G_SA
#undef G_SB
#undef G_STAGE
#undef G_LDA
#undef G_LDB
#undef G_MMA
#undef G_LD8
#undef G_LDA8
#undef G_LDB8
#undef G_MMA8
#undef G_WAIT_V
#undef G_WAIT_L
#undef G_BAR
#undef G_SCHED
}

__device__ __forceinline__ u32x4 pack8(const f32x4& v0, const f32x4& v1) { u32x4 w; w.x = cvt_pk_bf16(v0[0], v0[1]); w.y = cvt_pk_bf16(v0[2], v0[3]); w.z = cvt_pk_bf16(v1[0], v1[1]); w.w = cvt_pk_bf16(v1[2], v1[3]); return w; }
__device__ __forceinline__ void unpack8(const u32x4& w, f32x4& v0, f32x4& v1) { v0 = (f32x4){bf_lo(w.x), bf_hi(w.x), bf_lo(w.y), bf_hi(w.y)}; v1 = (f32x4){bf_lo(w.z), bf_hi(w.z), bf_lo(w.w), bf_hi(w.w)}; }

struct EpiProj {
    bf16_t* proj; bf16_t* gates; const float* lb;
    __device__ __forceinline__ bool keep(const Unit&) const { return false; }
    __device__ __forceinline__ void operator()(f32x4 (&acc)[2][2][4][2], const Unit& u, int wr, int wc, int fr, int fq) const {
        const int row0 = u.pm * BM + wr * 64 + fr, pn = u.pn;
        bf16_t* base; int ldc, colt, kind;
        if (pn < 14) { base = proj; ldc = PROJ_LD; colt = pn * BM; kind = (pn == 2 || pn == 3) ? 1 : 0; } else { base = gates; ldc = GATE_LD; colt = (pn - 14) * BM; kind = 2; }
        const int col0 = colt + wc * 32 + 8 * fq;
        f32x4 lbv[2][2];
        if (kind == 1) {
#pragma unroll
            for (int bj = 0; bj < 2; ++bj) { const float* lp = lb + (pn - 2) * BM + bj * HALF + wc * 32 + 8 * fq; lbv[bj][0] = *(const f32x4*)lp; lbv[bj][1] = *(const f32x4*)(lp + 4); }
        }
#pragma unroll
        for (int ai = 0; ai < 2; ++ai)
#pragma unroll
            for (int m = 0; m < 4; ++m) { bf16_t* rowp = base + (size_t)(row0 + ai * HALF + m * 16) * ldc + col0;
#pragma unroll
                for (int bj = 0; bj < 2; ++bj) { f32x4 v0 = acc[ai][bj][m][0], v1 = acc[ai][bj][m][1];
                    if (kind == 1) {
#pragma unroll
                        for (int j = 0; j < 4; ++j) { const float l0 = lbv[bj][0][j], l1 = lbv[bj][1][j];
                            v0[j] = fast_log(l0 + (1.0f - l0) * sigmoidf_(v0[j])); v1[j] = fast_log(l1 + (1.0f - l1) * sigmoidf_(v1[j])); }
                    } else if (kind == 2) {
#pragma unroll
                        for (int j = 0; j < 4; ++j) { v0[j] = sigmoidf_(v0[j]); v1[j] = sigmoidf_(v1[j]); }
                    }
                    *(u32x4*)(rowp + bj * HALF) = pack8(v0, v1); } }
    }
};
struct EpiMerge {
    const bf16_t* gates; bf16_t* out;
    __device__ __forceinline__ bool keep(const Unit& u) const { return u.sub == 0; }
    __device__ __forceinline__ void operator()(f32x4 (&acc)[2][2][4][2], const Unit& u, int wr, int wc, int fr, int fq) const {
        const int row0 = u.pm * BM + wr * 64 + fr, col0 = u.pn * BM + wc * 32 + 8 * fq;
#pragma unroll
        for (int ai = 0; ai < 2; ++ai)
#pragma unroll
            for (int m = 0; m < 4; ++m) { const size_t r = (size_t)(row0 + ai * HALF + m * 16); const bf16_t* gp = gates + r * GATE_LD + col0;
#pragma unroll
                for (int bj = 0; bj < 2; ++bj) {
                    f32x4 b0, b1; unpack8(*(const u32x4*)(gp + 1024 + bj * HALF), b0, b1);
                    if (u.sub == 0) { f32x4 a0, a1; unpack8(*(const u32x4*)(gp + bj * HALF), a0, a1);
#pragma unroll
                        for (int j = 0; j < 4; ++j) { acc[ai][bj][m][0][j] *= a0[j] * fast_rcp(fmaxf(b0[j], 1e-30f)); acc[ai][bj][m][1][j] *= a1[j] * fast_rcp(fmaxf(b1[j], 1e-30f)); }
                    } else {
                        *(u32x4*)(out + r * D + col0 + bj * HALF) = pack8(acc[ai][bj][m][0] * b0, acc[ai][bj][m][1] * b1);
                    } } }
    }
};
struct EpiMix {
    const float* x; const float* mod; bf16_t* h;
    __device__ __forceinline__ bool keep(const Unit&) const { return false; }
    __device__ __forceinline__ void operator()(f32x4 (&acc)[2][2][4][2], const Unit& u, int wr, int wc, int fr, int fq) const {
        const int row0 = u.pm * BM + wr * 64 + fr, col0 = u.pn * BM + wc * 32 + 8 * fq, b = u.pm >> 3;
        f32x4 g[2][2];
#pragma unroll
        for (int bj = 0; bj < 2; ++bj) { const float* gp = mod + (size_t)b * 6144 + 2048 + col0 + bj * HALF; g[bj][0] = *(const f32x4*)gp; g[bj][1] = *(const f32x4*)(gp + 4); }
#pragma unroll
        for (int ai = 0; ai < 2; ++ai)
#pragma unroll
            for (int m = 0; m < 4; ++m) { const size_t r = (size_t)(row0 + ai * HALF + m * 16);
#pragma unroll
                for (int bj = 0; bj < 2; ++bj) { const float* xp = x + r * D + col0 + bj * HALF; const f32x4 x0 = *(const f32x4*)xp, x1 = *(const f32x4*)(xp + 4);
                    *(u32x4*)(h + r * D + col0 + bj * HALF) = pack8(x0 + g[bj][0] * acc[ai][bj][m][0], x1 + g[bj][1] * acc[ai][bj][m][1]); }
                asm volatile("" ::: "memory"); }
    }
};
struct EpiSwiglu {
    static constexpr float WSC = 1.0f / 32.0f;
    const float* b1; unsigned char* act;
    __device__ __forceinline__ bool keep(const Unit&) const { return false; }
    __device__ __forceinline__ void operator()(f32x4 (&acc)[2][2][4][2], const Unit& u, int wr, int wc, int fr, int fq) const {
        const int row0 = u.pm * BM + wr * 64 + fr, hc0 = u.pn * HALF + wc * 32 + 8 * fq;
        const float* bp = b1 + (size_t)u.e * 2048 + hc0;
        const f32x4 bg0 = *(const f32x4*)bp, bg1 = *(const f32x4*)(bp + 4), bl0 = *(const f32x4*)(bp + 1024), bl1 = *(const f32x4*)(bp + 1028);
#pragma unroll
        for (int ai = 0; ai < 2; ++ai)
#pragma unroll
            for (int m = 0; m < 4; ++m) { const size_t r = (size_t)(row0 + ai * HALF + m * 16);
                f32x4 o0, o1;
#pragma unroll
                for (int j = 0; j < 4; ++j) {
                    float gl = fminf(acc[ai][0][m][0][j] * WSC + bg0[j], SW_LIMIT), li = fminf(fmaxf(acc[ai][1][m][0][j] * WSC + bl0[j], -SW_LIMIT), SW_LIMIT);
                    o0[j] = gl * sigmoidf_(SW_ALPHA * gl) * (li + 1.0f);
                    gl = fminf(acc[ai][0][m][1][j] * WSC + bg1[j], SW_LIMIT); li = fminf(fmaxf(acc[ai][1][m][1][j] * WSC + bl1[j], -SW_LIMIT), SW_LIMIT);
                    o1[j] = gl * sigmoidf_(SW_ALPHA * gl) * (li + 1.0f); }
                *(u32x2*)(act + r * DFF + hc0) = (u32x2){pk4_fp8(o0[0], o0[1], o0[2], o0[3]), pk4_fp8(o1[0], o1[1], o1[2], o1[3])}; }
    }
};
struct EpiMoeOut {
    const float* b2; const int* rslot; const float* rw; bf16_t* yo01; bf16_t* yo23;
    __device__ __forceinline__ bool keep(const Unit&) const { return false; }
    __device__ __forceinline__ void operator()(f32x4 (&acc)[2][2][4][2], const Unit& u, int wr, int wc, int fr, int fq) const {
        const int row0 = u.pm * BM + wr * 64 + fr, col0 = u.pn * BM + wc * 32 + 8 * fq;
        f32x4 bv[2][2];
#pragma unroll
        for (int bj = 0; bj < 2; ++bj) { const float* bp = b2 + (size_t)u.e * D + col0 + bj * HALF; bv[bj][0] = *(const f32x4*)bp; bv[bj][1] = *(const f32x4*)(bp + 4); }
#pragma unroll
        for (int ai = 0; ai < 2; ++ai)
#pragma unroll
            for (int m = 0; m < 4; ++m) { const int r = row0 + ai * HALF + m * 16; const int slot = rslot[r]; const float w = rw[r];
                if (slot >= 0) { const int tok = slot >> 2, j = slot & 3;
                    bf16_t* dst = (j < 2 ? yo01 + (size_t)tok * 2048 + (size_t)j * 1024 : yo23 + (size_t)tok * 2048 + (size_t)(j - 2) * 1024) + col0;
#pragma unroll
                    for (int bj = 0; bj < 2; ++bj) *(u32x4*)(dst + bj * HALF) = pack8((acc[ai][bj][m][0] * (1.0f / 32.0f) + bv[bj][0]) * w, (acc[ai][bj][m][1] * (1.0f / 32.0f) + bv[bj][1]) * w); } }
    }
};
}

struct Args { const float* in[20]; float* out; unsigned char* ws; int ph_lo, ph_hi; };

__device__ __forceinline__ void transpose_item(const float* W, int N, bf16_t* WT, int ldwt, int k0, int n0, int dst_row0, LAS float* scr, int lane) {
    const int ks = lane >> 4, n4 = (lane & 15) * 4;
    f32x4 v[16];
#pragma unroll
    for (int i = 0; i < 16; ++i) v[i] = *(const f32x4*)(W + (size_t)(k0 + 4 * i + ks) * N + n0 + n4);
#pragma unroll
    for (int i = 0; i < 16; ++i) { LAS float* s = scr + (4 * i + ks) * 65 + n4; s[0] = v[i][0]; s[1] = v[i][1]; s[2] = v[i][2]; s[3] = v[i][3]; }
    LDS_WAIT(); asm volatile("" ::: "memory");
    const int kc = lane & 7;
#pragma unroll
    for (int p = 0; p < 8; ++p) { const int n = (lane >> 3) + 8 * p; const LAS float* s = scr + (8 * kc) * 65 + n;
        u32x4 o; o.x = cvt_pk_bf16(s[0], s[65]); o.y = cvt_pk_bf16(s[2 * 65], s[3 * 65]); o.z = cvt_pk_bf16(s[4 * 65], s[5 * 65]); o.w = cvt_pk_bf16(s[6 * 65], s[7 * 65]);
        *(u32x4*)(WT + (size_t)(dst_row0 + n) * ldwt + k0 + 8 * kc) = o; }
    LDS_WAIT(); asm volatile("" ::: "memory");
}

__device__ __forceinline__ void transpose_item_fp8(const float* W, int N, unsigned char* WT, int ldwt, int k0, int n0, int dst_row0, LAS float* scr, int lane) {
    const int ks = lane >> 3, n4 = (lane & 7) * 4;
    f32x4 v[16];
#pragma unroll
    for (int i = 0; i < 16; ++i) v[i] = *(const f32x4*)(W + (size_t)(k0 + 8 * i + ks) * N + n0 + n4);
#pragma unroll
    for (int i = 0; i < 16; ++i) { LAS float* s = scr + (8 * i + ks) * 33 + n4; s[0] = v[i][0]; s[1] = v[i][1]; s[2] = v[i][2]; s[3] = v[i][3]; }
    LDS_WAIT(); asm volatile("" ::: "memory");
    const int kc = lane & 7;
#pragma unroll
    for (int p = 0; p < 4; ++p) { const int n = (lane >> 3) + 8 * p; const LAS float* s = scr + (16 * kc) * 33 + n;
        u32x4 o;
        o.x = pk4_fp8(32.f * s[0], 32.f * s[33], 32.f * s[2 * 33], 32.f * s[3 * 33]); o.y = pk4_fp8(32.f * s[4 * 33], 32.f * s[5 * 33], 32.f * s[6 * 33], 32.f * s[7 * 33]);
        o.z = pk4_fp8(32.f * s[8 * 33], 32.f * s[9 * 33], 32.f * s[10 * 33], 32.f * s[11 * 33]); o.w = pk4_fp8(32.f * s[12 * 33], 32.f * s[13 * 33], 32.f * s[14 * 33], 32.f * s[15 * 33]);
        *(u32x4*)(WT + (size_t)(dst_row0 + n) * ldwt + k0 + 16 * kc) = o; }
    LDS_WAIT(); asm volatile("" ::: "memory");
}

__global__ void __launch_bounds__(NTHREADS, 2) fwd_kernel(Args args) {
    extern __shared__ __attribute__((aligned(16))) unsigned char lds_raw[];
    LAS unsigned char* lds = (LAS unsigned char*)lds_raw;
    volatile LAS unsigned* MISC = (volatile LAS unsigned*)(lds + MISC_OFF);
    const int G = gridDim.x, bid = blockIdx.x;
    const int wave_sg = __builtin_amdgcn_readfirstlane((int)threadIdx.x >> 6);
#define PHASE_IDS() int lane; asm volatile("v_mbcnt_lo_u32_b32 %0, -1, 0\n\tv_mbcnt_hi_u32_b32 %0, -1, %0" : "=v"(lane)); const int wave = wave_sg; const int tid = wave * 64 + lane; const int gw = bid * NWAVES + wave, NGW = G * NWAVES; (void)lane; (void)wave; (void)gw; (void)NGW
#define CAS __attribute__((address_space(4)))
#define PHASE_ARGS() const CAS Args* ap = (const CAS Args*)__builtin_amdgcn_kernarg_segment_ptr(); asm volatile("" : "+s"(ap)); unsigned char* const ws = ap->ws; unsigned* const ctl = (unsigned*)(ws + WS_CTL); (void)ctl
#define ARG(i) (ap->in[i])
#define WSP(T, off) ((T*)(ws + (off)))
    enum { I_X = 0, I_C, I_WADA, I_BADA, I_NMIX, I_WIN, I_LBT, I_HGNW, I_CONVW, I_WHG, I_WCV, I_WMIX, I_NFFN, I_WR, I_BR, I_W1, I_B1, I_W2, I_B2, I_NFIN };
    { PHASE_IDS(); for (int u = tid; u < 64; u += NTHREADS) MISC[u] = 0u; }
    __syncthreads();
    XcdBarrier bar; bar.bar = nullptr; bar.x = 0; bar.st = nullptr;
#if MK_ONE_LAUNCH
    { PHASE_ARGS(); bar = xcd_barrier_post(ctl + CW_BAR, MISC + 8); }
#define GRID_BAR() xcd_barrier(bar)
#else
#define GRID_BAR() do { } while (0)
#endif
    const int lo = args.ph_lo, hi = args.ph_hi;
#ifndef PH_MASK
#define PH_MASK 0x7ff
#endif
#define IN(k) (((PH_MASK >> (k)) & 1) && lo <= (k) && (k) < hi)
#define BOTH(k) (IN(k) && IN((k) + 1))

    if (IN(0)) for (int rep_ = 0; rep_ < 1 + ((MK_REPEAT >> 0) & 1); ++rep_) { PHASE_IDS(); PHASE_ARGS();
        const float* cvec = ARG(I_C); const float* w_ada = ARG(I_WADA); const float* b_ada = ARG(I_BADA); const float* lbtab = ARG(I_LBT);
        const float* w_in = ARG(I_WIN); const float* w_hg = ARG(I_WHG); const float* w_cv = ARG(I_WCV); const float* w_mix = ARG(I_WMIX); const float* w1 = ARG(I_W1); const float* w2 = ARG(I_W2);
        float* MOD = WSP(float, WS_MOD); float* LB = WSP(float, WS_LB);
        bf16_t* Win_t = WSP(bf16_t, WS_WIN); bf16_t* Whg_t = WSP(bf16_t, WS_WHG); bf16_t* Wcv_t = WSP(bf16_t, WS_WCV); bf16_t* Wmix_t = WSP(bf16_t, WS_WMIX); unsigned char* W1_t = WSP(unsigned char, WS_W1); unsigned char* W2_t = WSP(unsigned char, WS_W2);
        LAS float* scr = (LAS float*)(lds + wave * 16896);
        for (int it = gw; it < 384; it += NGW) {
            const int n0 = it * 16, cl = lane & 15, kq = lane >> 4;
            float acc[32];
#pragma unroll
            for (int b = 0; b < 32; ++b) acc[b] = 0.f;
            for (int ch = 0; ch < 16; ++ch) {
                { const int b = lane >> 1, part = lane & 1;
#pragma unroll
                    for (int q = 0; q < 4; ++q) {
                        const float* cp = cvec + (size_t)b * D + q * 256 + ch * 16 + part * 8;
                        const f32x4 c0 = *(const f32x4*)cp, c1 = *(const f32x4*)(cp + 4);
#pragma unroll
                        for (int j = 0; j < 4; ++j) { scr[(q * 16 + part * 8 + j) * 32 + b] = c0[j] * sigmoidf_(c0[j]); scr[(q * 16 + part * 8 + 4 + j) * 32 + b] = c1[j] * sigmoidf_(c1[j]); }
                    } }
                float wv[16];
#pragma unroll
                for (int kk = 0; kk < 16; ++kk) wv[kk] = w_ada[(size_t)(kq * 256 + ch * 16 + kk) * 6144 + n0 + cl];
                LDS_WAIT(); asm volatile("" ::: "memory");
#pragma unroll
                for (int kk = 0; kk < 16; ++kk) {
                    const LAS f32x4* sp = (const LAS f32x4*)(scr + (kq * 16 + kk) * 32);
#pragma unroll
                    for (int b4 = 0; b4 < 8; ++b4) { const f32x4 s = sp[b4]; acc[4 * b4] += wv[kk] * s[0]; acc[4 * b4 + 1] += wv[kk] * s[1]; acc[4 * b4 + 2] += wv[kk] * s[2]; acc[4 * b4 + 3] += wv[kk] * s[3]; }
                }
                LDS_WAIT(); asm volatile("" ::: "memory");
            }
            const float bias = b_ada[n0 + cl];
#pragma unroll
            for (int b = 0; b < 32; ++b) { float v = acc[b]; v += __shfl_xor(v, 16); v += __shfl_xor(v, 32); if (kq == 0) MOD[(size_t)b * 6144 + n0 + cl] = v + bias; }
        }
        if (bid == (G > 1 ? 1 : 0)) { const int k = tid; const float l0 = lbtab[k], l1 = lbtab[HW + k]; LB[k] = fast_rcp(1.0f + fast_exp(l1 - l0)); }
        {
            constexpr int I_IN = 16 * 88, I_HG = 8 * 16, I_CV = 8 * 16, I_MIX = 16 * 16, I_W1 = 32 * 8 * 64, I_W2 = 32 * 8 * 32;
            constexpr int NITEMS = I_IN + I_HG + I_CV + I_MIX + I_W1 + I_W2;
            for (int it = gw; it < NITEMS; it += NGW) {
                int r = it;
                if (r < I_IN) { const int kb = r / 88, nb = r % 88; transpose_item(w_in, INC, Win_t, D, kb * 64, nb * 64, nb * 64, scr, lane); continue; } r -= I_IN;
                if (r < I_HG) { const int kb = r / 16, nb = r % 16; transpose_item(w_hg, D, Whg_t, HW, kb * 64, nb * 64, nb * 64, scr, lane); continue; } r -= I_HG;
                if (r < I_CV) { const int kb = r / 16, nb = r % 16; transpose_item(w_cv, D, Wcv_t, HW, kb * 64, nb * 64, nb * 64, scr, lane); continue; } r -= I_CV;
                if (r < I_MIX) { const int kb = r / 16, nb = r % 16; transpose_item(w_mix, D, Wmix_t, D, kb * 64, nb * 64, nb * 64, scr, lane); continue; } r -= I_MIX;
                if (r < I_W1) { const int e = r / 512, q = r % 512, kb = q / 64, nb = q % 64;
                    const int pn = nb >> 3, wi = (nb & 7) * 32; const int src = wi < 128 ? pn * 128 + wi : 1024 + pn * 128 + (wi - 128);
                    transpose_item_fp8(w1 + (size_t)e * D * 2048, 2048, W1_t + (size_t)e * 2048 * D, D, kb * 128, src, nb * 32, scr, lane); continue; } r -= I_W1;
                { const int e = r / 256, q = r % 256, kb = q / 32, nb = q % 32;
                    transpose_item_fp8(w2 + (size_t)e * DFF * D, D, W2_t + (size_t)e * D * DFF, DFF, kb * 128, nb * 32, nb * 32, scr, lane); }
            }
        }
        if (BOTH(0)) GRID_BAR();
    }

    if (IN(1)) for (int rep_ = 0; rep_ < 1 + ((MK_REPEAT >> 1) & 1); ++rep_) { PHASE_IDS(); PHASE_ARGS();
        const float* x = ARG(I_X); const float* norm_mix_w = ARG(I_NMIX); const float* MOD = WSP(float, WS_MOD); bf16_t* U = WSP(bf16_t, WS_U);
        for (int m0 = gw * 32; m0 < NTOK; m0 += NGW * 32) {
            const int b = m0 >> 11;
            f32x4 A[4], Sh[4];
#pragma unroll
            for (int j = 0; j < 4; ++j) { const int k = 4 * lane + 256 * j; const f32x4 w = *(const f32x4*)(norm_mix_w + k), sc = *(const f32x4*)(MOD + (size_t)b * 6144 + 1024 + k);
                A[j] = w * (sc + 1.0f); Sh[j] = *(const f32x4*)(MOD + (size_t)b * 6144 + k); }
            for (int r = 0; r < 32; ++r) {
                const float* xr = x + (size_t)(m0 + r) * D; f32x4 v[4]; float s = 0.f;
#pragma unroll
                for (int j = 0; j < 4; ++j) { v[j] = *(const f32x4*)(xr + 4 * lane + 256 * j); s += (v[j][0] * v[j][0] + v[j][1] * v[j][1]) + (v[j][2] * v[j][2] + v[j][3] * v[j][3]); }
                const float rs = __builtin_amdgcn_rsqf(wave_sum(s) * (1.0f / D) + EPS);
                bf16_t* ur = U + (size_t)(m0 + r) * D;
#pragma unroll
                for (int j = 0; j < 4; ++j) { const f32x4 o = v[j] * rs * A[j] + Sh[j]; u32x2 w; w.x = cvt_pk_bf16(o[0], o[1]); w.y = cvt_pk_bf16(o[2], o[3]); *(u32x2*)(ur + 4 * lane + 256 * j) = w; }
            }
        }
        if (BOTH(1)) GRID_BAR();
    }

    if (IN(2)) for (int rep_ = 0; rep_ < 1 + ((MK_REPEAT >> 2) & 1); ++rep_) { PHASE_ARGS();
        gm::DenseOrder S{NTOK / 256, INC / 256, G, bid, 1}; gm::DenseA AM{D, 0u, 2}; gm::EpiProj E{WSP(bf16_t, WS_PROJ), (bf16_t*)ap->out, WSP(float, WS_LB)};
        gm::gemm_phase<false>(wave_sg, lds, (const char*)WSP(bf16_t, WS_U), (const char*)WSP(bf16_t, WS_WIN), D, 0, 0u, S, E, AM);
        if (BOTH(2)) GRID_BAR();
    }

    if (IN(3)) for (int rep_ = 0; rep_ < 1 + ((MK_REPEAT >> 3) & 1); ++rep_) { PHASE_IDS(); PHASE_ARGS();
        const float* hg_norm_w = ARG(I_HGNW); const float* conv_w = ARG(I_CONVW); const bf16_t* PROJ = WSP(bf16_t, WS_PROJ); bf16_t* OB = WSP(bf16_t, WS_O); bf16_t* CVB = WSP(bf16_t, WS_CV);
        const int nchainblk = (G >= 256) ? 128 : (G >= 2 ? G / 2 : 1);
        if (bid < nchainblk) {
            constexpr int LDQ = 136, LDT = 72;
            LAS bf16_t* QT = (LAS bf16_t*)(lds);
            LAS bf16_t* KT = QT + 64 * LDQ;
            LAS bf16_t* QB = KT + 64 * LDQ;
            LAS bf16_t* KBT = QB + 64 * LDQ;
            LAS bf16_t* VT = KBT + 128 * LDT;
            LAS bf16_t* PM = VT + 128 * LDT;
            LAS bf16_t* ST = PM + 64 * LDT;
            LAS bf16_t* OS = ST + 128 * LDQ;
            LAS float* SEG = (LAS float*)(OS + 64 * LDQ);
            LAS float* DEC = SEG + 8 * 128;
            const int fr = lane & 15, fq = lane >> 4, w = wave;
            for (int chain = bid; chain < BATCH * NHEAD; chain += nchainblk) {
                const int b = chain >> 2, h = chain & 3;
                __syncthreads();
                for (int i = tid; i < 128 * LDQ / 2; i += NTHREADS) ((LAS unsigned*)ST)[i] = 0u;
                f32x4 Sacc[8];
#pragma unroll
                for (int i = 0; i < 8; ++i) Sacc[i] = (f32x4){0.f, 0.f, 0.f, 0.f};
                const int ot = tid >> 3, ocg = tid & 7;
                f32x4 nwv[4];
#pragma unroll
                for (int q = 0; q < 2; ++q) { nwv[2 * q] = *(const f32x4*)(hg_norm_w + q * 64 + 8 * ocg); nwv[2 * q + 1] = *(const f32x4*)(hg_norm_w + q * 64 + 8 * ocg + 4); }
                const bf16_t* pbase = PROJ + (size_t)(b * SEQ) * PROJ_LD + h * DK;
                unsigned rq[8], rl[8], rv[8];
#pragma unroll
                for (int r = 0; r < 8; ++r) { const bf16_t* p = pbase + (size_t)(8 * w + r) * PROJ_LD + 2 * lane; rq[r] = *(const unsigned*)p; rl[r] = *(const unsigned*)(p + 512); rv[r] = *(const unsigned*)(p + 1024); }
                for (int c = 0; c < NCHUNK; ++c) {
                    const int m0 = c * CHUNK;
                    float cs0[8], cs1[8]; { float a0 = 0.f, a1 = 0.f;
#pragma unroll
                        for (int r = 0; r < 8; ++r) { a0 += bf_lo(rl[r]); a1 += bf_hi(rl[r]); cs0[r] = a0; cs1[r] = a1; }
                        *(LAS f32x2*)(SEG + w * 128 + 2 * lane) = (f32x2){a0, a1}; }
                    LDS_WAIT(); __syncthreads();
                    float pre0 = 0.f, pre1 = 0.f, bm0 = 0.f, bm1 = 0.f, bl0 = 0.f, bl1 = 0.f;
#pragma unroll
                    for (int s = 0; s < 8; ++s) { const f32x2 t2 = *(const LAS f32x2*)(SEG + s * 128 + 2 * lane); if (s < w) { pre0 += t2[0]; pre1 += t2[1]; } if (s < 4) { bm0 += t2[0]; bm1 += t2[1]; } bl0 += t2[0]; bl1 += t2[1]; }
                    const float em0 = fast_exp(fmaxf(bm0, -80.f)), em1 = fast_exp(fmaxf(bm1, -80.f));
                    const float el0 = fast_exp(fmaxf(bl0 - bm0, -80.f)), el1 = fast_exp(fmaxf(bl1 - bm1, -80.f));
                    if (w == 0) *(LAS f32x2*)(DEC + 2 * lane) = (f32x2){fast_exp(fmaxf(bl0, -80.f)), fast_exp(fmaxf(bl1, -80.f))};
                    unsigned kb0[4], kb1[4], vt0[4], vt1[4];
#pragma unroll
                    for (int r = 0; r < 8; ++r) {
                        const int t = 8 * w + r;
                        const float lf0 = bf_lo(rl[r]), lf1 = bf_hi(rl[r]);
                        const float d0 = fminf(fmaxf(pre0 + cs0[r] - bm0, -80.f), 80.f), d1 = fminf(fmaxf(pre1 + cs1[r] - bm1, -80.f), 80.f);
                        const float e0 = fast_exp(d0), e1 = fast_exp(d1), i0 = fast_exp(-d0), i1 = fast_exp(-d1);
                        const float kk0 = 1.0f - fast_exp(lf0), kk1 = 1.0f - fast_exp(lf1);
                        const float qt0 = bf_lo(rq[r]) * e0, qt1 = bf_hi(rq[r]) * e1, kt0 = kk0 * i0, kt1 = kk1 * i1;
                        *(LAS unsigned*)(QT + t * LDQ + 2 * lane) = cvt_pk_bf16(qt0, qt1);
                        *(LAS unsigned*)(KT + t * LDQ + 2 * lane) = cvt_pk_bf16(kt0, kt1);
                        *(LAS unsigned*)(QB + t * LDQ + 2 * lane) = cvt_pk_bf16(qt0 * em0, qt1 * em1);
                        const unsigned kbp = cvt_pk_bf16(kt0 * el0, kt1 * el1);
                        if (r & 1) { kb0[r >> 1] |= (kbp << 16); kb1[r >> 1] |= (kbp & 0xffff0000u); vt0[r >> 1] |= (rv[r] << 16); vt1[r >> 1] |= (rv[r] & 0xffff0000u); }
                        else { kb0[r >> 1] = kbp & 0xffffu; kb1[r >> 1] = kbp >> 16; vt0[r >> 1] = rv[r] & 0xffffu; vt1[r >> 1] = rv[r] >> 16; }
                    }
                    *(LAS u32x4*)(KBT + (2 * lane) * LDT + 8 * w) = (u32x4){kb0[0], kb0[1], kb0[2], kb0[3]};
                    *(LAS u32x4*)(KBT + (2 * lane + 1) * LDT + 8 * w) = (u32x4){kb1[0], kb1[1], kb1[2], kb1[3]};
                    *(LAS u32x4*)(VT + (2 * lane) * LDT + 8 * w) = (u32x4){vt0[0], vt0[1], vt0[2], vt0[3]};
                    *(LAS u32x4*)(VT + (2 * lane + 1) * LDT + 8 * w) = (u32x4){vt1[0], vt1[1], vt1[2], vt1[3]};
                    LDS_WAIT(); __syncthreads();
                    u32x4 gg[2];
                    { const bf16_t* gp = pbase + (size_t)(m0 + ot) * PROJ_LD + 1536 + 8 * ocg; gg[0] = *(const u32x4*)gp; gg[1] = *(const u32x4*)(gp + 64); }
                    if (c + 1 < NCHUNK) {
#pragma unroll
                        for (int r = 0; r < 8; ++r) { const bf16_t* p = pbase + (size_t)(m0 + CHUNK + 8 * w + r) * PROJ_LD + 2 * lane; rq[r] = *(const unsigned*)p; rl[r] = *(const unsigned*)(p + 512); rv[r] = *(const unsigned*)(p + 1024); }
                    }
#pragma unroll
                    for (int x2 = 0; x2 < 2; ++x2) { const int id = 2 * w + x2, si = id >> 2, ti = id & 3;
                        f32x4 sc = (f32x4){0.f, 0.f, 0.f, 0.f};
                        if (si <= ti) {
#pragma unroll
                            for (int ks = 0; ks < 4; ++ks) { const bf16x8 a = *(const LAS bf16x8*)(KT + (16 * si + fr) * LDQ + 32 * ks + 8 * fq), bb = *(const LAS bf16x8*)(QT + (16 * ti + fr) * LDQ + 32 * ks + 8 * fq);
                                sc = __builtin_amdgcn_mfma_f32_16x16x32_bf16(a, bb, sc, 0, 0, 0); }
                            const int t = 16 * ti + fr, s0 = 16 * si + 4 * fq;
#pragma unroll
                            for (int j = 0; j < 4; ++j) sc[j] = (s0 + j <= t) ? sc[j] : 0.f;
                        }
                        *(LAS u32x2*)(PM + (16 * ti + fr) * LDT + 16 * si + 4 * fq) = (u32x2){cvt_pk_bf16(sc[0], sc[1]), cvt_pk_bf16(sc[2], sc[3])};
                    }
                    f32x4 oacc[4];
                    { bf16x8 sa[4];
#pragma unroll
                        for (int ks = 0; ks < 4; ++ks) sa[ks] = *(const LAS bf16x8*)(ST + (16 * w + fr) * LDQ + 32 * ks + 8 * fq);
#pragma unroll
                        for (int ti = 0; ti < 4; ++ti) { oacc[ti] = (f32x4){0.f, 0.f, 0.f, 0.f};
#pragma unroll
                            for (int ks = 0; ks < 4; ++ks) { const bf16x8 bb = *(const LAS bf16x8*)(QB + (16 * ti + fr) * LDQ + 32 * ks + 8 * fq); oacc[ti] = __builtin_amdgcn_mfma_f32_16x16x32_bf16(sa[ks], bb, oacc[ti], 0, 0, 0); } } }
                    LDS_WAIT(); __syncthreads();
                    { bf16x8 va[2];
#pragma unroll
                        for (int ks = 0; ks < 2; ++ks) va[ks] = *(const LAS bf16x8*)(VT + (16 * w + fr) * LDT + 32 * ks + 8 * fq);
#pragma unroll
                        for (int ti = 0; ti < 4; ++ti)
#pragma unroll
                            for (int ks = 0; ks < 2; ++ks) { const bf16x8 bb = *(const LAS bf16x8*)(PM + (16 * ti + fr) * LDT + 32 * ks + 8 * fq); oacc[ti] = __builtin_amdgcn_mfma_f32_16x16x32_bf16(va[ks], bb, oacc[ti], 0, 0, 0); }
#pragma unroll
                        for (int i = 0; i < 8; ++i) { const f32x4 dv = *(const LAS f32x4*)(DEC + 16 * i + 4 * fq); Sacc[i] = Sacc[i] * dv;
#pragma unroll
                            for (int ks = 0; ks < 2; ++ks) { const bf16x8 a = *(const LAS bf16x8*)(KBT + (16 * i + fr) * LDT + 32 * ks + 8 * fq); Sacc[i] = __builtin_amdgcn_mfma_f32_16x16x32_bf16(a, va[ks], Sacc[i], 0, 0, 0); } } }
#pragma unroll
                    for (int ti = 0; ti < 4; ++ti) *(LAS u32x2*)(OS + (16 * ti + fr) * LDQ + 16 * w + 4 * fq) = (u32x2){cvt_pk_bf16(oacc[ti][0], oacc[ti][1]), cvt_pk_bf16(oacc[ti][2], oacc[ti][3])};
#pragma unroll
                    for (int i = 0; i < 8; ++i) *(LAS u32x2*)(ST + (16 * w + fr) * LDQ + 16 * i + 4 * fq) = (u32x2){cvt_pk_bf16(Sacc[i][0], Sacc[i][1]), cvt_pk_bf16(Sacc[i][2], Sacc[i][3])};
                    LDS_WAIT(); __syncthreads();
                    { f32x4 o[4]; const u32x4 ow0 = *(const LAS u32x4*)(OS + ot * LDQ + 8 * ocg), ow1 = *(const LAS u32x4*)(OS + ot * LDQ + 64 + 8 * ocg); gm::unpack8(ow0, o[0], o[1]); gm::unpack8(ow1, o[2], o[3]);
                        float ss = 0.f;
#pragma unroll
                        for (int q = 0; q < 4; ++q) ss += (o[q][0] * o[q][0] + o[q][1] * o[q][1]) + (o[q][2] * o[q][2] + o[q][3] * o[q][3]);
                        ss += __shfl_xor(ss, 1); ss += __shfl_xor(ss, 2); ss += __shfl_xor(ss, 4);
                        const float rn = __builtin_amdgcn_rsqf(ss * (1.0f / 128.0f) + EPS);
                        bf16_t* op = OB + (size_t)(b * SEQ + m0 + ot) * HW + h * DK + 8 * ocg;
#pragma unroll
                        for (int q = 0; q < 2; ++q) { f32x4 g0, g1; gm::unpack8(gg[q], g0, g1);
#pragma unroll
                            for (int j = 0; j < 4; ++j) { g0[j] = g0[j] * sigmoidf_(g0[j]); g1[j] = g1[j] * sigmoidf_(g1[j]); }
                            *(u32x4*)(op + 64 * q) = gm::pack8(o[2 * q] * rn * nwv[2 * q] * g0, o[2 * q + 1] * rn * nwv[2 * q + 1] * g1); } }
                }
            }
        } else {
            const int nconv = G - nchainblk;
            f32x4 cw[3][2];
#pragma unroll
            for (int j = 0; j < 3; ++j) { cw[j][0] = *(const f32x4*)(conv_w + j * 512 + 8 * lane); cw[j][1] = *(const f32x4*)(conv_w + j * 512 + 8 * lane + 4); }
            for (int it = bid - nchainblk; it < BATCH * 8; it += nconv) {
                const int b = it >> 3, t0 = (it & 7) * 256 + wave * 32;
                const bf16_t* pb = PROJ + (size_t)(b * SEQ) * PROJ_LD + 2048 + 8 * lane;
                f32x4 p1[2], p2[2];
#pragma unroll
                for (int q = 0; q < 2; ++q) { p1[q] = (f32x4){0.f, 0.f, 0.f, 0.f}; p2[q] = p1[q]; }
                if (t0 > 0) {
                    f32x4 a0, a1, c0, c1;
                    gm::unpack8(*(const u32x4*)(pb + (size_t)(t0 - 2) * PROJ_LD + 512), a0, a1); gm::unpack8(*(const u32x4*)(pb + (size_t)(t0 - 2) * PROJ_LD + 1024), c0, c1); p2[0] = a0 * c0; p2[1] = a1 * c1;
                    gm::unpack8(*(const u32x4*)(pb + (size_t)(t0 - 1) * PROJ_LD + 512), a0, a1); gm::unpack8(*(const u32x4*)(pb + (size_t)(t0 - 1) * PROJ_LD + 1024), c0, c1); p1[0] = a0 * c0; p1[1] = a1 * c1;
                }
                for (int r = 0; r < 32; ++r) { const size_t ro = (size_t)(t0 + r) * PROJ_LD;
                    f32x4 a0, a1, c0, c1, g0, g1;
                    gm::unpack8(*(const u32x4*)(pb + ro + 512), a0, a1); gm::unpack8(*(const u32x4*)(pb + ro + 1024), c0, c1); gm::unpack8(*(const u32x4*)(pb + ro), g0, g1);
                    const f32x4 q0 = a0 * c0, q1 = a1 * c1;
                    const f32x4 y0 = g0 * (cw[0][0] * p2[0] + cw[1][0] * p1[0] + cw[2][0] * q0), y1 = g1 * (cw[0][1] * p2[1] + cw[1][1] * p1[1] + cw[2][1] * q1);
                    *(u32x4*)(CVB + (size_t)(b * SEQ + t0 + r) * HW + 8 * lane) = gm::pack8(y0, y1);
                    p2[0] = p1[0]; p2[1] = p1[1]; p1[0] = q0; p1[1] = q1; }
            }
        }
        if (BOTH(3)) GRID_BAR();
    }

    if (IN(4)) for (int rep_ = 0; rep_ < 1 + ((MK_REPEAT >> 4) & 1); ++rep_) { PHASE_ARGS();
        gm::DenseOrder S{NTOK / 256, D / 256, G, bid, 2}; gm::DenseA AM{HW, (unsigned)(WS_CV - WS_O), 2}; gm::EpiMerge E{(const bf16_t*)ap->out, WSP(bf16_t, WS_U)};
        gm::gemm_phase<false>(wave_sg, lds, (const char*)WSP(bf16_t, WS_O), (const char*)WSP(bf16_t, WS_WHG), HW, 0, (unsigned)(WS_WCV - WS_WHG), S, E, AM);
        if (BOTH(4)) GRID_BAR();
    }

    if (IN(5)) for (int rep_ = 0; rep_ < 1 + ((MK_REPEAT >> 5) & 1); ++rep_) { PHASE_ARGS();
        gm::DenseOrder S{NTOK / 256, D / 256, G, bid, 1}; gm::DenseA AM{D, 0u, 2}; gm::EpiMix E{ARG(I_X), WSP(float, WS_MOD), WSP(bf16_t, WS_H)};
        gm::gemm_phase<false>(wave_sg, lds, (const char*)WSP(bf16_t, WS_U), (const char*)WSP(bf16_t, WS_WMIX), D, 0, 0u, S, E, AM);
        if (BOTH(5)) GRID_BAR();
    }

    if (IN(6)) { PHASE_IDS(); PHASE_ARGS();
        const float* norm_ffn_w = ARG(I_NFFN); const float* w_router = ARG(I_WR); const float* b_router = ARG(I_BR); const float* MOD = WSP(float, WS_MOD);
        const bf16_t* HB = WSP(bf16_t, WS_H); unsigned char* U2Q = WSP(unsigned char, WS_U2Q); int* TOPI = WSP(int, WS_TOPI); float* TOPP = WSP(float, WS_TOPP); int* POS = WSP(int, WS_POS);
        LAS float* WRT = (LAS float*)lds;
        LAS unsigned* LCNT = (LAS unsigned*)(lds + 131072);
        LAS unsigned* LBASE = LCNT + 32;
        LAS unsigned* LASS = LCNT + 64;
        for (int i = tid; i < 32 * 1024; i += NTHREADS) { const int e = i >> 10, k = i & 1023; WRT[i] = w_router[(size_t)k * NE + e]; }
        for (int tb = bid; tb < NTOK / 256; tb += G) {
            if (tid < 32) LCNT[tid] = 0u;
            LDS_WAIT(); __syncthreads();
            const int b = (tb * 256) >> 11;
            f32x4 A[4], Sh[4];
#pragma unroll
            for (int j = 0; j < 4; ++j) { const int k = 4 * lane + 256 * j; const f32x4 w = *(const f32x4*)(norm_ffn_w + k), sc = *(const f32x4*)(MOD + (size_t)b * 6144 + 4096 + k);
                A[j] = w * (sc + 1.0f); Sh[j] = *(const f32x4*)(MOD + (size_t)b * 6144 + 3072 + k); }
            const int myexp = ((lane >> 5) & 1) * 16 + ((lane >> 4) & 1) * 8 + ((lane >> 3) & 1) * 4 + ((lane >> 2) & 1) * 2 + ((lane >> 1) & 1);
            const float mybr = b_router[myexp];
            for (int p = 0; p < 16; ++p) {
                const int ltok = wave * 32 + 2 * p, tok = tb * 256 + ltok;
                f32x4 uu[2][4];
#pragma unroll
                for (int xx = 0; xx < 2; ++xx) {
                    const bf16_t* hr = HB + (size_t)(tok + xx) * D; float s = 0.f;
#pragma unroll
                    for (int j = 0; j < 4; ++j) { const u32x2 w = *(const u32x2*)(hr + 4 * lane + 256 * j); uu[xx][j] = (f32x4){bf_lo(w.x), bf_hi(w.x), bf_lo(w.y), bf_hi(w.y)};
                        s += (uu[xx][j][0] * uu[xx][j][0] + uu[xx][j][1] * uu[xx][j][1]) + (uu[xx][j][2] * uu[xx][j][2] + uu[xx][j][3] * uu[xx][j][3]); }
                    const float rs = __builtin_amdgcn_rsqf(wave_sum(s) * (1.0f / D) + EPS);
                    unsigned char* ur = U2Q + (size_t)(tok + xx) * D;
#pragma unroll
                    for (int j = 0; j < 4; ++j) { uu[xx][j] = uu[xx][j] * rs * A[j] + Sh[j]; *(unsigned*)(ur + 4 * lane + 256 * j) = pk4_fp8(uu[xx][j][0], uu[xx][j][1], uu[xx][j][2], uu[xx][j][3]); }
                }
                float a0[32], a1[32];
#pragma unroll
                for (int e = 0; e < 32; ++e) { float s0 = 0.f, s1 = 0.f;
#pragma unroll
                    for (int j = 0; j < 4; ++j) { const f32x4 w = *(const LAS f32x4*)(WRT + e * 1024 + 4 * lane + 256 * j);
                        s0 += (w[0] * uu[0][j][0] + w[1] * uu[0][j][1]) + (w[2] * uu[0][j][2] + w[3] * uu[0][j][3]);
                        s1 += (w[0] * uu[1][j][0] + w[1] * uu[1][j][1]) + (w[2] * uu[1][j][2] + w[3] * uu[1][j][3]); }
                    a0[e] = s0; a1[e] = s1; }
#define TR_STEP(arr, mask, n) do { const bool sel = (lane & (mask)) != 0; _Pragma("unroll") for (int i = 0; i < (n); ++i) { const float keep = sel ? arr[(n) + i] : arr[i], send = sel ? arr[i] : arr[(n) + i]; arr[i] = keep + __shfl_xor(send, (mask)); } } while (0)
                TR_STEP(a0, 32, 16); TR_STEP(a0, 16, 8); TR_STEP(a0, 8, 4); TR_STEP(a0, 4, 2); TR_STEP(a0, 2, 1); a0[0] += __shfl_xor(a0[0], 1);
                TR_STEP(a1, 32, 16); TR_STEP(a1, 16, 8); TR_STEP(a1, 8, 4); TR_STEP(a1, 4, 2); TR_STEP(a1, 2, 1); a1[0] += __shfl_xor(a1[0], 1);
#pragma unroll
                for (int xx = 0; xx < 2; ++xx) {
                    float val = (xx == 0 ? a0[0] : a1[0]) + mybr;
                    float tv[4]; int tix[4];
#pragma unroll
                    for (int r = 0; r < 4; ++r) { float bv = val; int bi = myexp;
#pragma unroll
                        for (int o = 1; o < 64; o <<= 1) { const float ov = __shfl_xor(bv, o); const int oi = __shfl_xor(bi, o); if (ov > bv || (ov == bv && oi < bi)) { bv = ov; bi = oi; } }
                        tv[r] = bv; tix[r] = bi; if (myexp == bi) val = -3.0e38f; }
                    const float e1 = fast_exp(tv[1] - tv[0]), e2 = fast_exp(tv[2] - tv[0]), e3 = fast_exp(tv[3] - tv[0]); const float inv = fast_rcp(1.0f + e1 + e2 + e3);
                    if (lane < 4) { const int e = lane == 0 ? tix[0] : lane == 1 ? tix[1] : lane == 2 ? tix[2] : tix[3]; const float pr = (lane == 0 ? 1.0f : lane == 1 ? e1 : lane == 2 ? e2 : e3) * inv;
                        TOPI[(size_t)(tok + xx) * 4 + lane] = e; TOPP[(size_t)(tok + xx) * 4 + lane] = pr;
                        const unsigned rank = __hip_atomic_fetch_add(LCNT + e, 1u, __ATOMIC_RELAXED, __HIP_MEMORY_SCOPE_WORKGROUP); LASS[(ltok + xx) * 4 + lane] = ((unsigned)e << 16) | rank; }
                }
            }
            LDS_WAIT(); __syncthreads();
            if (tid < 32) LBASE[tid] = atomicAdd(ctl + CW_CNT + 64 * tid, (unsigned)LCNT[tid]);
            LDS_WAIT(); __syncthreads();
            for (int i = tid; i < 1024; i += NTHREADS) { const unsigned v = LASS[i]; POS[(size_t)tb * 1024 + i] = (int)(LBASE[v >> 16] + (v & 0xffffu)); }
            __syncthreads();
        }
        if (BOTH(6)) GRID_BAR();
    }

    LAS int* PADSTART = (LAS int*)(lds + TBL_OFF); LAS int* TILE_E = PADSTART + 64;
    int ntiles = 0;
    {
        if (lo <= 9 && hi > 7) { PHASE_IDS(); PHASE_ARGS();
            __syncthreads();
            if (tid == 0) { int acc = 0; for (int e = 0; e < NE; ++e) { PADSTART[e] = acc; const int cnt = (int)__hip_atomic_load(ctl + CW_CNT + 64 * e, __ATOMIC_RELAXED, __HIP_MEMORY_SCOPE_AGENT); const int nt_e = (cnt + 255) >> 8; for (int t = 0; t < nt_e; ++t) TILE_E[(acc >> 8) + t] = e; acc += nt_e << 8; } PADSTART[NE] = acc; }
            LDS_WAIT(); __syncthreads();
            ntiles = PADSTART[NE] >> 8;
        }
    }

    if (IN(7)) for (int rep_ = 0; rep_ < 1 + ((MK_REPEAT >> 7) & 1); ++rep_) { PHASE_IDS(); PHASE_ARGS();
        const int* TOPI = WSP(int, WS_TOPI); const float* TOPP = WSP(float, WS_TOPP); const int* POS = WSP(int, WS_POS); int* RTOK = WSP(int, WS_RTOK); int* RSLOT = WSP(int, WS_RSLOT); float* RW = WSP(float, WS_RW);
        for (int i = bid * NTHREADS + tid; i < NASSIGN; i += G * NTHREADS) { const int e = TOPI[i]; const int row = PADSTART[e] + POS[i]; RTOK[row] = i >> 2; RSLOT[row] = i; RW[row] = TOPP[i]; }
        for (int e = bid; e < NE; e += G) { const int cnt = (int)__hip_atomic_load(ctl + CW_CNT + 64 * e, __ATOMIC_RELAXED, __HIP_MEMORY_SCOPE_AGENT);
            for (int r = PADSTART[e] + cnt + tid; r < PADSTART[e + 1]; r += NTHREADS) { RTOK[r] = 0; RSLOT[r] = -1; RW[r] = 0.f; } }
        if (BOTH(7)) GRID_BAR();
    }

    if (IN(8)) for (int rep_ = 0; rep_ < 1 + ((MK_REPEAT >> 8) & 1); ++rep_) { PHASE_ARGS();
        gm::MoeOrder S{ntiles, 2048 / 256, G, bid, TILE_E}; gm::GatherA AM{D, WSP(int, WS_RTOK), 1}; gm::EpiSwiglu E{ARG(I_B1), WSP(unsigned char, WS_ACT)};
        gm::gemm_phase<true>(wave_sg, lds, (const char*)WSP(char, WS_U2Q), (const char*)WSP(char, WS_W1), D, 2048, 0u, S, E, AM);
        if (BOTH(8)) GRID_BAR();
    }

    if (IN(9)) for (int rep_ = 0; rep_ < 1 + ((MK_REPEAT >> 9) & 1); ++rep_) { PHASE_ARGS();
        gm::MoeOrder S{ntiles, D / 256, G, bid, TILE_E}; gm::DenseA AM{DFF, 0u, 1}; gm::EpiMoeOut E{ARG(I_B2), WSP(int, WS_RSLOT), WSP(float, WS_RW), (bf16_t*)ap->out, WSP(bf16_t, WS_YO23)};
        gm::gemm_phase<true>(wave_sg, lds, (const char*)WSP(char, WS_ACT), (const char*)WSP(char, WS_W2), DFF, D, 0u, S, E, AM);
        if (BOTH(9)) GRID_BAR();
    }

#if MK_PROBE
    if (lo == 100) { PHASE_IDS(); PHASE_ARGS();
        float* out = ap->out;
        const bf16_t* src = MK_PROBE == 1 ? WSP(bf16_t, WS_U) : MK_PROBE == 3 ? WSP(bf16_t, WS_O) : MK_PROBE == 4 ? WSP(bf16_t, WS_U) : MK_PROBE == 5 ? WSP(bf16_t, WS_H) : WSP(bf16_t, WS_U);
        for (size_t i = (size_t)bid * NTHREADS + tid; i < (size_t)NTOK * D; i += (size_t)G * NTHREADS) {
            float v;
            if (MK_PROBE == 3) { const size_t t = i >> 10, c = i & 1023; v = bf1(c < 512 ? src[t * 512 + c] : WSP(bf16_t, WS_CV)[t * 512 + (c - 512)]); }
            else if (MK_PROBE == 2) { const size_t t = i >> 10, c = i & 1023; const bf16_t* P = WSP(bf16_t, WS_PROJ) + t * PROJ_LD; v = bf1(P[c]) + bf1(P[c + 1024]) + bf1(P[c + 2048]) + (c < 512 ? bf1(P[c + 3072]) : 0.f); }
            else if (MK_PROBE == 6) { const size_t t = i >> 10, c = i & 1023; v = bf1(src[i]) + (c < 4 ? (float)WSP(int, WS_TOPI)[t * 4 + c] : c < 8 ? WSP(float, WS_TOPP)[t * 4 + (c - 4)] : 0.f); }
            else v = bf1(src[i]);
            out[i] = v; }
    }
#endif
    if (IN(10)) { PHASE_IDS(); PHASE_ARGS();
#if MK_FP8TEST
        float tscale = 1.0f;
        {
            typedef int v8i __attribute__((ext_vector_type(8)));
            const int fr = lane & 15, fq = lane >> 4;
            v8i ta, tb;
#pragma unroll
            for (int d = 0; d < 8; ++d) { float av[4], bv[4];
#pragma unroll
                for (int e = 0; e < 4; ++e) { const int k = 32 * fq + 4 * d + e; av[e] = (float)(((fr * 7 + k * 3) % 5) - 2); bv[e] = (float)(((k * 5 + fr * 11) % 7) - 3); }
                int w = __builtin_amdgcn_cvt_pk_fp8_f32(av[0], av[1], 0, false); w = __builtin_amdgcn_cvt_pk_fp8_f32(av[2], av[3], w, true); ta[d] = w;
                w = __builtin_amdgcn_cvt_pk_fp8_f32(bv[0], bv[1], 0, false); w = __builtin_amdgcn_cvt_pk_fp8_f32(bv[2], bv[3], w, true); tb[d] = w; }
            f32x4 tc = {0.f, 0.f, 0.f, 0.f};
            tc = __builtin_amdgcn_mfma_scale_f32_16x16x128_f8f6f4(ta, tb, tc, 0, 0, 0, 0x7A7A7A7A, 0, 0x7F7F7F7F);
            bool bad = false;
#pragma unroll
            for (int r = 0; r < 4; ++r) { const int i = 4 * fq + r, j = fr; float ref = 0.f;
                for (int k = 0; k < 128; ++k) ref += (float)(((i * 7 + k * 3) % 5) - 2) * (float)(((k * 5 + j * 11) % 7) - 3);
                ref *= (1.0f / 32.0f); if (fabsf(tc[r] - ref) > 1e-3f) bad = true; }
            if (__any(bad)) tscale = 4.0f;
        }
#endif
        const float* norm_final_w = ARG(I_NFIN); const float* MOD = WSP(float, WS_MOD); const bf16_t* HB = WSP(bf16_t, WS_H); const bf16_t* YO01 = (const bf16_t*)ap->out; const bf16_t* YO23 = WSP(bf16_t, WS_YO23); float* out = ap->out;
        for (int m0 = gw * 32; m0 < NTOK; m0 += NGW * 32) {
            const int b = m0 >> 11;
            f32x4 gf[4], nf[4];
#pragma unroll
            for (int j = 0; j < 4; ++j) { const int k = 4 * lane + 256 * j; gf[j] = *(const f32x4*)(MOD + (size_t)b * 6144 + 5120 + k); nf[j] = *(const f32x4*)(norm_final_w + k); }
            for (int r = 0; r < 32; ++r) {
                const size_t tok = (size_t)(m0 + r);
                const bf16_t* hr = HB + tok * D; const bf16_t* y0 = YO01 + tok * 2048; const bf16_t* y2 = YO23 + tok * 2048;
                f32x4 v[4]; float s = 0.f;
#pragma unroll
                for (int j = 0; j < 4; ++j) { const int k = 4 * lane + 256 * j;
                    const u32x2 hw = *(const u32x2*)(hr + k), ya = *(const u32x2*)(y0 + k), yb = *(const u32x2*)(y0 + 1024 + k), yc = *(const u32x2*)(y2 + k), yd = *(const u32x2*)(y2 + 1024 + k);
                    f32x4 y = (f32x4){bf_lo(ya.x), bf_hi(ya.x), bf_lo(ya.y), bf_hi(ya.y)};
                    y += (f32x4){bf_lo(yb.x), bf_hi(yb.x), bf_lo(yb.y), bf_hi(yb.y)}; y += (f32x4){bf_lo(yc.x), bf_hi(yc.x), bf_lo(yc.y), bf_hi(yc.y)}; y += (f32x4){bf_lo(yd.x), bf_hi(yd.x), bf_lo(yd.y), bf_hi(yd.y)};
                    v[j] = (f32x4){bf_lo(hw.x), bf_hi(hw.x), bf_lo(hw.y), bf_hi(hw.y)} + gf[j] * y;
                    s += (v[j][0] * v[j][0] + v[j][1] * v[j][1]) + (v[j][2] * v[j][2] + v[j][3] * v[j][3]); }
                const float rs = __builtin_amdgcn_rsqf(wave_sum(s) * (1.0f / D) + EPS);
                float* orow = out + tok * D;
#pragma unroll
                #if MK_FP8TEST
                for (int j = 0; j < 4; ++j) *(f32x4*)(orow + 4 * lane + 256 * j) = v[j] * rs * nf[j] * tscale;
#else
                for (int j = 0; j < 4; ++j) *(f32x4*)(orow + 4 * lane + 256 * j) = v[j] * rs * nf[j];
#endif
            }
        }
    }
#undef IN
#undef BOTH
}

extern "C" void kernel_launch(void* const* d_in, const int* in_sizes, int n_in, void* d_out, int out_size, void* d_ws, size_t ws_size, hipStream_t stream) {
    static int grid = 0;
    if (grid == 0) {
        if (n_in != 20 || out_size != NTOK * D || ws_size < WS_END) { fprintf(stderr, "kernel_launch: unexpected shapes (n_in %d out %d ws %zu)\n", n_in, out_size, ws_size); grid = -1; return; }
        if (hipFuncSetAttribute((const void*)fwd_kernel, hipFuncAttributeMaxDynamicSharedMemorySize, LDS_BYTES) != hipSuccess) { fprintf(stderr, "kernel_launch: hipFuncSetAttribute failed\n"); grid = -1; return; }
        int dev = 0, cus = 0, per_cu = 0;
        (void)hipGetDevice(&dev); (void)hipDeviceGetAttribute(&cus, hipDeviceAttributeMultiprocessorCount, dev);
        if (hipOccupancyMaxActiveBlocksPerMultiprocessor(&per_cu, (const void*)fwd_kernel, NTHREADS, LDS_BYTES) != hipSuccess || per_cu < 1) fprintf(stderr, "kernel_launch: occupancy query says %d\n", per_cu);
        (void)hipGetLastError();
        grid = cus > 0 ? cus : 256;
    }
    if (grid < 0) return;
    (void)hipMemsetAsync((char*)d_ws + WS_CTL, 0, CTL_ZERO_BYTES, stream);
    Args a{};
    for (int i = 0; i < 20; ++i) a.in[i] = (const float*)d_in[i];
    a.out = (float*)d_out; a.ws = (unsigned char*)d_ws;
#if MK_ONE_LAUNCH
    a.ph_lo = 0; a.ph_hi = NPHASE;
    hipLaunchKernelGGL(fwd_kernel, dim3(grid), dim3(NTHREADS), LDS_BYTES, stream, a);
#else
#if MK_PROBE
    for (int p = 0; p <= MK_PROBE; ++p) { a.ph_lo = p; a.ph_hi = p + 1; hipLaunchKernelGGL(fwd_kernel, dim3(grid), dim3(NTHREADS), LDS_BYTES, stream, a); }
    a.ph_lo = 100; a.ph_hi = 101; hipLaunchKernelGGL(fwd_kernel, dim3(grid), dim3(NTHREADS), LDS_BYTES, stream, a);
#else
    for (int p = 0; p < NPHASE; ++p) { a.ph_lo = p; a.ph_hi = p + 1; hipLaunchKernelGGL(fwd_kernel, dim3(grid), dim3(NTHREADS), LDS_BYTES, stream, a); }
#endif
#endif
}
```

```cpp
#include <hip/hip_runtime.h>
#include <cstdio>
#include <cstdint>

#ifndef MK_PROBE
#define MK_PROBE 0
#endif
#ifndef MK_REPEAT
#define MK_REPEAT 0
#endif
#ifndef MK_FP8TEST
#define MK_FP8TEST 0
#endif
#ifndef MK_STAGGER
#define MK_STAGGER 0
#endif
#ifndef MK_TPROBE
#define MK_TPROBE 0
#endif
#ifndef MK_PHT
#define MK_PHT 0
#endif
#ifndef MK_P2FP8
#define MK_P2FP8 0
#endif
#ifndef MK_ONE_LAUNCH
#define MK_ONE_LAUNCH 1
#endif

#define LAS __attribute__((address_space(3)))
#define GAS __attribute__((address_space(1)))
typedef unsigned short bf16_t;
typedef short bf16x8 __attribute__((ext_vector_type(8)));
typedef float f32x4 __attribute__((ext_vector_type(4)));
typedef float f32x2 __attribute__((ext_vector_type(2)));
typedef unsigned u32x4 __attribute__((ext_vector_type(4)));
typedef unsigned u32x2 __attribute__((ext_vector_type(2)));
typedef int v8i __attribute__((ext_vector_type(8)));

constexpr int D = 1024, BATCH = 32, SEQ = 2048, NTOK = BATCH * SEQ;
constexpr int HW = 512, NHEAD = 4, DK = 128, CHUNK = 64, NCHUNK = SEQ / CHUNK;
constexpr int INC = 5632, PROJ_LD = 3584, GATE_LD = 2048;
constexpr int NE = 32, TOPK = 4, DFF = 1024, NASSIGN = NTOK * TOPK;
constexpr int MAXTILES = NASSIGN / 256 + NE;
constexpr int MAXROWS = MAXTILES * 256;
constexpr float EPS = 1e-6f, SW_LIMIT = 7.0f, SW_ALPHA = 1.702f;
constexpr int NWAVES = 8, NTHREADS = 512;
constexpr int NPHASE = 11;

constexpr size_t MiB = 1u << 20;
constexpr size_t WS_CTL = 0, CTL_ZERO_BYTES = 65536;
constexpr size_t WS_MOD = 1 * MiB;
constexpr size_t WS_LB = WS_MOD + 32 * 6144 * 4;
constexpr size_t WS_WIN = 2 * MiB;
constexpr size_t WS_WHG = 13 * MiB, WS_WCV = 14 * MiB, WS_WMIX = 15 * MiB;
constexpr size_t WS_W2 = 18 * MiB;
constexpr size_t WS_W1 = 50 * MiB;
constexpr size_t WS_U2Q = 114 * MiB;
constexpr size_t WS_U = 210 * MiB;
constexpr size_t WS_PROJ = 338 * MiB;
constexpr size_t WS_O = 786 * MiB;
constexpr size_t WS_CV = 850 * MiB;
constexpr size_t WS_H = 338 * MiB;
constexpr size_t WS_ACT = 466 * MiB;
constexpr size_t WS_TOPI = 994 * MiB, WS_TOPP = 995 * MiB, WS_POS = 996 * MiB;
constexpr size_t WS_RTOK = 997 * MiB, WS_RSLOT = 997 * MiB + 1081344 + 0, WS_RW = WS_RSLOT + 1081344;
constexpr size_t WS_YA = 50 * MiB, WS_YB = 730 * MiB; constexpr int YSPLIT = 147456;
constexpr size_t WS_YO23_UNUSED = 730 * MiB;
constexpr size_t WS_END = 1001 * MiB;
static_assert(WS_RW + 1081344 <= WS_END && MAXROWS * 4 == 1081344, "tables");
static_assert(WS_ACT + (size_t)MAXROWS * 1024 <= WS_YB && WS_YB + (size_t)(MAXROWS - YSPLIT) * 2048 <= WS_TOPI && WS_YA + (size_t)YSPLIT * 2048 <= WS_H && YSPLIT % 256 == 0, "expert output map");
constexpr int CW_TMO = 0, CW_BAR = 4096, CW_CNT = 8192, CW_TP = 12288;

constexpr int LDS_BYTES = 163840;
constexpr int MISC_OFF = LDS_BYTES - 256;
constexpr int TBL_OFF = 131072;
constexpr int SIDE_OFF = TBL_OFF + 8192;

#define LDS_WAIT() asm volatile("s_waitcnt lgkmcnt(0)" ::: "memory")
#define VM_WAIT() asm volatile("s_waitcnt vmcnt(0)" ::: "memory")
typedef __bf16 bf16x2_t __attribute__((ext_vector_type(2)));
__device__ __forceinline__ unsigned cvt_pk_bf16(float lo, float hi) { const f32x2 v = {lo, hi}; const bf16x2_t b = __builtin_convertvector(v, bf16x2_t); return __builtin_bit_cast(unsigned, b); }
__device__ __forceinline__ unsigned pk4_fp8(float a, float b, float c, float d) {
    a = fminf(fmaxf(a, -448.f), 448.f); b = fminf(fmaxf(b, -448.f), 448.f); c = fminf(fmaxf(c, -448.f), 448.f); d = fminf(fmaxf(d, -448.f), 448.f);
    int w = __builtin_amdgcn_cvt_pk_fp8_f32(a, b, 0, false); w = __builtin_amdgcn_cvt_pk_fp8_f32(c, d, w, true); return (unsigned)w; }
__device__ __forceinline__ f32x4 fp8x4_to_f32(unsigned w) {
    const f32x2 lo = __builtin_amdgcn_cvt_pk_f32_fp8((int)w, false), hi = __builtin_amdgcn_cvt_pk_f32_fp8((int)w, true); return (f32x4){lo[0], lo[1], hi[0], hi[1]}; }
__device__ __forceinline__ float bf_lo(unsigned u) { return __uint_as_float(u << 16); }
__device__ __forceinline__ float bf_hi(unsigned u) { return __uint_as_float(u & 0xffff0000u); }
__device__ __forceinline__ float bf1(bf16_t u) { return __uint_as_float(((unsigned)u) << 16); }
__device__ __forceinline__ float fast_rcp(float x) { return __builtin_amdgcn_rcpf(x); }
__device__ __forceinline__ float fast_exp(float x) { return __builtin_amdgcn_exp2f(x * 1.44269504089f); }
__device__ __forceinline__ float fast_log(float x) { return __builtin_amdgcn_logf(x) * 0.69314718056f; }
__device__ __forceinline__ float sigmoidf_(float x) { return fast_rcp(1.0f + fast_exp(-x)); }
__device__ __forceinline__ float wave_sum(float v) {
#pragma unroll
    for (int o = 1; o < 64; o <<= 1) v += __shfl_xor(v, o);
    return v;
}

#define XB_TMO      128
#define XB_XCNT(j)  (256  + 64 * (j))
#define XB_XSUB(j)  (1280 + 64 * (j))
#define XB_XGEN(j)  (2304 + 64 * (j))
#define XB_TOP      3328
#define XB_TOPGEN   3392
#define XCD_BAR_WORDS 3456
#define XB_SPIN_CAP (1u << 20)
__device__ __forceinline__ unsigned xb_ld(unsigned* p)              { return __hip_atomic_load(p, __ATOMIC_RELAXED, __HIP_MEMORY_SCOPE_AGENT); }
__device__ __forceinline__ unsigned xb_add(unsigned* p, unsigned v) { return __hip_atomic_fetch_add(p, v, __ATOMIC_RELAXED, __HIP_MEMORY_SCOPE_AGENT); }
__device__ __forceinline__ unsigned xb_xcc_id() { return (unsigned)__builtin_amdgcn_s_getreg((3 << 11) | 20) & 0xFu; }
#define XB_SPIN(cond, bar) do { unsigned _sp = 0; while (cond) { __builtin_amdgcn_s_sleep(1); \
    if ((++_sp & 255u) == 0u) { if (xb_ld(&(bar)[XB_TMO])) break; if (_sp > XB_SPIN_CAP) { atomicAdd(&(bar)[XB_TMO], 1u); break; } } } } while (0)
struct XcdBarrier { unsigned* bar; unsigned x; volatile LAS unsigned* st; };
__device__ __forceinline__ XcdBarrier xcd_barrier_post(unsigned* bar, volatile LAS unsigned* st) {
    XcdBarrier b; b.bar = bar; b.x = xb_xcc_id(); b.st = st;
    if (threadIdx.x == 0) (void)xb_add(&bar[XB_XCNT(b.x)], 1u);
    return b;
}
__device__ __forceinline__ void xcd_barrier_complete(unsigned* bar, unsigned x, unsigned& nloc, unsigned& nx) {
    const unsigned G = gridDim.x * gridDim.y * gridDim.z;
    unsigned sum, cnt, mine, sp = 0u;
    for (;;) {
        sum = 0u; cnt = 0u; mine = 0u;
#pragma unroll
        for (unsigned j = 0; j < 16; ++j) { const unsigned c = xb_ld(&bar[XB_XCNT(j)]); sum += c; cnt += (c > 0u) ? 1u : 0u; mine = (j == x) ? c : mine; }
        if (sum == G) break;
        __builtin_amdgcn_s_sleep(1);
        if ((++sp & 255u) == 0u) { if (xb_ld(&bar[XB_TMO])) break; if (sp > XB_SPIN_CAP) { atomicAdd(&bar[XB_TMO], 1u); break; } }
    }
    nloc = mine > 0u ? mine : 1u; nx = cnt > 0u ? cnt : 1u;
}
__device__ __forceinline__ void xcd_barrier(const XcdBarrier& b) {
    asm volatile("s_waitcnt vmcnt(0)" ::: "memory");
    __syncthreads();
    if (threadIdx.x == 0) {
        unsigned* bar = b.bar;
        __builtin_amdgcn_s_waitcnt(0);
        unsigned nloc = b.st[0], nx = b.st[1];
        if (nloc == 0u) { xcd_barrier_complete(bar, b.x, nloc, nx); b.st[0] = nloc; b.st[1] = nx; }
        const unsigned old = xb_add(&bar[XB_XSUB(b.x)], 1u);
        const unsigned gen = old / nloc;
        if (old + 1u == (gen + 1u) * nloc) {
            __builtin_amdgcn_fence(__ATOMIC_RELEASE, "agent");
            asm volatile("s_waitcnt vmcnt(0)" ::: "memory");
            const unsigned og = xb_add(&bar[XB_TOP], 1u);
            const unsigned tg = og / nx;
            if (og + 1u == (tg + 1u) * nx) xb_add(&bar[XB_TOPGEN], 1u);
            else XB_SPIN(xb_ld(&bar[XB_TOPGEN]) == tg, bar);
            __builtin_amdgcn_fence(__ATOMIC_ACQUIRE, "agent");
            xb_add(&bar[XB_XGEN(b.x)], 1u);
            asm volatile("s_waitcnt vmcnt(0)" ::: "memory");
        } else {
            XB_SPIN(xb_ld(&bar[XB_XGEN(b.x)]) == gen, bar);
            __builtin_amdgcn_fence(__ATOMIC_ACQUIRE, "agent");
            asm volatile("s_waitcnt vmcnt(0)" ::: "memory");
        }
    }
    __syncthreads();
}

namespace gm {
constexpr int BM = 256, BK = 64, HALF = 128, HTB = HALF * BK * 2, STAGE_BYTES = 8 * HTB, NXCD = 8, WGM = 8;
__device__ __forceinline__ int lds_byte(int r, int c) { const int st = (r >> 4) * 2 + (c >> 5), rr = r & 15, cc = c & 31, ob = rr * 64 + cc * 2; return st * 1024 + (ob ^ (((ob >> 9) & 1) << 5)); }
__device__ __forceinline__ void stage_rc(int b, int& R, int& C) { const int st = b / 1024, sb = b % 1024, swz = sb ^ (((sb >> 9) & 1) << 5); R = (st >> 1) * 16 + swz / 64; C = (st & 1) * 32 + (swz % 64) / 2; }
__device__ __forceinline__ int perm32(int rho) { const int n = rho >> 4, i = rho & 15; return 8 * (i >> 2) + 4 * n + (i & 3); }

struct Unit { int pm, pn, e, sub; };

__device__ __forceinline__ bool tile_order(int nM, int nN, long L, int& pm, int& pn) {
    const int nwg = nM * nN; if (L >= nwg) return false;
    int wgid = (int)L; { const int q = nwg / NXCD, r = nwg % NXCD, xcd = wgid % NXCD, off = wgid / NXCD; wgid = (xcd < r ? xcd * (q + 1) : r * (q + 1) + (xcd - r) * q) + off; }
    const int nig = WGM * nN, gid = wgid / nig, fm = gid * WGM, gsz = (nM - fm) < WGM ? (nM - fm) : WGM;
    pm = fm + ((wgid % nig) % gsz); pn = (wgid % nig) / gsz; return true;
}
struct DenseOrder {
    int nM, nN, G, c, nsub;
    __device__ __forceinline__ bool next(int i, Unit& u) const { const int ti = i / nsub; u.sub = i - ti * nsub; u.e = 0; return tile_order(nM, nN, (long)ti * G + c, u.pm, u.pn); }
};
struct MoeOrder {
    int nM, nN, G, c; const LAS int* tile_e;
    __device__ __forceinline__ bool next(int i, Unit& u) const { u.sub = 0; if (!tile_order(nM, nN, (long)i * G + c, u.pm, u.pn)) return false; u.e = tile_e[u.pm]; return true; }
};
struct DenseA { int K; unsigned sub_stride; int ES;
    __device__ __forceinline__ void offsets(const Unit& u, int tid, unsigned (&o)[2][2]) const {
#pragma unroll
        for (int i = 0; i < 2; ++i) { int R, C; stage_rc(tid * 16 + i * 8192, R, C);
#pragma unroll
            for (int h = 0; h < 2; ++h) o[h][i] = (unsigned)((u.pm * BM + h * HALF + R) * K * ES + C * 2) + (unsigned)u.sub * sub_stride; } }
    static constexpr bool GATHER = false;
    __device__ __forceinline__ const char* tok_ptr(const Unit&) const { return nullptr; }
    __device__ __forceinline__ void next_offsets(const Unit& u, int tid, unsigned (&o)[2][2], const LAS int*) const { offsets(u, tid, o); } };
struct GatherA { int K; const int* row_tok; int ES;
    __device__ __forceinline__ void offsets(const Unit& u, int tid, unsigned (&o)[2][2]) const {
#pragma unroll
        for (int i = 0; i < 2; ++i) { int R, C; stage_rc(tid * 16 + i * 8192, R, C);
#pragma unroll
            for (int h = 0; h < 2; ++h) { const int tok = row_tok[u.pm * BM + h * HALF + R]; o[h][i] = (unsigned)(tok * K * ES + C * 2); } } }
    static constexpr bool GATHER = true;
    __device__ __forceinline__ const char* tok_ptr(const Unit& u) const { return (const char*)(row_tok + u.pm * BM); }
    __device__ __forceinline__ void next_offsets(const Unit&, int tid, unsigned (&o)[2][2], const LAS int* stok) const {
#pragma unroll
        for (int i = 0; i < 2; ++i) { int R, C; stage_rc(tid * 16 + i * 8192, R, C);
#pragma unroll
            for (int h = 0; h < 2; ++h) { const int tok = stok[h * HALF + R]; o[h][i] = (unsigned)(tok * K * ES + C * 2); } } } };

template <bool FP8, class Epi, class Sched, class AMap>
__device__ __forceinline__ void gemm_phase(int wave_sg, LAS unsigned char* lds, const char* Abase, const char* Bbase, int K, int Nb, unsigned b_sub_stride, const Sched& S, const Epi& E, const AMap& AM) {
    int lane; asm volatile("v_mbcnt_lo_u32_b32 %0, -1, 0\n\tv_mbcnt_hi_u32_b32 %0, -1, %0" : "=v"(lane));
    const int wid = wave_sg, tid = wid * 64 + lane, wr = wid >> 2, wc = wid & 3, fr = lane & 15, fq = lane >> 4;
    constexpr int ES = FP8 ? 1 : 2;
    const int nt = K * ES / (BK * 2);
    unsigned voffB[2];
#pragma unroll
    for (int i = 0; i < 2; ++i) { int R, C; stage_rc(tid * 16 + i * 8192, R, C); const int Rb = (R & ~31) + perm32(R & 31); voffB[i] = (unsigned)(Rb * K * ES + C * 2); }
    const size_t kstep = (size_t)(BK * 2);
    const size_t hstep = (size_t)HALF * K * ES;
    const unsigned ldsw = (unsigned)wid * 1024u;
    const int aoff = lds_byte(wr * 64 + fr, fq * 8), boff = lds_byte(wc * 32 + fr, fq * 8);
#define G_SA(b, h) (((b) * 2 + (h)) * HTB)
#define G_SB(b, h) ((4 + (b) * 2 + (h)) * HTB)
#define G_STAGE(bufoff, gbase, voff) do { _Pragma("unroll") for (int _i = 0; _i < 2; ++_i) \
        __builtin_amdgcn_global_load_lds((const unsigned*)((const char*)(gbase) + (voff)[_i]), (LAS unsigned*)(lds + (bufoff) + ldsw + _i * 8192), 16, 0, 0); } while (0)
#define G_LDA(dst, b, h) do { _Pragma("unroll") for (int m = 0; m < 4; ++m) _Pragma("unroll") for (int k = 0; k < 2; ++k) dst[m][k] = *(const LAS bf16x8*)(lds + G_SA(b, h) + aoff + m * 2048 + k * 1024); } while (0)
#define G_LDB(dst, b, h) do { _Pragma("unroll") for (int n = 0; n < 2; ++n) _Pragma("unroll") for (int k = 0; k < 2; ++k) dst[n][k] = *(const LAS bf16x8*)(lds + G_SB(b, h) + boff + n * 2048 + k * 1024); } while (0)
#define G_MMA(ai, bj, At, Bt) do { __builtin_amdgcn_s_setprio(1); _Pragma("unroll") for (int m = 0; m < 4; ++m) _Pragma("unroll") for (int n = 0; n < 2; ++n) _Pragma("unroll") for (int k = 0; k < 2; ++k) \
        acc[ai][bj][m][n] = __builtin_amdgcn_mfma_f32_16x16x32_bf16(Bt[n][k], At[m][k], acc[ai][bj][m][n], 0, 0, 0); __builtin_amdgcn_s_setprio(0); } while (0)
#define G_LD8(dst, off) do { const u32x4 _l = *(const LAS u32x4*)(lds + (off)), _h = *(const LAS u32x4*)(lds + (off) + 1024); dst = (v8i){(int)_l.x, (int)_l.y, (int)_l.z, (int)_l.w, (int)_h.x, (int)_h.y, (int)_h.z, (int)_h.w}; } while (0)
#define G_LDA8(dst, b, h) do { _Pragma("unroll") for (int m = 0; m < 4; ++m) G_LD8(dst[m], G_SA(b, h) + aoff + m * 2048); } while (0)
#define G_LDB8(dst, b, h) do { _Pragma("unroll") for (int n = 0; n < 2; ++n) G_LD8(dst[n], G_SB(b, h) + boff + n * 2048); } while (0)
#define G_MMA8(ai, bj, At, Bt) do { __builtin_amdgcn_s_setprio(1); _Pragma("unroll") for (int m = 0; m < 4; ++m) _Pragma("unroll") for (int n = 0; n < 2; ++n) \
        acc[ai][bj][m][n] = __builtin_amdgcn_mfma_scale_f32_16x16x128_f8f6f4(Bt[n], At[m], acc[ai][bj][m][n], 0, 0, 0, 0x7F7F7F7F, 0, 0x7F7F7F7F); __builtin_amdgcn_s_setprio(0); } while (0)
#define G_PIN(ai, bj) asm volatile("" :: "v"(acc[ai][bj][0][0][0]), "v"(acc[ai][bj][0][1][0]), "v"(acc[ai][bj][1][0][0]), "v"(acc[ai][bj][1][1][0]), "v"(acc[ai][bj][2][0][0]), "v"(acc[ai][bj][2][1][0]), "v"(acc[ai][bj][3][0][0]), "v"(acc[ai][bj][3][1][0]) : "memory")
#define G_WAIT_V(n) asm volatile("s_waitcnt vmcnt(" #n ")" ::: "memory")
#define G_WAIT_L(n) asm volatile("s_waitcnt lgkmcnt(" #n ")" ::: "memory")
#define G_WAIT_VS() do { if (fi) { if (Epi::NST == 16) G_WAIT_V(24); else if (Epi::NST == 8) G_WAIT_V(16); else G_WAIT_V(8); } else G_WAIT_V(8); } while (0)
#define G_BAR __builtin_amdgcn_s_barrier()
#define G_SCHED __builtin_amdgcn_sched_barrier(0)
    Unit cur, nxt; int ui = 0;
#if MK_TPROBE
    unsigned long long tp_c = 0; const unsigned long long tp_c0 = __builtin_amdgcn_s_memtime(), tp_r0 = __builtin_amdgcn_s_memrealtime();
#endif
    if (!S.next(0, cur)) return;
#if MK_STAGGER
    {
        const unsigned long long t0 = __builtin_amdgcn_s_memrealtime(); const unsigned long long dly = (unsigned long long)(blockIdx.x & 7) * MK_STAGGER;
        while (__builtin_amdgcn_s_memrealtime() - t0 < dly) __builtin_amdgcn_s_sleep(8);
    }
#endif
    unsigned rA[2][2];
    AM.offsets(cur, tid, rA);
    const char* cB = Bbase + ((size_t)cur.e * Nb + (size_t)cur.pn * BM) * K * ES + (size_t)cur.sub * b_sub_stride;
    G_STAGE(G_SB(0, 0), cB, voffB); G_STAGE(G_SB(0, 1), cB + hstep, voffB); G_STAGE(G_SA(0, 0), Abase, rA[0]); G_STAGE(G_SA(0, 1), Abase, rA[1]);
    if (wr == 1) G_BAR;
    G_WAIT_V(2); G_BAR;
    G_STAGE(G_SB(1, 0), cB + kstep, voffB); G_STAGE(G_SA(1, 0), Abase + kstep, rA[0]); G_STAGE(G_SB(1, 1), cB + hstep + kstep, voffB);
    G_WAIT_V(6); G_BAR;
    f32x4 acc[2][2][4][2];
#pragma unroll
    for (int a = 0; a < 2; ++a)
#pragma unroll
        for (int b = 0; b < 2; ++b)
#pragma unroll
            for (int m = 0; m < 4; ++m)
#pragma unroll
                for (int n = 0; n < 2; ++n) acc[a][b][m][n] = (f32x4){0.f, 0.f, 0.f, 0.f};
    for (;;) {
        const bool has_next = S.next(ui + 1, nxt);
        const char* nB = has_next ? Bbase + ((size_t)nxt.e * Nb + (size_t)nxt.pn * BM) * K * ES + (size_t)nxt.sub * b_sub_stride : cB;
#if MK_TPROBE
        unsigned long long tp_a = 0; if (Epi::TPROBE && wid == 0) { tp_a = __builtin_amdgcn_s_memrealtime(); if (ui > 0 && lane == 0) { volatile LAS unsigned* M = (volatile LAS unsigned*)(lds + MISC_OFF); M[19] += (unsigned)(tp_a - tp_c); } }
#endif
        if (wid == 0) {
            int l16 = lane * 16; asm volatile("" : "+v"(l16));
#pragma unroll
            for (int k = 0; k < Epi::NSB; ++k) { const char* sp = E.sb_ptr(cur, k); if (l16 < 16 * E.sb_lanes(k)) __builtin_amdgcn_global_load_lds((const unsigned*)(sp + l16), (LAS unsigned*)(lds + SIDE_OFF + (ui & 1) * 4096 + 1024 * (k + 1)), 16, 0, 0); }
            if (AMap::GATHER && has_next) __builtin_amdgcn_global_load_lds((const unsigned*)(AM.tok_ptr(nxt) + l16), (LAS unsigned*)(lds + SIDE_OFF + ((ui + 1) & 1) * 4096), 16, 0, 0);
        }
#pragma nounroll
        for (int t = 0; t < nt; t += 2) {
            if constexpr (Epi::HAS_MID) { if (t == nt / 2) { int lz = lane; asm volatile("" : "+v"(lz)); E.mid(acc, cur, wr, wc, lz & 15, lz >> 4); } }
            bf16x8 At[4][2], B0[2][2], B1[2][2];
            v8i At8[4], B08[2], B18[2];
            const bool last = (t == nt - 2);
            constexpr bool fi = false;
            const char* b2 = last ? nB : cB + (size_t)(t + 2) * kstep; const char* b3 = b2 + kstep;
            if constexpr (FP8) { G_LDB8(B08, 0, 0); G_LDB8(B18, 0, 1); G_SCHED; G_LDA8(At8, 0, 0); } else { G_LDB(B0, 0, 0); G_LDB(B1, 0, 1); G_SCHED; G_LDA(At, 0, 0); }
            G_STAGE(G_SA(1, 1), Abase + (size_t)(t + 1) * kstep, rA[1]);
            G_WAIT_VS(); G_WAIT_L(0); G_BAR;
            if constexpr (FP8) { G_MMA8(0, 0, At8, B08); G_MMA8(0, 1, At8, B18); } else { G_MMA(0, 0, At, B0); G_MMA(0, 1, At, B1); }
            G_PIN(0, 0); G_PIN(0, 1);
            G_BAR; G_SCHED;
            if (last && has_next) { int tz = tid; asm volatile("" : "+v"(tz)); AM.next_offsets(nxt, tz, rA, (const LAS int*)(lds + SIDE_OFF + ((ui + 1) & 1) * 4096)); }
            const char* a2 = Abase + (last ? (size_t)0 : (size_t)(t + 2) * kstep);
            if constexpr (FP8) { G_LDA8(At8, 0, 1); } else { G_LDA(At, 0, 1); }
            G_STAGE(G_SB(0, 0), b2, voffB); G_STAGE(G_SB(0, 1), b2 + hstep, voffB); G_STAGE(G_SA(0, 0), a2, rA[0]);
            G_WAIT_VS(); G_WAIT_L(0); G_BAR;
            if constexpr (FP8) { G_MMA8(1, 0, At8, B08); G_MMA8(1, 1, At8, B18); } else { G_MMA(1, 0, At, B0); G_MMA(1, 1, At, B1); }
            G_PIN(1, 0); G_PIN(1, 1);
            G_BAR; G_SCHED;
            if constexpr (FP8) { G_LDB8(B08, 1, 0); G_LDB8(B18, 1, 1); G_SCHED; G_LDA8(At8, 1, 0); } else { G_LDB(B0, 1, 0); G_LDB(B1, 1, 1); G_SCHED; G_LDA(At, 1, 0); }
            G_STAGE(G_SA(0, 1), a2, rA[1]);
            G_WAIT_VS(); G_WAIT_L(0); G_BAR;
            if constexpr (FP8) { G_MMA8(0, 0, At8, B08); G_MMA8(0, 1, At8, B18); } else { G_MMA(0, 0, At, B0); G_MMA(0, 1, At, B1); }
            G_PIN(0, 0); G_PIN(0, 1);
            G_BAR; G_SCHED;
            if constexpr (FP8) { G_LDA8(At8, 1, 1); } else { G_LDA(At, 1, 1); }
            G_STAGE(G_SB(1, 0), b3, voffB); G_STAGE(G_SB(1, 1), b3 + hstep, voffB); G_STAGE(G_SA(1, 0), a2 + kstep, rA[0]);
            G_WAIT_VS(); G_WAIT_L(0); G_BAR;
            if constexpr (FP8) { G_MMA8(1, 0, At8, B08); G_MMA8(1, 1, At8, B18); } else { G_MMA(1, 0, At, B0); G_MMA(1, 1, At, B1); }
            G_PIN(1, 0); G_PIN(1, 1);
            G_BAR; G_SCHED;
        }
#if MK_TPROBE
        unsigned long long tp_b = 0; if (Epi::TPROBE && wid == 0) tp_b = __builtin_amdgcn_s_memrealtime();
#endif
        if (wr == 0) G_BAR;
        { int lz = lane; asm volatile("" : "+v"(lz));
          E(acc, cur, wr, wc, lz & 15, lz >> 4, (const LAS unsigned char*)(lds + SIDE_OFF + (ui & 1) * 4096 + 1024)); }
#if MK_TPROBE
        if (Epi::TPROBE && wid == 0) { tp_c = __builtin_amdgcn_s_memrealtime(); if (lane == 0) { volatile LAS unsigned* M = (volatile LAS unsigned*)(lds + MISC_OFF); M[16] += (unsigned)(tp_b - tp_a); M[17] += (unsigned)(tp_c - tp_b); M[18] += 1u; } }
#endif
        if (!has_next) break;
        if (!E.keep(cur)) {
#pragma unroll
            for (int a = 0; a < 2; ++a)
#pragma unroll
                for (int b = 0; b < 2; ++b)
#pragma unroll
                    for (int m = 0; m < 4; ++m)
#pragma unroll
                        for (int n = 0; n < 2; ++n) acc[a][b][m][n] = (f32x4){0.f, 0.f, 0.f, 0.f};
        }
        cur = nxt; cB = nB; ++ui;
        if (wr == 1) G_BAR;
    }
    G_WAIT_V(0);
    G_BAR;
#if MK_TPROBE
    if constexpr (Epi::TPROBE) if (wid == 0) { volatile LAS unsigned* M = (volatile LAS unsigned*)(lds + MISC_OFF);
        const unsigned long long t0 = __builtin_amdgcn_s_memrealtime();
        const unsigned long long d = MK_TPROBE == 4 ? 10000ull * (__builtin_amdgcn_s_memtime() - tp_c0) / (t0 - tp_r0)
                                   : 4ull * (unsigned long long)(MK_TPROBE == 1 ? M[16] : MK_TPROBE == 2 ? M[17] : M[19]);
        while (__builtin_amdgcn_s_memrealtime() - t0 < d) __builtin_amdgcn_s_sleep(8); }
#endif
#undef G_SA
#undef G_SB
#undef G_STAGE
#undef G_LDA
#undef G_LDB
#undef G_MMA
#undef G_LD8
#undef G_LDA8
#undef G_LDB8
#undef G_MMA8
#undef G_WAIT_V
#undef G_PIN
#undef G_WAIT_VS
#undef G_WAIT_L
#undef G_BAR
#undef G_SCHED
}

__device__ __forceinline__ u32x4 pack8(const f32x4& v0, const f32x4& v1) { u32x4 w; w.x = cvt_pk_bf16(v0[0], v0[1]); w.y = cvt_pk_bf16(v0[2], v0[3]); w.z = cvt_pk_bf16(v1[0], v1[1]); w.w = cvt_pk_bf16(v1[2], v1[3]); return w; }
__device__ __forceinline__ void unpack8(const u32x4& w, f32x4& v0, f32x4& v1) { v0 = (f32x4){bf_lo(w.x), bf_hi(w.x), bf_lo(w.y), bf_hi(w.y)}; v1 = (f32x4){bf_lo(w.z), bf_hi(w.z), bf_lo(w.w), bf_hi(w.w)}; }

struct EpiProj {
    static constexpr bool HAS_MID = false;
    static constexpr float PSC = MK_P2FP8 ? (1.0f / 32.0f) : 1.0f;
    bf16_t* proj; bf16_t* gates; const float* lb;
    static constexpr int NSB = 0, NST = 16; static constexpr bool TPROBE = true;
    __device__ __forceinline__ const char* sb_ptr(const Unit&, int) const { return nullptr; }
    __device__ __forceinline__ int sb_lanes(int) const { return 0; }
    __device__ __forceinline__ bool keep(const Unit&) const { return false; }
    __device__ __forceinline__ void operator()(f32x4 (&acc)[2][2][4][2], const Unit& u, int wr, int wc, int fr, int fq, const LAS unsigned char* side) const {
        const int row0 = u.pm * BM + wr * 64 + fr, pn = u.pn;
        bf16_t* base; int ldc, colt, kind;
        if (pn < 14) { base = proj; ldc = PROJ_LD; colt = pn * BM; kind = (pn == 2 || pn == 3) ? 1 : 0; } else { base = gates; ldc = GATE_LD; colt = (pn - 14) * BM; kind = 2; }
        const int col0 = colt + wc * 32 + 8 * fq;
        f32x4 lbv[2][2];
        if (kind == 1) {
#pragma unroll
            for (int bj = 0; bj < 2; ++bj) { const float* lp = lb + (pn - 2) * BM + bj * HALF + wc * 32 + 8 * fq; lbv[bj][0] = *(const f32x4*)lp; lbv[bj][1] = *(const f32x4*)(lp + 4); }
        }
#pragma unroll
        for (int ai = 0; ai < 2; ++ai)
#pragma unroll
            for (int m = 0; m < 4; ++m) { bf16_t* rowp = base + (size_t)(row0 + ai * HALF + m * 16) * ldc + col0;
#pragma unroll
                for (int bj = 0; bj < 2; ++bj) { f32x4 v0 = acc[ai][bj][m][0] * PSC, v1 = acc[ai][bj][m][1] * PSC;
                    if (kind == 1) {
#pragma unroll
                        for (int j = 0; j < 4; ++j) { const float l0 = lbv[bj][0][j], l1 = lbv[bj][1][j];
                            v0[j] = fast_log(l0 + (1.0f - l0) * sigmoidf_(v0[j])); v1[j] = fast_log(l1 + (1.0f - l1) * sigmoidf_(v1[j])); }
                    } else if (kind == 2) {
#pragma unroll
                        for (int j = 0; j < 4; ++j) { v0[j] = sigmoidf_(v0[j]); v1[j] = sigmoidf_(v1[j]); }
                    }
                    *(u32x4*)(rowp + bj * HALF) = pack8(v0, v1); } }
    }
};
struct EpiMerge {
    static constexpr bool HAS_MID = true;
    const bf16_t* gates; bf16_t* out;
    static constexpr int NSB = 0, NST = 0; static constexpr bool TPROBE = false;
    __device__ __forceinline__ const char* sb_ptr(const Unit&, int) const { return nullptr; }
    __device__ __forceinline__ int sb_lanes(int) const { return 0; }
    __device__ __forceinline__ bool keep(const Unit&) const { return false; }
    __device__ __forceinline__ void mid(f32x4 (&acc)[2][2][4][2], const Unit& u, int wr, int wc, int fr, int fq) const {
        const int row0 = u.pm * BM + wr * 64 + fr, col0 = u.pn * BM + wc * 32 + 8 * fq;
#pragma unroll
        for (int ai = 0; ai < 2; ++ai) {
            u32x4 gb[4][2], ga[4][2];
#pragma unroll
            for (int m = 0; m < 4; ++m) { const bf16_t* gp = gates + (size_t)(row0 + ai * HALF + m * 16) * GATE_LD + col0;
#pragma unroll
                for (int bj = 0; bj < 2; ++bj) { gb[m][bj] = *(const u32x4*)(gp + 1024 + bj * HALF); ga[m][bj] = *(const u32x4*)(gp + bj * HALF); } }
#pragma unroll
            for (int m = 0; m < 4; ++m)
#pragma unroll
                for (int bj = 0; bj < 2; ++bj) { f32x4 b0, b1, a0, a1; unpack8(gb[m][bj], b0, b1); unpack8(ga[m][bj], a0, a1);
#pragma unroll
                    for (int j = 0; j < 4; ++j) { acc[ai][bj][m][0][j] *= a0[j] * fast_rcp(fmaxf(b0[j], 1e-30f)); acc[ai][bj][m][1][j] *= a1[j] * fast_rcp(fmaxf(b1[j], 1e-30f)); } }
            asm volatile("" ::: "memory"); }
    }
    __device__ __forceinline__ void operator()(f32x4 (&acc)[2][2][4][2], const Unit& u, int wr, int wc, int fr, int fq, const LAS unsigned char* side) const {
        const int row0 = u.pm * BM + wr * 64 + fr, col0 = u.pn * BM + wc * 32 + 8 * fq;
#pragma unroll
        for (int ai = 0; ai < 2; ++ai) {
            u32x4 gb[4][2];
#pragma unroll
            for (int m = 0; m < 4; ++m) { const bf16_t* gp = gates + (size_t)(row0 + ai * HALF + m * 16) * GATE_LD + col0;
#pragma unroll
                for (int bj = 0; bj < 2; ++bj) gb[m][bj] = *(const u32x4*)(gp + 1024 + bj * HALF); }
#pragma unroll
            for (int m = 0; m < 4; ++m) { const size_t r = (size_t)(row0 + ai * HALF + m * 16);
#pragma unroll
                for (int bj = 0; bj < 2; ++bj) { f32x4 b0, b1; unpack8(gb[m][bj], b0, b1); *(u32x4*)(out + r * D + col0 + bj * HALF) = pack8(acc[ai][bj][m][0] * b0, acc[ai][bj][m][1] * b1); } }
            asm volatile("" ::: "memory"); }
    }
};
struct EpiMix {
    static constexpr bool HAS_MID = false;
    const float* x; const float* mod; bf16_t* h;
    static constexpr int NSB = 0, NST = 0; static constexpr bool TPROBE = false;
    __device__ __forceinline__ const char* sb_ptr(const Unit&, int) const { return nullptr; }
    __device__ __forceinline__ int sb_lanes(int) const { return 0; }
    __device__ __forceinline__ bool keep(const Unit&) const { return false; }
    __device__ __forceinline__ void operator()(f32x4 (&acc)[2][2][4][2], const Unit& u, int wr, int wc, int fr, int fq, const LAS unsigned char* side) const {
        const int row0 = u.pm * BM + wr * 64 + fr, col0 = u.pn * BM + wc * 32 + 8 * fq, b = u.pm >> 3;
        f32x4 g[2][2];
#pragma unroll
        for (int bj = 0; bj < 2; ++bj) { const float* gp = mod + (size_t)b * 6144 + 2048 + col0 + bj * HALF; g[bj][0] = *(const f32x4*)gp; g[bj][1] = *(const f32x4*)(gp + 4); }
#pragma unroll
        for (int ai = 0; ai < 2; ++ai) {
            f32x4 xv[4][2][2];
#pragma unroll
            for (int m = 0; m < 4; ++m)
#pragma unroll
                for (int bj = 0; bj < 2; ++bj) { const float* xp = x + (size_t)(row0 + ai * HALF + m * 16) * D + col0 + bj * HALF; xv[m][bj][0] = *(const f32x4*)xp; xv[m][bj][1] = *(const f32x4*)(xp + 4); }
#pragma unroll
            for (int m = 0; m < 4; ++m) { const size_t r = (size_t)(row0 + ai * HALF + m * 16);
#pragma unroll
                for (int bj = 0; bj < 2; ++bj) *(u32x4*)(h + r * D + col0 + bj * HALF) = pack8(xv[m][bj][0] + g[bj][0] * acc[ai][bj][m][0], xv[m][bj][1] + g[bj][1] * acc[ai][bj][m][1]); }
            asm volatile("" ::: "memory"); }
    }
};
struct EpiSwiglu {
    static constexpr bool HAS_MID = false;
    static constexpr float WSC = 1.0f / 32.0f;
    const float* b1; unsigned char* act; unsigned* tpw;
    __device__ __forceinline__ unsigned* tp_words() const { return tpw; }
    static constexpr bool TPROBE = false;
    static constexpr int NSB = 2, NST = 8;
    __device__ __forceinline__ const char* sb_ptr(const Unit& u, int k) const { return (const char*)(b1 + (size_t)u.e * 2048 + k * 1024 + u.pn * HALF); }
    __device__ __forceinline__ int sb_lanes(int) const { return 32; }
    __device__ __forceinline__ bool keep(const Unit&) const { return false; }
    __device__ __forceinline__ void operator()(f32x4 (&acc)[2][2][4][2], const Unit& u, int wr, int wc, int fr, int fq, const LAS unsigned char* side) const {
        const int row0 = u.pm * BM + wr * 64 + fr, hc0 = u.pn * HALF + wc * 32 + 8 * fq;
        const LAS float* bp = (const LAS float*)side + wc * 32 + 8 * fq;
        const f32x4 bg0 = *(const LAS f32x4*)bp, bg1 = *(const LAS f32x4*)(bp + 4), bl0 = *(const LAS f32x4*)(bp + 256), bl1 = *(const LAS f32x4*)(bp + 260);
#pragma unroll
        for (int ai = 0; ai < 2; ++ai)
#pragma unroll
            for (int m = 0; m < 4; ++m) { const size_t r = (size_t)(row0 + ai * HALF + m * 16);
                f32x4 o0, o1;
#pragma unroll
                for (int j = 0; j < 4; ++j) {
                    float gl = fminf(acc[ai][0][m][0][j] * WSC + bg0[j], SW_LIMIT), li = fminf(fmaxf(acc[ai][1][m][0][j] * WSC + bl0[j], -SW_LIMIT), SW_LIMIT);
                    o0[j] = gl * sigmoidf_(SW_ALPHA * gl) * (li + 1.0f);
                    gl = fminf(acc[ai][0][m][1][j] * WSC + bg1[j], SW_LIMIT); li = fminf(fmaxf(acc[ai][1][m][1][j] * WSC + bl1[j], -SW_LIMIT), SW_LIMIT);
                    o1[j] = gl * sigmoidf_(SW_ALPHA * gl) * (li + 1.0f); }
                *(u32x2*)(act + r * DFF + hc0) = (u32x2){pk4_fp8(o0[0], o0[1], o0[2], o0[3]), pk4_fp8(o1[0], o1[1], o1[2], o1[3])}; }
    }
};
struct EpiMoeOut {
    static constexpr bool HAS_MID = false;
    const float* b2; const float* rw; unsigned char* ya;
    static constexpr bool TPROBE = false;
    static constexpr int NSB = 2, NST = 16;
    __device__ __forceinline__ const char* sb_ptr(const Unit& u, int k) const { return k == 0 ? (const char*)(b2 + (size_t)u.e * D + u.pn * BM) : (const char*)(rw + u.pm * BM); }
    __device__ __forceinline__ int sb_lanes(int) const { return 64; }
    __device__ __forceinline__ bool keep(const Unit&) const { return false; }
    __device__ __forceinline__ void operator()(f32x4 (&acc)[2][2][4][2], const Unit& u, int wr, int wc, int fr, int fq, const LAS unsigned char* side) const {
        const int lrow0 = wr * 64 + fr, col0 = u.pn * BM + wc * 32 + 8 * fq, row_t = u.pm * BM;
        unsigned char* tbase = ya + (size_t)row_t * D + col0;
        const LAS float* sb = (const LAS float*)side; const LAS float* srw = (const LAS float*)(side + 1024);
        f32x4 bv[2][2];
#pragma unroll
        for (int bj = 0; bj < 2; ++bj) { const LAS float* bp = sb + bj * HALF + wc * 32 + 8 * fq; bv[bj][0] = *(const LAS f32x4*)bp; bv[bj][1] = *(const LAS f32x4*)(bp + 4); }
#pragma unroll
        for (int ai = 0; ai < 2; ++ai)
#pragma unroll
            for (int m = 0; m < 4; ++m) { const int lr = lrow0 + ai * HALF + m * 16; const float w = srw[lr]; unsigned char* dst = tbase + (size_t)lr * D;
#pragma unroll
                for (int bj = 0; bj < 2; ++bj) { const f32x4 o0 = (acc[ai][bj][m][0] * (1.0f / 32.0f) + bv[bj][0]) * w, o1 = (acc[ai][bj][m][1] * (1.0f / 32.0f) + bv[bj][1]) * w;
                    *(u32x2*)(dst + bj * HALF) = (u32x2){pk4_fp8(o0[0], o0[1], o0[2], o0[3]), pk4_fp8(o1[0], o1[1], o1[2], o1[3])}; } }
    }
};
}

struct Args { const float* in[20]; float* out; unsigned char* ws; int ph_lo, ph_hi; };

__device__ __forceinline__ void transpose_item(const float* W, int N, bf16_t* WT, int ldwt, int k0, int n0, int dst_row0, LAS float* scr, int lane) {
    const int ks = lane >> 4, n4 = (lane & 15) * 4;
    f32x4 v[16];
#pragma unroll
    for (int i = 0; i < 16; ++i) v[i] = *(const f32x4*)(W + (size_t)(k0 + 4 * i + ks) * N + n0 + n4);
#pragma unroll
    for (int i = 0; i < 16; ++i) { LAS float* s = scr + (4 * i + ks) * 65 + n4; s[0] = v[i][0]; s[1] = v[i][1]; s[2] = v[i][2]; s[3] = v[i][3]; }
    LDS_WAIT(); asm volatile("" ::: "memory");
    const int kc = lane & 7;
#pragma unroll
    for (int p = 0; p < 8; ++p) { const int n = (lane >> 3) + 8 * p; const LAS float* s = scr + (8 * kc) * 65 + n;
        u32x4 o; o.x = cvt_pk_bf16(s[0], s[65]); o.y = cvt_pk_bf16(s[2 * 65], s[3 * 65]); o.z = cvt_pk_bf16(s[4 * 65], s[5 * 65]); o.w = cvt_pk_bf16(s[6 * 65], s[7 * 65]);
        *(u32x4*)(WT + (size_t)(dst_row0 + n) * ldwt + k0 + 8 * kc) = o; }
    LDS_WAIT(); asm volatile("" ::: "memory");
}

__device__ __forceinline__ void transpose_item_fp8(const float* W, int N, unsigned char* WT, int ldwt, int k0, int n0, int dst_row0, LAS float* scr, int lane) {
    const int ks = lane >> 3, n4 = (lane & 7) * 4;
    f32x4 v[16];
#pragma unroll
    for (int i = 0; i < 16; ++i) v[i] = *(const f32x4*)(W + (size_t)(k0 + 8 * i + ks) * N + n0 + n4);
#pragma unroll
    for (int i = 0; i < 16; ++i) { LAS float* s = scr + (8 * i + ks) * 33 + n4; s[0] = v[i][0]; s[1] = v[i][1]; s[2] = v[i][2]; s[3] = v[i][3]; }
    LDS_WAIT(); asm volatile("" ::: "memory");
    const int kc = lane & 7;
#pragma unroll
    for (int p = 0; p < 4; ++p) { const int n = (lane >> 3) + 8 * p; const LAS float* s = scr + (16 * kc) * 33 + n;
        u32x4 o;
        o.x = pk4_fp8(32.f * s[0], 32.f * s[33], 32.f * s[2 * 33], 32.f * s[3 * 33]); o.y = pk4_fp8(32.f * s[4 * 33], 32.f * s[5 * 33], 32.f * s[6 * 33], 32.f * s[7 * 33]);
        o.z = pk4_fp8(32.f * s[8 * 33], 32.f * s[9 * 33], 32.f * s[10 * 33], 32.f * s[11 * 33]); o.w = pk4_fp8(32.f * s[12 * 33], 32.f * s[13 * 33], 32.f * s[14 * 33], 32.f * s[15 * 33]);
        *(u32x4*)(WT + (size_t)(dst_row0 + n) * ldwt + k0 + 16 * kc) = o; }
    LDS_WAIT(); asm volatile("" ::: "memory");
}

__global__ void __launch_bounds__(NTHREADS, 2) fwd_kernel(Args args) {
    extern __shared__ __attribute__((aligned(16))) unsigned char lds_raw[];
    LAS unsigned char* lds = (LAS unsigned char*)lds_raw;
    volatile LAS unsigned* MISC = (volatile LAS unsigned*)(lds + MISC_OFF);
    const int G = gridDim.x, bid = blockIdx.x;
    const int wave_sg = __builtin_amdgcn_readfirstlane((int)threadIdx.x >> 6);
#define PHASE_IDS() int lane; asm volatile("v_mbcnt_lo_u32_b32 %0, -1, 0\n\tv_mbcnt_hi_u32_b32 %0, -1, %0" : "=v"(lane)); const int wave = wave_sg; const int tid = wave * 64 + lane; const int gw = bid * NWAVES + wave, NGW = G * NWAVES; (void)lane; (void)wave; (void)gw; (void)NGW
#define CAS __attribute__((address_space(4)))
#define PHASE_ARGS() const CAS Args* ap = (const CAS Args*)__builtin_amdgcn_kernarg_segment_ptr(); asm volatile("" : "+s"(ap)); unsigned char* const ws = ap->ws; unsigned* const ctl = (unsigned*)(ws + WS_CTL); (void)ctl
#define ARG(i) (ap->in[i])
#define WSP(T, off) ((T*)(ws + (off)))
    enum { I_X = 0, I_C, I_WADA, I_BADA, I_NMIX, I_WIN, I_LBT, I_HGNW, I_CONVW, I_WHG, I_WCV, I_WMIX, I_NFFN, I_WR, I_BR, I_W1, I_B1, I_W2, I_B2, I_NFIN };
    { PHASE_IDS(); for (int u = tid; u < 64; u += NTHREADS) MISC[u] = 0u; }
    __syncthreads();
    XcdBarrier bar; bar.bar = nullptr; bar.x = 0; bar.st = nullptr;
#if MK_ONE_LAUNCH
    { PHASE_ARGS(); bar = xcd_barrier_post(ctl + CW_BAR, MISC + 8); }
#define GRID_BAR() xcd_barrier(bar)
#else
#define GRID_BAR() do { } while (0)
#endif
    const int lo = args.ph_lo, hi = args.ph_hi;
#if MK_PHT
    const unsigned long long pht0 = __builtin_amdgcn_s_memrealtime(); unsigned long long phtk = 0;
#endif
#ifndef PH_MASK
#define PH_MASK 0x7ff
#endif
#define IN(k) (((PH_MASK >> (k)) & 1) && lo <= (k) && (k) < hi)
#define BOTH(k) (IN(k) && IN((k) + 1))

    if (IN(0)) for (int rep_ = 0; rep_ < 1 + ((MK_REPEAT >> 0) & 1); ++rep_) { PHASE_IDS(); PHASE_ARGS();
        const float* cvec = ARG(I_C); const float* w_ada = ARG(I_WADA); const float* b_ada = ARG(I_BADA); const float* lbtab = ARG(I_LBT);
        const float* w_in = ARG(I_WIN); const float* w_hg = ARG(I_WHG); const float* w_cv = ARG(I_WCV); const float* w_mix = ARG(I_WMIX); const float* w1 = ARG(I_W1); const float* w2 = ARG(I_W2);
        float* MOD = WSP(float, WS_MOD); float* LB = WSP(float, WS_LB);
        bf16_t* Win_t = WSP(bf16_t, WS_WIN); bf16_t* Whg_t = WSP(bf16_t, WS_WHG); bf16_t* Wcv_t = WSP(bf16_t, WS_WHG) + 512;        bf16_t* Wmix_t = WSP(bf16_t, WS_WMIX); unsigned char* W1_t = WSP(unsigned char, WS_W1); unsigned char* W2_t = WSP(unsigned char, WS_W2);
        LAS float* scr = (LAS float*)(lds + wave * 16896);
        for (int it = gw; it < 384; it += NGW) {
            const int n0 = it * 16, cl = lane & 15, kq = lane >> 4;
            float acc[32];
#pragma unroll
            for (int b = 0; b < 32; ++b) acc[b] = 0.f;
            for (int ch = 0; ch < 16; ++ch) {
                { const int b = lane >> 1, part = lane & 1;
#pragma unroll
                    for (int q = 0; q < 4; ++q) {
                        const float* cp = cvec + (size_t)b * D + q * 256 + ch * 16 + part * 8;
                        const f32x4 c0 = *(const f32x4*)cp, c1 = *(const f32x4*)(cp + 4);
#pragma unroll
                        for (int j = 0; j < 4; ++j) { scr[(q * 16 + part * 8 + j) * 32 + b] = c0[j] * sigmoidf_(c0[j]); scr[(q * 16 + part * 8 + 4 + j) * 32 + b] = c1[j] * sigmoidf_(c1[j]); }
                    } }
                float wv[16];
#pragma unroll
                for (int kk = 0; kk < 16; ++kk) wv[kk] = w_ada[(size_t)(kq * 256 + ch * 16 + kk) * 6144 + n0 + cl];
                LDS_WAIT(); asm volatile("" ::: "memory");
#pragma unroll
                for (int kk = 0; kk < 16; ++kk) {
                    const LAS f32x4* sp = (const LAS f32x4*)(scr + (kq * 16 + kk) * 32);
#pragma unroll
                    for (int b4 = 0; b4 < 8; ++b4) { const f32x4 s = sp[b4]; acc[4 * b4] += wv[kk] * s[0]; acc[4 * b4 + 1] += wv[kk] * s[1]; acc[4 * b4 + 2] += wv[kk] * s[2]; acc[4 * b4 + 3] += wv[kk] * s[3]; }
                }
                LDS_WAIT(); asm volatile("" ::: "memory");
            }
            const float bias = b_ada[n0 + cl];
#pragma unroll
            for (int b = 0; b < 32; ++b) { float v = acc[b]; v += __shfl_xor(v, 16); v += __shfl_xor(v, 32); if (kq == 0) MOD[(size_t)b * 6144 + n0 + cl] = v + bias; }
        }
        if (bid == (G > 1 ? 1 : 0)) { const int k = tid; const float l0 = lbtab[k], l1 = lbtab[HW + k]; LB[k] = fast_rcp(1.0f + fast_exp(l1 - l0)); }
        {
            constexpr int I_IN = 16 * 88, I_HG = 8 * 16, I_CV = 8 * 16, I_MIX = 16 * 16, I_W1 = 32 * 8 * 64, I_W2 = 32 * 8 * 32;
            constexpr int NITEMS = I_IN + I_HG + I_CV + I_MIX + I_W1 + I_W2;
            for (int it = gw; it < NITEMS; it += NGW) {
                int r = it;
#if MK_P2FP8
                if (r < I_IN) { const int kb = r / 176, nb = r % 176; transpose_item_fp8(w_in, INC, (unsigned char*)Win_t, D, kb * 128, nb * 32, nb * 32, scr, lane); continue; } r -= I_IN;
#else
                if (r < I_IN) { const int kb = r / 88, nb = r % 88; transpose_item(w_in, INC, Win_t, D, kb * 64, nb * 64, nb * 64, scr, lane); continue; } r -= I_IN;
#endif
                if (r < I_HG) { const int kb = r / 16, nb = r % 16; transpose_item(w_hg, D, Whg_t, D, kb * 64, nb * 64, nb * 64, scr, lane); continue; } r -= I_HG;
                if (r < I_CV) { const int kb = r / 16, nb = r % 16; transpose_item(w_cv, D, Wcv_t, D, kb * 64, nb * 64, nb * 64, scr, lane); continue; } r -= I_CV;
                if (r < I_MIX) { const int kb = r / 16, nb = r % 16; transpose_item(w_mix, D, Wmix_t, D, kb * 64, nb * 64, nb * 64, scr, lane); continue; } r -= I_MIX;
                if (r < I_W1) { const int e = r / 512, q = r % 512, kb = q / 64, nb = q % 64;
                    const int pn = nb >> 3, wi = (nb & 7) * 32; const int src = wi < 128 ? pn * 128 + wi : 1024 + pn * 128 + (wi - 128);
                    transpose_item_fp8(w1 + (size_t)e * D * 2048, 2048, W1_t + (size_t)e * 2048 * D, D, kb * 128, src, nb * 32, scr, lane); continue; } r -= I_W1;
                { const int e = r / 256, q = r % 256, kb = q / 32, nb = q % 32;
                    transpose_item_fp8(w2 + (size_t)e * DFF * D, D, W2_t + (size_t)e * D * DFF, DFF, kb * 128, nb * 32, nb * 32, scr, lane); }
            }
        }
        if (BOTH(0)) GRID_BAR();
#if MK_PHT
        if (MK_PHT == 1) phtk = __builtin_amdgcn_s_memrealtime() - pht0;
#endif
    }

    if (IN(1)) for (int rep_ = 0; rep_ < 1 + ((MK_REPEAT >> 1) & 1); ++rep_) { PHASE_IDS(); PHASE_ARGS();
        const float* x = ARG(I_X); const float* norm_mix_w = ARG(I_NMIX); const float* MOD = WSP(float, WS_MOD); bf16_t* U = WSP(bf16_t, WS_U);
        for (int m0 = gw * 32; m0 < NTOK; m0 += NGW * 32) {
            const int b = m0 >> 11;
            f32x4 A[4], Sh[4];
#pragma unroll
            for (int j = 0; j < 4; ++j) { const int k = 4 * lane + 256 * j; const f32x4 w = *(const f32x4*)(norm_mix_w + k), sc = *(const f32x4*)(MOD + (size_t)b * 6144 + 1024 + k);
                A[j] = w * (sc + 1.0f); Sh[j] = *(const f32x4*)(MOD + (size_t)b * 6144 + k); }
            for (int r = 0; r < 32; ++r) {
                const float* xr = x + (size_t)(m0 + r) * D; f32x4 v[4]; float s = 0.f;
#pragma unroll
                for (int j = 0; j < 4; ++j) { v[j] = *(const f32x4*)(xr + 4 * lane + 256 * j); s += (v[j][0] * v[j][0] + v[j][1] * v[j][1]) + (v[j][2] * v[j][2] + v[j][3] * v[j][3]); }
                const float rs = __builtin_amdgcn_rsqf(wave_sum(s) * (1.0f / D) + EPS);
#if MK_P2FP8
                unsigned char* ur = (unsigned char*)U + (size_t)(m0 + r) * D;
#pragma unroll
                for (int j = 0; j < 4; ++j) { const f32x4 o = v[j] * rs * A[j] + Sh[j]; *(unsigned*)(ur + 4 * lane + 256 * j) = pk4_fp8(o[0], o[1], o[2], o[3]); }
#else
                bf16_t* ur = U + (size_t)(m0 + r) * D;
#pragma unroll
                for (int j = 0; j < 4; ++j) { const f32x4 o = v[j] * rs * A[j] + Sh[j]; u32x2 w; w.x = cvt_pk_bf16(o[0], o[1]); w.y = cvt_pk_bf16(o[2], o[3]); *(u32x2*)(ur + 4 * lane + 256 * j) = w; }
#endif
            }
        }
        if (BOTH(1)) GRID_BAR();
#if MK_PHT
        if (MK_PHT == 2) phtk = __builtin_amdgcn_s_memrealtime() - pht0;
#endif
    }

    if (IN(2)) for (int rep_ = 0; rep_ < 1 + ((MK_REPEAT >> 2) & 1); ++rep_) { PHASE_ARGS();
        gm::DenseOrder S{NTOK / 256, INC / 256, G, bid, 1}; gm::DenseA AM{D, 0u, MK_P2FP8 ? 1 : 2}; gm::EpiProj E{WSP(bf16_t, WS_PROJ), (bf16_t*)ap->out, WSP(float, WS_LB)};
        gm::gemm_phase<(MK_P2FP8 != 0)>(wave_sg, lds, (const char*)WSP(bf16_t, WS_U), (const char*)WSP(bf16_t, WS_WIN), D, 0, 0u, S, E, AM);
        if (BOTH(2)) GRID_BAR();
#if MK_PHT
        if (MK_PHT == 3) phtk = __builtin_amdgcn_s_memrealtime() - pht0;
#endif
    }

    if (IN(3)) for (int rep_ = 0; rep_ < 1 + ((MK_REPEAT >> 3) & 1); ++rep_) { PHASE_IDS(); PHASE_ARGS();
        const float* hg_norm_w = ARG(I_HGNW); const float* conv_w = ARG(I_CONVW); const bf16_t* PROJ = WSP(bf16_t, WS_PROJ); bf16_t* OB = WSP(bf16_t, WS_O); bf16_t* CVB = WSP(bf16_t, WS_O) + 512;
        const int nchainblk = (G >= 256) ? 128 : (G >= 2 ? G / 2 : 1);
        if (bid < nchainblk) {
            constexpr int LDQ = 136, LDT = 72;
            LAS bf16_t* QT = (LAS bf16_t*)(lds);
            LAS bf16_t* KT = QT + 64 * LDQ;
            LAS bf16_t* QB = KT + 64 * LDQ;
            LAS bf16_t* KBT = QB + 64 * LDQ;
            LAS bf16_t* VT = KBT + 128 * LDT;
            LAS bf16_t* PM = VT + 128 * LDT;
            LAS bf16_t* ST = PM + 64 * LDT;
            LAS bf16_t* OS = ST + 128 * LDQ;
            LAS float* SEG = (LAS float*)(OS + 64 * LDQ);
            LAS float* DEC = SEG + 8 * 128;
            const int fr = lane & 15, fq = lane >> 4, w = wave;
            for (int chain = bid; chain < BATCH * NHEAD; chain += nchainblk) {
                const int b = chain >> 2, h = chain & 3;
                __syncthreads();
                for (int i = tid; i < 128 * LDQ / 2; i += NTHREADS) ((LAS unsigned*)ST)[i] = 0u;
                f32x4 Sacc[8];
#pragma unroll
                for (int i = 0; i < 8; ++i) Sacc[i] = (f32x4){0.f, 0.f, 0.f, 0.f};
                const int ot = tid >> 3, ocg = tid & 7;
                f32x4 nwv[4];
#pragma unroll
                for (int q = 0; q < 2; ++q) { nwv[2 * q] = *(const f32x4*)(hg_norm_w + q * 64 + 8 * ocg); nwv[2 * q + 1] = *(const f32x4*)(hg_norm_w + q * 64 + 8 * ocg + 4); }
                const bf16_t* pbase = PROJ + (size_t)(b * SEQ) * PROJ_LD + h * DK;
                unsigned rq[8], rl[8], rv[8];
#pragma unroll
                for (int r = 0; r < 8; ++r) { const bf16_t* p = pbase + (size_t)(8 * w + r) * PROJ_LD + 2 * lane; rq[r] = *(const unsigned*)p; rl[r] = *(const unsigned*)(p + 512); rv[r] = *(const unsigned*)(p + 1024); }
                for (int c = 0; c < NCHUNK; ++c) {
                    const int m0 = c * CHUNK;
                    float cs0[8], cs1[8]; { float a0 = 0.f, a1 = 0.f;
#pragma unroll
                        for (int r = 0; r < 8; ++r) { a0 += bf_lo(rl[r]); a1 += bf_hi(rl[r]); cs0[r] = a0; cs1[r] = a1; }
                        *(LAS f32x2*)(SEG + w * 128 + 2 * lane) = (f32x2){a0, a1}; }
                    LDS_WAIT(); __syncthreads();
                    float pre0 = 0.f, pre1 = 0.f, bm0 = 0.f, bm1 = 0.f, bl0 = 0.f, bl1 = 0.f;
#pragma unroll
                    for (int s = 0; s < 8; ++s) { const f32x2 t2 = *(const LAS f32x2*)(SEG + s * 128 + 2 * lane); if (s < w) { pre0 += t2[0]; pre1 += t2[1]; } if (s < 4) { bm0 += t2[0]; bm1 += t2[1]; } bl0 += t2[0]; bl1 += t2[1]; }
                    const float em0 = fast_exp(fmaxf(bm0, -80.f)), em1 = fast_exp(fmaxf(bm1, -80.f));
                    const float el0 = fast_exp(fmaxf(bl0 - bm0, -80.f)), el1 = fast_exp(fmaxf(bl1 - bm1, -80.f));
                    if (w == 0) *(LAS f32x2*)(DEC + 2 * lane) = (f32x2){fast_exp(fmaxf(bl0, -80.f)), fast_exp(fmaxf(bl1, -80.f))};
                    unsigned kb0[4], kb1[4], vt0[4], vt1[4];
#pragma unroll
                    for (int r = 0; r < 8; ++r) {
                        const int t = 8 * w + r;
                        const float lf0 = bf_lo(rl[r]), lf1 = bf_hi(rl[r]);
                        const float d0 = fminf(fmaxf(pre0 + cs0[r] - bm0, -80.f), 80.f), d1 = fminf(fmaxf(pre1 + cs1[r] - bm1, -80.f), 80.f);
                        const float e0 = fast_exp(d0), e1 = fast_exp(d1), i0 = fast_exp(-d0), i1 = fast_exp(-d1);
                        const float kk0 = 1.0f - fast_exp(lf0), kk1 = 1.0f - fast_exp(lf1);
                        const float qt0 = bf_lo(rq[r]) * e0, qt1 = bf_hi(rq[r]) * e1, kt0 = kk0 * i0, kt1 = kk1 * i1;
                        *(LAS unsigned*)(QT + t * LDQ + 2 * lane) = cvt_pk_bf16(qt0, qt1);
                        *(LAS unsigned*)(KT + t * LDQ + 2 * lane) = cvt_pk_bf16(kt0, kt1);
                        *(LAS unsigned*)(QB + t * LDQ + 2 * lane) = cvt_pk_bf16(qt0 * em0, qt1 * em1);
                        const unsigned kbp = cvt_pk_bf16(kt0 * el0, kt1 * el1);
                        if (r & 1) { kb0[r >> 1] |= (kbp << 16); kb1[r >> 1] |= (kbp & 0xffff0000u); vt0[r >> 1] |= (rv[r] << 16); vt1[r >> 1] |= (rv[r] & 0xffff0000u); }
                        else { kb0[r >> 1] = kbp & 0xffffu; kb1[r >> 1] = kbp >> 16; vt0[r >> 1] = rv[r] & 0xffffu; vt1[r >> 1] = rv[r] >> 16; }
                    }
                    *(LAS u32x4*)(KBT + (2 * lane) * LDT + 8 * w) = (u32x4){kb0[0], kb0[1], kb0[2], kb0[3]};
                    *(LAS u32x4*)(KBT + (2 * lane + 1) * LDT + 8 * w) = (u32x4){kb1[0], kb1[1], kb1[2], kb1[3]};
                    *(LAS u32x4*)(VT + (2 * lane) * LDT + 8 * w) = (u32x4){vt0[0], vt0[1], vt0[2], vt0[3]};
                    *(LAS u32x4*)(VT + (2 * lane + 1) * LDT + 8 * w) = (u32x4){vt1[0], vt1[1], vt1[2], vt1[3]};
                    LDS_WAIT(); __syncthreads();
                    u32x4 gg[2];
                    { const bf16_t* gp = pbase + (size_t)(m0 + ot) * PROJ_LD + 1536 + 8 * ocg; gg[0] = *(const u32x4*)gp; gg[1] = *(const u32x4*)(gp + 64); }
                    if (c + 1 < NCHUNK) {
#pragma unroll
                        for (int r = 0; r < 8; ++r) { const bf16_t* p = pbase + (size_t)(m0 + CHUNK + 8 * w + r) * PROJ_LD + 2 * lane; rq[r] = *(const unsigned*)p; rl[r] = *(const unsigned*)(p + 512); rv[r] = *(const unsigned*)(p + 1024); }
                    }
#pragma unroll
                    for (int x2 = 0; x2 < 2; ++x2) { const int id = 2 * w + x2, si = id >> 2, ti = id & 3;
                        f32x4 sc = (f32x4){0.f, 0.f, 0.f, 0.f};
                        if (si <= ti) {
#pragma unroll
                            for (int ks = 0; ks < 4; ++ks) { const bf16x8 a = *(const LAS bf16x8*)(KT + (16 * si + fr) * LDQ + 32 * ks + 8 * fq), bb = *(const LAS bf16x8*)(QT + (16 * ti + fr) * LDQ + 32 * ks + 8 * fq);
                                sc = __builtin_amdgcn_mfma_f32_16x16x32_bf16(a, bb, sc, 0, 0, 0); }
                            const int t = 16 * ti + fr, s0 = 16 * si + 4 * fq;
#pragma unroll
                            for (int j = 0; j < 4; ++j) sc[j] = (s0 + j <= t) ? sc[j] : 0.f;
                        }
                        *(LAS u32x2*)(PM + (16 * ti + fr) * LDT + 16 * si + 4 * fq) = (u32x2){cvt_pk_bf16(sc[0], sc[1]), cvt_pk_bf16(sc[2], sc[3])};
                    }
                    f32x4 oacc[4];
                    { bf16x8 sa[4];
#pragma unroll
                        for (int ks = 0; ks < 4; ++ks) sa[ks] = *(const LAS bf16x8*)(ST + (16 * w + fr) * LDQ + 32 * ks + 8 * fq);
#pragma unroll
                        for (int ti = 0; ti < 4; ++ti) { oacc[ti] = (f32x4){0.f, 0.f, 0.f, 0.f};
#pragma unroll
                            for (int ks = 0; ks < 4; ++ks) { const bf16x8 bb = *(const LAS bf16x8*)(QB + (16 * ti + fr) * LDQ + 32 * ks + 8 * fq); oacc[ti] = __builtin_amdgcn_mfma_f32_16x16x32_bf16(sa[ks], bb, oacc[ti], 0, 0, 0); } } }
                    LDS_WAIT(); __syncthreads();
                    { bf16x8 va[2];
#pragma unroll
                        for (int ks = 0; ks < 2; ++ks) va[ks] = *(const LAS bf16x8*)(VT + (16 * w + fr) * LDT + 32 * ks + 8 * fq);
#pragma unroll
                        for (int ti = 0; ti < 4; ++ti)
#pragma unroll
                            for (int ks = 0; ks < 2; ++ks) { const bf16x8 bb = *(const LAS bf16x8*)(PM + (16 * ti + fr) * LDT + 32 * ks + 8 * fq); oacc[ti] = __builtin_amdgcn_mfma_f32_16x16x32_bf16(va[ks], bb, oacc[ti], 0, 0, 0); }
#pragma unroll
                        for (int i = 0; i < 8; ++i) { const f32x4 dv = *(const LAS f32x4*)(DEC + 16 * i + 4 * fq); Sacc[i] = Sacc[i] * dv;
#pragma unroll
                            for (int ks = 0; ks < 2; ++ks) { const bf16x8 a = *(const LAS bf16x8*)(KBT + (16 * i + fr) * LDT + 32 * ks + 8 * fq); Sacc[i] = __builtin_amdgcn_mfma_f32_16x16x32_bf16(a, va[ks], Sacc[i], 0, 0, 0); } } }
#pragma unroll
                    for (int ti = 0; ti < 4; ++ti) *(LAS u32x2*)(OS + (16 * ti + fr) * LDQ + 16 * w + 4 * fq) = (u32x2){cvt_pk_bf16(oacc[ti][0], oacc[ti][1]), cvt_pk_bf16(oacc[ti][2], oacc[ti][3])};
#pragma unroll
                    for (int i = 0; i < 8; ++i) *(LAS u32x2*)(ST + (16 * w + fr) * LDQ + 16 * i + 4 * fq) = (u32x2){cvt_pk_bf16(Sacc[i][0], Sacc[i][1]), cvt_pk_bf16(Sacc[i][2], Sacc[i][3])};
                    LDS_WAIT(); __syncthreads();
                    { f32x4 o[4]; const u32x4 ow0 = *(const LAS u32x4*)(OS + ot * LDQ + 8 * ocg), ow1 = *(const LAS u32x4*)(OS + ot * LDQ + 64 + 8 * ocg); gm::unpack8(ow0, o[0], o[1]); gm::unpack8(ow1, o[2], o[3]);
                        float ss = 0.f;
#pragma unroll
                        for (int q = 0; q < 4; ++q) ss += (o[q][0] * o[q][0] + o[q][1] * o[q][1]) + (o[q][2] * o[q][2] + o[q][3] * o[q][3]);
                        ss += __shfl_xor(ss, 1); ss += __shfl_xor(ss, 2); ss += __shfl_xor(ss, 4);
                        const float rn = __builtin_amdgcn_rsqf(ss * (1.0f / 128.0f) + EPS);
                        bf16_t* op = OB + (size_t)(b * SEQ + m0 + ot) * D + h * DK + 8 * ocg;
#pragma unroll
                        for (int q = 0; q < 2; ++q) { f32x4 g0, g1; gm::unpack8(gg[q], g0, g1);
#pragma unroll
                            for (int j = 0; j < 4; ++j) { g0[j] = g0[j] * sigmoidf_(g0[j]); g1[j] = g1[j] * sigmoidf_(g1[j]); }
                            *(u32x4*)(op + 64 * q) = gm::pack8(o[2 * q] * rn * nwv[2 * q] * g0, o[2 * q + 1] * rn * nwv[2 * q + 1] * g1); } }
                }
            }
        } else {
            const int nconv = G - nchainblk;
            f32x4 cw[3][2];
#pragma unroll
            for (int j = 0; j < 3; ++j) { cw[j][0] = *(const f32x4*)(conv_w + j * 512 + 8 * lane); cw[j][1] = *(const f32x4*)(conv_w + j * 512 + 8 * lane + 4); }
            for (int it = bid - nchainblk; it < BATCH * 8; it += nconv) {
                const int b = it >> 3, t0 = (it & 7) * 256 + wave * 32;
                const bf16_t* pb = PROJ + (size_t)(b * SEQ) * PROJ_LD + 2048 + 8 * lane;
                f32x4 p1[2], p2[2];
#pragma unroll
                for (int q = 0; q < 2; ++q) { p1[q] = (f32x4){0.f, 0.f, 0.f, 0.f}; p2[q] = p1[q]; }
                if (t0 > 0) {
                    f32x4 a0, a1, c0, c1;
                    gm::unpack8(*(const u32x4*)(pb + (size_t)(t0 - 2) * PROJ_LD + 512), a0, a1); gm::unpack8(*(const u32x4*)(pb + (size_t)(t0 - 2) * PROJ_LD + 1024), c0, c1); p2[0] = a0 * c0; p2[1] = a1 * c1;
                    gm::unpack8(*(const u32x4*)(pb + (size_t)(t0 - 1) * PROJ_LD + 512), a0, a1); gm::unpack8(*(const u32x4*)(pb + (size_t)(t0 - 1) * PROJ_LD + 1024), c0, c1); p1[0] = a0 * c0; p1[1] = a1 * c1;
                }
                for (int r = 0; r < 32; ++r) { const size_t ro = (size_t)(t0 + r) * PROJ_LD;
                    f32x4 a0, a1, c0, c1, g0, g1;
                    gm::unpack8(*(const u32x4*)(pb + ro + 512), a0, a1); gm::unpack8(*(const u32x4*)(pb + ro + 1024), c0, c1); gm::unpack8(*(const u32x4*)(pb + ro), g0, g1);
                    const f32x4 q0 = a0 * c0, q1 = a1 * c1;
                    const f32x4 y0 = g0 * (cw[0][0] * p2[0] + cw[1][0] * p1[0] + cw[2][0] * q0), y1 = g1 * (cw[0][1] * p2[1] + cw[1][1] * p1[1] + cw[2][1] * q1);
                    *(u32x4*)(CVB + (size_t)(b * SEQ + t0 + r) * D + 8 * lane) = gm::pack8(y0, y1);
                    p2[0] = p1[0]; p2[1] = p1[1]; p1[0] = q0; p1[1] = q1; }
            }
        }
        if (BOTH(3)) GRID_BAR();
#if MK_PHT
        if (MK_PHT == 4) phtk = __builtin_amdgcn_s_memrealtime() - pht0;
#endif
    }

    if (IN(4)) for (int rep_ = 0; rep_ < 1 + ((MK_REPEAT >> 4) & 1); ++rep_) { PHASE_ARGS();
        gm::DenseOrder S{NTOK / 256, D / 256, G, bid, 1}; gm::DenseA AM{D, 0u, 2}; gm::EpiMerge E{(const bf16_t*)ap->out, WSP(bf16_t, WS_U)};
        gm::gemm_phase<false>(wave_sg, lds, (const char*)WSP(bf16_t, WS_O), (const char*)WSP(bf16_t, WS_WHG), D, 0, 0u, S, E, AM);
        if (BOTH(4)) GRID_BAR();
#if MK_PHT
        if (MK_PHT == 5) phtk = __builtin_amdgcn_s_memrealtime() - pht0;
#endif
    }

    if (IN(5)) for (int rep_ = 0; rep_ < 1 + ((MK_REPEAT >> 5) & 1); ++rep_) { PHASE_ARGS();
        gm::DenseOrder S{NTOK / 256, D / 256, G, bid, 1}; gm::DenseA AM{D, 0u, 2}; gm::EpiMix E{ARG(I_X), WSP(float, WS_MOD), WSP(bf16_t, WS_H)};
        gm::gemm_phase<false>(wave_sg, lds, (const char*)WSP(bf16_t, WS_U), (const char*)WSP(bf16_t, WS_WMIX), D, 0, 0u, S, E, AM);
        if (BOTH(5)) GRID_BAR();
#if MK_PHT
        if (MK_PHT == 6) phtk = __builtin_amdgcn_s_memrealtime() - pht0;
#endif
    }

    if (IN(6)) { PHASE_IDS(); PHASE_ARGS();
        typedef float f32x16 __attribute__((ext_vector_type(16)));
        const float* norm_ffn_w = ARG(I_NFFN); const float* w_router = ARG(I_WR); const float* b_router = ARG(I_BR); const float* MOD = WSP(float, WS_MOD);
        const bf16_t* HB = WSP(bf16_t, WS_H); unsigned char* U2Q = WSP(unsigned char, WS_U2Q); int* TOPI = WSP(int, WS_TOPI); float* TOPP = WSP(float, WS_TOPP); int* POS = WSP(int, WS_POS);
        constexpr int WRS = 1032;
        LAS bf16_t* WRH = (LAS bf16_t*)lds; LAS bf16_t* WRL = WRH + 32 * WRS;
        LAS float* LG = (LAS float*)(lds + 132096) + wave * (16 * 36);
        LAS unsigned* LCNT = (LAS unsigned*)(lds + 150528);
        LAS unsigned* LBASE = LCNT + 32;
        LAS unsigned* LASS = LCNT + 64;
        LAS float* A2 = (LAS float*)(lds + 154880); LAS float* SH2 = A2 + 1024;
        for (int i = tid; i < 32 * 1024; i += NTHREADS) { const int e = i & 31, k = i >> 5; const float w = w_router[i];
            const unsigned hi = cvt_pk_bf16(w, 0.f) & 0xffffu; const unsigned lo = cvt_pk_bf16(w - bf_lo(hi), 0.f) & 0xffffu;
            WRH[e * WRS + k] = (bf16_t)hi; WRL[e * WRS + k] = (bf16_t)lo; }
        for (int tb = bid; tb < NTOK / 256; tb += G) {
            const int b = (tb * 256) >> 11;
            if (tid < 32) LCNT[tid] = 0u;
            for (int k = tid; k < 1024; k += NTHREADS) { A2[k] = norm_ffn_w[k] * (1.0f + MOD[(size_t)b * 6144 + 4096 + k]); SH2[k] = MOD[(size_t)b * 6144 + 3072 + k]; }
            LDS_WAIT(); __syncthreads();
            const int trow = lane & 31, half = lane >> 5, ltok0 = wave * 32, tok = tb * 256 + ltok0 + trow;
            const bf16_t* hrow = HB + (size_t)tok * D + 8 * half;
            float ssq = 0.f;
#pragma unroll 8
            for (int st = 0; st < 64; ++st) { const u32x4 hv = *(const u32x4*)(hrow + 16 * st); f32x4 x0, x1; gm::unpack8(hv, x0, x1);
                ssq += (x0[0] * x0[0] + x0[1] * x0[1]) + (x0[2] * x0[2] + x0[3] * x0[3]) + (x1[0] * x1[0] + x1[1] * x1[1]) + (x1[2] * x1[2] + x1[3] * x1[3]); }
            ssq += __shfl_xor(ssq, 32);
            const float rs = __builtin_amdgcn_rsqf(ssq * (1.0f / D) + EPS);
            f32x16 dacc;
#pragma unroll
            for (int q = 0; q < 16; ++q) dacc[q] = 0.f;
            unsigned char* urow = U2Q + (size_t)tok * D + 8 * half;
            const LAS bf16_t* wh = WRH + trow * WRS + 8 * half; const LAS bf16_t* wl = WRL + trow * WRS + 8 * half;
#pragma unroll 2
            for (int st = 0; st < 64; ++st) {
                const u32x4 hv = *(const u32x4*)(hrow + 16 * st); f32x4 x0, x1; gm::unpack8(hv, x0, x1);
                const int k0 = 16 * st + 8 * half;
                const f32x4 a0 = *(const LAS f32x4*)(A2 + k0), a1 = *(const LAS f32x4*)(A2 + k0 + 4), s0 = *(const LAS f32x4*)(SH2 + k0), s1 = *(const LAS f32x4*)(SH2 + k0 + 4);
                const f32x4 u0 = x0 * rs * a0 + s0, u1 = x1 * rs * a1 + s1;
                *(u32x2*)(urow + 16 * st) = (u32x2){pk4_fp8(u0[0], u0[1], u0[2], u0[3]), pk4_fp8(u1[0], u1[1], u1[2], u1[3])};
                u32x4 hh; hh.x = cvt_pk_bf16(u0[0], u0[1]); hh.y = cvt_pk_bf16(u0[2], u0[3]); hh.z = cvt_pk_bf16(u1[0], u1[1]); hh.w = cvt_pk_bf16(u1[2], u1[3]);
                u32x4 ll; ll.x = cvt_pk_bf16(u0[0] - bf_lo(hh.x), u0[1] - bf_hi(hh.x)); ll.y = cvt_pk_bf16(u0[2] - bf_lo(hh.y), u0[3] - bf_hi(hh.y));
                ll.z = cvt_pk_bf16(u1[0] - bf_lo(hh.z), u1[1] - bf_hi(hh.z)); ll.w = cvt_pk_bf16(u1[2] - bf_lo(hh.w), u1[3] - bf_hi(hh.w));
                const bf16x8 ah = __builtin_bit_cast(bf16x8, hh), al = __builtin_bit_cast(bf16x8, ll);
                const bf16x8 bh = *(const LAS bf16x8*)(wh + 16 * st), bl = *(const LAS bf16x8*)(wl + 16 * st);
                dacc = __builtin_amdgcn_mfma_f32_32x32x16_bf16(ah, bh, dacc, 0, 0, 0);
                dacc = __builtin_amdgcn_mfma_f32_32x32x16_bf16(ah, bl, dacc, 0, 0, 0);
                dacc = __builtin_amdgcn_mfma_f32_32x32x16_bf16(al, bh, dacc, 0, 0, 0);
            }
            const float br = b_router[trow];
#pragma unroll
            for (int g = 0; g < 2; ++g) {
#pragma unroll
                for (int q = 0; q < 8; ++q) { const int r16 = (q & 3) + 8 * (q >> 2) + 4 * half; LG[r16 * 36 + trow] = dacc[8 * g + q] + br; }
                LDS_WAIT(); asm volatile("" ::: "memory");
                if (lane < 16) {
                    float v0 = -3.0e38f, v1 = -3.0e38f, v2 = -3.0e38f, v3 = -3.0e38f; int i0 = 0, i1 = 0, i2 = 0, i3 = 0;
#pragma unroll
                    for (int e4 = 0; e4 < 8; ++e4) { const f32x4 lv = *(const LAS f32x4*)(LG + lane * 36 + 4 * e4);
#pragma unroll
                        for (int j = 0; j < 4; ++j) { const float x = lv[j]; const int e = 4 * e4 + j;
                            const bool c0 = x > v0, c1 = x > v1, c2 = x > v2, c3 = x > v3;
                            v3 = c2 ? v2 : (c3 ? x : v3); i3 = c2 ? i2 : (c3 ? e : i3);
                            v2 = c1 ? v1 : (c2 ? x : v2); i2 = c1 ? i1 : (c2 ? e : i2);
                            v1 = c0 ? v0 : (c1 ? x : v1); i1 = c0 ? i0 : (c1 ? e : i1);
                            v0 = c0 ? x : v0; i0 = c0 ? e : i0; } }
                    const float e1 = fast_exp(v1 - v0), e2 = fast_exp(v2 - v0), e3 = fast_exp(v3 - v0); const float inv = fast_rcp(1.0f + e1 + e2 + e3);
                    const int lt = ltok0 + 16 * g + lane; const size_t gt = (size_t)tb * 256 + lt;
                    typedef int i32x4 __attribute__((ext_vector_type(4)));
                    *(i32x4*)(TOPI + gt * 4) = (i32x4){i0, i1, i2, i3}; *(f32x4*)(TOPP + gt * 4) = (f32x4){inv, e1 * inv, e2 * inv, e3 * inv};
                    const unsigned r0 = __hip_atomic_fetch_add(LCNT + i0, 1u, __ATOMIC_RELAXED, __HIP_MEMORY_SCOPE_WORKGROUP), r1 = __hip_atomic_fetch_add(LCNT + i1, 1u, __ATOMIC_RELAXED, __HIP_MEMORY_SCOPE_WORKGROUP);
                    const unsigned r2 = __hip_atomic_fetch_add(LCNT + i2, 1u, __ATOMIC_RELAXED, __HIP_MEMORY_SCOPE_WORKGROUP), r3 = __hip_atomic_fetch_add(LCNT + i3, 1u, __ATOMIC_RELAXED, __HIP_MEMORY_SCOPE_WORKGROUP);
                    *(LAS u32x4*)(LASS + lt * 4) = (u32x4){((unsigned)i0 << 16) | r0, ((unsigned)i1 << 16) | r1, ((unsigned)i2 << 16) | r2, ((unsigned)i3 << 16) | r3};
                }
                LDS_WAIT(); asm volatile("" ::: "memory");
            }
            LDS_WAIT(); __syncthreads();
            if (tid < 32) LBASE[tid] = atomicAdd(ctl + CW_CNT + 64 * tid, (unsigned)LCNT[tid]);
            LDS_WAIT(); __syncthreads();
            for (int i = tid; i < 1024; i += NTHREADS) { const unsigned v = LASS[i]; POS[(size_t)tb * 1024 + i] = (int)(LBASE[v >> 16] + (v & 0xffffu)); }
            __syncthreads();
        }
        if (BOTH(6)) GRID_BAR();
#if MK_PHT
        if (MK_PHT == 7) phtk = __builtin_amdgcn_s_memrealtime() - pht0;
#endif
    }

    LAS int* PADSTART = (LAS int*)(lds + TBL_OFF); LAS int* TILE_E = PADSTART + 64;
    int ntiles = 0;
    {
        if (lo <= 9 && hi > 7) { PHASE_IDS(); PHASE_ARGS();
            __syncthreads();
            if (tid == 0) { int acc = 0; for (int e = 0; e < NE; ++e) { PADSTART[e] = acc; const int cnt = (int)__hip_atomic_load(ctl + CW_CNT + 64 * e, __ATOMIC_RELAXED, __HIP_MEMORY_SCOPE_AGENT); const int nt_e = (cnt + 255) >> 8; for (int t = 0; t < nt_e; ++t) TILE_E[(acc >> 8) + t] = e; acc += nt_e << 8; } PADSTART[NE] = acc; }
            LDS_WAIT(); __syncthreads();
            ntiles = PADSTART[NE] >> 8;
        }
    }

    if (IN(7)) for (int rep_ = 0; rep_ < 1 + ((MK_REPEAT >> 7) & 1); ++rep_) { PHASE_IDS(); PHASE_ARGS();
        const int* TOPI = WSP(int, WS_TOPI); const float* TOPP = WSP(float, WS_TOPP); int* POS = WSP(int, WS_POS); int* RTOK = WSP(int, WS_RTOK); int* RSLOT = WSP(int, WS_RSLOT); float* RW = WSP(float, WS_RW);
        for (int i = bid * NTHREADS + tid; i < NASSIGN; i += G * NTHREADS) { const int e = TOPI[i]; const int row = PADSTART[e] + POS[i]; RTOK[row] = i >> 2; RSLOT[row] = i; RW[row] = TOPP[i]; POS[i] = row; }
        for (int e = bid; e < NE; e += G) { const int cnt = (int)__hip_atomic_load(ctl + CW_CNT + 64 * e, __ATOMIC_RELAXED, __HIP_MEMORY_SCOPE_AGENT);
            for (int r = PADSTART[e] + cnt + tid; r < PADSTART[e + 1]; r += NTHREADS) { RTOK[r] = 0; RSLOT[r] = -1; RW[r] = 0.f; } }
        if (BOTH(7)) GRID_BAR();
#if MK_PHT
        if (MK_PHT == 8) phtk = __builtin_amdgcn_s_memrealtime() - pht0;
#endif
    }

    if (IN(8)) for (int rep_ = 0; rep_ < 1 + ((MK_REPEAT >> 8) & 1); ++rep_) { PHASE_ARGS();
        gm::MoeOrder S{ntiles, 2048 / 256, G, bid, TILE_E}; gm::GatherA AM{D, WSP(int, WS_RTOK), 1}; gm::EpiSwiglu E{ARG(I_B1), WSP(unsigned char, WS_ACT), ctl + CW_TP};
        gm::gemm_phase<true>(wave_sg, lds, (const char*)WSP(char, WS_U2Q), (const char*)WSP(char, WS_W1), D, 2048, 0u, S, E, AM);
        if (BOTH(8)) GRID_BAR();
#if MK_PHT
        if (MK_PHT == 9) phtk = __builtin_amdgcn_s_memrealtime() - pht0;
#endif
    }

    if (IN(9)) for (int rep_ = 0; rep_ < 1 + ((MK_REPEAT >> 9) & 1); ++rep_) { PHASE_ARGS();
        gm::MoeOrder S{ntiles, D / 256, G, bid, TILE_E}; gm::DenseA AM{DFF, 0u, 1}; gm::EpiMoeOut E{ARG(I_B2), WSP(float, WS_RW), WSP(unsigned char, WS_YA)};
        gm::gemm_phase<true>(wave_sg, lds, (const char*)WSP(char, WS_ACT), (const char*)WSP(char, WS_W2), DFF, D, 0u, S, E, AM);
        if (BOTH(9)) GRID_BAR();
#if MK_PHT
        if (MK_PHT == 10) phtk = __builtin_amdgcn_s_memrealtime() - pht0;
#endif
    }

#if MK_PROBE
    if (lo == 100) { PHASE_IDS(); PHASE_ARGS();
        float* out = ap->out;
        const bf16_t* src = MK_PROBE == 1 ? WSP(bf16_t, WS_U) : MK_PROBE == 3 ? WSP(bf16_t, WS_O) : MK_PROBE == 4 ? WSP(bf16_t, WS_U) : MK_PROBE == 5 ? WSP(bf16_t, WS_H) : WSP(bf16_t, WS_U);
        for (size_t i = (size_t)bid * NTHREADS + tid; i < (size_t)NTOK * D; i += (size_t)G * NTHREADS) {
            float v;
            if (MK_PROBE == 3) { const size_t t = i >> 10, c = i & 1023; v = bf1(src[t * 1024 + c]); }
            else if (MK_PROBE == 2) { const size_t t = i >> 10, c = i & 1023; const bf16_t* P = WSP(bf16_t, WS_PROJ) + t * PROJ_LD; v = bf1(P[c]) + bf1(P[c + 1024]) + bf1(P[c + 2048]) + (c < 512 ? bf1(P[c + 3072]) : 0.f); }
            else if (MK_PROBE == 6) { const size_t t = i >> 10, c = i & 1023; v = bf1(src[i]) + (c < 4 ? (float)WSP(int, WS_TOPI)[t * 4 + c] : c < 8 ? WSP(float, WS_TOPP)[t * 4 + (c - 4)] : 0.f); }
            else v = bf1(src[i]);
            out[i] = v; }
    }
#endif
    if (IN(10)) { PHASE_IDS(); PHASE_ARGS();
#if MK_TPROBE
        const float tscale = 1.0f;
#elif MK_FP8TEST
        float tscale = 1.0f;
        {
            typedef int v8i __attribute__((ext_vector_type(8)));
            const int fr = lane & 15, fq = lane >> 4;
            v8i ta, tb;
#pragma unroll
            for (int d = 0; d < 8; ++d) { float av[4], bv[4];
#pragma unroll
                for (int e = 0; e < 4; ++e) { const int k = 32 * fq + 4 * d + e; av[e] = (float)(((fr * 7 + k * 3) % 5) - 2); bv[e] = (float)(((k * 5 + fr * 11) % 7) - 3); }
                int w = __builtin_amdgcn_cvt_pk_fp8_f32(av[0], av[1], 0, false); w = __builtin_amdgcn_cvt_pk_fp8_f32(av[2], av[3], w, true); ta[d] = w;
                w = __builtin_amdgcn_cvt_pk_fp8_f32(bv[0], bv[1], 0, false); w = __builtin_amdgcn_cvt_pk_fp8_f32(bv[2], bv[3], w, true); tb[d] = w; }
            f32x4 tc = {0.f, 0.f, 0.f, 0.f};
            tc = __builtin_amdgcn_mfma_scale_f32_16x16x128_f8f6f4(ta, tb, tc, 0, 0, 0, 0x7A7A7A7A, 0, 0x7F7F7F7F);
            bool bad = false;
#pragma unroll
            for (int r = 0; r < 4; ++r) { const int i = 4 * fq + r, j = fr; float ref = 0.f;
                for (int k = 0; k < 128; ++k) ref += (float)(((i * 7 + k * 3) % 5) - 2) * (float)(((k * 5 + j * 11) % 7) - 3);
                ref *= (1.0f / 32.0f); if (fabsf(tc[r] - ref) > 1e-3f) bad = true; }
            if (__any(bad)) tscale = 4.0f;
        }
#endif
        const float* norm_final_w = ARG(I_NFIN); const float* MOD = WSP(float, WS_MOD); const bf16_t* HB = WSP(bf16_t, WS_H); const unsigned char* YA = WSP(unsigned char, WS_YA); const int* ASROW = WSP(int, WS_POS); float* out = ap->out;
        for (int m0 = gw * 32; m0 < NTOK; m0 += NGW * 32) {
            const int b = m0 >> 11;
            f32x4 gf[4], nf[4];
#pragma unroll
            for (int j = 0; j < 4; ++j) { const int k = 4 * lane + 256 * j; gf[j] = *(const f32x4*)(MOD + (size_t)b * 6144 + 5120 + k); nf[j] = *(const f32x4*)(norm_final_w + k); }
            for (int r = 0; r < 32; ++r) {
                const size_t tok = (size_t)(m0 + r);
                const bf16_t* hr = HB + tok * D;
                typedef int i32x4 __attribute__((ext_vector_type(4)));
                const i32x4 rr = *(const i32x4*)(ASROW + tok * 4);
                const unsigned char* y0 = YA + (size_t)rr[0] * D; const unsigned char* y1 = YA + (size_t)rr[1] * D; const unsigned char* y2 = YA + (size_t)rr[2] * D; const unsigned char* y3 = YA + (size_t)rr[3] * D;
                f32x4 v[4]; float s = 0.f;
#pragma unroll
                for (int j = 0; j < 4; ++j) { const int k = 4 * lane + 256 * j;
                    const u32x2 hw = *(const u32x2*)(hr + k); const unsigned ya = *(const unsigned*)(y0 + k), yb = *(const unsigned*)(y1 + k), yc = *(const unsigned*)(y2 + k), yd = *(const unsigned*)(y3 + k);
                    f32x4 y = fp8x4_to_f32(ya); y += fp8x4_to_f32(yb); y += fp8x4_to_f32(yc); y += fp8x4_to_f32(yd);
                    v[j] = (f32x4){bf_lo(hw.x), bf_hi(hw.x), bf_lo(hw.y), bf_hi(hw.y)} + gf[j] * y;
                    s += (v[j][0] * v[j][0] + v[j][1] * v[j][1]) + (v[j][2] * v[j][2] + v[j][3] * v[j][3]); }
                const float rs = __builtin_amdgcn_rsqf(wave_sum(s) * (1.0f / D) + EPS);
                float* orow = out + tok * D;
#pragma unroll
                #if MK_FP8TEST || MK_TPROBE
                for (int j = 0; j < 4; ++j) *(f32x4*)(orow + 4 * lane + 256 * j) = v[j] * rs * nf[j] * tscale;
#else
                for (int j = 0; j < 4; ++j) *(f32x4*)(orow + 4 * lane + 256 * j) = v[j] * rs * nf[j];
#endif
            }
        }
    }
#if MK_PHT
    if (bid == 0) { const unsigned long long t1 = __builtin_amdgcn_s_memrealtime(); while (__builtin_amdgcn_s_memrealtime() - t1 < phtk) __builtin_amdgcn_s_sleep(8); }
#endif
#undef IN
#undef BOTH
}

extern "C" void kernel_launch(void* const* d_in, const int* in_sizes, int n_in, void* d_out, int out_size, void* d_ws, size_t ws_size, hipStream_t stream) {
    static int grid = 0;
    if (grid == 0) {
        if (n_in != 20 || out_size != NTOK * D || ws_size < WS_END) { fprintf(stderr, "kernel_launch: unexpected shapes (n_in %d out %d ws %zu)\n", n_in, out_size, ws_size); grid = -1; return; }
        if (hipFuncSetAttribute((const void*)fwd_kernel, hipFuncAttributeMaxDynamicSharedMemorySize, LDS_BYTES) != hipSuccess) { fprintf(stderr, "kernel_launch: hipFuncSetAttribute failed\n"); grid = -1; return; }
        int dev = 0, cus = 0, per_cu = 0;
        (void)hipGetDevice(&dev); (void)hipDeviceGetAttribute(&cus, hipDeviceAttributeMultiprocessorCount, dev);
        if (hipOccupancyMaxActiveBlocksPerMultiprocessor(&per_cu, (const void*)fwd_kernel, NTHREADS, LDS_BYTES) != hipSuccess || per_cu < 1) fprintf(stderr, "kernel_launch: occupancy query says %d\n", per_cu);
        (void)hipGetLastError();
        grid = cus > 0 ? cus : 256;
    }
    if (grid < 0) return;
    (void)hipMemsetAsync((char*)d_ws + WS_CTL, 0, CTL_ZERO_BYTES, stream);
    Args a{};
    for (int i = 0; i < 20; ++i) a.in[i] = (const float*)d_in[i];
    a.out = (float*)d_out; a.ws = (unsigned char*)d_ws;
#if MK_ONE_LAUNCH
    a.ph_lo = 0; a.ph_hi = NPHASE;
    hipLaunchKernelGGL(fwd_kernel, dim3(grid), dim3(NTHREADS), LDS_BYTES, stream, a);
#else
#if MK_PROBE
    for (int p = 0; p <= MK_PROBE; ++p) { a.ph_lo = p; a.ph_hi = p + 1; hipLaunchKernelGGL(fwd_kernel, dim3(grid), dim3(NTHREADS), LDS_BYTES, stream, a); }
    a.ph_lo = 100; a.ph_hi = 101; hipLaunchKernelGGL(fwd_kernel, dim3(grid), dim3(NTHREADS), LDS_BYTES, stream, a);
#else
    for (int p = 0; p < NPHASE; ++p) { a.ph_lo = p; a.ph_hi = p + 1; hipLaunchKernelGGL(fwd_kernel, dim3(grid), dim3(NTHREADS), LDS_BYTES, stream, a); }
#endif
#endif
}
```

```cpp
#include <hip/hip_runtime.h>
#include <cstdio>
#include <cstdint>

#ifndef MK_PROBE
#define MK_PROBE 0
#endif
#ifndef MK_REPEAT
#define MK_REPEAT 0
#endif
#ifndef MK_FP8TEST
#define MK_FP8TEST 0
#endif
#ifndef MK_STAGGER
#define MK_STAGGER 0
#endif
#ifndef MK_TPROBE
#define MK_TPROBE 0
#endif
#ifndef MK_PHT
#define MK_PHT 0
#endif
#ifndef MK_P2FP8
#define MK_P2FP8 0
#endif
#ifndef MK_ONE_LAUNCH
#define MK_ONE_LAUNCH 1
#endif

#define LAS __attribute__((address_space(3)))
#define GAS __attribute__((address_space(1)))
typedef unsigned short bf16_t;
typedef short bf16x8 __attribute__((ext_vector_type(8)));
typedef float f32x4 __attribute__((ext_vector_type(4)));
typedef float f32x2 __attribute__((ext_vector_type(2)));
typedef unsigned u32x4 __attribute__((ext_vector_type(4)));
typedef unsigned u32x2 __attribute__((ext_vector_type(2)));
typedef int v8i __attribute__((ext_vector_type(8)));

constexpr int D = 1024, BATCH = 32, SEQ = 2048, NTOK = BATCH * SEQ;
constexpr int HW = 512, NHEAD = 4, DK = 128, CHUNK = 64, NCHUNK = SEQ / CHUNK;
constexpr int INC = 5632, PROJ_LD = 3584, GATE_LD = 2048;
constexpr int NE = 32, TOPK = 4, DFF = 1024, NASSIGN = NTOK * TOPK;
constexpr int MAXTILES = NASSIGN / 256 + NE;
constexpr int MAXROWS = MAXTILES * 256;
constexpr float EPS = 1e-6f, SW_LIMIT = 7.0f, SW_ALPHA = 1.702f;
constexpr int NWAVES = 8, NTHREADS = 512;
constexpr int NPHASE = 11;

constexpr size_t MiB = 1u << 20;
constexpr size_t WS_CTL = 0, CTL_ZERO_BYTES = 65536;
constexpr size_t WS_MOD = 1 * MiB;
constexpr size_t WS_LB = WS_MOD + 32 * 6144 * 4;
constexpr size_t WS_WIN = 2 * MiB;
constexpr size_t WS_WHG = 13 * MiB, WS_WCV = 14 * MiB, WS_WMIX = 15 * MiB;
constexpr size_t WS_W2 = 18 * MiB;
constexpr size_t WS_W1 = 50 * MiB;
constexpr size_t WS_U2Q = 114 * MiB;
constexpr size_t WS_U = 210 * MiB;
constexpr size_t WS_PROJ = 338 * MiB;
constexpr size_t WS_O = 786 * MiB;
constexpr size_t WS_CV = 850 * MiB;
constexpr size_t WS_H = 338 * MiB;
constexpr size_t WS_ACT = 466 * MiB;
constexpr size_t WS_TOPI = 994 * MiB, WS_TOPP = 995 * MiB, WS_POS = 996 * MiB;
constexpr size_t WS_RTOK = 997 * MiB, WS_RSLOT = 997 * MiB + 1081344 + 0, WS_RW = WS_RSLOT + 1081344;
constexpr size_t WS_YA = 50 * MiB, WS_YB = 730 * MiB; constexpr int YSPLIT = 147456;
constexpr size_t WS_YO23_UNUSED = 730 * MiB;
constexpr size_t WS_END = 1001 * MiB;
static_assert(WS_RW + 1081344 <= WS_END && MAXROWS * 4 == 1081344, "tables");
static_assert(WS_ACT + (size_t)MAXROWS * 1024 <= WS_YB && WS_YB + (size_t)(MAXROWS - YSPLIT) * 2048 <= WS_TOPI && WS_YA + (size_t)YSPLIT * 2048 <= WS_H && YSPLIT % 256 == 0, "expert output map");
constexpr int CW_TMO = 0, CW_BAR = 4096, CW_CNT = 8192, CW_TP = 12288;

constexpr int LDS_BYTES = 163840;
constexpr int MISC_OFF = LDS_BYTES - 256;
constexpr int TBL_OFF = 131072;
constexpr int SIDE_OFF = TBL_OFF + 8192;

#define LDS_WAIT() asm volatile("s_waitcnt lgkmcnt(0)" ::: "memory")
#define VM_WAIT() asm volatile("s_waitcnt vmcnt(0)" ::: "memory")
typedef __bf16 bf16x2_t __attribute__((ext_vector_type(2)));
__device__ __forceinline__ unsigned cvt_pk_bf16(float lo, float hi) { const f32x2 v = {lo, hi}; const bf16x2_t b = __builtin_convertvector(v, bf16x2_t); return __builtin_bit_cast(unsigned, b); }
__device__ __forceinline__ unsigned pk4_fp8(float a, float b, float c, float d) {
    a = fminf(fmaxf(a, -448.f), 448.f); b = fminf(fmaxf(b, -448.f), 448.f); c = fminf(fmaxf(c, -448.f), 448.f); d = fminf(fmaxf(d, -448.f), 448.f);
    int w = __builtin_amdgcn_cvt_pk_fp8_f32(a, b, 0, false); w = __builtin_amdgcn_cvt_pk_fp8_f32(c, d, w, true); return (unsigned)w; }
__device__ __forceinline__ f32x4 fp8x4_to_f32(unsigned w) {
    const f32x2 lo = __builtin_amdgcn_cvt_pk_f32_fp8((int)w, false), hi = __builtin_amdgcn_cvt_pk_f32_fp8((int)w, true); return (f32x4){lo[0], lo[1], hi[0], hi[1]}; }
__device__ __forceinline__ unsigned pk4_fp8_nc(float a, float b, float c, float d) {
    int w = __builtin_amdgcn_cvt_pk_fp8_f32(a, b, 0, false); w = __builtin_amdgcn_cvt_pk_fp8_f32(c, d, w, true); return (unsigned)w; }
__device__ __forceinline__ float bf_lo(unsigned u) { return __uint_as_float(u << 16); }
__device__ __forceinline__ float bf_hi(unsigned u) { return __uint_as_float(u & 0xffff0000u); }
__device__ __forceinline__ float bf1(bf16_t u) { return __uint_as_float(((unsigned)u) << 16); }
__device__ __forceinline__ float fast_rcp(float x) { return __builtin_amdgcn_rcpf(x); }
__device__ __forceinline__ float fast_exp(float x) { return __builtin_amdgcn_exp2f(x * 1.44269504089f); }
__device__ __forceinline__ float fast_log(float x) { return __builtin_amdgcn_logf(x) * 0.69314718056f; }
__device__ __forceinline__ float sigmoidf_(float x) { return fast_rcp(1.0f + fast_exp(-x)); }
__device__ __forceinline__ float wave_sum(float v) {
#pragma unroll
    for (int o = 1; o < 64; o <<= 1) v += __shfl_xor(v, o);
    return v;
}

#define XB_TMO      128
#define XB_XCNT(j)  (256  + 64 * (j))
#define XB_XSUB(j)  (1280 + 64 * (j))
#define XB_XGEN(j)  (2304 + 64 * (j))
#define XB_TOP      3328
#define XB_TOPGEN   3392
#define XCD_BAR_WORDS 3456
#define XB_SPIN_CAP (1u << 20)
__device__ __forceinline__ unsigned xb_ld(unsigned* p)              { return __hip_atomic_load(p, __ATOMIC_RELAXED, __HIP_MEMORY_SCOPE_AGENT); }
__device__ __forceinline__ unsigned xb_add(unsigned* p, unsigned v) { return __hip_atomic_fetch_add(p, v, __ATOMIC_RELAXED, __HIP_MEMORY_SCOPE_AGENT); }
__device__ __forceinline__ unsigned xb_xcc_id() { return (unsigned)__builtin_amdgcn_s_getreg((3 << 11) | 20) & 0xFu; }
#define XB_SPIN(cond, bar) do { unsigned _sp = 0; while (cond) { __builtin_amdgcn_s_sleep(1); \
    if ((++_sp & 255u) == 0u) { if (xb_ld(&(bar)[XB_TMO])) break; if (_sp > XB_SPIN_CAP) { atomicAdd(&(bar)[XB_TMO], 1u); break; } } } } while (0)
struct XcdBarrier { unsigned* bar; unsigned x; volatile LAS unsigned* st; };
__device__ __forceinline__ XcdBarrier xcd_barrier_post(unsigned* bar, volatile LAS unsigned* st) {
    XcdBarrier b; b.bar = bar; b.x = xb_xcc_id(); b.st = st;
    if (threadIdx.x == 0) (void)xb_add(&bar[XB_XCNT(b.x)], 1u);
    return b;
}
__device__ __forceinline__ void xcd_barrier_complete(unsigned* bar, unsigned x, unsigned& nloc, unsigned& nx) {
    const unsigned G = gridDim.x * gridDim.y * gridDim.z;
    unsigned sum, cnt, mine, sp = 0u;
    for (;;) {
        sum = 0u; cnt = 0u; mine = 0u;
#pragma unroll
        for (unsigned j = 0; j < 16; ++j) { const unsigned c = xb_ld(&bar[XB_XCNT(j)]); sum += c; cnt += (c > 0u) ? 1u : 0u; mine = (j == x) ? c : mine; }
        if (sum == G) break;
        __builtin_amdgcn_s_sleep(1);
        if ((++sp & 255u) == 0u) { if (xb_ld(&bar[XB_TMO])) break; if (sp > XB_SPIN_CAP) { atomicAdd(&bar[XB_TMO], 1u); break; } }
    }
    nloc = mine > 0u ? mine : 1u; nx = cnt > 0u ? cnt : 1u;
}
__device__ __forceinline__ void xcd_barrier(const XcdBarrier& b) {
    asm volatile("s_waitcnt vmcnt(0)" ::: "memory");
    __syncthreads();
    if (threadIdx.x == 0) {
        unsigned* bar = b.bar;
        __builtin_amdgcn_s_waitcnt(0);
        unsigned nloc = b.st[0], nx = b.st[1];
        if (nloc == 0u) { xcd_barrier_complete(bar, b.x, nloc, nx); b.st[0] = nloc; b.st[1] = nx; }
        const unsigned old = xb_add(&bar[XB_XSUB(b.x)], 1u);
        const unsigned gen = old / nloc;
        if (old + 1u == (gen + 1u) * nloc) {
            __builtin_amdgcn_fence(__ATOMIC_RELEASE, "agent");
            asm volatile("s_waitcnt vmcnt(0)" ::: "memory");
            const unsigned og = xb_add(&bar[XB_TOP], 1u);
            const unsigned tg = og / nx;
            if (og + 1u == (tg + 1u) * nx) xb_add(&bar[XB_TOPGEN], 1u);
            else XB_SPIN(xb_ld(&bar[XB_TOPGEN]) == tg, bar);
            __builtin_amdgcn_fence(__ATOMIC_ACQUIRE, "agent");
            xb_add(&bar[XB_XGEN(b.x)], 1u);
            asm volatile("s_waitcnt vmcnt(0)" ::: "memory");
        } else {
            XB_SPIN(xb_ld(&bar[XB_XGEN(b.x)]) == gen, bar);
            __builtin_amdgcn_fence(__ATOMIC_ACQUIRE, "agent");
            asm volatile("s_waitcnt vmcnt(0)" ::: "memory");
        }
    }
    __syncthreads();
}

namespace gm {
constexpr int BM = 256, BK = 64, HALF = 128, HTB = HALF * BK * 2, STAGE_BYTES = 8 * HTB, NXCD = 8, WGM = 8;
__device__ __forceinline__ int lds_byte(int r, int c) { const int st = (r >> 4) * 2 + (c >> 5), rr = r & 15, cc = c & 31, ob = rr * 64 + cc * 2; return st * 1024 + (ob ^ (((ob >> 9) & 1) << 5)); }
__device__ __forceinline__ void stage_rc(int b, int& R, int& C) { const int st = b / 1024, sb = b % 1024, swz = sb ^ (((sb >> 9) & 1) << 5); R = (st >> 1) * 16 + swz / 64; C = (st & 1) * 32 + (swz % 64) / 2; }
__device__ __forceinline__ int perm32(int rho) { const int n = rho >> 4, i = rho & 15; return 8 * (i >> 2) + 4 * n + (i & 3); }

struct Unit { int pm, pn, e, sub; };

__device__ __forceinline__ bool tile_order(int nM, int nN, long L, int& pm, int& pn) {
    const int nwg = nM * nN; if (L >= nwg) return false;
    int wgid = (int)L; { const int q = nwg / NXCD, r = nwg % NXCD, xcd = wgid % NXCD, off = wgid / NXCD; wgid = (xcd < r ? xcd * (q + 1) : r * (q + 1) + (xcd - r) * q) + off; }
    const int nig = WGM * nN, gid = wgid / nig, fm = gid * WGM, gsz = (nM - fm) < WGM ? (nM - fm) : WGM;
    pm = fm + ((wgid % nig) % gsz); pn = (wgid % nig) / gsz; return true;
}
struct DenseOrder {
    int nM, nN, G, c, nsub;
    __device__ __forceinline__ bool next(int i, Unit& u) const { const int ti = i / nsub; u.sub = i - ti * nsub; u.e = 0; return tile_order(nM, nN, (long)ti * G + c, u.pm, u.pn); }
};
struct MoeOrder {
    int nM, nN, G, c; const LAS int* tile_e;
    __device__ __forceinline__ bool next(int i, Unit& u) const { u.sub = 0; if (!tile_order(nM, nN, (long)i * G + c, u.pm, u.pn)) return false; u.e = tile_e[u.pm]; return true; }
};
struct DenseA { int K; unsigned sub_stride; int ES;
    __device__ __forceinline__ void offsets(const Unit& u, int tid, unsigned (&o)[2][2]) const {
#pragma unroll
        for (int i = 0; i < 2; ++i) { int R, C; stage_rc(tid * 16 + i * 8192, R, C);
#pragma unroll
            for (int h = 0; h < 2; ++h) o[h][i] = (unsigned)((u.pm * BM + h * HALF + R) * K * ES + C * 2) + (unsigned)u.sub * sub_stride; } }
    static constexpr bool GATHER = false;
    __device__ __forceinline__ const char* tok_ptr(const Unit&) const { return nullptr; }
    __device__ __forceinline__ void next_offsets(const Unit& u, int tid, unsigned (&o)[2][2], const LAS int*) const { offsets(u, tid, o); } };
struct GatherA { int K; const int* row_tok; int ES;
    __device__ __forceinline__ void offsets(const Unit& u, int tid, unsigned (&o)[2][2]) const {
#pragma unroll
        for (int i = 0; i < 2; ++i) { int R, C; stage_rc(tid * 16 + i * 8192, R, C);
#pragma unroll
            for (int h = 0; h < 2; ++h) { const int tok = row_tok[u.pm * BM + h * HALF + R]; o[h][i] = (unsigned)(tok * K * ES + C * 2); } } }
    static constexpr bool GATHER = true;
    __device__ __forceinline__ const char* tok_ptr(const Unit& u) const { return (const char*)(row_tok + u.pm * BM); }
    __device__ __forceinline__ void next_offsets(const Unit&, int tid, unsigned (&o)[2][2], const LAS int* stok) const {
#pragma unroll
        for (int i = 0; i < 2; ++i) { int R, C; stage_rc(tid * 16 + i * 8192, R, C);
#pragma unroll
            for (int h = 0; h < 2; ++h) { const int tok = stok[h * HALF + R]; o[h][i] = (unsigned)(tok * K * ES + C * 2); } } } };

template <bool FP8, class Epi, class Sched, class AMap>
__device__ __forceinline__ void gemm_phase(int wave_sg, LAS unsigned char* lds, const char* Abase, const char* Bbase, int K, int Nb, unsigned b_sub_stride, const Sched& S, const Epi& E, const AMap& AM) {
    int lane; asm volatile("v_mbcnt_lo_u32_b32 %0, -1, 0\n\tv_mbcnt_hi_u32_b32 %0, -1, %0" : "=v"(lane));
    const int wid = wave_sg, tid = wid * 64 + lane, wr = wid >> 2, wc = wid & 3, fr = lane & 15, fq = lane >> 4;
    constexpr int ES = FP8 ? 1 : 2;
    const int nt = K * ES / (BK * 2);
    unsigned voffB[2];
#pragma unroll
    for (int i = 0; i < 2; ++i) { int R, C; stage_rc(tid * 16 + i * 8192, R, C); const int Rb = (R & ~31) + perm32(R & 31); voffB[i] = (unsigned)(Rb * K * ES + C * 2); }
    const size_t kstep = (size_t)(BK * 2);
    const size_t hstep = (size_t)HALF * K * ES;
    const unsigned ldsw = (unsigned)wid * 1024u;
    const int aoff = lds_byte(wr * 64 + fr, fq * 8), boff = lds_byte(wc * 32 + fr, fq * 8);
#define G_SA(b, h) (((b) * 2 + (h)) * HTB)
#define G_SB(b, h) ((4 + (b) * 2 + (h)) * HTB)
#define G_STAGE(bufoff, gbase, voff) do { _Pragma("unroll") for (int _i = 0; _i < 2; ++_i) \
        __builtin_amdgcn_global_load_lds((const unsigned*)((const char*)(gbase) + (voff)[_i]), (LAS unsigned*)(lds + (bufoff) + ldsw + _i * 8192), 16, 0, 0); } while (0)
#define G_LDA(dst, b, h) do { _Pragma("unroll") for (int m = 0; m < 4; ++m) _Pragma("unroll") for (int k = 0; k < 2; ++k) dst[m][k] = *(const LAS bf16x8*)(lds + G_SA(b, h) + aoff + m * 2048 + k * 1024); } while (0)
#define G_LDB(dst, b, h) do { _Pragma("unroll") for (int n = 0; n < 2; ++n) _Pragma("unroll") for (int k = 0; k < 2; ++k) dst[n][k] = *(const LAS bf16x8*)(lds + G_SB(b, h) + boff + n * 2048 + k * 1024); } while (0)
#define G_MMA(ai, bj, At, Bt) do { __builtin_amdgcn_s_setprio(1); _Pragma("unroll") for (int m = 0; m < 4; ++m) _Pragma("unroll") for (int n = 0; n < 2; ++n) _Pragma("unroll") for (int k = 0; k < 2; ++k) \
        acc[ai][bj][m][n] = __builtin_amdgcn_mfma_f32_16x16x32_bf16(Bt[n][k], At[m][k], acc[ai][bj][m][n], 0, 0, 0); __builtin_amdgcn_s_setprio(0); } while (0)
#define G_LD8(dst, off) do { const u32x4 _l = *(const LAS u32x4*)(lds + (off)), _h = *(const LAS u32x4*)(lds + (off) + 1024); dst = (v8i){(int)_l.x, (int)_l.y, (int)_l.z, (int)_l.w, (int)_h.x, (int)_h.y, (int)_h.z, (int)_h.w}; } while (0)
#define G_LDA8(dst, b, h) do { _Pragma("unroll") for (int m = 0; m < 4; ++m) G_LD8(dst[m], G_SA(b, h) + aoff + m * 2048); } while (0)
#define G_LDB8(dst, b, h) do { _Pragma("unroll") for (int n = 0; n < 2; ++n) G_LD8(dst[n], G_SB(b, h) + boff + n * 2048); } while (0)
#define G_MMA8(ai, bj, At, Bt) do { __builtin_amdgcn_s_setprio(1); _Pragma("unroll") for (int m = 0; m < 4; ++m) _Pragma("unroll") for (int n = 0; n < 2; ++n) \
        acc[ai][bj][m][n] = __builtin_amdgcn_mfma_scale_f32_16x16x128_f8f6f4(Bt[n], At[m], acc[ai][bj][m][n], 0, 0, 0, 0x7F7F7F7F, 0, 0x7F7F7F7F); __builtin_amdgcn_s_setprio(0); } while (0)
#define G_PIN(ai, bj) asm volatile("" :: "v"(acc[ai][bj][0][0][0]), "v"(acc[ai][bj][0][1][0]), "v"(acc[ai][bj][1][0][0]), "v"(acc[ai][bj][1][1][0]), "v"(acc[ai][bj][2][0][0]), "v"(acc[ai][bj][2][1][0]), "v"(acc[ai][bj][3][0][0]), "v"(acc[ai][bj][3][1][0]) : "memory")
#define G_WAIT_V(n) asm volatile("s_waitcnt vmcnt(" #n ")" ::: "memory")
#define G_WAIT_L(n) asm volatile("s_waitcnt lgkmcnt(" #n ")" ::: "memory")
#define G_WAIT_VS() do { if (fi) { if (Epi::NST == 16) G_WAIT_V(24); else if (Epi::NST == 8) G_WAIT_V(16); else G_WAIT_V(8); } else G_WAIT_V(8); } while (0)
#define G_BAR __builtin_amdgcn_s_barrier()
#define G_SCHED __builtin_amdgcn_sched_barrier(0)
    Unit cur, nxt; int ui = 0;
#if MK_TPROBE
    unsigned long long tp_c = 0; const unsigned long long tp_c0 = __builtin_amdgcn_s_memtime(), tp_r0 = __builtin_amdgcn_s_memrealtime();
#endif
    if (!S.next(0, cur)) return;
#if MK_STAGGER
    {
        const unsigned long long t0 = __builtin_amdgcn_s_memrealtime(); const unsigned long long dly = (unsigned long long)(blockIdx.x & 7) * MK_STAGGER;
        while (__builtin_amdgcn_s_memrealtime() - t0 < dly) __builtin_amdgcn_s_sleep(8);
    }
#endif
    unsigned rA[2][2];
    AM.offsets(cur, tid, rA);
    const char* cB = Bbase + ((size_t)cur.e * Nb + (size_t)cur.pn * BM) * K * ES + (size_t)cur.sub * b_sub_stride;
    G_STAGE(G_SB(0, 0), cB, voffB); G_STAGE(G_SB(0, 1), cB + hstep, voffB); G_STAGE(G_SA(0, 0), Abase, rA[0]); G_STAGE(G_SA(0, 1), Abase, rA[1]);
    if (wr == 1) G_BAR;
    G_WAIT_V(2); G_BAR;
    G_STAGE(G_SB(1, 0), cB + kstep, voffB); G_STAGE(G_SA(1, 0), Abase + kstep, rA[0]); G_STAGE(G_SB(1, 1), cB + hstep + kstep, voffB);
    G_WAIT_V(6); G_BAR;
    f32x4 acc[2][2][4][2];
#pragma unroll
    for (int a = 0; a < 2; ++a)
#pragma unroll
        for (int b = 0; b < 2; ++b)
#pragma unroll
            for (int m = 0; m < 4; ++m)
#pragma unroll
                for (int n = 0; n < 2; ++n) acc[a][b][m][n] = (f32x4){0.f, 0.f, 0.f, 0.f};
    for (;;) {
        const bool has_next = S.next(ui + 1, nxt);
        const char* nB = has_next ? Bbase + ((size_t)nxt.e * Nb + (size_t)nxt.pn * BM) * K * ES + (size_t)nxt.sub * b_sub_stride : cB;
#if MK_TPROBE
        unsigned long long tp_a = 0; if (Epi::TPROBE && wid == 0) { tp_a = __builtin_amdgcn_s_memrealtime(); if (ui > 0 && lane == 0) { volatile LAS unsigned* M = (volatile LAS unsigned*)(lds + MISC_OFF); M[19] += (unsigned)(tp_a - tp_c); } }
#endif
        if (wid == 0) {
            int l16 = lane * 16; asm volatile("" : "+v"(l16));
#pragma unroll
            for (int k = 0; k < Epi::NSB; ++k) { const char* sp = E.sb_ptr(cur, k); if (l16 < 16 * E.sb_lanes(k)) __builtin_amdgcn_global_load_lds((const unsigned*)(sp + l16), (LAS unsigned*)(lds + SIDE_OFF + (ui & 1) * 4096 + 1024 * (k + 1)), 16, 0, 0); }
            if (AMap::GATHER && has_next) __builtin_amdgcn_global_load_lds((const unsigned*)(AM.tok_ptr(nxt) + l16), (LAS unsigned*)(lds + SIDE_OFF + ((ui + 1) & 1) * 4096), 16, 0, 0);
        }
#pragma nounroll
        for (int t = 0; t < nt; t += 2) {
            if constexpr (Epi::HAS_MID) { if (t == nt / 2) { int lz = lane; asm volatile("" : "+v"(lz)); E.mid(acc, cur, wr, wc, lz & 15, lz >> 4); } }
            bf16x8 At[4][2], B0[2][2], B1[2][2];
            v8i At8[4], B08[2], B18[2];
            const bool last = (t == nt - 2);
            constexpr bool fi = false;
            const char* b2 = last ? nB : cB + (size_t)(t + 2) * kstep; const char* b3 = b2 + kstep;
            if constexpr (FP8) { G_LDB8(B08, 0, 0); G_LDB8(B18, 0, 1); G_SCHED; G_LDA8(At8, 0, 0); } else { G_LDB(B0, 0, 0); G_LDB(B1, 0, 1); G_SCHED; G_LDA(At, 0, 0); }
            G_STAGE(G_SA(1, 1), Abase + (size_t)(t + 1) * kstep, rA[1]);
            G_WAIT_VS(); G_WAIT_L(0); G_BAR;
            if constexpr (FP8) { G_MMA8(0, 0, At8, B08); G_MMA8(0, 1, At8, B18); } else { G_MMA(0, 0, At, B0); G_MMA(0, 1, At, B1); }
            if constexpr (FP8) { G_PIN(0, 0); G_PIN(0, 1); }
            G_BAR; G_SCHED;
            if (last && has_next) { int tz = tid; asm volatile("" : "+v"(tz)); AM.next_offsets(nxt, tz, rA, (const LAS int*)(lds + SIDE_OFF + ((ui + 1) & 1) * 4096)); }
            const char* a2 = Abase + (last ? (size_t)0 : (size_t)(t + 2) * kstep);
            if constexpr (FP8) { G_LDA8(At8, 0, 1); } else { G_LDA(At, 0, 1); }
            G_STAGE(G_SB(0, 0), b2, voffB); G_STAGE(G_SB(0, 1), b2 + hstep, voffB); G_STAGE(G_SA(0, 0), a2, rA[0]);
            G_WAIT_VS(); G_WAIT_L(0); G_BAR;
            if constexpr (FP8) { G_MMA8(1, 0, At8, B08); G_MMA8(1, 1, At8, B18); } else { G_MMA(1, 0, At, B0); G_MMA(1, 1, At, B1); }
            if constexpr (FP8) { G_PIN(1, 0); G_PIN(1, 1); }
            G_BAR; G_SCHED;
            if constexpr (FP8) { G_LDB8(B08, 1, 0); G_LDB8(B18, 1, 1); G_SCHED; G_LDA8(At8, 1, 0); } else { G_LDB(B0, 1, 0); G_LDB(B1, 1, 1); G_SCHED; G_LDA(At, 1, 0); }
            G_STAGE(G_SA(0, 1), a2, rA[1]);
            G_WAIT_VS(); G_WAIT_L(0); G_BAR;
            if constexpr (FP8) { G_MMA8(0, 0, At8, B08); G_MMA8(0, 1, At8, B18); } else { G_MMA(0, 0, At, B0); G_MMA(0, 1, At, B1); }
            if constexpr (FP8) { G_PIN(0, 0); G_PIN(0, 1); }
            G_BAR; G_SCHED;
            if constexpr (FP8) { G_LDA8(At8, 1, 1); } else { G_LDA(At, 1, 1); }
            G_STAGE(G_SB(1, 0), b3, voffB); G_STAGE(G_SB(1, 1), b3 + hstep, voffB); G_STAGE(G_SA(1, 0), a2 + kstep, rA[0]);
            G_WAIT_VS(); G_WAIT_L(0); G_BAR;
            if constexpr (FP8) { G_MMA8(1, 0, At8, B08); G_MMA8(1, 1, At8, B18); } else { G_MMA(1, 0, At, B0); G_MMA(1, 1, At, B1); }
            if constexpr (FP8) { G_PIN(1, 0); G_PIN(1, 1); }
            G_BAR; G_SCHED;
        }
#if MK_TPROBE
        unsigned long long tp_b = 0; if (Epi::TPROBE && wid == 0) tp_b = __builtin_amdgcn_s_memrealtime();
#endif
        if (wr == 0) G_BAR;
        { int lz = lane; asm volatile("" : "+v"(lz));
          E(acc, cur, wr, wc, lz & 15, lz >> 4, (const LAS unsigned char*)(lds + SIDE_OFF + (ui & 1) * 4096 + 1024)); }
#if MK_TPROBE
        if (Epi::TPROBE && wid == 0) { tp_c = __builtin_amdgcn_s_memrealtime(); if (lane == 0) { volatile LAS unsigned* M = (volatile LAS unsigned*)(lds + MISC_OFF); M[16] += (unsigned)(tp_b - tp_a); M[17] += (unsigned)(tp_c - tp_b); M[18] += 1u; } }
#endif
        if (!has_next) break;
        if (!E.keep(cur)) {
#pragma unroll
            for (int a = 0; a < 2; ++a)
#pragma unroll
                for (int b = 0; b < 2; ++b)
#pragma unroll
                    for (int m = 0; m < 4; ++m)
#pragma unroll
                        for (int n = 0; n < 2; ++n) acc[a][b][m][n] = (f32x4){0.f, 0.f, 0.f, 0.f};
        }
        cur = nxt; cB = nB; ++ui;
        if (wr == 1) G_BAR;
    }
    G_WAIT_V(0);
    G_BAR;
#if MK_TPROBE
    if constexpr (Epi::TPROBE) if (wid == 0) { volatile LAS unsigned* M = (volatile LAS unsigned*)(lds + MISC_OFF);
        const unsigned long long t0 = __builtin_amdgcn_s_memrealtime();
        const unsigned long long d = MK_TPROBE == 4 ? 10000ull * (__builtin_amdgcn_s_memtime() - tp_c0) / (t0 - tp_r0)
                                   : 4ull * (unsigned long long)(MK_TPROBE == 1 ? M[16] : MK_TPROBE == 2 ? M[17] : M[19]);
        while (__builtin_amdgcn_s_memrealtime() - t0 < d) __builtin_amdgcn_s_sleep(8); }
#endif
#undef G_SA
#undef G_SB
#undef G_STAGE
#undef G_LDA
#undef G_LDB
#undef G_MMA
#undef G_LD8
#undef G_LDA8
#undef G_LDB8
#undef G_MMA8
#undef G_WAIT_V
#undef G_PIN
#undef G_WAIT_VS
#undef G_WAIT_L
#undef G_BAR
#undef G_SCHED
}

__device__ __forceinline__ u32x4 pack8(const f32x4& v0, const f32x4& v1) { u32x4 w; w.x = cvt_pk_bf16(v0[0], v0[1]); w.y = cvt_pk_bf16(v0[2], v0[3]); w.z = cvt_pk_bf16(v1[0], v1[1]); w.w = cvt_pk_bf16(v1[2], v1[3]); return w; }
__device__ __forceinline__ void unpack8(const u32x4& w, f32x4& v0, f32x4& v1) { v0 = (f32x4){bf_lo(w.x), bf_hi(w.x), bf_lo(w.y), bf_hi(w.y)}; v1 = (f32x4){bf_lo(w.z), bf_hi(w.z), bf_lo(w.w), bf_hi(w.w)}; }

struct EpiProj {
    static constexpr bool HAS_MID = false;
    static constexpr float PSC = MK_P2FP8 ? (1.0f / 32.0f) : 1.0f;
    bf16_t* proj; bf16_t* gates; const float* lb;
    static constexpr int NSB = 0, NST = 16; static constexpr bool TPROBE = true;
    __device__ __forceinline__ const char* sb_ptr(const Unit&, int) const { return nullptr; }
    __device__ __forceinline__ int sb_lanes(int) const { return 0; }
    __device__ __forceinline__ bool keep(const Unit&) const { return false; }
    __device__ __forceinline__ void operator()(f32x4 (&acc)[2][2][4][2], const Unit& u, int wr, int wc, int fr, int fq, const LAS unsigned char* side) const {
        const int row0 = u.pm * BM + wr * 64 + fr, pn = u.pn;
        if (pn >= 10) {
            const bool isg = pn >= 14; const int q = isg ? pn - 14 : pn - 10; const int c0 = q * HALF + wc * 32 + 8 * fq;
#pragma unroll
            for (int ai = 0; ai < 2; ++ai)
#pragma unroll
                for (int m = 0; m < 4; ++m) { const size_t r = (size_t)(row0 + ai * HALF + m * 16);
                    f32x4 a0 = acc[ai][0][m][0] * PSC, a1 = acc[ai][0][m][1] * PSC, b0 = acc[ai][1][m][0] * PSC, b1 = acc[ai][1][m][1] * PSC;
                    if (isg) {
#pragma unroll
                        for (int j = 0; j < 4; ++j) { b0[j] = sigmoidf_(b0[j]); b1[j] = sigmoidf_(b1[j]); a0[j] = sigmoidf_(a0[j]) * fast_rcp(fmaxf(b0[j], 1e-30f)); a1[j] = sigmoidf_(a1[j]) * fast_rcp(fmaxf(b1[j], 1e-30f)); }
                        *(u32x4*)(gates + r * GATE_LD + c0) = pack8(a0, a1); *(u32x4*)(gates + r * GATE_LD + 1024 + c0) = pack8(b0, b1);
                    } else {
                        *(u32x4*)(proj + r * PROJ_LD + 2560 + c0) = pack8(a0 * b0, a1 * b1);
                    } }
            return;
        }
        bf16_t* base = proj; const int ldc = PROJ_LD, colt = pn * BM, kind = (pn == 2 || pn == 3) ? 1 : 0;
        const int col0 = colt + wc * 32 + 8 * fq;
        f32x4 lbv[2][2];
        if (kind == 1) {
#pragma unroll
            for (int bj = 0; bj < 2; ++bj) { const float* lp = lb + (pn - 2) * BM + bj * HALF + wc * 32 + 8 * fq; lbv[bj][0] = *(const f32x4*)lp; lbv[bj][1] = *(const f32x4*)(lp + 4); }
        }
#pragma unroll
        for (int ai = 0; ai < 2; ++ai)
#pragma unroll
            for (int m = 0; m < 4; ++m) { bf16_t* rowp = base + (size_t)(row0 + ai * HALF + m * 16) * ldc + col0;
#pragma unroll
                for (int bj = 0; bj < 2; ++bj) { f32x4 v0 = acc[ai][bj][m][0] * PSC, v1 = acc[ai][bj][m][1] * PSC;
                    if (kind == 1) {
#pragma unroll
                        for (int j = 0; j < 4; ++j) { const float l0 = lbv[bj][0][j], l1 = lbv[bj][1][j];
                            v0[j] = fast_log(l0 + (1.0f - l0) * sigmoidf_(v0[j])); v1[j] = fast_log(l1 + (1.0f - l1) * sigmoidf_(v1[j])); }
                    }
                    *(u32x4*)(rowp + bj * HALF) = pack8(v0, v1); } }
    }
};
struct EpiMerge {
    static constexpr bool HAS_MID = true;
    const bf16_t* gates; bf16_t* out;
    static constexpr int NSB = 0, NST = 0; static constexpr bool TPROBE = false;
    __device__ __forceinline__ const char* sb_ptr(const Unit&, int) const { return nullptr; }
    __device__ __forceinline__ int sb_lanes(int) const { return 0; }
    __device__ __forceinline__ bool keep(const Unit&) const { return false; }
    __device__ __forceinline__ void mid(f32x4 (&acc)[2][2][4][2], const Unit& u, int wr, int wc, int fr, int fq) const {
        const int row0 = u.pm * BM + wr * 64 + fr, col0 = u.pn * BM + wc * 32 + 8 * fq;
#pragma unroll
        for (int ai = 0; ai < 2; ++ai) {
            u32x4 ga[4][2];
#pragma unroll
            for (int m = 0; m < 4; ++m) { const bf16_t* gp = gates + (size_t)(row0 + ai * HALF + m * 16) * GATE_LD + col0;
#pragma unroll
                for (int bj = 0; bj < 2; ++bj) ga[m][bj] = *(const u32x4*)(gp + bj * HALF); }
#pragma unroll
            for (int m = 0; m < 4; ++m)
#pragma unroll
                for (int bj = 0; bj < 2; ++bj) { f32x4 a0, a1; unpack8(ga[m][bj], a0, a1); acc[ai][bj][m][0] *= a0; acc[ai][bj][m][1] *= a1; }
            asm volatile("" ::: "memory"); }
    }
    __device__ __forceinline__ void operator()(f32x4 (&acc)[2][2][4][2], const Unit& u, int wr, int wc, int fr, int fq, const LAS unsigned char* side) const {
        const int row0 = u.pm * BM + wr * 64 + fr, col0 = u.pn * BM + wc * 32 + 8 * fq;
#pragma unroll
        for (int ai = 0; ai < 2; ++ai) {
            u32x4 gb[4][2];
#pragma unroll
            for (int m = 0; m < 4; ++m) { const bf16_t* gp = gates + (size_t)(row0 + ai * HALF + m * 16) * GATE_LD + col0;
#pragma unroll
                for (int bj = 0; bj < 2; ++bj) gb[m][bj] = *(const u32x4*)(gp + 1024 + bj * HALF); }
#pragma unroll
            for (int m = 0; m < 4; ++m) { const size_t r = (size_t)(row0 + ai * HALF + m * 16);
#pragma unroll
                for (int bj = 0; bj < 2; ++bj) { f32x4 b0, b1; unpack8(gb[m][bj], b0, b1); *(u32x4*)(out + r * D + col0 + bj * HALF) = pack8(acc[ai][bj][m][0] * b0, acc[ai][bj][m][1] * b1); } }
            asm volatile("" ::: "memory"); }
    }
};
struct EpiMix {
    static constexpr bool HAS_MID = false;
    const float* x; const float* mod; bf16_t* h;
    static constexpr int NSB = 0, NST = 0; static constexpr bool TPROBE = false;
    __device__ __forceinline__ const char* sb_ptr(const Unit&, int) const { return nullptr; }
    __device__ __forceinline__ int sb_lanes(int) const { return 0; }
    __device__ __forceinline__ bool keep(const Unit&) const { return false; }
    __device__ __forceinline__ void operator()(f32x4 (&acc)[2][2][4][2], const Unit& u, int wr, int wc, int fr, int fq, const LAS unsigned char* side) const {
        const int row0 = u.pm * BM + wr * 64 + fr, col0 = u.pn * BM + wc * 32 + 8 * fq, b = u.pm >> 3;
        f32x4 g[2][2];
#pragma unroll
        for (int bj = 0; bj < 2; ++bj) { const float* gp = mod + (size_t)b * 6144 + 2048 + col0 + bj * HALF; g[bj][0] = *(const f32x4*)gp; g[bj][1] = *(const f32x4*)(gp + 4); }
#pragma unroll
        for (int ai = 0; ai < 2; ++ai) {
            f32x4 xv[4][2][2];
#pragma unroll
            for (int m = 0; m < 4; ++m)
#pragma unroll
                for (int bj = 0; bj < 2; ++bj) { const float* xp = x + (size_t)(row0 + ai * HALF + m * 16) * D + col0 + bj * HALF; xv[m][bj][0] = *(const f32x4*)xp; xv[m][bj][1] = *(const f32x4*)(xp + 4); }
#pragma unroll
            for (int m = 0; m < 4; ++m) { const size_t r = (size_t)(row0 + ai * HALF + m * 16);
#pragma unroll
                for (int bj = 0; bj < 2; ++bj) *(u32x4*)(h + r * D + col0 + bj * HALF) = pack8(xv[m][bj][0] + g[bj][0] * acc[ai][bj][m][0], xv[m][bj][1] + g[bj][1] * acc[ai][bj][m][1]); }
            asm volatile("" ::: "memory"); }
    }
};
struct EpiSwiglu {
    static constexpr bool HAS_MID = false;
    static constexpr float WSC = 1.0f / 32.0f;
    const float* b1; unsigned char* act; unsigned* tpw;
    __device__ __forceinline__ unsigned* tp_words() const { return tpw; }
    static constexpr bool TPROBE = false;
    static constexpr int NSB = 2, NST = 8;
    __device__ __forceinline__ const char* sb_ptr(const Unit& u, int k) const { return (const char*)(b1 + (size_t)u.e * 2048 + k * 1024 + u.pn * HALF); }
    __device__ __forceinline__ int sb_lanes(int) const { return 32; }
    __device__ __forceinline__ bool keep(const Unit&) const { return false; }
    __device__ __forceinline__ void operator()(f32x4 (&acc)[2][2][4][2], const Unit& u, int wr, int wc, int fr, int fq, const LAS unsigned char* side) const {
        const int row0 = u.pm * BM + wr * 64 + fr, hc0 = u.pn * HALF + wc * 32 + 8 * fq;
        const LAS float* bp = (const LAS float*)side + wc * 32 + 8 * fq;
        const f32x4 bg0 = *(const LAS f32x4*)bp, bg1 = *(const LAS f32x4*)(bp + 4), bl0 = *(const LAS f32x4*)(bp + 256), bl1 = *(const LAS f32x4*)(bp + 260);
#pragma unroll
        for (int ai = 0; ai < 2; ++ai)
#pragma unroll
            for (int m = 0; m < 4; ++m) { const size_t r = (size_t)(row0 + ai * HALF + m * 16);
                f32x4 o0, o1;
#pragma unroll
                for (int j = 0; j < 4; ++j) {
                    float gl = fminf(acc[ai][0][m][0][j] * WSC + bg0[j], SW_LIMIT), li = fminf(fmaxf(acc[ai][1][m][0][j] * WSC + bl0[j], -SW_LIMIT), SW_LIMIT);
                    o0[j] = gl * sigmoidf_(SW_ALPHA * gl) * (li + 1.0f);
                    gl = fminf(acc[ai][0][m][1][j] * WSC + bg1[j], SW_LIMIT); li = fminf(fmaxf(acc[ai][1][m][1][j] * WSC + bl1[j], -SW_LIMIT), SW_LIMIT);
                    o1[j] = gl * sigmoidf_(SW_ALPHA * gl) * (li + 1.0f); }
                *(u32x2*)(act + r * DFF + hc0) = (u32x2){pk4_fp8_nc(o0[0], o0[1], o0[2], o0[3]), pk4_fp8_nc(o1[0], o1[1], o1[2], o1[3])}; }
    }
};
struct EpiMoeOut {
    static constexpr bool HAS_MID = false;
    const float* b2; const float* rw; unsigned char* ya;
    static constexpr bool TPROBE = false;
    static constexpr int NSB = 2, NST = 16;
    __device__ __forceinline__ const char* sb_ptr(const Unit& u, int k) const { return k == 0 ? (const char*)(b2 + (size_t)u.e * D + u.pn * BM) : (const char*)(rw + u.pm * BM); }
    __device__ __forceinline__ int sb_lanes(int) const { return 64; }
    __device__ __forceinline__ bool keep(const Unit&) const { return false; }
    __device__ __forceinline__ void operator()(f32x4 (&acc)[2][2][4][2], const Unit& u, int wr, int wc, int fr, int fq, const LAS unsigned char* side) const {
        const int lrow0 = wr * 64 + fr, col0 = u.pn * BM + wc * 32 + 8 * fq, row_t = u.pm * BM;
        unsigned char* tbase = ya + (size_t)row_t * D + col0;
        const LAS float* sb = (const LAS float*)side; const LAS float* srw = (const LAS float*)(side + 1024);
        f32x4 bv[2][2];
#pragma unroll
        for (int bj = 0; bj < 2; ++bj) { const LAS float* bp = sb + bj * HALF + wc * 32 + 8 * fq; bv[bj][0] = *(const LAS f32x4*)bp; bv[bj][1] = *(const LAS f32x4*)(bp + 4); }
#pragma unroll
        for (int ai = 0; ai < 2; ++ai)
#pragma unroll
            for (int m = 0; m < 4; ++m) { const int lr = lrow0 + ai * HALF + m * 16; const float w = srw[lr]; unsigned char* dst = tbase + (size_t)lr * D;
#pragma unroll
                for (int bj = 0; bj < 2; ++bj) { const f32x4 o0 = (acc[ai][bj][m][0] * (1.0f / 32.0f) + bv[bj][0]) * w, o1 = (acc[ai][bj][m][1] * (1.0f / 32.0f) + bv[bj][1]) * w;
                    *(u32x2*)(dst + bj * HALF) = (u32x2){pk4_fp8(o0[0], o0[1], o0[2], o0[3]), pk4_fp8(o1[0], o1[1], o1[2], o1[3])}; } }
    }
};
}

struct Args { const float* in[20]; float* out; unsigned char* ws; int ph_lo, ph_hi; };

__device__ __forceinline__ void transpose_item(const float* W, int N, bf16_t* WT, int ldwt, int k0, int n0, int dst_row0, LAS float* scr, int lane) {
    const int ks = lane >> 4, n4 = (lane & 15) * 4;
    f32x4 v[16];
#pragma unroll
    for (int i = 0; i < 16; ++i) v[i] = *(const f32x4*)(W + (size_t)(k0 + 4 * i + ks) * N + n0 + n4);
#pragma unroll
    for (int i = 0; i < 16; ++i) { LAS float* s = scr + (4 * i + ks) * 65 + n4; s[0] = v[i][0]; s[1] = v[i][1]; s[2] = v[i][2]; s[3] = v[i][3]; }
    LDS_WAIT(); asm volatile("" ::: "memory");
    const int kc = lane & 7;
#pragma unroll
    for (int p = 0; p < 8; ++p) { const int n = (lane >> 3) + 8 * p; const LAS float* s = scr + (8 * kc) * 65 + n;
        u32x4 o; o.x = cvt_pk_bf16(s[0], s[65]); o.y = cvt_pk_bf16(s[2 * 65], s[3 * 65]); o.z = cvt_pk_bf16(s[4 * 65], s[5 * 65]); o.w = cvt_pk_bf16(s[6 * 65], s[7 * 65]);
        *(u32x4*)(WT + (size_t)(dst_row0 + n) * ldwt + k0 + 8 * kc) = o; }
    LDS_WAIT(); asm volatile("" ::: "memory");
}

__device__ __forceinline__ void transpose_item_fp8(const float* W, int N, unsigned char* WT, int ldwt, int k0, int n0, int dst_row0, LAS float* scr, int lane) {
    const int ks = lane >> 3, n4 = (lane & 7) * 4;
    f32x4 v[16];
#pragma unroll
    for (int i = 0; i < 16; ++i) v[i] = *(const f32x4*)(W + (size_t)(k0 + 8 * i + ks) * N + n0 + n4);
#pragma unroll
    for (int i = 0; i < 16; ++i) { LAS float* s = scr + (8 * i + ks) * 33 + n4; s[0] = v[i][0]; s[1] = v[i][1]; s[2] = v[i][2]; s[3] = v[i][3]; }
    LDS_WAIT(); asm volatile("" ::: "memory");
    const int kc = lane & 7;
#pragma unroll
    for (int p = 0; p < 4; ++p) { const int n = (lane >> 3) + 8 * p; const LAS float* s = scr + (16 * kc) * 33 + n;
        u32x4 o;
        o.x = pk4_fp8(32.f * s[0], 32.f * s[33], 32.f * s[2 * 33], 32.f * s[3 * 33]); o.y = pk4_fp8(32.f * s[4 * 33], 32.f * s[5 * 33], 32.f * s[6 * 33], 32.f * s[7 * 33]);
        o.z = pk4_fp8(32.f * s[8 * 33], 32.f * s[9 * 33], 32.f * s[10 * 33], 32.f * s[11 * 33]); o.w = pk4_fp8(32.f * s[12 * 33], 32.f * s[13 * 33], 32.f * s[14 * 33], 32.f * s[15 * 33]);
        *(u32x4*)(WT + (size_t)(dst_row0 + n) * ldwt + k0 + 16 * kc) = o; }
    LDS_WAIT(); asm volatile("" ::: "memory");
}

__global__ void __launch_bounds__(NTHREADS, 2) fwd_kernel(Args args) {
    extern __shared__ __attribute__((aligned(16))) unsigned char lds_raw[];
    LAS unsigned char* lds = (LAS unsigned char*)lds_raw;
    volatile LAS unsigned* MISC = (volatile LAS unsigned*)(lds + MISC_OFF);
    const int G = gridDim.x, bid = blockIdx.x;
    const int wave_sg = __builtin_amdgcn_readfirstlane((int)threadIdx.x >> 6);
#define PHASE_IDS() int lane; asm volatile("v_mbcnt_lo_u32_b32 %0, -1, 0\n\tv_mbcnt_hi_u32_b32 %0, -1, %0" : "=v"(lane)); const int wave = wave_sg; const int tid = wave * 64 + lane; const int gw = bid * NWAVES + wave, NGW = G * NWAVES; (void)lane; (void)wave; (void)gw; (void)NGW
#define CAS __attribute__((address_space(4)))
#define PHASE_ARGS() const CAS Args* ap = (const CAS Args*)__builtin_amdgcn_kernarg_segment_ptr(); asm volatile("" : "+s"(ap)); unsigned char* const ws = ap->ws; unsigned* const ctl = (unsigned*)(ws + WS_CTL); (void)ctl
#define ARG(i) (ap->in[i])
#define WSP(T, off) ((T*)(ws + (off)))
    enum { I_X = 0, I_C, I_WADA, I_BADA, I_NMIX, I_WIN, I_LBT, I_HGNW, I_CONVW, I_WHG, I_WCV, I_WMIX, I_NFFN, I_WR, I_BR, I_W1, I_B1, I_W2, I_B2, I_NFIN };
    { PHASE_IDS(); for (int u = tid; u < 64; u += NTHREADS) MISC[u] = 0u; }
    __syncthreads();
    XcdBarrier bar; bar.bar = nullptr; bar.x = 0; bar.st = nullptr;
#if MK_ONE_LAUNCH
    { PHASE_ARGS(); bar = xcd_barrier_post(ctl + CW_BAR, MISC + 8); }
#define GRID_BAR() xcd_barrier(bar)
#else
#define GRID_BAR() do { } while (0)
#endif
    const int lo = args.ph_lo, hi = args.ph_hi;
#if MK_PHT
    const unsigned long long pht0 = __builtin_amdgcn_s_memrealtime(); unsigned long long phtk = 0;
#endif
#ifndef PH_MASK
#define PH_MASK 0x7ff
#endif
#define IN(k) (((PH_MASK >> (k)) & 1) && lo <= (k) && (k) < hi)
#define BOTH(k) (IN(k) && IN((k) + 1))

    if (IN(0)) for (int rep_ = 0; rep_ < 1 + ((MK_REPEAT >> 0) & 1); ++rep_) { PHASE_IDS(); PHASE_ARGS();
        const float* cvec = ARG(I_C); const float* w_ada = ARG(I_WADA); const float* b_ada = ARG(I_BADA); const float* lbtab = ARG(I_LBT);
        const float* w_in = ARG(I_WIN); const float* w_hg = ARG(I_WHG); const float* w_cv = ARG(I_WCV); const float* w_mix = ARG(I_WMIX); const float* w1 = ARG(I_W1); const float* w2 = ARG(I_W2);
        float* MOD = WSP(float, WS_MOD); float* LB = WSP(float, WS_LB);
        bf16_t* Win_t = WSP(bf16_t, WS_WIN); bf16_t* Whg_t = WSP(bf16_t, WS_WHG); bf16_t* Wcv_t = WSP(bf16_t, WS_WHG) + 512;        bf16_t* Wmix_t = WSP(bf16_t, WS_WMIX); unsigned char* W1_t = WSP(unsigned char, WS_W1); unsigned char* W2_t = WSP(unsigned char, WS_W2);
        LAS float* scr = (LAS float*)(lds + wave * 16896);
        for (int it = gw; it < 384; it += NGW) {
            const int n0 = it * 16, cl = lane & 15, kq = lane >> 4;
            float acc[32];
#pragma unroll
            for (int b = 0; b < 32; ++b) acc[b] = 0.f;
            for (int ch = 0; ch < 16; ++ch) {
                { const int b = lane >> 1, part = lane & 1;
#pragma unroll
                    for (int q = 0; q < 4; ++q) {
                        const float* cp = cvec + (size_t)b * D + q * 256 + ch * 16 + part * 8;
                        const f32x4 c0 = *(const f32x4*)cp, c1 = *(const f32x4*)(cp + 4);
#pragma unroll
                        for (int j = 0; j < 4; ++j) { scr[(q * 16 + part * 8 + j) * 32 + b] = c0[j] * sigmoidf_(c0[j]); scr[(q * 16 + part * 8 + 4 + j) * 32 + b] = c1[j] * sigmoidf_(c1[j]); }
                    } }
                float wv[16];
#pragma unroll
                for (int kk = 0; kk < 16; ++kk) wv[kk] = w_ada[(size_t)(kq * 256 + ch * 16 + kk) * 6144 + n0 + cl];
                LDS_WAIT(); asm volatile("" ::: "memory");
#pragma unroll
                for (int kk = 0; kk < 16; ++kk) {
                    const LAS f32x4* sp = (const LAS f32x4*)(scr + (kq * 16 + kk) * 32);
#pragma unroll
                    for (int b4 = 0; b4 < 8; ++b4) { const f32x4 s = sp[b4]; acc[4 * b4] += wv[kk] * s[0]; acc[4 * b4 + 1] += wv[kk] * s[1]; acc[4 * b4 + 2] += wv[kk] * s[2]; acc[4 * b4 + 3] += wv[kk] * s[3]; }
                }
                LDS_WAIT(); asm volatile("" ::: "memory");
            }
            const float bias = b_ada[n0 + cl];
#pragma unroll
            for (int b = 0; b < 32; ++b) { float v = acc[b]; v += __shfl_xor(v, 16); v += __shfl_xor(v, 32); if (kq == 0) MOD[(size_t)b * 6144 + n0 + cl] = v + bias; }
        }
        if (bid == (G > 1 ? 1 : 0)) { const int k = tid; const float l0 = lbtab[k], l1 = lbtab[HW + k]; LB[k] = fast_rcp(1.0f + fast_exp(l1 - l0)); }
        {
            constexpr int I_IN = 16 * 88, I_HG = 8 * 16, I_CV = 8 * 16, I_MIX = 16 * 16, I_W1 = 32 * 8 * 64, I_W2 = 32 * 8 * 32;
            constexpr int NITEMS = I_IN + I_HG + I_CV + I_MIX + I_W1 + I_W2;
            for (int it = gw; it < NITEMS; it += NGW) {
                int r = it;
#if MK_P2FP8
                if (r < I_IN) { const int kb = r / 176, nb = r % 176; transpose_item_fp8(w_in, INC, (unsigned char*)Win_t, D, kb * 128, nb * 32, nb * 32, scr, lane); continue; } r -= I_IN;
#else
                if (r < I_IN) { const int kb = r / 88, nb = r % 88; const int pn = nb >> 2, wi = (nb & 3) * 64;
                    const int src = pn < 10 ? nb * 64 : pn < 14 ? (wi < 128 ? 2560 + (pn - 10) * 128 + wi : 3072 + (pn - 10) * 128 + (wi - 128)) : (wi < 128 ? 3584 + (pn - 14) * 128 + wi : 4608 + (pn - 14) * 128 + (wi - 128));
                    transpose_item(w_in, INC, Win_t, D, kb * 64, src, nb * 64, scr, lane); continue; } r -= I_IN;
#endif
                if (r < I_HG) { const int kb = r / 16, nb = r % 16; transpose_item(w_hg, D, Whg_t, D, kb * 64, nb * 64, nb * 64, scr, lane); continue; } r -= I_HG;
                if (r < I_CV) { const int kb = r / 16, nb = r % 16; transpose_item(w_cv, D, Wcv_t, D, kb * 64, nb * 64, nb * 64, scr, lane); continue; } r -= I_CV;
                if (r < I_MIX) { const int kb = r / 16, nb = r % 16; transpose_item(w_mix, D, Wmix_t, D, kb * 64, nb * 64, nb * 64, scr, lane); continue; } r -= I_MIX;
                if (r < I_W1) { const int e = r / 512, q = r % 512, kb = q / 64, nb = q % 64;
                    const int pn = nb >> 3, wi = (nb & 7) * 32; const int src = wi < 128 ? pn * 128 + wi : 1024 + pn * 128 + (wi - 128);
                    transpose_item_fp8(w1 + (size_t)e * D * 2048, 2048, W1_t + (size_t)e * 2048 * D, D, kb * 128, src, nb * 32, scr, lane); continue; } r -= I_W1;
                { const int e = r / 256, q = r % 256, kb = q / 32, nb = q % 32;
                    transpose_item_fp8(w2 + (size_t)e * DFF * D, D, W2_t + (size_t)e * D * DFF, DFF, kb * 128, nb * 32, nb * 32, scr, lane); }
            }
        }
        if (BOTH(0)) GRID_BAR();
#if MK_PHT
        if (MK_PHT == 1) phtk = __builtin_amdgcn_s_memrealtime() - pht0;
#endif
    }

    if (IN(1)) for (int rep_ = 0; rep_ < 1 + ((MK_REPEAT >> 1) & 1); ++rep_) { PHASE_IDS(); PHASE_ARGS();
        const float* x = ARG(I_X); const float* norm_mix_w = ARG(I_NMIX); const float* MOD = WSP(float, WS_MOD); bf16_t* U = WSP(bf16_t, WS_U);
        for (int m0 = gw * 32; m0 < NTOK; m0 += NGW * 32) {
            const int b = m0 >> 11;
            f32x4 A[4], Sh[4];
#pragma unroll
            for (int j = 0; j < 4; ++j) { const int k = 4 * lane + 256 * j; const f32x4 w = *(const f32x4*)(norm_mix_w + k), sc = *(const f32x4*)(MOD + (size_t)b * 6144 + 1024 + k);
                A[j] = w * (sc + 1.0f); Sh[j] = *(const f32x4*)(MOD + (size_t)b * 6144 + k); }
            for (int r = 0; r < 32; r += 4) {
                f32x4 v[4][4]; float ss[4];
#pragma unroll
                for (int q = 0; q < 4; ++q) { const float* xr = x + (size_t)(m0 + r + q) * D; ss[q] = 0.f;
#pragma unroll
                    for (int j = 0; j < 4; ++j) v[q][j] = *(const f32x4*)(xr + 4 * lane + 256 * j); }
#pragma unroll
                for (int q = 0; q < 4; ++q) {
#pragma unroll
                    for (int j = 0; j < 4; ++j) ss[q] += (v[q][j][0] * v[q][j][0] + v[q][j][1] * v[q][j][1]) + (v[q][j][2] * v[q][j][2] + v[q][j][3] * v[q][j][3]);
                    const float rs = __builtin_amdgcn_rsqf(wave_sum(ss[q]) * (1.0f / D) + EPS);
#if MK_P2FP8
                    unsigned char* ur = (unsigned char*)U + (size_t)(m0 + r + q) * D;
#pragma unroll
                    for (int j = 0; j < 4; ++j) { const f32x4 o = v[q][j] * rs * A[j] + Sh[j]; *(unsigned*)(ur + 4 * lane + 256 * j) = pk4_fp8(o[0], o[1], o[2], o[3]); }
#else
                    bf16_t* ur = U + (size_t)(m0 + r + q) * D;
#pragma unroll
                    for (int j = 0; j < 4; ++j) { const f32x4 o = v[q][j] * rs * A[j] + Sh[j]; u32x2 w; w.x = cvt_pk_bf16(o[0], o[1]); w.y = cvt_pk_bf16(o[2], o[3]); *(u32x2*)(ur + 4 * lane + 256 * j) = w; }
#endif
                }
            }
        }
        if (BOTH(1)) GRID_BAR();
#if MK_PHT
        if (MK_PHT == 2) phtk = __builtin_amdgcn_s_memrealtime() - pht0;
#endif
    }

    if (IN(2)) for (int rep_ = 0; rep_ < 1 + ((MK_REPEAT >> 2) & 1); ++rep_) { PHASE_ARGS();
        gm::DenseOrder S{NTOK / 256, INC / 256, G, bid, 1}; gm::DenseA AM{D, 0u, MK_P2FP8 ? 1 : 2}; gm::EpiProj E{WSP(bf16_t, WS_PROJ), (bf16_t*)ap->out, WSP(float, WS_LB)};
        gm::gemm_phase<(MK_P2FP8 != 0)>(wave_sg, lds, (const char*)WSP(bf16_t, WS_U), (const char*)WSP(bf16_t, WS_WIN), D, 0, 0u, S, E, AM);
        if (BOTH(2)) GRID_BAR();
#if MK_PHT
        if (MK_PHT == 3) phtk = __builtin_amdgcn_s_memrealtime() - pht0;
#endif
    }

    if (IN(3)) for (int rep_ = 0; rep_ < 1 + ((MK_REPEAT >> 3) & 1); ++rep_) { PHASE_IDS(); PHASE_ARGS();
        const float* hg_norm_w = ARG(I_HGNW); const float* conv_w = ARG(I_CONVW); const bf16_t* PROJ = WSP(bf16_t, WS_PROJ); bf16_t* OB = WSP(bf16_t, WS_O); bf16_t* CVB = WSP(bf16_t, WS_O) + 512;
        const int nchainblk = (G >= 256) ? 128 : (G >= 2 ? G / 2 : 1);
        if (bid < nchainblk) {
            constexpr int LDQ = 136, LDT = 72;
            LAS bf16_t* QT = (LAS bf16_t*)(lds);
            LAS bf16_t* KT = QT + 64 * LDQ;
            LAS bf16_t* QB = KT + 64 * LDQ;
            LAS bf16_t* KBT = QB + 64 * LDQ;
            LAS bf16_t* VT = KBT + 128 * LDT;
            LAS bf16_t* PM = VT + 128 * LDT;
            LAS bf16_t* ST = PM + 64 * LDT;
            LAS bf16_t* OS = ST + 128 * LDQ;
            LAS float* SEG = (LAS float*)(OS + 64 * LDQ);
            LAS float* DEC = SEG + 8 * 128;
            const int fr = lane & 15, fq = lane >> 4, w = wave;
            for (int chain = bid; chain < BATCH * NHEAD; chain += nchainblk) {
                const int b = chain >> 2, h = chain & 3;
                __syncthreads();
                for (int i = tid; i < 128 * LDQ / 2; i += NTHREADS) ((LAS unsigned*)ST)[i] = 0u;
                f32x4 Sacc[8];
#pragma unroll
                for (int i = 0; i < 8; ++i) Sacc[i] = (f32x4){0.f, 0.f, 0.f, 0.f};
                const int ot = tid >> 3, ocg = tid & 7;
                f32x4 nwv[4];
#pragma unroll
                for (int q = 0; q < 2; ++q) { nwv[2 * q] = *(const f32x4*)(hg_norm_w + q * 64 + 8 * ocg); nwv[2 * q + 1] = *(const f32x4*)(hg_norm_w + q * 64 + 8 * ocg + 4); }
                const bf16_t* pbase = PROJ + (size_t)(b * SEQ) * PROJ_LD + h * DK;
                unsigned rq[8], rl[8], rv[8];
#pragma unroll
                for (int r = 0; r < 8; ++r) { const bf16_t* p = pbase + (size_t)(8 * w + r) * PROJ_LD + 2 * lane; rq[r] = *(const unsigned*)p; rl[r] = *(const unsigned*)(p + 512); rv[r] = *(const unsigned*)(p + 1024); }
                for (int c = 0; c < NCHUNK; ++c) {
                    const int m0 = c * CHUNK;
                    float cs0[8], cs1[8]; { float a0 = 0.f, a1 = 0.f;
#pragma unroll
                        for (int r = 0; r < 8; ++r) { a0 += bf_lo(rl[r]); a1 += bf_hi(rl[r]); cs0[r] = a0; cs1[r] = a1; }
                        *(LAS f32x2*)(SEG + w * 128 + 2 * lane) = (f32x2){a0, a1}; }
                    LDS_WAIT(); __syncthreads();
                    float pre0 = 0.f, pre1 = 0.f, bm0 = 0.f, bm1 = 0.f, bl0 = 0.f, bl1 = 0.f;
#pragma unroll
                    for (int s = 0; s < 8; ++s) { const f32x2 t2 = *(const LAS f32x2*)(SEG + s * 128 + 2 * lane); if (s < w) { pre0 += t2[0]; pre1 += t2[1]; } if (s < 4) { bm0 += t2[0]; bm1 += t2[1]; } bl0 += t2[0]; bl1 += t2[1]; }
                    const float em0 = fast_exp(fmaxf(bm0, -80.f)), em1 = fast_exp(fmaxf(bm1, -80.f));
                    const float el0 = fast_exp(fmaxf(bl0 - bm0, -80.f)), el1 = fast_exp(fmaxf(bl1 - bm1, -80.f));
                    if (w == 0) *(LAS f32x2*)(DEC + 2 * lane) = (f32x2){fast_exp(fmaxf(bl0, -80.f)), fast_exp(fmaxf(bl1, -80.f))};
                    unsigned kb0[4], kb1[4], vt0[4], vt1[4];
#pragma unroll
                    for (int r = 0; r < 8; ++r) {
                        const int t = 8 * w + r;
                        const float lf0 = bf_lo(rl[r]), lf1 = bf_hi(rl[r]);
                        const float d0 = fminf(fmaxf(pre0 + cs0[r] - bm0, -80.f), 80.f), d1 = fminf(fmaxf(pre1 + cs1[r] - bm1, -80.f), 80.f);
                        const float e0 = fast_exp(d0), e1 = fast_exp(d1), i0 = fast_exp(-d0), i1 = fast_exp(-d1);
                        const float kk0 = 1.0f - fast_exp(lf0), kk1 = 1.0f - fast_exp(lf1);
                        const float qt0 = bf_lo(rq[r]) * e0, qt1 = bf_hi(rq[r]) * e1, kt0 = kk0 * i0, kt1 = kk1 * i1;
                        *(LAS unsigned*)(QT + t * LDQ + 2 * lane) = cvt_pk_bf16(qt0, qt1);
                        *(LAS unsigned*)(KT + t * LDQ + 2 * lane) = cvt_pk_bf16(kt0, kt1);
                        *(LAS unsigned*)(QB + t * LDQ + 2 * lane) = cvt_pk_bf16(qt0 * em0, qt1 * em1);
                        const unsigned kbp = cvt_pk_bf16(kt0 * el0, kt1 * el1);
                        if (r & 1) { kb0[r >> 1] |= (kbp << 16); kb1[r >> 1] |= (kbp & 0xffff0000u); vt0[r >> 1] |= (rv[r] << 16); vt1[r >> 1] |= (rv[r] & 0xffff0000u); }
                        else { kb0[r >> 1] = kbp & 0xffffu; kb1[r >> 1] = kbp >> 16; vt0[r >> 1] = rv[r] & 0xffffu; vt1[r >> 1] = rv[r] >> 16; }
                    }
                    *(LAS u32x4*)(KBT + (2 * lane) * LDT + 8 * w) = (u32x4){kb0[0], kb0[1], kb0[2], kb0[3]};
                    *(LAS u32x4*)(KBT + (2 * lane + 1) * LDT + 8 * w) = (u32x4){kb1[0], kb1[1], kb1[2], kb1[3]};
                    *(LAS u32x4*)(VT + (2 * lane) * LDT + 8 * w) = (u32x4){vt0[0], vt0[1], vt0[2], vt0[3]};
                    *(LAS u32x4*)(VT + (2 * lane + 1) * LDT + 8 * w) = (u32x4){vt1[0], vt1[1], vt1[2], vt1[3]};
                    LDS_WAIT(); __syncthreads();
                    u32x4 gg[2];
                    { const bf16_t* gp = pbase + (size_t)(m0 + ot) * PROJ_LD + 1536 + 8 * ocg; gg[0] = *(const u32x4*)gp; gg[1] = *(const u32x4*)(gp + 64); }
                    if (c + 1 < NCHUNK) {
#pragma unroll
                        for (int r = 0; r < 8; ++r) { const bf16_t* p = pbase + (size_t)(m0 + CHUNK + 8 * w + r) * PROJ_LD + 2 * lane; rq[r] = *(const unsigned*)p; rl[r] = *(const unsigned*)(p + 512); rv[r] = *(const unsigned*)(p + 1024); }
                    }
#pragma unroll
                    for (int x2 = 0; x2 < 2; ++x2) { const int id = 2 * w + x2, si = id >> 2, ti = id & 3;
                        f32x4 sc = (f32x4){0.f, 0.f, 0.f, 0.f};
                        if (si <= ti) {
#pragma unroll
                            for (int ks = 0; ks < 4; ++ks) { const bf16x8 a = *(const LAS bf16x8*)(KT + (16 * si + fr) * LDQ + 32 * ks + 8 * fq), bb = *(const LAS bf16x8*)(QT + (16 * ti + fr) * LDQ + 32 * ks + 8 * fq);
                                sc = __builtin_amdgcn_mfma_f32_16x16x32_bf16(a, bb, sc, 0, 0, 0); }
                            const int t = 16 * ti + fr, s0 = 16 * si + 4 * fq;
#pragma unroll
                            for (int j = 0; j < 4; ++j) sc[j] = (s0 + j <= t) ? sc[j] : 0.f;
                        }
                        *(LAS u32x2*)(PM + (16 * ti + fr) * LDT + 16 * si + 4 * fq) = (u32x2){cvt_pk_bf16(sc[0], sc[1]), cvt_pk_bf16(sc[2], sc[3])};
                    }
                    f32x4 oacc[4];
                    { bf16x8 sa[4];
#pragma unroll
                        for (int ks = 0; ks < 4; ++ks) sa[ks] = *(const LAS bf16x8*)(ST + (16 * w + fr) * LDQ + 32 * ks + 8 * fq);
#pragma unroll
                        for (int ti = 0; ti < 4; ++ti) { oacc[ti] = (f32x4){0.f, 0.f, 0.f, 0.f};
#pragma unroll
                            for (int ks = 0; ks < 4; ++ks) { const bf16x8 bb = *(const LAS bf16x8*)(QB + (16 * ti + fr) * LDQ + 32 * ks + 8 * fq); oacc[ti] = __builtin_amdgcn_mfma_f32_16x16x32_bf16(sa[ks], bb, oacc[ti], 0, 0, 0); } } }
                    LDS_WAIT(); __syncthreads();
                    { bf16x8 va[2];
#pragma unroll
                        for (int ks = 0; ks < 2; ++ks) va[ks] = *(const LAS bf16x8*)(VT + (16 * w + fr) * LDT + 32 * ks + 8 * fq);
#pragma unroll
                        for (int ti = 0; ti < 4; ++ti)
#pragma unroll
                            for (int ks = 0; ks < 2; ++ks) { const bf16x8 bb = *(const LAS bf16x8*)(PM + (16 * ti + fr) * LDT + 32 * ks + 8 * fq); oacc[ti] = __builtin_amdgcn_mfma_f32_16x16x32_bf16(va[ks], bb, oacc[ti], 0, 0, 0); }
#pragma unroll
                        for (int i = 0; i < 8; ++i) { const f32x4 dv = *(const LAS f32x4*)(DEC + 16 * i + 4 * fq); Sacc[i] = Sacc[i] * dv;
#pragma unroll
                            for (int ks = 0; ks < 2; ++ks) { const bf16x8 a = *(const LAS bf16x8*)(KBT + (16 * i + fr) * LDT + 32 * ks + 8 * fq); Sacc[i] = __builtin_amdgcn_mfma_f32_16x16x32_bf16(a, va[ks], Sacc[i], 0, 0, 0); } } }
#pragma unroll
                    for (int ti = 0; ti < 4; ++ti) *(LAS u32x2*)(OS + (16 * ti + fr) * LDQ + 16 * w + 4 * fq) = (u32x2){cvt_pk_bf16(oacc[ti][0], oacc[ti][1]), cvt_pk_bf16(oacc[ti][2], oacc[ti][3])};
#pragma unroll
                    for (int i = 0; i < 8; ++i) *(LAS u32x2*)(ST + (16 * w + fr) * LDQ + 16 * i + 4 * fq) = (u32x2){cvt_pk_bf16(Sacc[i][0], Sacc[i][1]), cvt_pk_bf16(Sacc[i][2], Sacc[i][3])};
                    LDS_WAIT(); __syncthreads();
                    { f32x4 o[4]; const u32x4 ow0 = *(const LAS u32x4*)(OS + ot * LDQ + 8 * ocg), ow1 = *(const LAS u32x4*)(OS + ot * LDQ + 64 + 8 * ocg); gm::unpack8(ow0, o[0], o[1]); gm::unpack8(ow1, o[2], o[3]);
                        float ss = 0.f;
#pragma unroll
                        for (int q = 0; q < 4; ++q) ss += (o[q][0] * o[q][0] + o[q][1] * o[q][1]) + (o[q][2] * o[q][2] + o[q][3] * o[q][3]);
                        ss += __shfl_xor(ss, 1); ss += __shfl_xor(ss, 2); ss += __shfl_xor(ss, 4);
                        const float rn = __builtin_amdgcn_rsqf(ss * (1.0f / 128.0f) + EPS);
                        bf16_t* op = OB + (size_t)(b * SEQ + m0 + ot) * D + h * DK + 8 * ocg;
#pragma unroll
                        for (int q = 0; q < 2; ++q) { f32x4 g0, g1; gm::unpack8(gg[q], g0, g1);
#pragma unroll
                            for (int j = 0; j < 4; ++j) { g0[j] = g0[j] * sigmoidf_(g0[j]); g1[j] = g1[j] * sigmoidf_(g1[j]); }
                            *(u32x4*)(op + 64 * q) = gm::pack8(o[2 * q] * rn * nwv[2 * q] * g0, o[2 * q + 1] * rn * nwv[2 * q + 1] * g1); } }
                }
            }
        } else {
            const int nconv = G - nchainblk;
            f32x4 cw[3][2];
#pragma unroll
            for (int j = 0; j < 3; ++j) { cw[j][0] = *(const f32x4*)(conv_w + j * 512 + 8 * lane); cw[j][1] = *(const f32x4*)(conv_w + j * 512 + 8 * lane + 4); }
            for (int it = bid - nchainblk; it < BATCH * 8; it += nconv) {
                const int b = it >> 3, t0 = (it & 7) * 256 + wave * 32;
                const bf16_t* pb = PROJ + (size_t)(b * SEQ) * PROJ_LD + 2048 + 8 * lane;
                f32x4 p1[2], p2[2];
#pragma unroll
                for (int q = 0; q < 2; ++q) { p1[q] = (f32x4){0.f, 0.f, 0.f, 0.f}; p2[q] = p1[q]; }
                if (t0 > 0) { gm::unpack8(*(const u32x4*)(pb + (size_t)(t0 - 2) * PROJ_LD + 512), p2[0], p2[1]); gm::unpack8(*(const u32x4*)(pb + (size_t)(t0 - 1) * PROJ_LD + 512), p1[0], p1[1]); }
                for (int r = 0; r < 32; ++r) { const size_t ro = (size_t)(t0 + r) * PROJ_LD;
                    f32x4 q0, q1, g0, g1;
                    gm::unpack8(*(const u32x4*)(pb + ro + 512), q0, q1); gm::unpack8(*(const u32x4*)(pb + ro), g0, g1);
                    const f32x4 y0 = g0 * (cw[0][0] * p2[0] + cw[1][0] * p1[0] + cw[2][0] * q0), y1 = g1 * (cw[0][1] * p2[1] + cw[1][1] * p1[1] + cw[2][1] * q1);
                    *(u32x4*)(CVB + (size_t)(b * SEQ + t0 + r) * D + 8 * lane) = gm::pack8(y0, y1);
                    p2[0] = p1[0]; p2[1] = p1[1]; p1[0] = q0; p1[1] = q1; }
            }
        }
        if (BOTH(3)) GRID_BAR();
#if MK_PHT
        if (MK_PHT == 4) phtk = __builtin_amdgcn_s_memrealtime() - pht0;
#endif
    }

    if (IN(4)) for (int rep_ = 0; rep_ < 1 + ((MK_REPEAT >> 4) & 1); ++rep_) { PHASE_ARGS();
        gm::DenseOrder S{NTOK / 256, D / 256, G, bid, 1}; gm::DenseA AM{D, 0u, 2}; gm::EpiMerge E{(const bf16_t*)ap->out, WSP(bf16_t, WS_U)};
        gm::gemm_phase<false>(wave_sg, lds, (const char*)WSP(bf16_t, WS_O), (const char*)WSP(bf16_t, WS_WHG), D, 0, 0u, S, E, AM);
        if (BOTH(4)) GRID_BAR();
#if MK_PHT
        if (MK_PHT == 5) phtk = __builtin_amdgcn_s_memrealtime() - pht0;
#endif
    }

    if (IN(5)) for (int rep_ = 0; rep_ < 1 + ((MK_REPEAT >> 5) & 1); ++rep_) { PHASE_ARGS();
        gm::DenseOrder S{NTOK / 256, D / 256, G, bid, 1}; gm::DenseA AM{D, 0u, 2}; gm::EpiMix E{ARG(I_X), WSP(float, WS_MOD), WSP(bf16_t, WS_H)};
        gm::gemm_phase<false>(wave_sg, lds, (const char*)WSP(bf16_t, WS_U), (const char*)WSP(bf16_t, WS_WMIX), D, 0, 0u, S, E, AM);
        if (BOTH(5)) GRID_BAR();
#if MK_PHT
        if (MK_PHT == 6) phtk = __builtin_amdgcn_s_memrealtime() - pht0;
#endif
    }

    if (IN(6)) { PHASE_IDS(); PHASE_ARGS();
        typedef float f32x16 __attribute__((ext_vector_type(16)));
        const float* norm_ffn_w = ARG(I_NFFN); const float* w_router = ARG(I_WR); const float* b_router = ARG(I_BR); const float* MOD = WSP(float, WS_MOD);
        const bf16_t* HB = WSP(bf16_t, WS_H); unsigned char* U2Q = WSP(unsigned char, WS_U2Q); int* TOPI = WSP(int, WS_TOPI); float* TOPP = WSP(float, WS_TOPP); int* POS = WSP(int, WS_POS);
        constexpr int WRS = 1032;
        LAS bf16_t* WRH = (LAS bf16_t*)lds; LAS bf16_t* WRL = WRH + 32 * WRS;
        LAS float* LG = (LAS float*)(lds + 132096) + wave * (16 * 36);
        LAS unsigned* LCNT = (LAS unsigned*)(lds + 150528);
        LAS unsigned* LBASE = LCNT + 32;
        LAS unsigned* LASS = LCNT + 64;
        LAS float* A2 = (LAS float*)(lds + 154880); LAS float* SH2 = A2 + 1024;
        for (int i = tid; i < 32 * 1024; i += NTHREADS) { const int e = i & 31, k = i >> 5; const float w = w_router[i];
            const unsigned hi = cvt_pk_bf16(w, 0.f) & 0xffffu; const unsigned lo = cvt_pk_bf16(w - bf_lo(hi), 0.f) & 0xffffu;
            WRH[e * WRS + k] = (bf16_t)hi; WRL[e * WRS + k] = (bf16_t)lo; }
        for (int tb = bid; tb < NTOK / 256; tb += G) {
            const int b = (tb * 256) >> 11;
            if (tid < 32) LCNT[tid] = 0u;
            for (int k = tid; k < 1024; k += NTHREADS) { A2[k] = norm_ffn_w[k] * (1.0f + MOD[(size_t)b * 6144 + 4096 + k]); SH2[k] = MOD[(size_t)b * 6144 + 3072 + k]; }
            LDS_WAIT(); __syncthreads();
            const int trow = lane & 31, half = lane >> 5, ltok0 = wave * 32, tok = tb * 256 + ltok0 + trow;
            const bf16_t* hrow = HB + (size_t)tok * D + 8 * half;
            float ssq = 0.f;
#pragma unroll 8
            for (int st = 0; st < 64; ++st) { const u32x4 hv = *(const u32x4*)(hrow + 16 * st); f32x4 x0, x1; gm::unpack8(hv, x0, x1);
                ssq += (x0[0] * x0[0] + x0[1] * x0[1]) + (x0[2] * x0[2] + x0[3] * x0[3]) + (x1[0] * x1[0] + x1[1] * x1[1]) + (x1[2] * x1[2] + x1[3] * x1[3]); }
            ssq += __shfl_xor(ssq, 32);
            const float rs = __builtin_amdgcn_rsqf(ssq * (1.0f / D) + EPS);
            f32x16 dacc;
#pragma unroll
            for (int q = 0; q < 16; ++q) dacc[q] = 0.f;
            unsigned char* urow = U2Q + (size_t)tok * D + 8 * half;
            const LAS bf16_t* wh = WRH + trow * WRS + 8 * half; const LAS bf16_t* wl = WRL + trow * WRS + 8 * half;
#pragma unroll 2
            for (int st = 0; st < 64; ++st) {
                const u32x4 hv = *(const u32x4*)(hrow + 16 * st); f32x4 x0, x1; gm::unpack8(hv, x0, x1);
                const int k0 = 16 * st + 8 * half;
                const f32x4 a0 = *(const LAS f32x4*)(A2 + k0), a1 = *(const LAS f32x4*)(A2 + k0 + 4), s0 = *(const LAS f32x4*)(SH2 + k0), s1 = *(const LAS f32x4*)(SH2 + k0 + 4);
                const f32x4 u0 = x0 * rs * a0 + s0, u1 = x1 * rs * a1 + s1;
                *(u32x2*)(urow + 16 * st) = (u32x2){pk4_fp8(u0[0], u0[1], u0[2], u0[3]), pk4_fp8(u1[0], u1[1], u1[2], u1[3])};
                u32x4 hh; hh.x = cvt_pk_bf16(u0[0], u0[1]); hh.y = cvt_pk_bf16(u0[2], u0[3]); hh.z = cvt_pk_bf16(u1[0], u1[1]); hh.w = cvt_pk_bf16(u1[2], u1[3]);
                u32x4 ll; ll.x = cvt_pk_bf16(u0[0] - bf_lo(hh.x), u0[1] - bf_hi(hh.x)); ll.y = cvt_pk_bf16(u0[2] - bf_lo(hh.y), u0[3] - bf_hi(hh.y));
                ll.z = cvt_pk_bf16(u1[0] - bf_lo(hh.z), u1[1] - bf_hi(hh.z)); ll.w = cvt_pk_bf16(u1[2] - bf_lo(hh.w), u1[3] - bf_hi(hh.w));
                const bf16x8 ah = __builtin_bit_cast(bf16x8, hh), al = __builtin_bit_cast(bf16x8, ll);
                const bf16x8 bh = *(const LAS bf16x8*)(wh + 16 * st), bl = *(const LAS bf16x8*)(wl + 16 * st);
                dacc = __builtin_amdgcn_mfma_f32_32x32x16_bf16(ah, bh, dacc, 0, 0, 0);
                dacc = __builtin_amdgcn_mfma_f32_32x32x16_bf16(ah, bl, dacc, 0, 0, 0);
                dacc = __builtin_amdgcn_mfma_f32_32x32x16_bf16(al, bh, dacc, 0, 0, 0);
            }
            const float br = b_router[trow];
#pragma unroll
            for (int g = 0; g < 2; ++g) {
#pragma unroll
                for (int q = 0; q < 8; ++q) { const int r16 = (q & 3) + 8 * (q >> 2) + 4 * half; LG[r16 * 36 + trow] = dacc[8 * g + q] + br; }
                LDS_WAIT(); asm volatile("" ::: "memory");
                if (lane < 16) {
                    float v0 = -3.0e38f, v1 = -3.0e38f, v2 = -3.0e38f, v3 = -3.0e38f; int i0 = 0, i1 = 0, i2 = 0, i3 = 0;
#pragma unroll
                    for (int e4 = 0; e4 < 8; ++e4) { const f32x4 lv = *(const LAS f32x4*)(LG + lane * 36 + 4 * e4);
#pragma unroll
                        for (int j = 0; j < 4; ++j) { const float x = lv[j]; const int e = 4 * e4 + j;
                            const bool c0 = x > v0, c1 = x > v1, c2 = x > v2, c3 = x > v3;
                            v3 = c2 ? v2 : (c3 ? x : v3); i3 = c2 ? i2 : (c3 ? e : i3);
                            v2 = c1 ? v1 : (c2 ? x : v2); i2 = c1 ? i1 : (c2 ? e : i2);
                            v1 = c0 ? v0 : (c1 ? x : v1); i1 = c0 ? i0 : (c1 ? e : i1);
                            v0 = c0 ? x : v0; i0 = c0 ? e : i0; } }
                    const float e1 = fast_exp(v1 - v0), e2 = fast_exp(v2 - v0), e3 = fast_exp(v3 - v0); const float inv = fast_rcp(1.0f + e1 + e2 + e3);
                    const int lt = ltok0 + 16 * g + lane; const size_t gt = (size_t)tb * 256 + lt;
                    typedef int i32x4 __attribute__((ext_vector_type(4)));
                    *(i32x4*)(TOPI + gt * 4) = (i32x4){i0, i1, i2, i3}; *(f32x4*)(TOPP + gt * 4) = (f32x4){inv, e1 * inv, e2 * inv, e3 * inv};
                    const unsigned r0 = __hip_atomic_fetch_add(LCNT + i0, 1u, __ATOMIC_RELAXED, __HIP_MEMORY_SCOPE_WORKGROUP), r1 = __hip_atomic_fetch_add(LCNT + i1, 1u, __ATOMIC_RELAXED, __HIP_MEMORY_SCOPE_WORKGROUP);
                    const unsigned r2 = __hip_atomic_fetch_add(LCNT + i2, 1u, __ATOMIC_RELAXED, __HIP_MEMORY_SCOPE_WORKGROUP), r3 = __hip_atomic_fetch_add(LCNT + i3, 1u, __ATOMIC_RELAXED, __HIP_MEMORY_SCOPE_WORKGROUP);
                    *(LAS u32x4*)(LASS + lt * 4) = (u32x4){((unsigned)i0 << 16) | r0, ((unsigned)i1 << 16) | r1, ((unsigned)i2 << 16) | r2, ((unsigned)i3 << 16) | r3};
                }
                LDS_WAIT(); asm volatile("" ::: "memory");
            }
            LDS_WAIT(); __syncthreads();
            if (tid < 32) LBASE[tid] = atomicAdd(ctl + CW_CNT + 64 * tid, (unsigned)LCNT[tid]);
            LDS_WAIT(); __syncthreads();
            for (int i = tid; i < 1024; i += NTHREADS) { const unsigned v = LASS[i]; POS[(size_t)tb * 1024 + i] = (int)(LBASE[v >> 16] + (v & 0xffffu)); }
            __syncthreads();
        }
        if (BOTH(6)) GRID_BAR();
#if MK_PHT
        if (MK_PHT == 7) phtk = __builtin_amdgcn_s_memrealtime() - pht0;
#endif
    }

    LAS int* PADSTART = (LAS int*)(lds + TBL_OFF); LAS int* TILE_E = PADSTART + 64;
    int ntiles = 0;
    {
        if (lo <= 9 && hi > 7) { PHASE_IDS(); PHASE_ARGS();
            __syncthreads();
            if (wave == 0) {
                const int cnt = lane < NE ? (int)__hip_atomic_load(ctl + CW_CNT + 64 * lane, __ATOMIC_RELAXED, __HIP_MEMORY_SCOPE_AGENT) : 0;
                const int padded = ((cnt + 255) >> 8) << 8; int incl = padded;
#pragma unroll
                for (int o = 1; o < 32; o <<= 1) { const int v = __shfl_up(incl, o); if ((lane & 31) >= o) incl += v; }
                if (lane < NE) PADSTART[lane] = incl - padded;
                if (lane == NE - 1) PADSTART[NE] = incl;
            }
            LDS_WAIT(); __syncthreads();
            for (int t = tid; t < (PADSTART[NE] >> 8); t += NTHREADS) { int e = 0;
#pragma unroll
                for (int q = 1; q < NE; ++q) e += ((PADSTART[q] >> 8) <= t) ? 1 : 0;
                TILE_E[t] = e; }
            LDS_WAIT(); __syncthreads();
            ntiles = PADSTART[NE] >> 8;
        }
    }

    if (IN(7)) for (int rep_ = 0; rep_ < 1 + ((MK_REPEAT >> 7) & 1); ++rep_) { PHASE_IDS(); PHASE_ARGS();
        const int* TOPI = WSP(int, WS_TOPI); const float* TOPP = WSP(float, WS_TOPP); int* POS = WSP(int, WS_POS); int* RTOK = WSP(int, WS_RTOK); int* RSLOT = WSP(int, WS_RSLOT); float* RW = WSP(float, WS_RW);
        for (int i = bid * NTHREADS + tid; i < NASSIGN; i += G * NTHREADS) { const int e = TOPI[i]; const int row = PADSTART[e] + POS[i]; RTOK[row] = i >> 2; RSLOT[row] = i; RW[row] = TOPP[i]; POS[i] = row; }
        for (int e = bid; e < NE; e += G) { const int cnt = (int)__hip_atomic_load(ctl + CW_CNT + 64 * e, __ATOMIC_RELAXED, __HIP_MEMORY_SCOPE_AGENT);
            for (int r = PADSTART[e] + cnt + tid; r < PADSTART[e + 1]; r += NTHREADS) { RTOK[r] = 0; RSLOT[r] = -1; RW[r] = 0.f; } }
        if (BOTH(7)) GRID_BAR();
#if MK_PHT
        if (MK_PHT == 8) phtk = __builtin_amdgcn_s_memrealtime() - pht0;
#endif
    }

    if (IN(8)) for (int rep_ = 0; rep_ < 1 + ((MK_REPEAT >> 8) & 1); ++rep_) { PHASE_ARGS();
        gm::MoeOrder S{ntiles, 2048 / 256, G, bid, TILE_E}; gm::GatherA AM{D, WSP(int, WS_RTOK), 1}; gm::EpiSwiglu E{ARG(I_B1), WSP(unsigned char, WS_ACT), ctl + CW_TP};
        gm::gemm_phase<true>(wave_sg, lds, (const char*)WSP(char, WS_U2Q), (const char*)WSP(char, WS_W1), D, 2048, 0u, S, E, AM);
        if (BOTH(8)) GRID_BAR();
#if MK_PHT
        if (MK_PHT == 9) phtk = __builtin_amdgcn_s_memrealtime() - pht0;
#endif
    }

    if (IN(9)) for (int rep_ = 0; rep_ < 1 + ((MK_REPEAT >> 9) & 1); ++rep_) { PHASE_ARGS();
        gm::MoeOrder S{ntiles, D / 256, G, bid, TILE_E}; gm::DenseA AM{DFF, 0u, 1}; gm::EpiMoeOut E{ARG(I_B2), WSP(float, WS_RW), WSP(unsigned char, WS_YA)};
        gm::gemm_phase<true>(wave_sg, lds, (const char*)WSP(char, WS_ACT), (const char*)WSP(char, WS_W2), DFF, D, 0u, S, E, AM);
        if (BOTH(9)) GRID_BAR();
#if MK_PHT
        if (MK_PHT == 10) phtk = __builtin_amdgcn_s_memrealtime() - pht0;
#endif
    }

#if MK_PROBE
    if (lo == 100) { PHASE_IDS(); PHASE_ARGS();
        float* out = ap->out;
        const bf16_t* src = MK_PROBE == 1 ? WSP(bf16_t, WS_U) : MK_PROBE == 3 ? WSP(bf16_t, WS_O) : MK_PROBE == 4 ? WSP(bf16_t, WS_U) : MK_PROBE == 5 ? WSP(bf16_t, WS_H) : WSP(bf16_t, WS_U);
        for (size_t i = (size_t)bid * NTHREADS + tid; i < (size_t)NTOK * D; i += (size_t)G * NTHREADS) {
            float v;
            if (MK_PROBE == 3) { const size_t t = i >> 10, c = i & 1023; v = bf1(src[t * 1024 + c]); }
            else if (MK_PROBE == 2) { const size_t t = i >> 10, c = i & 1023; const bf16_t* P = WSP(bf16_t, WS_PROJ) + t * PROJ_LD; v = bf1(P[c]) + bf1(P[c + 1024]) + bf1(P[c + 2048]) + (c < 512 ? bf1(P[c + 3072]) : 0.f); }
            else if (MK_PROBE == 6) { const size_t t = i >> 10, c = i & 1023; v = bf1(src[i]) + (c < 4 ? (float)WSP(int, WS_TOPI)[t * 4 + c] : c < 8 ? WSP(float, WS_TOPP)[t * 4 + (c - 4)] : 0.f); }
            else v = bf1(src[i]);
            out[i] = v; }
    }
#endif
    if (IN(10)) { PHASE_IDS(); PHASE_ARGS();
#if MK_TPROBE
        const float tscale = 1.0f;
#elif MK_FP8TEST
        float tscale = 1.0f;
        {
            typedef int v8i __attribute__((ext_vector_type(8)));
            const int fr = lane & 15, fq = lane >> 4;
            v8i ta, tb;
#pragma unroll
            for (int d = 0; d < 8; ++d) { float av[4], bv[4];
#pragma unroll
                for (int e = 0; e < 4; ++e) { const int k = 32 * fq + 4 * d + e; av[e] = (float)(((fr * 7 + k * 3) % 5) - 2); bv[e] = (float)(((k * 5 + fr * 11) % 7) - 3); }
                int w = __builtin_amdgcn_cvt_pk_fp8_f32(av[0], av[1], 0, false); w = __builtin_amdgcn_cvt_pk_fp8_f32(av[2], av[3], w, true); ta[d] = w;
                w = __builtin_amdgcn_cvt_pk_fp8_f32(bv[0], bv[1], 0, false); w = __builtin_amdgcn_cvt_pk_fp8_f32(bv[2], bv[3], w, true); tb[d] = w; }
            f32x4 tc = {0.f, 0.f, 0.f, 0.f};
            tc = __builtin_amdgcn_mfma_scale_f32_16x16x128_f8f6f4(ta, tb, tc, 0, 0, 0, 0x7A7A7A7A, 0, 0x7F7F7F7F);
            bool bad = false;
#pragma unroll
            for (int r = 0; r < 4; ++r) { const int i = 4 * fq + r, j = fr; float ref = 0.f;
                for (int k = 0; k < 128; ++k) ref += (float)(((i * 7 + k * 3) % 5) - 2) * (float)(((k * 5 + j * 11) % 7) - 3);
                ref *= (1.0f / 32.0f); if (fabsf(tc[r] - ref) > 1e-3f) bad = true; }
            if (__any(bad)) tscale = 4.0f;
        }
#endif
        const float* norm_final_w = ARG(I_NFIN); const float* MOD = WSP(float, WS_MOD); const bf16_t* HB = WSP(bf16_t, WS_H); const unsigned char* YA = WSP(unsigned char, WS_YA); const int* ASROW = WSP(int, WS_POS); float* out = ap->out;
        for (int m0 = gw * 32; m0 < NTOK; m0 += NGW * 32) {
            const int b = m0 >> 11;
            f32x4 gf[4], nf[4];
#pragma unroll
            for (int j = 0; j < 4; ++j) { const int k = 4 * lane + 256 * j; gf[j] = *(const f32x4*)(MOD + (size_t)b * 6144 + 5120 + k); nf[j] = *(const f32x4*)(norm_final_w + k); }
            for (int r = 0; r < 32; ++r) {
                const size_t tok = (size_t)(m0 + r);
                const bf16_t* hr = HB + tok * D;
                typedef int i32x4 __attribute__((ext_vector_type(4)));
                const i32x4 rr = *(const i32x4*)(ASROW + tok * 4);
                const unsigned char* y0 = YA + (size_t)rr[0] * D; const unsigned char* y1 = YA + (size_t)rr[1] * D; const unsigned char* y2 = YA + (size_t)rr[2] * D; const unsigned char* y3 = YA + (size_t)rr[3] * D;
                f32x4 v[4]; float s = 0.f;
#pragma unroll
                for (int j = 0; j < 4; ++j) { const int k = 4 * lane + 256 * j;
                    const u32x2 hw = *(const u32x2*)(hr + k); const unsigned ya = *(const unsigned*)(y0 + k), yb = *(const unsigned*)(y1 + k), yc = *(const unsigned*)(y2 + k), yd = *(const unsigned*)(y3 + k);
                    f32x4 y = fp8x4_to_f32(ya); y += fp8x4_to_f32(yb); y += fp8x4_to_f32(yc); y += fp8x4_to_f32(yd);
                    v[j] = (f32x4){bf_lo(hw.x), bf_hi(hw.x), bf_lo(hw.y), bf_hi(hw.y)} + gf[j] * y;
                    s += (v[j][0] * v[j][0] + v[j][1] * v[j][1]) + (v[j][2] * v[j][2] + v[j][3] * v[j][3]); }
                const float rs = __builtin_amdgcn_rsqf(wave_sum(s) * (1.0f / D) + EPS);
                float* orow = out + tok * D;
#pragma unroll
                #if MK_FP8TEST || MK_TPROBE
                for (int j = 0; j < 4; ++j) *(f32x4*)(orow + 4 * lane + 256 * j) = v[j] * rs * nf[j] * tscale;
#else
                for (int j = 0; j < 4; ++j) *(f32x4*)(orow + 4 * lane + 256 * j) = v[j] * rs * nf[j];
#endif
            }
        }
    }
#if MK_PHT
    if (bid == 0) { const unsigned long long t1 = __builtin_amdgcn_s_memrealtime(); while (__builtin_amdgcn_s_memrealtime() - t1 < phtk) __builtin_amdgcn_s_sleep(8); }
#endif
#undef IN
#undef BOTH
}

extern "C" void kernel_launch(void* const* d_in, const int* in_sizes, int n_in, void* d_out, int out_size, void* d_ws, size_t ws_size, hipStream_t stream) {
    static int grid = 0;
    if (grid == 0) {
        if (n_in != 20 || out_size != NTOK * D || ws_size < WS_END) { fprintf(stderr, "kernel_launch: unexpected shapes (n_in %d out %d ws %zu)\n", n_in, out_size, ws_size); grid = -1; return; }
        if (hipFuncSetAttribute((const void*)fwd_kernel, hipFuncAttributeMaxDynamicSharedMemorySize, LDS_BYTES) != hipSuccess) { fprintf(stderr, "kernel_launch: hipFuncSetAttribute failed\n"); grid = -1; return; }
        int dev = 0, cus = 0, per_cu = 0;
        (void)hipGetDevice(&dev); (void)hipDeviceGetAttribute(&cus, hipDeviceAttributeMultiprocessorCount, dev);
        if (hipOccupancyMaxActiveBlocksPerMultiprocessor(&per_cu, (const void*)fwd_kernel, NTHREADS, LDS_BYTES) != hipSuccess || per_cu < 1) fprintf(stderr, "kernel_launch: occupancy query says %d\n", per_cu);
        (void)hipGetLastError();
        grid = cus > 0 ? cus : 256;
    }
    if (grid < 0) return;
    (void)hipMemsetAsync((char*)d_ws + WS_CTL, 0, CTL_ZERO_BYTES, stream);
    Args a{};
    for (int i = 0; i < 20; ++i) a.in[i] = (const float*)d_in[i];
    a.out = (float*)d_out; a.ws = (unsigned char*)d_ws;
#if MK_ONE_LAUNCH
    a.ph_lo = 0; a.ph_hi = NPHASE;
    hipLaunchKernelGGL(fwd_kernel, dim3(grid), dim3(NTHREADS), LDS_BYTES, stream, a);
#else
#if MK_PROBE
    for (int p = 0; p <= MK_PROBE; ++p) { a.ph_lo = p; a.ph_hi = p + 1; hipLaunchKernelGGL(fwd_kernel, dim3(grid), dim3(NTHREADS), LDS_BYTES, stream, a); }
    a.ph_lo = 100; a.ph_hi = 101; hipLaunchKernelGGL(fwd_kernel, dim3(grid), dim3(NTHREADS), LDS_BYTES, stream, a);
#else
    for (int p = 0; p < NPHASE; ++p) { a.ph_lo = p; a.ph_hi = p + 1; hipLaunchKernelGGL(fwd_kernel, dim3(grid), dim3(NTHREADS), LDS_BYTES, stream, a); }
#endif
#endif
}
```

```cpp
#include <hip/hip_runtime.h>
#include <cstdio>
#include <cstdint>

#ifndef MK_PROBE
#define MK_PROBE 0
#endif
#ifndef MK_REPEAT
#define MK_REPEAT 0
#endif
#ifndef MK_FP8TEST
#define MK_FP8TEST 0
#endif
#ifndef MK_STAGGER
#define MK_STAGGER 0
#endif
#ifndef MK_TPROBE
#define MK_TPROBE 0
#endif
#ifndef MK_PHT
#define MK_PHT 0
#endif
#ifndef MK_P2FP8
#define MK_P2FP8 0
#endif
#ifndef MK_BG
#define MK_BG 0
#endif
#ifndef MK_ONE_LAUNCH
#define MK_ONE_LAUNCH 1
#endif

#define LAS __attribute__((address_space(3)))
#define GAS __attribute__((address_space(1)))
typedef unsigned short bf16_t;
typedef short bf16x8 __attribute__((ext_vector_type(8)));
typedef float f32x4 __attribute__((ext_vector_type(4)));
typedef float f32x2 __attribute__((ext_vector_type(2)));
typedef unsigned u32x4 __attribute__((ext_vector_type(4)));
typedef unsigned u32x2 __attribute__((ext_vector_type(2)));
typedef int v8i __attribute__((ext_vector_type(8)));

constexpr int D = 1024, BATCH = 32, SEQ = 2048, NTOK = BATCH * SEQ;
constexpr int HW = 512, NHEAD = 4, DK = 128, CHUNK = 64, NCHUNK = SEQ / CHUNK;
constexpr int INC = 5632, PROJ_LD = 3584, GATE_LD = 2048;
constexpr int NE = 32, TOPK = 4, DFF = 1024, NASSIGN = NTOK * TOPK;
constexpr int MAXTILES = NASSIGN / 256 + NE;
constexpr int MAXROWS = MAXTILES * 256;
constexpr float EPS = 1e-6f, SW_LIMIT = 7.0f, SW_ALPHA = 1.702f;
constexpr int NWAVES = 8, NTHREADS = 512;
constexpr int NPHASE = 11;

constexpr size_t MiB = 1u << 20;
constexpr size_t WS_CTL = 0, CTL_ZERO_BYTES = 65536;
constexpr size_t WS_MOD = 1 * MiB;
constexpr size_t WS_LB = WS_MOD + 32 * 6144 * 4;
constexpr size_t WS_WIN = 2 * MiB;
constexpr size_t WS_WHG = 13 * MiB, WS_WCV = 14 * MiB, WS_WMIX = 15 * MiB;
constexpr size_t WS_W2 = 18 * MiB;
constexpr size_t WS_W1 = 50 * MiB;
constexpr size_t WS_U2Q = 114 * MiB;
constexpr size_t WS_U = 210 * MiB;
constexpr size_t WS_PROJ = 338 * MiB;
constexpr size_t WS_O = 786 * MiB;
constexpr size_t WS_CV = 850 * MiB;
constexpr size_t WS_H = 338 * MiB;
constexpr size_t WS_ACT = 466 * MiB;
constexpr size_t WS_TOPI = 994 * MiB, WS_TOPP = 995 * MiB, WS_POS = 996 * MiB;
constexpr size_t WS_RTOK = 997 * MiB, WS_RSLOT = 997 * MiB + 1081344 + 0, WS_RW = WS_RSLOT + 1081344;
constexpr size_t WS_YA = 50 * MiB, WS_YB = 730 * MiB; constexpr int YSPLIT = 147456;
constexpr size_t WS_YO23_UNUSED = 730 * MiB;
constexpr size_t WS_END = 1001 * MiB;
static_assert(WS_RW + 1081344 <= WS_END && MAXROWS * 4 == 1081344, "tables");
static_assert(WS_ACT + (size_t)MAXROWS * 1024 <= WS_YB && WS_YB + (size_t)(MAXROWS - YSPLIT) * 2048 <= WS_TOPI && WS_YA + (size_t)YSPLIT * 2048 <= WS_H && YSPLIT % 256 == 0, "expert output map");
constexpr int CW_TMO = 0, CW_BAR = 4096, CW_CNT = 8192, CW_TP = 12288, CW_Q = 12544;

constexpr int LDS_BYTES = 163840;
constexpr int MISC_OFF = LDS_BYTES - 256;
constexpr int TBL_OFF = 135168;
constexpr int SIDE_OFF = TBL_OFF + 8192;

#define LDS_WAIT() asm volatile("s_waitcnt lgkmcnt(0)" ::: "memory")
#define VM_WAIT() asm volatile("s_waitcnt vmcnt(0)" ::: "memory")
typedef __bf16 bf16x2_t __attribute__((ext_vector_type(2)));
__device__ __forceinline__ unsigned cvt_pk_bf16(float lo, float hi) { const f32x2 v = {lo, hi}; const bf16x2_t b = __builtin_convertvector(v, bf16x2_t); return __builtin_bit_cast(unsigned, b); }
__device__ __forceinline__ unsigned pk4_fp8(float a, float b, float c, float d) {
    a = fminf(fmaxf(a, -448.f), 448.f); b = fminf(fmaxf(b, -448.f), 448.f); c = fminf(fmaxf(c, -448.f), 448.f); d = fminf(fmaxf(d, -448.f), 448.f);
    int w = __builtin_amdgcn_cvt_pk_fp8_f32(a, b, 0, false); w = __builtin_amdgcn_cvt_pk_fp8_f32(c, d, w, true); return (unsigned)w; }
__device__ __forceinline__ f32x4 fp8x4_to_f32(unsigned w) {
    const f32x2 lo = __builtin_amdgcn_cvt_pk_f32_fp8((int)w, false), hi = __builtin_amdgcn_cvt_pk_f32_fp8((int)w, true); return (f32x4){lo[0], lo[1], hi[0], hi[1]}; }
__device__ __forceinline__ unsigned pk4_fp8_nc(float a, float b, float c, float d) {
    int w = __builtin_amdgcn_cvt_pk_fp8_f32(a, b, 0, false); w = __builtin_amdgcn_cvt_pk_fp8_f32(c, d, w, true); return (unsigned)w; }
__device__ __forceinline__ float bf_lo(unsigned u) { return __uint_as_float(u << 16); }
__device__ __forceinline__ float bf_hi(unsigned u) { return __uint_as_float(u & 0xffff0000u); }
__device__ __forceinline__ float bf1(bf16_t u) { return __uint_as_float(((unsigned)u) << 16); }
__device__ __forceinline__ float fast_rcp(float x) { return __builtin_amdgcn_rcpf(x); }
__device__ __forceinline__ float fast_exp(float x) { return __builtin_amdgcn_exp2f(x * 1.44269504089f); }
__device__ __forceinline__ float fast_log(float x) { return __builtin_amdgcn_logf(x) * 0.69314718056f; }
__device__ __forceinline__ float sigmoidf_(float x) { return fast_rcp(1.0f + fast_exp(-x)); }
__device__ __forceinline__ float wave_sum(float v) {
#pragma unroll
    for (int o = 1; o < 64; o <<= 1) v += __shfl_xor(v, o);
    return v;
}

#define XB_TMO      128
#define XB_XCNT(j)  (256  + 64 * (j))
#define XB_XSUB(j)  (1280 + 64 * (j))
#define XB_XGEN(j)  (2304 + 64 * (j))
#define XB_TOP      3328
#define XB_TOPGEN   3392
#define XCD_BAR_WORDS 3456
#define XB_SPIN_CAP (1u << 20)
__device__ __forceinline__ unsigned xb_ld(unsigned* p)              { return __hip_atomic_load(p, __ATOMIC_RELAXED, __HIP_MEMORY_SCOPE_AGENT); }
__device__ __forceinline__ unsigned xb_add(unsigned* p, unsigned v) { return __hip_atomic_fetch_add(p, v, __ATOMIC_RELAXED, __HIP_MEMORY_SCOPE_AGENT); }
__device__ __forceinline__ unsigned xb_xcc_id() { return (unsigned)__builtin_amdgcn_s_getreg((3 << 11) | 20) & 0xFu; }
#define XB_SPIN(cond, bar) do { unsigned _sp = 0; while (cond) { __builtin_amdgcn_s_sleep(1); \
    if ((++_sp & 255u) == 0u) { if (xb_ld(&(bar)[XB_TMO])) break; if (_sp > XB_SPIN_CAP) { atomicAdd(&(bar)[XB_TMO], 1u); break; } } } } while (0)
struct XcdBarrier { unsigned* bar; unsigned x; volatile LAS unsigned* st; };
__device__ __forceinline__ XcdBarrier xcd_barrier_post(unsigned* bar, volatile LAS unsigned* st) {
    XcdBarrier b; b.bar = bar; b.x = xb_xcc_id(); b.st = st;
    if (threadIdx.x == 0) (void)xb_add(&bar[XB_XCNT(b.x)], 1u);
    return b;
}
__device__ __forceinline__ void xcd_barrier_complete(unsigned* bar, unsigned x, unsigned& nloc, unsigned& nx) {
    const unsigned G = gridDim.x * gridDim.y * gridDim.z;
    unsigned sum, cnt, mine, sp = 0u;
    for (;;) {
        sum = 0u; cnt = 0u; mine = 0u;
#pragma unroll
        for (unsigned j = 0; j < 16; ++j) { const unsigned c = xb_ld(&bar[XB_XCNT(j)]); sum += c; cnt += (c > 0u) ? 1u : 0u; mine = (j == x) ? c : mine; }
        if (sum == G) break;
        __builtin_amdgcn_s_sleep(1);
        if ((++sp & 255u) == 0u) { if (xb_ld(&bar[XB_TMO])) break; if (sp > XB_SPIN_CAP) { atomicAdd(&bar[XB_TMO], 1u); break; } }
    }
    nloc = mine > 0u ? mine : 1u; nx = cnt > 0u ? cnt : 1u;
}
__device__ __forceinline__ void xcd_barrier(const XcdBarrier& b) {
    asm volatile("s_waitcnt vmcnt(0)" ::: "memory");
    __syncthreads();
    if (threadIdx.x == 0) {
        unsigned* bar = b.bar;
        __builtin_amdgcn_s_waitcnt(0);
        unsigned nloc = b.st[0], nx = b.st[1];
        if (nloc == 0u) { xcd_barrier_complete(bar, b.x, nloc, nx); b.st[0] = nloc; b.st[1] = nx; }
        const unsigned old = xb_add(&bar[XB_XSUB(b.x)], 1u);
        const unsigned gen = old / nloc;
        if (old + 1u == (gen + 1u) * nloc) {
            __builtin_amdgcn_fence(__ATOMIC_RELEASE, "agent");
            asm volatile("s_waitcnt vmcnt(0)" ::: "memory");
            const unsigned og = xb_add(&bar[XB_TOP], 1u);
            const unsigned tg = og / nx;
            if (og + 1u == (tg + 1u) * nx) xb_add(&bar[XB_TOPGEN], 1u);
            else XB_SPIN(xb_ld(&bar[XB_TOPGEN]) == tg, bar);
            __builtin_amdgcn_fence(__ATOMIC_ACQUIRE, "agent");
            xb_add(&bar[XB_XGEN(b.x)], 1u);
            asm volatile("s_waitcnt vmcnt(0)" ::: "memory");
        } else {
            XB_SPIN(xb_ld(&bar[XB_XGEN(b.x)]) == gen, bar);
            __builtin_amdgcn_fence(__ATOMIC_ACQUIRE, "agent");
            asm volatile("s_waitcnt vmcnt(0)" ::: "memory");
        }
    }
    __syncthreads();
}

namespace gm {
constexpr int BM = 256, BK = 64, HALF = 128, HTB = HALF * BK * 2, STAGE_BYTES = 8 * HTB, NXCD = 8, WGM = 8;
__device__ __forceinline__ int lds_byte(int r, int c) { const int st = (r >> 4) * 2 + (c >> 5), rr = r & 15, cc = c & 31, ob = rr * 64 + cc * 2; return st * 1024 + (ob ^ (((ob >> 9) & 1) << 5)); }
__device__ __forceinline__ void stage_rc(int b, int& R, int& C) { const int st = b / 1024, sb = b % 1024, swz = sb ^ (((sb >> 9) & 1) << 5); R = (st >> 1) * 16 + swz / 64; C = (st & 1) * 32 + (swz % 64) / 2; }
__device__ __forceinline__ int perm32(int rho) { const int n = rho >> 4, i = rho & 15; return 8 * (i >> 2) + 4 * n + (i & 3); }

struct Unit { int pm, pn, e, sub; };

__device__ __forceinline__ bool tile_order(int nM, int nN, long L, int& pm, int& pn) {
    const int nwg = nM * nN; if (L >= nwg) return false;
    int wgid = (int)L; { const int q = nwg / NXCD, r = nwg % NXCD, xcd = wgid % NXCD, off = wgid / NXCD; wgid = (xcd < r ? xcd * (q + 1) : r * (q + 1) + (xcd - r) * q) + off; }
    const int nig = WGM * nN, gid = wgid / nig, fm = gid * WGM, gsz = (nM - fm) < WGM ? (nM - fm) : WGM;
    pm = fm + ((wgid % nig) % gsz); pn = (wgid % nig) / gsz; return true;
}
struct DenseOrder {
    int nM, nN, G, c, nsub;
    __device__ __forceinline__ bool next(int i, Unit& u) const { const int ti = i / nsub; u.sub = i - ti * nsub; u.e = 0; return tile_order(nM, nN, (long)ti * G + c, u.pm, u.pn); }
};
struct MoeOrder {
    int nM, nN, G, c; const LAS int* tile_e;
    __device__ __forceinline__ bool next(int i, Unit& u) const { u.sub = 0; if (!tile_order(nM, nN, (long)i * G + c, u.pm, u.pn)) return false; u.e = tile_e[u.pm]; return true; }
};
struct DenseA { int K; unsigned sub_stride; int ES;
    __device__ __forceinline__ void offsets(const Unit& u, int tid, unsigned (&o)[2][2]) const {
#pragma unroll
        for (int i = 0; i < 2; ++i) { int R, C; stage_rc(tid * 16 + i * 8192, R, C);
#pragma unroll
            for (int h = 0; h < 2; ++h) o[h][i] = (unsigned)((u.pm * BM + h * HALF + R) * K * ES + C * 2) + (unsigned)u.sub * sub_stride; } }
    static constexpr bool GATHER = false;
    __device__ __forceinline__ const char* tok_ptr(const Unit&) const { return nullptr; }
    __device__ __forceinline__ void next_offsets(const Unit& u, int tid, unsigned (&o)[2][2], const LAS int*) const { offsets(u, tid, o); } };
struct GatherA { int K; const int* row_tok; int ES;
    __device__ __forceinline__ void offsets(const Unit& u, int tid, unsigned (&o)[2][2]) const {
#pragma unroll
        for (int i = 0; i < 2; ++i) { int R, C; stage_rc(tid * 16 + i * 8192, R, C);
#pragma unroll
            for (int h = 0; h < 2; ++h) { const int tok = row_tok[u.pm * BM + h * HALF + R]; o[h][i] = (unsigned)(tok * K * ES + C * 2); } } }
    static constexpr bool GATHER = true;
    __device__ __forceinline__ const char* tok_ptr(const Unit& u) const { return (const char*)(row_tok + u.pm * BM); }
    __device__ __forceinline__ void next_offsets(const Unit&, int tid, unsigned (&o)[2][2], const LAS int* stok) const {
#pragma unroll
        for (int i = 0; i < 2; ++i) { int R, C; stage_rc(tid * 16 + i * 8192, R, C);
#pragma unroll
            for (int h = 0; h < 2; ++h) { const int tok = stok[h * HALF + R]; o[h][i] = (unsigned)(tok * K * ES + C * 2); } } } };

template <bool FP8, class Epi, class Sched, class AMap>
__device__ __forceinline__ void gemm_phase(int wave_sg, LAS unsigned char* lds, const char* Abase, const char* Bbase, int K, int Nb, unsigned b_sub_stride, const Sched& S, const Epi& E, const AMap& AM) {
    int lane; asm volatile("v_mbcnt_lo_u32_b32 %0, -1, 0\n\tv_mbcnt_hi_u32_b32 %0, -1, %0" : "=v"(lane));
    const int wid = wave_sg, tid = wid * 64 + lane, wr = wid >> 2, wc = wid & 3, fr = lane & 15, fq = lane >> 4;
    constexpr int ES = FP8 ? 1 : 2;
    const int nt = K * ES / (BK * 2);
    unsigned voffB[2];
#pragma unroll
    for (int i = 0; i < 2; ++i) { int R, C; stage_rc(tid * 16 + i * 8192, R, C); const int Rb = (R & ~31) + perm32(R & 31); voffB[i] = (unsigned)(Rb * K * ES + C * 2); }
    const size_t kstep = (size_t)(BK * 2);
    const size_t hstep = (size_t)HALF * K * ES;
    const unsigned ldsw = (unsigned)wid * 1024u;
    const int aoff = lds_byte(wr * 64 + fr, fq * 8), boff = lds_byte(wc * 32 + fr, fq * 8);
#define G_SA(b, h) (((b) * 2 + (h)) * HTB)
#define G_SB(b, h) ((4 + (b) * 2 + (h)) * HTB)
#define G_STAGE(bufoff, gbase, voff) do { _Pragma("unroll") for (int _i = 0; _i < 2; ++_i) \
        __builtin_amdgcn_global_load_lds((const unsigned*)((const char*)(gbase) + (voff)[_i]), (LAS unsigned*)(lds + (bufoff) + ldsw + _i * 8192), 16, 0, 0); } while (0)
#define G_LDA(dst, b, h) do { _Pragma("unroll") for (int m = 0; m < 4; ++m) _Pragma("unroll") for (int k = 0; k < 2; ++k) dst[m][k] = *(const LAS bf16x8*)(lds + G_SA(b, h) + aoff + m * 2048 + k * 1024); } while (0)
#define G_LDB(dst, b, h) do { _Pragma("unroll") for (int n = 0; n < 2; ++n) _Pragma("unroll") for (int k = 0; k < 2; ++k) dst[n][k] = *(const LAS bf16x8*)(lds + G_SB(b, h) + boff + n * 2048 + k * 1024); } while (0)
#define G_MMA(ai, bj, At, Bt) do { __builtin_amdgcn_s_setprio(1); _Pragma("unroll") for (int m = 0; m < 4; ++m) _Pragma("unroll") for (int n = 0; n < 2; ++n) _Pragma("unroll") for (int k = 0; k < 2; ++k) \
        acc[ai][bj][m][n] = __builtin_amdgcn_mfma_f32_16x16x32_bf16(Bt[n][k], At[m][k], acc[ai][bj][m][n], 0, 0, 0); __builtin_amdgcn_s_setprio(0); } while (0)
#define G_LD8(dst, off) do { const u32x4 _l = *(const LAS u32x4*)(lds + (off)), _h = *(const LAS u32x4*)(lds + (off) + 1024); dst = (v8i){(int)_l.x, (int)_l.y, (int)_l.z, (int)_l.w, (int)_h.x, (int)_h.y, (int)_h.z, (int)_h.w}; } while (0)
#define G_LDA8(dst, b, h) do { _Pragma("unroll") for (int m = 0; m < 4; ++m) G_LD8(dst[m], G_SA(b, h) + aoff + m * 2048); } while (0)
#define G_LDB8(dst, b, h) do { _Pragma("unroll") for (int n = 0; n < 2; ++n) G_LD8(dst[n], G_SB(b, h) + boff + n * 2048); } while (0)
#define G_MMA8(ai, bj, At, Bt) do { __builtin_amdgcn_s_setprio(1); _Pragma("unroll") for (int m = 0; m < 4; ++m) _Pragma("unroll") for (int n = 0; n < 2; ++n) \
        acc[ai][bj][m][n] = __builtin_amdgcn_mfma_scale_f32_16x16x128_f8f6f4(Bt[n], At[m], acc[ai][bj][m][n], 0, 0, 0, 0x7F7F7F7F, 0, 0x7F7F7F7F); __builtin_amdgcn_s_setprio(0); } while (0)
#define G_PIN(ai, bj) asm volatile("" :: "v"(acc[ai][bj][0][0][0]), "v"(acc[ai][bj][0][1][0]), "v"(acc[ai][bj][1][0][0]), "v"(acc[ai][bj][1][1][0]), "v"(acc[ai][bj][2][0][0]), "v"(acc[ai][bj][2][1][0]), "v"(acc[ai][bj][3][0][0]), "v"(acc[ai][bj][3][1][0]) : "memory")
#define G_WAIT_V(n) asm volatile("s_waitcnt vmcnt(" #n ")" ::: "memory")
#define G_WAIT_L(n) asm volatile("s_waitcnt lgkmcnt(" #n ")" ::: "memory")
#define G_WAIT_VS() do { if (fi) { if (Epi::NST == 16) G_WAIT_V(24); else if (Epi::NST == 8) G_WAIT_V(16); else G_WAIT_V(8); } else G_WAIT_V(8); } while (0)
#define G_BAR __builtin_amdgcn_s_barrier()
#define G_SCHED __builtin_amdgcn_sched_barrier(0)
    Unit cur, nxt; int ui = 0;
#if MK_TPROBE
    unsigned long long tp_c = 0; const unsigned long long tp_c0 = __builtin_amdgcn_s_memtime(), tp_r0 = __builtin_amdgcn_s_memrealtime();
#endif
    if (!S.next(0, cur)) return;
#if MK_STAGGER
    {
        const unsigned long long t0 = __builtin_amdgcn_s_memrealtime(); const unsigned long long dly = (unsigned long long)(blockIdx.x & 7) * MK_STAGGER;
        while (__builtin_amdgcn_s_memrealtime() - t0 < dly) __builtin_amdgcn_s_sleep(8);
    }
#endif
    unsigned rA[2][2];
    AM.offsets(cur, tid, rA);
    const char* cB = Bbase + ((size_t)cur.e * Nb + (size_t)cur.pn * BM) * K * ES + (size_t)cur.sub * b_sub_stride;
    G_STAGE(G_SB(0, 0), cB, voffB); G_STAGE(G_SB(0, 1), cB + hstep, voffB); G_STAGE(G_SA(0, 0), Abase, rA[0]); G_STAGE(G_SA(0, 1), Abase, rA[1]);
    if (wr == 1) G_BAR;
    G_WAIT_V(2); G_BAR;
    G_STAGE(G_SB(1, 0), cB + kstep, voffB); G_STAGE(G_SA(1, 0), Abase + kstep, rA[0]); G_STAGE(G_SB(1, 1), cB + hstep + kstep, voffB);
    G_WAIT_V(6); G_BAR;
    f32x4 acc[2][2][4][2];
#pragma unroll
    for (int a = 0; a < 2; ++a)
#pragma unroll
        for (int b = 0; b < 2; ++b)
#pragma unroll
            for (int m = 0; m < 4; ++m)
#pragma unroll
                for (int n = 0; n < 2; ++n) acc[a][b][m][n] = (f32x4){0.f, 0.f, 0.f, 0.f};
    for (;;) {
        const bool has_next = S.next(ui + 1, nxt);
        const char* nB = has_next ? Bbase + ((size_t)nxt.e * Nb + (size_t)nxt.pn * BM) * K * ES + (size_t)nxt.sub * b_sub_stride : cB;
#if MK_TPROBE
        unsigned long long tp_a = 0; if (Epi::TPROBE && wid == 0) { tp_a = __builtin_amdgcn_s_memrealtime(); if (ui > 0 && lane == 0) { volatile LAS unsigned* M = (volatile LAS unsigned*)(lds + MISC_OFF); M[19] += (unsigned)(tp_a - tp_c); } }
#endif
        if (wid == 0) {
            int l16 = lane * 16; asm volatile("" : "+v"(l16));
#pragma unroll
            for (int k = 0; k < Epi::NSB; ++k) { const char* sp = E.sb_ptr(cur, k); if (l16 < 16 * E.sb_lanes(k)) __builtin_amdgcn_global_load_lds((const unsigned*)(sp + l16), (LAS unsigned*)(lds + SIDE_OFF + (ui & 1) * 4096 + 1024 * (k + 1)), 16, 0, 0); }
            if (AMap::GATHER && has_next) __builtin_amdgcn_global_load_lds((const unsigned*)(AM.tok_ptr(nxt) + l16), (LAS unsigned*)(lds + SIDE_OFF + ((ui + 1) & 1) * 4096), 16, 0, 0);
        }
#pragma nounroll
        for (int t = 0; t < nt; t += 2) {
            if constexpr (Epi::HAS_MID) { if (t == nt / 2) { int lz = lane; asm volatile("" : "+v"(lz)); E.mid(acc, cur, wr, wc, lz & 15, lz >> 4); } }
            bf16x8 At[4][2], B0[2][2], B1[2][2];
            v8i At8[4], B08[2], B18[2];
            const bool last = (t == nt - 2);
            constexpr bool fi = false;
            const char* b2 = last ? nB : cB + (size_t)(t + 2) * kstep; const char* b3 = b2 + kstep;
            if constexpr (FP8) { G_LDB8(B08, 0, 0); G_LDB8(B18, 0, 1); G_SCHED; G_LDA8(At8, 0, 0); } else { G_LDB(B0, 0, 0); G_LDB(B1, 0, 1); G_SCHED; G_LDA(At, 0, 0); }
            G_STAGE(G_SA(1, 1), Abase + (size_t)(t + 1) * kstep, rA[1]);
            G_WAIT_VS(); G_WAIT_L(0); G_BAR;
            if constexpr (FP8) { G_MMA8(0, 0, At8, B08); G_MMA8(0, 1, At8, B18); } else { G_MMA(0, 0, At, B0); G_MMA(0, 1, At, B1); }
            if constexpr (FP8) { G_PIN(0, 0); G_PIN(0, 1); }
            G_BAR; G_SCHED;
            if (last && has_next) { int tz = tid; asm volatile("" : "+v"(tz)); AM.next_offsets(nxt, tz, rA, (const LAS int*)(lds + SIDE_OFF + ((ui + 1) & 1) * 4096)); }
            const char* a2 = Abase + (last ? (size_t)0 : (size_t)(t + 2) * kstep);
            if constexpr (FP8) { G_LDA8(At8, 0, 1); } else { G_LDA(At, 0, 1); }
            G_STAGE(G_SB(0, 0), b2, voffB); G_STAGE(G_SB(0, 1), b2 + hstep, voffB); G_STAGE(G_SA(0, 0), a2, rA[0]);
            G_WAIT_VS(); G_WAIT_L(0); G_BAR;
            if constexpr (FP8) { G_MMA8(1, 0, At8, B08); G_MMA8(1, 1, At8, B18); } else { G_MMA(1, 0, At, B0); G_MMA(1, 1, At, B1); }
            if constexpr (FP8) { G_PIN(1, 0); G_PIN(1, 1); }
            G_BAR; G_SCHED;
            if constexpr (FP8) { G_LDB8(B08, 1, 0); G_LDB8(B18, 1, 1); G_SCHED; G_LDA8(At8, 1, 0); } else { G_LDB(B0, 1, 0); G_LDB(B1, 1, 1); G_SCHED; G_LDA(At, 1, 0); }
            G_STAGE(G_SA(0, 1), a2, rA[1]);
            G_WAIT_VS(); G_WAIT_L(0); G_BAR;
            if constexpr (FP8) { G_MMA8(0, 0, At8, B08); G_MMA8(0, 1, At8, B18); } else { G_MMA(0, 0, At, B0); G_MMA(0, 1, At, B1); }
            if constexpr (FP8) { G_PIN(0, 0); G_PIN(0, 1); }
            G_BAR; G_SCHED;
            if constexpr (FP8) { G_LDA8(At8, 1, 1); } else { G_LDA(At, 1, 1); }
            G_STAGE(G_SB(1, 0), b3, voffB); G_STAGE(G_SB(1, 1), b3 + hstep, voffB); G_STAGE(G_SA(1, 0), a2 + kstep, rA[0]);
            G_WAIT_VS(); G_WAIT_L(0); G_BAR;
            if constexpr (FP8) { G_MMA8(1, 0, At8, B08); G_MMA8(1, 1, At8, B18); } else { G_MMA(1, 0, At, B0); G_MMA(1, 1, At, B1); }
            if constexpr (FP8) { G_PIN(1, 0); G_PIN(1, 1); }
            G_BAR; G_SCHED;
        }
#if MK_TPROBE
        unsigned long long tp_b = 0; if (Epi::TPROBE && wid == 0) tp_b = __builtin_amdgcn_s_memrealtime();
#endif
        if (wr == 0) G_BAR;
        { int lz = lane; asm volatile("" : "+v"(lz));
          E(acc, cur, wr, wc, lz & 15, lz >> 4, (const LAS unsigned char*)(lds + SIDE_OFF + (ui & 1) * 4096 + 1024)); }
#if MK_TPROBE
        if (Epi::TPROBE && wid == 0) { tp_c = __builtin_amdgcn_s_memrealtime(); if (lane == 0) { volatile LAS unsigned* M = (volatile LAS unsigned*)(lds + MISC_OFF); M[16] += (unsigned)(tp_b - tp_a); M[17] += (unsigned)(tp_c - tp_b); M[18] += 1u; } }
#endif
        if (!has_next) break;
        if (!E.keep(cur)) {
#pragma unroll
            for (int a = 0; a < 2; ++a)
#pragma unroll
                for (int b = 0; b < 2; ++b)
#pragma unroll
                    for (int m = 0; m < 4; ++m)
#pragma unroll
                        for (int n = 0; n < 2; ++n) acc[a][b][m][n] = (f32x4){0.f, 0.f, 0.f, 0.f};
        }
        cur = nxt; cB = nB; ++ui;
        if (wr == 1) G_BAR;
    }
    G_WAIT_V(0);
    G_BAR;
#if MK_TPROBE
    if constexpr (Epi::TPROBE) if (wid == 0) { volatile LAS unsigned* M = (volatile LAS unsigned*)(lds + MISC_OFF);
        const unsigned long long t0 = __builtin_amdgcn_s_memrealtime();
        const unsigned long long d = MK_TPROBE == 4 ? 10000ull * (__builtin_amdgcn_s_memtime() - tp_c0) / (t0 - tp_r0)
                                   : 4ull * (unsigned long long)(MK_TPROBE == 1 ? M[16] : MK_TPROBE == 2 ? M[17] : M[19]);
        while (__builtin_amdgcn_s_memrealtime() - t0 < d) __builtin_amdgcn_s_sleep(8); }
#endif
#undef G_SA
#undef G_SB
#undef G_STAGE
#undef G_LDA
#undef G_LDB
#undef G_MMA
#undef G_LD8
#undef G_LDA8
#undef G_LDB8
#undef G_MMA8
#undef G_WAIT_V
#undef G_PIN
#undef G_WAIT_VS
#undef G_WAIT_L
#undef G_BAR
#undef G_SCHED
}

__device__ __forceinline__ u32x4 pack8(const f32x4& v0, const f32x4& v1) { u32x4 w; w.x = cvt_pk_bf16(v0[0], v0[1]); w.y = cvt_pk_bf16(v0[2], v0[3]); w.z = cvt_pk_bf16(v1[0], v1[1]); w.w = cvt_pk_bf16(v1[2], v1[3]); return w; }
__device__ __forceinline__ void unpack8(const u32x4& w, f32x4& v0, f32x4& v1) { v0 = (f32x4){bf_lo(w.x), bf_hi(w.x), bf_lo(w.y), bf_hi(w.y)}; v1 = (f32x4){bf_lo(w.z), bf_hi(w.z), bf_lo(w.w), bf_hi(w.w)}; }

struct EpiProj {
    static constexpr bool HAS_MID = false;
    static constexpr float PSC = MK_P2FP8 ? (1.0f / 32.0f) : 1.0f;
    bf16_t* proj; bf16_t* gates; const float* lb;
    static constexpr int NSB = 0, NST = 16; static constexpr bool TPROBE = true;
    __device__ __forceinline__ const char* sb_ptr(const Unit&, int) const { return nullptr; }
    __device__ __forceinline__ int sb_lanes(int) const { return 0; }
    __device__ __forceinline__ bool keep(const Unit&) const { return false; }
    __device__ __forceinline__ void operator()(f32x4 (&acc)[2][2][4][2], const Unit& u, int wr, int wc, int fr, int fq, const LAS unsigned char* side) const {
        const int row0 = u.pm * BM + wr * 64 + fr, pn = u.pn;
        if (pn >= 10) {
            const bool isg = pn >= 14; const int q = isg ? pn - 14 : pn - 10; const int c0 = q * HALF + wc * 32 + 8 * fq;
#pragma unroll
            for (int ai = 0; ai < 2; ++ai)
#pragma unroll
                for (int m = 0; m < 4; ++m) { const size_t r = (size_t)(row0 + ai * HALF + m * 16);
                    f32x4 a0 = acc[ai][0][m][0] * PSC, a1 = acc[ai][0][m][1] * PSC, b0 = acc[ai][1][m][0] * PSC, b1 = acc[ai][1][m][1] * PSC;
                    if (isg) {
#pragma unroll
                        for (int j = 0; j < 4; ++j) { b0[j] = sigmoidf_(b0[j]); b1[j] = sigmoidf_(b1[j]); a0[j] = sigmoidf_(a0[j]) * fast_rcp(fmaxf(b0[j], 1e-30f)); a1[j] = sigmoidf_(a1[j]) * fast_rcp(fmaxf(b1[j], 1e-30f)); }
                        *(u32x4*)(gates + r * GATE_LD + c0) = pack8(a0, a1); *(u32x4*)(gates + r * GATE_LD + 1024 + c0) = pack8(b0, b1);
                    } else {
                        *(u32x4*)(proj + r * PROJ_LD + 2560 + c0) = pack8(a0 * b0, a1 * b1);
                    } }
            return;
        }
        bf16_t* base = proj; const int ldc = PROJ_LD, colt = pn * BM, kind = (pn == 2 || pn == 3) ? 1 : 0;
        const int col0 = colt + wc * 32 + 8 * fq;
        f32x4 lbv[2][2];
        if (kind == 1) {
#pragma unroll
            for (int bj = 0; bj < 2; ++bj) { const float* lp = lb + (pn - 2) * BM + bj * HALF + wc * 32 + 8 * fq; lbv[bj][0] = *(const f32x4*)lp; lbv[bj][1] = *(const f32x4*)(lp + 4); }
        }
#pragma unroll
        for (int ai = 0; ai < 2; ++ai)
#pragma unroll
            for (int m = 0; m < 4; ++m) { bf16_t* rowp = base + (size_t)(row0 + ai * HALF + m * 16) * ldc + col0;
#pragma unroll
                for (int bj = 0; bj < 2; ++bj) { f32x4 v0 = acc[ai][bj][m][0] * PSC, v1 = acc[ai][bj][m][1] * PSC;
                    if (kind == 1) {
#pragma unroll
                        for (int j = 0; j < 4; ++j) { const float l0 = lbv[bj][0][j], l1 = lbv[bj][1][j];
                            v0[j] = fast_log(l0 + (1.0f - l0) * sigmoidf_(v0[j])); v1[j] = fast_log(l1 + (1.0f - l1) * sigmoidf_(v1[j])); }
                    }
                    *(u32x4*)(rowp + bj * HALF) = pack8(v0, v1); } }
    }
};
struct EpiMerge {
    static constexpr bool HAS_MID = true;
    const bf16_t* gates; bf16_t* out;
    static constexpr int NSB = 0, NST = 0; static constexpr bool TPROBE = false;
    __device__ __forceinline__ const char* sb_ptr(const Unit&, int) const { return nullptr; }
    __device__ __forceinline__ int sb_lanes(int) const { return 0; }
    __device__ __forceinline__ bool keep(const Unit&) const { return false; }
    __device__ __forceinline__ void mid(f32x4 (&acc)[2][2][4][2], const Unit& u, int wr, int wc, int fr, int fq) const {
        const int row0 = u.pm * BM + wr * 64 + fr, col0 = u.pn * BM + wc * 32 + 8 * fq;
#pragma unroll
        for (int ai = 0; ai < 2; ++ai) {
            u32x4 ga[4][2];
#pragma unroll
            for (int m = 0; m < 4; ++m) { const bf16_t* gp = gates + (size_t)(row0 + ai * HALF + m * 16) * GATE_LD + col0;
#pragma unroll
                for (int bj = 0; bj < 2; ++bj) ga[m][bj] = *(const u32x4*)(gp + bj * HALF); }
#pragma unroll
            for (int m = 0; m < 4; ++m)
#pragma unroll
                for (int bj = 0; bj < 2; ++bj) { f32x4 a0, a1; unpack8(ga[m][bj], a0, a1); acc[ai][bj][m][0] *= a0; acc[ai][bj][m][1] *= a1; }
            asm volatile("" ::: "memory"); }
    }
    __device__ __forceinline__ void operator()(f32x4 (&acc)[2][2][4][2], const Unit& u, int wr, int wc, int fr, int fq, const LAS unsigned char* side) const {
        const int row0 = u.pm * BM + wr * 64 + fr, col0 = u.pn * BM + wc * 32 + 8 * fq;
#pragma unroll
        for (int ai = 0; ai < 2; ++ai) {
            u32x4 gb[4][2];
#pragma unroll
            for (int m = 0; m < 4; ++m) { const bf16_t* gp = gates + (size_t)(row0 + ai * HALF + m * 16) * GATE_LD + col0;
#pragma unroll
                for (int bj = 0; bj < 2; ++bj) gb[m][bj] = *(const u32x4*)(gp + 1024 + bj * HALF); }
#pragma unroll
            for (int m = 0; m < 4; ++m) { const size_t r = (size_t)(row0 + ai * HALF + m * 16);
#pragma unroll
                for (int bj = 0; bj < 2; ++bj) { f32x4 b0, b1; unpack8(gb[m][bj], b0, b1); *(u32x4*)(out + r * D + col0 + bj * HALF) = pack8(acc[ai][bj][m][0] * b0, acc[ai][bj][m][1] * b1); } }
            asm volatile("" ::: "memory"); }
    }
};
struct EpiMix {
    static constexpr bool HAS_MID = false;
    const float* x; const float* mod; bf16_t* h;
    static constexpr int NSB = 0, NST = 0; static constexpr bool TPROBE = false;
    __device__ __forceinline__ const char* sb_ptr(const Unit&, int) const { return nullptr; }
    __device__ __forceinline__ int sb_lanes(int) const { return 0; }
    __device__ __forceinline__ bool keep(const Unit&) const { return false; }
    __device__ __forceinline__ void operator()(f32x4 (&acc)[2][2][4][2], const Unit& u, int wr, int wc, int fr, int fq, const LAS unsigned char* side) const {
        const int row0 = u.pm * BM + wr * 64 + fr, col0 = u.pn * BM + wc * 32 + 8 * fq, b = u.pm >> 3;
        f32x4 g[2][2];
#pragma unroll
        for (int bj = 0; bj < 2; ++bj) { const float* gp = mod + (size_t)b * 6144 + 2048 + col0 + bj * HALF; g[bj][0] = *(const f32x4*)gp; g[bj][1] = *(const f32x4*)(gp + 4); }
#pragma unroll
        for (int ai = 0; ai < 2; ++ai) {
            f32x4 xv[4][2][2];
#pragma unroll
            for (int m = 0; m < 4; ++m)
#pragma unroll
                for (int bj = 0; bj < 2; ++bj) { const float* xp = x + (size_t)(row0 + ai * HALF + m * 16) * D + col0 + bj * HALF; xv[m][bj][0] = *(const f32x4*)xp; xv[m][bj][1] = *(const f32x4*)(xp + 4); }
#pragma unroll
            for (int m = 0; m < 4; ++m) { const size_t r = (size_t)(row0 + ai * HALF + m * 16);
#pragma unroll
                for (int bj = 0; bj < 2; ++bj) *(u32x4*)(h + r * D + col0 + bj * HALF) = pack8(xv[m][bj][0] + g[bj][0] * acc[ai][bj][m][0], xv[m][bj][1] + g[bj][1] * acc[ai][bj][m][1]); }
            asm volatile("" ::: "memory"); }
    }
};
struct EpiSwiglu {
    static constexpr bool HAS_MID = false;
    static constexpr float WSC = 1.0f / 32.0f;
    const float* b1; unsigned char* act; unsigned* tpw;
    __device__ __forceinline__ unsigned* tp_words() const { return tpw; }
    static constexpr bool TPROBE = false;
    static constexpr int NSB = 2, NST = 8;
    __device__ __forceinline__ const char* sb_ptr(const Unit& u, int k) const { return (const char*)(b1 + (size_t)u.e * 2048 + k * 1024 + u.pn * HALF); }
    __device__ __forceinline__ int sb_lanes(int) const { return 32; }
    __device__ __forceinline__ bool keep(const Unit&) const { return false; }
    __device__ __forceinline__ void operator()(f32x4 (&acc)[2][2][4][2], const Unit& u, int wr, int wc, int fr, int fq, const LAS unsigned char* side) const {
        const int row0 = u.pm * BM + wr * 64 + fr, hc0 = u.pn * HALF + wc * 32 + 8 * fq;
        const LAS float* bp = (const LAS float*)side + wc * 32 + 8 * fq;
        const f32x4 bg0 = *(const LAS f32x4*)bp, bg1 = *(const LAS f32x4*)(bp + 4), bl0 = *(const LAS f32x4*)(bp + 256), bl1 = *(const LAS f32x4*)(bp + 260);
#pragma unroll
        for (int ai = 0; ai < 2; ++ai)
#pragma unroll
            for (int m = 0; m < 4; ++m) { const size_t r = (size_t)(row0 + ai * HALF + m * 16);
                f32x4 o0, o1;
#pragma unroll
                for (int j = 0; j < 4; ++j) {
                    float gl = fminf(acc[ai][0][m][0][j] * WSC + bg0[j], SW_LIMIT), li = fminf(fmaxf(acc[ai][1][m][0][j] * WSC + bl0[j], -SW_LIMIT), SW_LIMIT);
                    o0[j] = gl * sigmoidf_(SW_ALPHA * gl) * (li + 1.0f);
                    gl = fminf(acc[ai][0][m][1][j] * WSC + bg1[j], SW_LIMIT); li = fminf(fmaxf(acc[ai][1][m][1][j] * WSC + bl1[j], -SW_LIMIT), SW_LIMIT);
                    o1[j] = gl * sigmoidf_(SW_ALPHA * gl) * (li + 1.0f); }
                *(u32x2*)(act + r * DFF + hc0) = (u32x2){pk4_fp8_nc(o0[0], o0[1], o0[2], o0[3]), pk4_fp8_nc(o1[0], o1[1], o1[2], o1[3])}; }
    }
};
struct EpiMoeOut {
    static constexpr bool HAS_MID = false;
    const float* b2; const float* rw; unsigned char* ya;
    static constexpr bool TPROBE = false;
    static constexpr int NSB = 2, NST = 16;
    __device__ __forceinline__ const char* sb_ptr(const Unit& u, int k) const { return k == 0 ? (const char*)(b2 + (size_t)u.e * D + u.pn * BM) : (const char*)(rw + u.pm * BM); }
    __device__ __forceinline__ int sb_lanes(int) const { return 64; }
    __device__ __forceinline__ bool keep(const Unit&) const { return false; }
    __device__ __forceinline__ void operator()(f32x4 (&acc)[2][2][4][2], const Unit& u, int wr, int wc, int fr, int fq, const LAS unsigned char* side) const {
        const int lrow0 = wr * 64 + fr, col0 = u.pn * BM + wc * 32 + 8 * fq, row_t = u.pm * BM;
        unsigned char* tbase = ya + (size_t)row_t * D + col0;
        const LAS float* sb = (const LAS float*)side; const LAS float* srw = (const LAS float*)(side + 1024);
        f32x4 bv[2][2];
#pragma unroll
        for (int bj = 0; bj < 2; ++bj) { const LAS float* bp = sb + bj * HALF + wc * 32 + 8 * fq; bv[bj][0] = *(const LAS f32x4*)bp; bv[bj][1] = *(const LAS f32x4*)(bp + 4); }
#pragma unroll
        for (int ai = 0; ai < 2; ++ai)
#pragma unroll
            for (int m = 0; m < 4; ++m) { const int lr = lrow0 + ai * HALF + m * 16; const float w = srw[lr]; unsigned char* dst = tbase + (size_t)lr * D;
#pragma unroll
                for (int bj = 0; bj < 2; ++bj) { const f32x4 o0 = (acc[ai][bj][m][0] * (1.0f / 32.0f) + bv[bj][0]) * w, o1 = (acc[ai][bj][m][1] * (1.0f / 32.0f) + bv[bj][1]) * w;
                    *(u32x2*)(dst + bj * HALF) = (u32x2){pk4_fp8(o0[0], o0[1], o0[2], o0[3]), pk4_fp8(o1[0], o1[1], o1[2], o1[3])}; } }
    }
};
}

struct Args { const float* in[20]; float* out; unsigned char* ws; int ph_lo, ph_hi; };

__device__ __forceinline__ void transpose_item(const float* W, int N, bf16_t* WT, int ldwt, int k0, int n0, int dst_row0, LAS float* scr, int lane) {
    const int ks = lane >> 4, n4 = (lane & 15) * 4;
    f32x4 v[16];
#pragma unroll
    for (int i = 0; i < 16; ++i) v[i] = *(const f32x4*)(W + (size_t)(k0 + 4 * i + ks) * N + n0 + n4);
#pragma unroll
    for (int i = 0; i < 16; ++i) { LAS float* s = scr + (4 * i + ks) * 65 + n4; s[0] = v[i][0]; s[1] = v[i][1]; s[2] = v[i][2]; s[3] = v[i][3]; }
    LDS_WAIT(); asm volatile("" ::: "memory");
    const int kc = lane & 7;
#pragma unroll
    for (int p = 0; p < 8; ++p) { const int n = (lane >> 3) + 8 * p; const LAS float* s = scr + (8 * kc) * 65 + n;
        u32x4 o; o.x = cvt_pk_bf16(s[0], s[65]); o.y = cvt_pk_bf16(s[2 * 65], s[3 * 65]); o.z = cvt_pk_bf16(s[4 * 65], s[5 * 65]); o.w = cvt_pk_bf16(s[6 * 65], s[7 * 65]);
        *(u32x4*)(WT + (size_t)(dst_row0 + n) * ldwt + k0 + 8 * kc) = o; }
    LDS_WAIT(); asm volatile("" ::: "memory");
}

template <bool NT = false>
__device__ __forceinline__ void transpose_item_fp8(const float* W, int N, unsigned char* WT, int ldwt, int k0, int n0, int dst_row0, LAS float* scr, int lane) {
    const int ks = lane >> 3, n4 = (lane & 7) * 4;
    f32x4 v[16];
#pragma unroll
    for (int i = 0; i < 16; ++i) { const f32x4* p = (const f32x4*)(W + (size_t)(k0 + 8 * i + ks) * N + n0 + n4); v[i] = NT ? __builtin_nontemporal_load(p) : *p; }
#pragma unroll
    for (int i = 0; i < 16; ++i) { LAS float* s = scr + (8 * i + ks) * 33 + n4; s[0] = v[i][0]; s[1] = v[i][1]; s[2] = v[i][2]; s[3] = v[i][3]; }
    LDS_WAIT(); asm volatile("" ::: "memory");
    const int kc = lane & 7;
#pragma unroll
    for (int p = 0; p < 4; ++p) { const int n = (lane >> 3) + 8 * p; const LAS float* s = scr + (16 * kc) * 33 + n;
        u32x4 o;
        o.x = pk4_fp8(32.f * s[0], 32.f * s[33], 32.f * s[2 * 33], 32.f * s[3 * 33]); o.y = pk4_fp8(32.f * s[4 * 33], 32.f * s[5 * 33], 32.f * s[6 * 33], 32.f * s[7 * 33]);
        o.z = pk4_fp8(32.f * s[8 * 33], 32.f * s[9 * 33], 32.f * s[10 * 33], 32.f * s[11 * 33]); o.w = pk4_fp8(32.f * s[12 * 33], 32.f * s[13 * 33], 32.f * s[14 * 33], 32.f * s[15 * 33]);
        u32x4* q = (u32x4*)(WT + (size_t)(dst_row0 + n) * ldwt + k0 + 16 * kc); if (NT) __builtin_nontemporal_store(o, q); else *q = o; }
    LDS_WAIT(); asm volatile("" ::: "memory");
}

constexpr int BG_W1 = 32 * 8 * 64, BG_W2 = 32 * 8 * 32, BG_N = BG_W1 + BG_W2;
struct BgCtx { const float* w1; const float* w2; unsigned char* W1q; unsigned char* W2q; unsigned* qhead; };
__device__ __forceinline__ bool bg_item(const BgCtx& c, LAS float* scr, int lane) {
    unsigned it = 0; if (lane == 0) it = __hip_atomic_fetch_add(c.qhead, 1u, __ATOMIC_RELAXED, __HIP_MEMORY_SCOPE_AGENT);
    it = (unsigned)__builtin_amdgcn_readfirstlane((int)it);
    if (it >= (unsigned)BG_N) return false;
    if (it < (unsigned)BG_W1) { const int r = (int)it, e = r / 512, q = r % 512, kb = q / 64, nb = q % 64;
        const int pn = nb >> 3, wi = (nb & 7) * 32; const int src = wi < 128 ? pn * 128 + wi : 1024 + pn * 128 + (wi - 128);
        transpose_item_fp8<true>(c.w1 + (size_t)e * D * 2048, 2048, c.W1q + (size_t)e * 2048 * D, D, kb * 128, src, nb * 32, scr, lane); }
    else { const int r = (int)it - BG_W1, e = r / 256, q = r % 256, kb = q / 32, nb = q % 32;
        transpose_item_fp8<true>(c.w2 + (size_t)e * DFF * D, D, c.W2q + (size_t)e * D * DFF, DFF, kb * 128, nb * 32, nb * 32, scr, lane); }
    return true;
}
__device__ __forceinline__ void xcd_barrier_bg(const XcdBarrier& b, const BgCtx& c, LAS unsigned char* lds, int wave, int lane, bool drain) {
    volatile LAS unsigned* M = (volatile LAS unsigned*)(lds + MISC_OFF);
    LAS float* scr = (LAS float*)(lds + wave * 16896);
    if (drain) { while (bg_item(c, scr, lane)) { } }
    asm volatile("s_waitcnt vmcnt(0)" ::: "memory");
    __syncthreads();
    if (threadIdx.x == 0) {
        unsigned* bar = b.bar;
        __builtin_amdgcn_s_waitcnt(0);
        unsigned nloc = b.st[0], nx = b.st[1];
        if (nloc == 0u) { xcd_barrier_complete(bar, b.x, nloc, nx); b.st[0] = nloc; b.st[1] = nx; }
        const unsigned old = xb_add(&bar[XB_XSUB(b.x)], 1u);
        const unsigned gen = old / nloc;
        if (old + 1u == (gen + 1u) * nloc) {
            __builtin_amdgcn_fence(__ATOMIC_RELEASE, "agent");
            asm volatile("s_waitcnt vmcnt(0)" ::: "memory");
            const unsigned og = xb_add(&bar[XB_TOP], 1u);
            const unsigned tg = og / nx;
            if (og + 1u == (tg + 1u) * nx) { xb_add(&bar[XB_TOPGEN], 1u); M[10] = 2u; } else M[10] = 1u;
            M[11] = tg;
        } else { M[10] = 0u; M[11] = gen; }
    }
    unsigned spins = 0;
    for (;;) {
        if (threadIdx.x == 0) { const unsigned role = M[10], g = M[11]; unsigned* bar = b.bar;
            bool rel = role == 2u ? true : role == 1u ? (xb_ld(&bar[XB_TOPGEN]) != g) : (xb_ld(&bar[XB_XGEN(b.x)]) != g);
            if (!rel && (++spins & 255u) == 0u) { if (xb_ld(&bar[XB_TMO])) rel = true; else if (spins > XB_SPIN_CAP) { atomicAdd(&bar[XB_TMO], 1u); rel = true; } }
            M[12] = rel ? 1u : 0u; }
        asm volatile("s_waitcnt lgkmcnt(0)" ::: "memory"); __syncthreads();
        const bool rel = M[12] != 0u;
        asm volatile("s_waitcnt lgkmcnt(0)" ::: "memory"); __syncthreads();
        if (rel) break;
        if (M[13] != 0u || !bg_item(c, scr, lane)) { M[13] = 1u; __builtin_amdgcn_s_sleep(16); }
    }
    if (threadIdx.x == 0) {
        __builtin_amdgcn_fence(__ATOMIC_ACQUIRE, "agent");
        if (M[10] != 0u) xb_add(&b.bar[XB_XGEN(b.x)], 1u);
        asm volatile("s_waitcnt vmcnt(0)" ::: "memory");
    }
    __syncthreads();
}

__global__ void __launch_bounds__(NTHREADS, 2) fwd_kernel(Args args) {
    extern __shared__ __attribute__((aligned(16))) unsigned char lds_raw[];
    LAS unsigned char* lds = (LAS unsigned char*)lds_raw;
    volatile LAS unsigned* MISC = (volatile LAS unsigned*)(lds + MISC_OFF);
    const int G = gridDim.x, bid = blockIdx.x;
    const int wave_sg = __builtin_amdgcn_readfirstlane((int)threadIdx.x >> 6);
#define PHASE_IDS() int lane; asm volatile("v_mbcnt_lo_u32_b32 %0, -1, 0\n\tv_mbcnt_hi_u32_b32 %0, -1, %0" : "=v"(lane)); const int wave = wave_sg; const int tid = wave * 64 + lane; const int gw = bid * NWAVES + wave, NGW = G * NWAVES; (void)lane; (void)wave; (void)gw; (void)NGW
#define CAS __attribute__((address_space(4)))
#define PHASE_ARGS() const CAS Args* ap = (const CAS Args*)__builtin_amdgcn_kernarg_segment_ptr(); asm volatile("" : "+s"(ap)); unsigned char* const ws = ap->ws; unsigned* const ctl = (unsigned*)(ws + WS_CTL); (void)ctl
#define ARG(i) (ap->in[i])
#define WSP(T, off) ((T*)(ws + (off)))
    enum { I_X = 0, I_C, I_WADA, I_BADA, I_NMIX, I_WIN, I_LBT, I_HGNW, I_CONVW, I_WHG, I_WCV, I_WMIX, I_NFFN, I_WR, I_BR, I_W1, I_B1, I_W2, I_B2, I_NFIN };
    { PHASE_IDS(); for (int u = tid; u < 64; u += NTHREADS) MISC[u] = 0u; }
    __syncthreads();
    XcdBarrier bar; bar.bar = nullptr; bar.x = 0; bar.st = nullptr;
#if MK_ONE_LAUNCH
    { PHASE_ARGS(); bar = xcd_barrier_post(ctl + CW_BAR, MISC + 8); }
#if MK_BG
#define GRID_BAR_X(drain) do { PHASE_IDS(); PHASE_ARGS(); const BgCtx bgc{ARG(I_W1), ARG(I_W2), WSP(unsigned char, WS_W1), WSP(unsigned char, WS_W2), ctl + CW_Q}; xcd_barrier_bg(bar, bgc, lds, wave, lane, drain); } while (0)
#define GRID_BAR() GRID_BAR_X(false)
#else
#define GRID_BAR() xcd_barrier(bar)
#endif
#else
#define GRID_BAR() do { } while (0)
#endif
    const int lo = args.ph_lo, hi = args.ph_hi;
#if MK_PHT
    const unsigned long long pht0 = __builtin_amdgcn_s_memrealtime(); unsigned long long phtk = 0;
#endif
#ifndef PH_MASK
#define PH_MASK 0x7ff
#endif
#define IN(k) (((PH_MASK >> (k)) & 1) && lo <= (k) && (k) < hi)
#define BOTH(k) (IN(k) && IN((k) + 1))

    if (IN(0)) for (int rep_ = 0; rep_ < 1 + ((MK_REPEAT >> 0) & 1); ++rep_) { PHASE_IDS(); PHASE_ARGS();
        const float* cvec = ARG(I_C); const float* w_ada = ARG(I_WADA); const float* b_ada = ARG(I_BADA); const float* lbtab = ARG(I_LBT);
        const float* w_in = ARG(I_WIN); const float* w_hg = ARG(I_WHG); const float* w_cv = ARG(I_WCV); const float* w_mix = ARG(I_WMIX); const float* w1 = ARG(I_W1); const float* w2 = ARG(I_W2);
        float* MOD = WSP(float, WS_MOD); float* LB = WSP(float, WS_LB);
        bf16_t* Win_t = WSP(bf16_t, WS_WIN); bf16_t* Whg_t = WSP(bf16_t, WS_WHG); bf16_t* Wcv_t = WSP(bf16_t, WS_WHG) + 512;        bf16_t* Wmix_t = WSP(bf16_t, WS_WMIX); unsigned char* W1_t = WSP(unsigned char, WS_W1); unsigned char* W2_t = WSP(unsigned char, WS_W2);
        LAS float* scr = (LAS float*)(lds + wave * 16896);
        for (int it = gw; it < 384; it += NGW) {
            const int n0 = it * 16, cl = lane & 15, kq = lane >> 4;
            float acc[32];
#pragma unroll
            for (int b = 0; b < 32; ++b) acc[b] = 0.f;
            for (int ch = 0; ch < 16; ++ch) {
                { const int b = lane >> 1, part = lane & 1;
#pragma unroll
                    for (int q = 0; q < 4; ++q) {
                        const float* cp = cvec + (size_t)b * D + q * 256 + ch * 16 + part * 8;
                        const f32x4 c0 = *(const f32x4*)cp, c1 = *(const f32x4*)(cp + 4);
#pragma unroll
                        for (int j = 0; j < 4; ++j) { scr[(q * 16 + part * 8 + j) * 32 + b] = c0[j] * sigmoidf_(c0[j]); scr[(q * 16 + part * 8 + 4 + j) * 32 + b] = c1[j] * sigmoidf_(c1[j]); }
                    } }
                float wv[16];
#pragma unroll
                for (int kk = 0; kk < 16; ++kk) wv[kk] = w_ada[(size_t)(kq * 256 + ch * 16 + kk) * 6144 + n0 + cl];
                LDS_WAIT(); asm volatile("" ::: "memory");
#pragma unroll
                for (int kk = 0; kk < 16; ++kk) {
                    const LAS f32x4* sp = (const LAS f32x4*)(scr + (kq * 16 + kk) * 32);
#pragma unroll
                    for (int b4 = 0; b4 < 8; ++b4) { const f32x4 s = sp[b4]; acc[4 * b4] += wv[kk] * s[0]; acc[4 * b4 + 1] += wv[kk] * s[1]; acc[4 * b4 + 2] += wv[kk] * s[2]; acc[4 * b4 + 3] += wv[kk] * s[3]; }
                }
                LDS_WAIT(); asm volatile("" ::: "memory");
            }
            const float bias = b_ada[n0 + cl];
#pragma unroll
            for (int b = 0; b < 32; ++b) { float v = acc[b]; v += __shfl_xor(v, 16); v += __shfl_xor(v, 32); if (kq == 0) MOD[(size_t)b * 6144 + n0 + cl] = v + bias; }
        }
        if (bid == (G > 1 ? 1 : 0)) { const int k = tid; const float l0 = lbtab[k], l1 = lbtab[HW + k]; LB[k] = fast_rcp(1.0f + fast_exp(l1 - l0)); }
        {
            constexpr int I_IN = 16 * 88, I_HG = 8 * 16, I_CV = 8 * 16, I_MIX = 16 * 16, I_W1 = 32 * 8 * 64, I_W2 = 32 * 8 * 32;
            constexpr int NITEMS = I_IN + I_HG + I_CV + I_MIX + ((MK_BG && MK_ONE_LAUNCH) ? 0 : I_W1 + I_W2);
            for (int it = gw; it < NITEMS; it += NGW) {
                int r = it;
#if MK_P2FP8
                if (r < I_IN) { const int kb = r / 176, nb = r % 176; transpose_item_fp8(w_in, INC, (unsigned char*)Win_t, D, kb * 128, nb * 32, nb * 32, scr, lane); continue; } r -= I_IN;
#else
                if (r < I_IN) { const int kb = r / 88, nb = r % 88; const int pn = nb >> 2, wi = (nb & 3) * 64;
                    const int src = pn < 10 ? nb * 64 : pn < 14 ? (wi < 128 ? 2560 + (pn - 10) * 128 + wi : 3072 + (pn - 10) * 128 + (wi - 128)) : (wi < 128 ? 3584 + (pn - 14) * 128 + wi : 4608 + (pn - 14) * 128 + (wi - 128));
                    transpose_item(w_in, INC, Win_t, D, kb * 64, src, nb * 64, scr, lane); continue; } r -= I_IN;
#endif
                if (r < I_HG) { const int kb = r / 16, nb = r % 16; transpose_item(w_hg, D, Whg_t, D, kb * 64, nb * 64, nb * 64, scr, lane); continue; } r -= I_HG;
                if (r < I_CV) { const int kb = r / 16, nb = r % 16; transpose_item(w_cv, D, Wcv_t, D, kb * 64, nb * 64, nb * 64, scr, lane); continue; } r -= I_CV;
                if (r < I_MIX) { const int kb = r / 16, nb = r % 16; transpose_item(w_mix, D, Wmix_t, D, kb * 64, nb * 64, nb * 64, scr, lane); continue; } r -= I_MIX;
                if (r < I_W1) { const int e = r / 512, q = r % 512, kb = q / 64, nb = q % 64;
                    const int pn = nb >> 3, wi = (nb & 7) * 32; const int src = wi < 128 ? pn * 128 + wi : 1024 + pn * 128 + (wi - 128);
                    transpose_item_fp8(w1 + (size_t)e * D * 2048, 2048, W1_t + (size_t)e * 2048 * D, D, kb * 128, src, nb * 32, scr, lane); continue; } r -= I_W1;
                { const int e = r / 256, q = r % 256, kb = q / 32, nb = q % 32;
                    transpose_item_fp8(w2 + (size_t)e * DFF * D, D, W2_t + (size_t)e * D * DFF, DFF, kb * 128, nb * 32, nb * 32, scr, lane); }
            }
        }
        if (BOTH(0)) GRID_BAR();
#if MK_PHT
        if (MK_PHT == 1) phtk = __builtin_amdgcn_s_memrealtime() - pht0;
#endif
    }

    if (IN(1)) for (int rep_ = 0; rep_ < 1 + ((MK_REPEAT >> 1) & 1); ++rep_) { PHASE_IDS(); PHASE_ARGS();
        const float* x = ARG(I_X); const float* norm_mix_w = ARG(I_NMIX); const float* MOD = WSP(float, WS_MOD); bf16_t* U = WSP(bf16_t, WS_U);
        for (int m0 = gw * 32; m0 < NTOK; m0 += NGW * 32) {
            const int b = m0 >> 11;
            f32x4 A[4], Sh[4];
#pragma unroll
            for (int j = 0; j < 4; ++j) { const int k = 4 * lane + 256 * j; const f32x4 w = *(const f32x4*)(norm_mix_w + k), sc = *(const f32x4*)(MOD + (size_t)b * 6144 + 1024 + k);
                A[j] = w * (sc + 1.0f); Sh[j] = *(const f32x4*)(MOD + (size_t)b * 6144 + k); }
            for (int r = 0; r < 32; r += 4) {
                f32x4 v[4][4]; float ss[4];
#pragma unroll
                for (int q = 0; q < 4; ++q) { const float* xr = x + (size_t)(m0 + r + q) * D; ss[q] = 0.f;
#pragma unroll
                    for (int j = 0; j < 4; ++j) v[q][j] = *(const f32x4*)(xr + 4 * lane + 256 * j); }
#pragma unroll
                for (int q = 0; q < 4; ++q) {
#pragma unroll
                    for (int j = 0; j < 4; ++j) ss[q] += (v[q][j][0] * v[q][j][0] + v[q][j][1] * v[q][j][1]) + (v[q][j][2] * v[q][j][2] + v[q][j][3] * v[q][j][3]);
                    const float rs = __builtin_amdgcn_rsqf(wave_sum(ss[q]) * (1.0f / D) + EPS);
#if MK_P2FP8
                    unsigned char* ur = (unsigned char*)U + (size_t)(m0 + r + q) * D;
#pragma unroll
                    for (int j = 0; j < 4; ++j) { const f32x4 o = v[q][j] * rs * A[j] + Sh[j]; *(unsigned*)(ur + 4 * lane + 256 * j) = pk4_fp8(o[0], o[1], o[2], o[3]); }
#else
                    bf16_t* ur = U + (size_t)(m0 + r + q) * D;
#pragma unroll
                    for (int j = 0; j < 4; ++j) { const f32x4 o = v[q][j] * rs * A[j] + Sh[j]; u32x2 w; w.x = cvt_pk_bf16(o[0], o[1]); w.y = cvt_pk_bf16(o[2], o[3]); *(u32x2*)(ur + 4 * lane + 256 * j) = w; }
#endif
                }
            }
        }
        if (BOTH(1)) GRID_BAR();
#if MK_PHT
        if (MK_PHT == 2) phtk = __builtin_amdgcn_s_memrealtime() - pht0;
#endif
    }

    if (IN(2)) for (int rep_ = 0; rep_ < 1 + ((MK_REPEAT >> 2) & 1); ++rep_) { PHASE_ARGS();
        gm::DenseOrder S{NTOK / 256, INC / 256, G, bid, 1}; gm::DenseA AM{D, 0u, MK_P2FP8 ? 1 : 2}; gm::EpiProj E{WSP(bf16_t, WS_PROJ), (bf16_t*)ap->out, WSP(float, WS_LB)};
        gm::gemm_phase<(MK_P2FP8 != 0)>(wave_sg, lds, (const char*)WSP(bf16_t, WS_U), (const char*)WSP(bf16_t, WS_WIN), D, 0, 0u, S, E, AM);
        if (BOTH(2)) GRID_BAR();
#if MK_PHT
        if (MK_PHT == 3) phtk = __builtin_amdgcn_s_memrealtime() - pht0;
#endif
    }

    if (IN(3)) for (int rep_ = 0; rep_ < 1 + ((MK_REPEAT >> 3) & 1); ++rep_) { PHASE_IDS(); PHASE_ARGS();
        const float* hg_norm_w = ARG(I_HGNW); const float* conv_w = ARG(I_CONVW); const bf16_t* PROJ = WSP(bf16_t, WS_PROJ); bf16_t* OB = WSP(bf16_t, WS_O); bf16_t* CVB = WSP(bf16_t, WS_O) + 512;
        const int nchainblk = (G >= 256) ? 128 : (G >= 2 ? G / 2 : 1);
        if (bid < nchainblk) {
            constexpr int LDQ = 136, LDT = 72;
            LAS bf16_t* QT = (LAS bf16_t*)(lds);
            LAS bf16_t* KT = QT + 64 * LDQ;
            LAS bf16_t* QB = KT + 64 * LDQ;
            LAS bf16_t* KBT = QB + 64 * LDQ;
            LAS bf16_t* VT = KBT + 128 * LDT;
            LAS bf16_t* PM = VT + 128 * LDT;
            LAS bf16_t* ST = PM + 64 * LDT;
            LAS bf16_t* OS = ST + 128 * LDQ;
            LAS float* SEG = (LAS float*)(OS + 64 * LDQ);
            LAS float* DEC = SEG + 8 * 128;
            const int fr = lane & 15, fq = lane >> 4, w = wave;
            for (int chain = bid; chain < BATCH * NHEAD; chain += nchainblk) {
                const int b = chain >> 2, h = chain & 3;
                __syncthreads();
                for (int i = tid; i < 128 * LDQ / 2; i += NTHREADS) ((LAS unsigned*)ST)[i] = 0u;
                f32x4 Sacc[8];
#pragma unroll
                for (int i = 0; i < 8; ++i) Sacc[i] = (f32x4){0.f, 0.f, 0.f, 0.f};
                const int ot = tid >> 3, ocg = tid & 7;
                f32x4 nwv[4];
#pragma unroll
                for (int q = 0; q < 2; ++q) { nwv[2 * q] = *(const f32x4*)(hg_norm_w + q * 64 + 8 * ocg); nwv[2 * q + 1] = *(const f32x4*)(hg_norm_w + q * 64 + 8 * ocg + 4); }
                const bf16_t* pbase = PROJ + (size_t)(b * SEQ) * PROJ_LD + h * DK;
                unsigned rq[8], rl[8], rv[8];
#pragma unroll
                for (int r = 0; r < 8; ++r) { const bf16_t* p = pbase + (size_t)(8 * w + r) * PROJ_LD + 2 * lane; rq[r] = *(const unsigned*)p; rl[r] = *(const unsigned*)(p + 512); rv[r] = *(const unsigned*)(p + 1024); }
                for (int c = 0; c < NCHUNK; ++c) {
                    const int m0 = c * CHUNK;
                    float cs0[8], cs1[8]; { float a0 = 0.f, a1 = 0.f;
#pragma unroll
                        for (int r = 0; r < 8; ++r) { a0 += bf_lo(rl[r]); a1 += bf_hi(rl[r]); cs0[r] = a0; cs1[r] = a1; }
                        *(LAS f32x2*)(SEG + w * 128 + 2 * lane) = (f32x2){a0, a1}; }
                    LDS_WAIT(); __builtin_amdgcn_s_barrier(); asm volatile("" ::: "memory");
                    float pre0 = 0.f, pre1 = 0.f, bm0 = 0.f, bm1 = 0.f, bl0 = 0.f, bl1 = 0.f;
#pragma unroll
                    for (int s = 0; s < 8; ++s) { const f32x2 t2 = *(const LAS f32x2*)(SEG + s * 128 + 2 * lane); if (s < w) { pre0 += t2[0]; pre1 += t2[1]; } if (s < 4) { bm0 += t2[0]; bm1 += t2[1]; } bl0 += t2[0]; bl1 += t2[1]; }
                    const float em0 = fast_exp(fmaxf(bm0, -80.f)), em1 = fast_exp(fmaxf(bm1, -80.f));
                    const float el0 = fast_exp(fmaxf(bl0 - bm0, -80.f)), el1 = fast_exp(fmaxf(bl1 - bm1, -80.f));
                    if (w == 0) *(LAS f32x2*)(DEC + 2 * lane) = (f32x2){fast_exp(fmaxf(bl0, -80.f)), fast_exp(fmaxf(bl1, -80.f))};
                    unsigned kb0[4], kb1[4], vt0[4], vt1[4];
#pragma unroll
                    for (int r = 0; r < 8; ++r) {
                        const int t = 8 * w + r;
                        const float lf0 = bf_lo(rl[r]), lf1 = bf_hi(rl[r]);
                        const float d0 = fminf(fmaxf(pre0 + cs0[r] - bm0, -80.f), 80.f), d1 = fminf(fmaxf(pre1 + cs1[r] - bm1, -80.f), 80.f);
                        const float e0 = fast_exp(d0), e1 = fast_exp(d1), i0 = fast_exp(-d0), i1 = fast_exp(-d1);
                        const float kk0 = 1.0f - fast_exp(lf0), kk1 = 1.0f - fast_exp(lf1);
                        const float qt0 = bf_lo(rq[r]) * e0, qt1 = bf_hi(rq[r]) * e1, kt0 = kk0 * i0, kt1 = kk1 * i1;
                        *(LAS unsigned*)(QT + t * LDQ + 2 * lane) = cvt_pk_bf16(qt0, qt1);
                        *(LAS unsigned*)(KT + t * LDQ + 2 * lane) = cvt_pk_bf16(kt0, kt1);
                        *(LAS unsigned*)(QB + t * LDQ + 2 * lane) = cvt_pk_bf16(qt0 * em0, qt1 * em1);
                        const unsigned kbp = cvt_pk_bf16(kt0 * el0, kt1 * el1);
                        if (r & 1) { kb0[r >> 1] |= (kbp << 16); kb1[r >> 1] |= (kbp & 0xffff0000u); vt0[r >> 1] |= (rv[r] << 16); vt1[r >> 1] |= (rv[r] & 0xffff0000u); }
                        else { kb0[r >> 1] = kbp & 0xffffu; kb1[r >> 1] = kbp >> 16; vt0[r >> 1] = rv[r] & 0xffffu; vt1[r >> 1] = rv[r] >> 16; }
                    }
                    *(LAS u32x4*)(KBT + (2 * lane) * LDT + 8 * w) = (u32x4){kb0[0], kb0[1], kb0[2], kb0[3]};
                    *(LAS u32x4*)(KBT + (2 * lane + 1) * LDT + 8 * w) = (u32x4){kb1[0], kb1[1], kb1[2], kb1[3]};
                    *(LAS u32x4*)(VT + (2 * lane) * LDT + 8 * w) = (u32x4){vt0[0], vt0[1], vt0[2], vt0[3]};
                    *(LAS u32x4*)(VT + (2 * lane + 1) * LDT + 8 * w) = (u32x4){vt1[0], vt1[1], vt1[2], vt1[3]};
                    LDS_WAIT(); __builtin_amdgcn_s_barrier(); asm volatile("" ::: "memory");
                    u32x4 gg[2];
                    { const bf16_t* gp = pbase + (size_t)(m0 + ot) * PROJ_LD + 1536 + 8 * ocg; gg[0] = *(const u32x4*)gp; gg[1] = *(const u32x4*)(gp + 64); }
                    if (c + 1 < NCHUNK) {
#pragma unroll
                        for (int r = 0; r < 8; ++r) { const bf16_t* p = pbase + (size_t)(m0 + CHUNK + 8 * w + r) * PROJ_LD + 2 * lane; rq[r] = *(const unsigned*)p; rl[r] = *(const unsigned*)(p + 512); rv[r] = *(const unsigned*)(p + 1024); }
                    }
#pragma unroll
                    for (int x2 = 0; x2 < 2; ++x2) { const int id = 2 * w + x2, si = id >> 2, ti = id & 3;
                        f32x4 sc = (f32x4){0.f, 0.f, 0.f, 0.f};
                        if (si <= ti) {
#pragma unroll
                            for (int ks = 0; ks < 4; ++ks) { const bf16x8 a = *(const LAS bf16x8*)(KT + (16 * si + fr) * LDQ + 32 * ks + 8 * fq), bb = *(const LAS bf16x8*)(QT + (16 * ti + fr) * LDQ + 32 * ks + 8 * fq);
                                sc = __builtin_amdgcn_mfma_f32_16x16x32_bf16(a, bb, sc, 0, 0, 0); }
                            const int t = 16 * ti + fr, s0 = 16 * si + 4 * fq;
#pragma unroll
                            for (int j = 0; j < 4; ++j) sc[j] = (s0 + j <= t) ? sc[j] : 0.f;
                        }
                        *(LAS u32x2*)(PM + (16 * ti + fr) * LDT + 16 * si + 4 * fq) = (u32x2){cvt_pk_bf16(sc[0], sc[1]), cvt_pk_bf16(sc[2], sc[3])};
                    }
                    f32x4 oacc[4];
                    { bf16x8 sa[4];
#pragma unroll
                        for (int ks = 0; ks < 4; ++ks) sa[ks] = *(const LAS bf16x8*)(ST + (16 * w + fr) * LDQ + 32 * ks + 8 * fq);
#pragma unroll
                        for (int ti = 0; ti < 4; ++ti) { oacc[ti] = (f32x4){0.f, 0.f, 0.f, 0.f};
#pragma unroll
                            for (int ks = 0; ks < 4; ++ks) { const bf16x8 bb = *(const LAS bf16x8*)(QB + (16 * ti + fr) * LDQ + 32 * ks + 8 * fq); oacc[ti] = __builtin_amdgcn_mfma_f32_16x16x32_bf16(sa[ks], bb, oacc[ti], 0, 0, 0); } } }
                    LDS_WAIT(); __builtin_amdgcn_s_barrier(); asm volatile("" ::: "memory");
                    { bf16x8 va[2];
#pragma unroll
                        for (int ks = 0; ks < 2; ++ks) va[ks] = *(const LAS bf16x8*)(VT + (16 * w + fr) * LDT + 32 * ks + 8 * fq);
#pragma unroll
                        for (int ti = 0; ti < 4; ++ti)
#pragma unroll
                            for (int ks = 0; ks < 2; ++ks) { const bf16x8 bb = *(const LAS bf16x8*)(PM + (16 * ti + fr) * LDT + 32 * ks + 8 * fq); oacc[ti] = __builtin_amdgcn_mfma_f32_16x16x32_bf16(va[ks], bb, oacc[ti], 0, 0, 0); }
#pragma unroll
                        for (int i = 0; i < 8; ++i) { const f32x4 dv = *(const LAS f32x4*)(DEC + 16 * i + 4 * fq); Sacc[i] = Sacc[i] * dv;
#pragma unroll
                            for (int ks = 0; ks < 2; ++ks) { const bf16x8 a = *(const LAS bf16x8*)(KBT + (16 * i + fr) * LDT + 32 * ks + 8 * fq); Sacc[i] = __builtin_amdgcn_mfma_f32_16x16x32_bf16(a, va[ks], Sacc[i], 0, 0, 0); } } }
#pragma unroll
                    for (int ti = 0; ti < 4; ++ti) *(LAS u32x2*)(OS + (16 * ti + fr) * LDQ + 16 * w + 4 * fq) = (u32x2){cvt_pk_bf16(oacc[ti][0], oacc[ti][1]), cvt_pk_bf16(oacc[ti][2], oacc[ti][3])};
#pragma unroll
                    for (int i = 0; i < 8; ++i) *(LAS u32x2*)(ST + (16 * w + fr) * LDQ + 16 * i + 4 * fq) = (u32x2){cvt_pk_bf16(Sacc[i][0], Sacc[i][1]), cvt_pk_bf16(Sacc[i][2], Sacc[i][3])};
                    LDS_WAIT(); __builtin_amdgcn_s_barrier(); asm volatile("" ::: "memory");
                    { f32x4 o[4]; const u32x4 ow0 = *(const LAS u32x4*)(OS + ot * LDQ + 8 * ocg), ow1 = *(const LAS u32x4*)(OS + ot * LDQ + 64 + 8 * ocg); gm::unpack8(ow0, o[0], o[1]); gm::unpack8(ow1, o[2], o[3]);
                        float ss = 0.f;
#pragma unroll
                        for (int q = 0; q < 4; ++q) ss += (o[q][0] * o[q][0] + o[q][1] * o[q][1]) + (o[q][2] * o[q][2] + o[q][3] * o[q][3]);
                        ss += __shfl_xor(ss, 1); ss += __shfl_xor(ss, 2); ss += __shfl_xor(ss, 4);
                        const float rn = __builtin_amdgcn_rsqf(ss * (1.0f / 128.0f) + EPS);
                        bf16_t* op = OB + (size_t)(b * SEQ + m0 + ot) * D + h * DK + 8 * ocg;
#pragma unroll
                        for (int q = 0; q < 2; ++q) { f32x4 g0, g1; gm::unpack8(gg[q], g0, g1);
#pragma unroll
                            for (int j = 0; j < 4; ++j) { g0[j] = g0[j] * sigmoidf_(g0[j]); g1[j] = g1[j] * sigmoidf_(g1[j]); }
                            *(u32x4*)(op + 64 * q) = gm::pack8(o[2 * q] * rn * nwv[2 * q] * g0, o[2 * q + 1] * rn * nwv[2 * q + 1] * g1); } }
                }
            }
        } else {
            const int nconv = G - nchainblk;
            f32x4 cw[3][2];
#pragma unroll
            for (int j = 0; j < 3; ++j) { cw[j][0] = *(const f32x4*)(conv_w + j * 512 + 8 * lane); cw[j][1] = *(const f32x4*)(conv_w + j * 512 + 8 * lane + 4); }
            for (int it = bid - nchainblk; it < BATCH * 8; it += nconv) {
                const int b = it >> 3, t0 = (it & 7) * 256 + wave * 32;
                const bf16_t* pb = PROJ + (size_t)(b * SEQ) * PROJ_LD + 2048 + 8 * lane;
                f32x4 p1[2], p2[2];
#pragma unroll
                for (int q = 0; q < 2; ++q) { p1[q] = (f32x4){0.f, 0.f, 0.f, 0.f}; p2[q] = p1[q]; }
                if (t0 > 0) { gm::unpack8(*(const u32x4*)(pb + (size_t)(t0 - 2) * PROJ_LD + 512), p2[0], p2[1]); gm::unpack8(*(const u32x4*)(pb + (size_t)(t0 - 1) * PROJ_LD + 512), p1[0], p1[1]); }
                for (int r = 0; r < 32; ++r) { const size_t ro = (size_t)(t0 + r) * PROJ_LD;
                    f32x4 q0, q1, g0, g1;
                    gm::unpack8(*(const u32x4*)(pb + ro + 512), q0, q1); gm::unpack8(*(const u32x4*)(pb + ro), g0, g1);
                    const f32x4 y0 = g0 * (cw[0][0] * p2[0] + cw[1][0] * p1[0] + cw[2][0] * q0), y1 = g1 * (cw[0][1] * p2[1] + cw[1][1] * p1[1] + cw[2][1] * q1);
                    *(u32x4*)(CVB + (size_t)(b * SEQ + t0 + r) * D + 8 * lane) = gm::pack8(y0, y1);
                    p2[0] = p1[0]; p2[1] = p1[1]; p1[0] = q0; p1[1] = q1; }
            }
        }
        if (BOTH(3)) GRID_BAR();
#if MK_PHT
        if (MK_PHT == 4) phtk = __builtin_amdgcn_s_memrealtime() - pht0;
#endif
    }

    if (IN(4)) for (int rep_ = 0; rep_ < 1 + ((MK_REPEAT >> 4) & 1); ++rep_) { PHASE_ARGS();
        gm::DenseOrder S{NTOK / 256, D / 256, G, bid, 1}; gm::DenseA AM{D, 0u, 2}; gm::EpiMerge E{(const bf16_t*)ap->out, WSP(bf16_t, WS_U)};
        gm::gemm_phase<false>(wave_sg, lds, (const char*)WSP(bf16_t, WS_O), (const char*)WSP(bf16_t, WS_WHG), D, 0, 0u, S, E, AM);
        if (BOTH(4)) GRID_BAR();
#if MK_PHT
        if (MK_PHT == 5) phtk = __builtin_amdgcn_s_memrealtime() - pht0;
#endif
    }

    if (IN(5)) for (int rep_ = 0; rep_ < 1 + ((MK_REPEAT >> 5) & 1); ++rep_) { PHASE_ARGS();
        gm::DenseOrder S{NTOK / 256, D / 256, G, bid, 1}; gm::DenseA AM{D, 0u, 2}; gm::EpiMix E{ARG(I_X), WSP(float, WS_MOD), WSP(bf16_t, WS_H)};
        gm::gemm_phase<false>(wave_sg, lds, (const char*)WSP(bf16_t, WS_U), (const char*)WSP(bf16_t, WS_WMIX), D, 0, 0u, S, E, AM);
        if (BOTH(5)) GRID_BAR();
#if MK_PHT
        if (MK_PHT == 6) phtk = __builtin_amdgcn_s_memrealtime() - pht0;
#endif
    }

    if (IN(6)) { PHASE_IDS(); PHASE_ARGS();
        typedef float f32x16 __attribute__((ext_vector_type(16)));
        const float* norm_ffn_w = ARG(I_NFFN); const float* w_router = ARG(I_WR); const float* b_router = ARG(I_BR); const float* MOD = WSP(float, WS_MOD);
        const bf16_t* HB = WSP(bf16_t, WS_H); unsigned char* U2Q = WSP(unsigned char, WS_U2Q); int* TOPI = WSP(int, WS_TOPI); float* TOPP = WSP(float, WS_TOPP); int* POS = WSP(int, WS_POS);
        constexpr int WRS = 1032;
        LAS bf16_t* WRH = (LAS bf16_t*)lds; LAS bf16_t* WRL = WRH + 32 * WRS;
        LAS float* LG = (LAS float*)(lds + 132096) + wave * (16 * 36);
        LAS unsigned* LCNT = (LAS unsigned*)(lds + 150528);
        LAS unsigned* LBASE = LCNT + 32;
        LAS unsigned* LASS = LCNT + 64;
        LAS float* A2 = (LAS float*)(lds + 154880); LAS float* SH2 = A2 + 1024;
        for (int i = tid; i < 32 * 1024; i += NTHREADS) { const int e = i & 31, k = i >> 5; const float w = w_router[i];
            const unsigned hi = cvt_pk_bf16(w, 0.f) & 0xffffu; const unsigned lo = cvt_pk_bf16(w - bf_lo(hi), 0.f) & 0xffffu;
            WRH[e * WRS + k] = (bf16_t)hi; WRL[e * WRS + k] = (bf16_t)lo; }
        for (int tb = bid; tb < NTOK / 256; tb += G) {
            const int b = (tb * 256) >> 11;
            if (tid < 32) LCNT[tid] = 0u;
            for (int k = tid; k < 1024; k += NTHREADS) { A2[k] = norm_ffn_w[k] * (1.0f + MOD[(size_t)b * 6144 + 4096 + k]); SH2[k] = MOD[(size_t)b * 6144 + 3072 + k]; }
            LDS_WAIT(); __syncthreads();
            const int trow = lane & 31, half = lane >> 5, ltok0 = wave * 32, tok = tb * 256 + ltok0 + trow;
            const bf16_t* hrow = HB + (size_t)tok * D + 8 * half;
            float ssq = 0.f;
#pragma unroll 8
            for (int st = 0; st < 64; ++st) { const u32x4 hv = *(const u32x4*)(hrow + 16 * st); f32x4 x0, x1; gm::unpack8(hv, x0, x1);
                ssq += (x0[0] * x0[0] + x0[1] * x0[1]) + (x0[2] * x0[2] + x0[3] * x0[3]) + (x1[0] * x1[0] + x1[1] * x1[1]) + (x1[2] * x1[2] + x1[3] * x1[3]); }
            ssq += __shfl_xor(ssq, 32);
            const float rs = __builtin_amdgcn_rsqf(ssq * (1.0f / D) + EPS);
            f32x16 dacc;
#pragma unroll
            for (int q = 0; q < 16; ++q) dacc[q] = 0.f;
            unsigned char* urow = U2Q + (size_t)tok * D + 8 * half;
            const LAS bf16_t* wh = WRH + trow * WRS + 8 * half; const LAS bf16_t* wl = WRL + trow * WRS + 8 * half;
#pragma unroll 2
            for (int st = 0; st < 64; ++st) {
                const u32x4 hv = *(const u32x4*)(hrow + 16 * st); f32x4 x0, x1; gm::unpack8(hv, x0, x1);
                const int k0 = 16 * st + 8 * half;
                const f32x4 a0 = *(const LAS f32x4*)(A2 + k0), a1 = *(const LAS f32x4*)(A2 + k0 + 4), s0 = *(const LAS f32x4*)(SH2 + k0), s1 = *(const LAS f32x4*)(SH2 + k0 + 4);
                const f32x4 u0 = x0 * rs * a0 + s0, u1 = x1 * rs * a1 + s1;
                *(u32x2*)(urow + 16 * st) = (u32x2){pk4_fp8(u0[0], u0[1], u0[2], u0[3]), pk4_fp8(u1[0], u1[1], u1[2], u1[3])};
                u32x4 hh; hh.x = cvt_pk_bf16(u0[0], u0[1]); hh.y = cvt_pk_bf16(u0[2], u0[3]); hh.z = cvt_pk_bf16(u1[0], u1[1]); hh.w = cvt_pk_bf16(u1[2], u1[3]);
                u32x4 ll; ll.x = cvt_pk_bf16(u0[0] - bf_lo(hh.x), u0[1] - bf_hi(hh.x)); ll.y = cvt_pk_bf16(u0[2] - bf_lo(hh.y), u0[3] - bf_hi(hh.y));
                ll.z = cvt_pk_bf16(u1[0] - bf_lo(hh.z), u1[1] - bf_hi(hh.z)); ll.w = cvt_pk_bf16(u1[2] - bf_lo(hh.w), u1[3] - bf_hi(hh.w));
                const bf16x8 ah = __builtin_bit_cast(bf16x8, hh), al = __builtin_bit_cast(bf16x8, ll);
                const bf16x8 bh = *(const LAS bf16x8*)(wh + 16 * st), bl = *(const LAS bf16x8*)(wl + 16 * st);
                dacc = __builtin_amdgcn_mfma_f32_32x32x16_bf16(ah, bh, dacc, 0, 0, 0);
                dacc = __builtin_amdgcn_mfma_f32_32x32x16_bf16(ah, bl, dacc, 0, 0, 0);
                dacc = __builtin_amdgcn_mfma_f32_32x32x16_bf16(al, bh, dacc, 0, 0, 0);
            }
            const float br = b_router[trow];
#pragma unroll
            for (int g = 0; g < 2; ++g) {
#pragma unroll
                for (int q = 0; q < 8; ++q) { const int r16 = (q & 3) + 8 * (q >> 2) + 4 * half; LG[r16 * 36 + trow] = dacc[8 * g + q] + br; }
                LDS_WAIT(); asm volatile("" ::: "memory");
                if (lane < 16) {
                    float v0 = -3.0e38f, v1 = -3.0e38f, v2 = -3.0e38f, v3 = -3.0e38f; int i0 = 0, i1 = 0, i2 = 0, i3 = 0;
#pragma unroll
                    for (int e4 = 0; e4 < 8; ++e4) { const f32x4 lv = *(const LAS f32x4*)(LG + lane * 36 + 4 * e4);
#pragma unroll
                        for (int j = 0; j < 4; ++j) { const float x = lv[j]; const int e = 4 * e4 + j;
                            const bool c0 = x > v0, c1 = x > v1, c2 = x > v2, c3 = x > v3;
                            v3 = c2 ? v2 : (c3 ? x : v3); i3 = c2 ? i2 : (c3 ? e : i3);
                            v2 = c1 ? v1 : (c2 ? x : v2); i2 = c1 ? i1 : (c2 ? e : i2);
                            v1 = c0 ? v0 : (c1 ? x : v1); i1 = c0 ? i0 : (c1 ? e : i1);
                            v0 = c0 ? x : v0; i0 = c0 ? e : i0; } }
                    const float e1 = fast_exp(v1 - v0), e2 = fast_exp(v2 - v0), e3 = fast_exp(v3 - v0); const float inv = fast_rcp(1.0f + e1 + e2 + e3);
                    const int lt = ltok0 + 16 * g + lane; const size_t gt = (size_t)tb * 256 + lt;
                    typedef int i32x4 __attribute__((ext_vector_type(4)));
                    *(i32x4*)(TOPI + gt * 4) = (i32x4){i0, i1, i2, i3}; *(f32x4*)(TOPP + gt * 4) = (f32x4){inv, e1 * inv, e2 * inv, e3 * inv};
                    const unsigned r0 = __hip_atomic_fetch_add(LCNT + i0, 1u, __ATOMIC_RELAXED, __HIP_MEMORY_SCOPE_WORKGROUP), r1 = __hip_atomic_fetch_add(LCNT + i1, 1u, __ATOMIC_RELAXED, __HIP_MEMORY_SCOPE_WORKGROUP);
                    const unsigned r2 = __hip_atomic_fetch_add(LCNT + i2, 1u, __ATOMIC_RELAXED, __HIP_MEMORY_SCOPE_WORKGROUP), r3 = __hip_atomic_fetch_add(LCNT + i3, 1u, __ATOMIC_RELAXED, __HIP_MEMORY_SCOPE_WORKGROUP);
                    *(LAS u32x4*)(LASS + lt * 4) = (u32x4){((unsigned)i0 << 16) | r0, ((unsigned)i1 << 16) | r1, ((unsigned)i2 << 16) | r2, ((unsigned)i3 << 16) | r3};
                }
                LDS_WAIT(); asm volatile("" ::: "memory");
            }
            LDS_WAIT(); __syncthreads();
            if (tid < 32) LBASE[tid] = atomicAdd(ctl + CW_CNT + 64 * tid, (unsigned)LCNT[tid]);
            LDS_WAIT(); __syncthreads();
            for (int i = tid; i < 1024; i += NTHREADS) { const unsigned v = LASS[i]; POS[(size_t)tb * 1024 + i] = (int)(LBASE[v >> 16] + (v & 0xffffu)); }
            __syncthreads();
        }
        if (BOTH(6)) GRID_BAR();
#if MK_PHT
        if (MK_PHT == 7) phtk = __builtin_amdgcn_s_memrealtime() - pht0;
#endif
    }

    LAS int* PADSTART = (LAS int*)(lds + TBL_OFF); LAS int* TILE_E = PADSTART + 64;
    int ntiles = 0;
    {
        if (lo <= 9 && hi > 7) { PHASE_IDS(); PHASE_ARGS();
            __syncthreads();
            if (wave == 0) {
                const int cnt = lane < NE ? (int)__hip_atomic_load(ctl + CW_CNT + 64 * lane, __ATOMIC_RELAXED, __HIP_MEMORY_SCOPE_AGENT) : 0;
                const int padded = ((cnt + 255) >> 8) << 8; int incl = padded;
#pragma unroll
                for (int o = 1; o < 32; o <<= 1) { const int v = __shfl_up(incl, o); if ((lane & 31) >= o) incl += v; }
                if (lane < NE) PADSTART[lane] = incl - padded;
                if (lane == NE - 1) PADSTART[NE] = incl;
            }
            LDS_WAIT(); __syncthreads();
            for (int t = tid; t < (PADSTART[NE] >> 8); t += NTHREADS) { int e = 0;
#pragma unroll
                for (int q = 1; q < NE; ++q) e += ((PADSTART[q] >> 8) <= t) ? 1 : 0;
                TILE_E[t] = e; }
            LDS_WAIT(); __syncthreads();
            ntiles = PADSTART[NE] >> 8;
        }
    }

    if (IN(7)) for (int rep_ = 0; rep_ < 1 + ((MK_REPEAT >> 7) & 1); ++rep_) { PHASE_IDS(); PHASE_ARGS();
        const int* TOPI = WSP(int, WS_TOPI); const float* TOPP = WSP(float, WS_TOPP); int* POS = WSP(int, WS_POS); int* RTOK = WSP(int, WS_RTOK); int* RSLOT = WSP(int, WS_RSLOT); float* RW = WSP(float, WS_RW);
        for (int i = bid * NTHREADS + tid; i < NASSIGN; i += G * NTHREADS) { const int e = TOPI[i]; const int row = PADSTART[e] + POS[i]; RTOK[row] = i >> 2; RSLOT[row] = i; RW[row] = TOPP[i]; POS[i] = row; }
        for (int e = bid; e < NE; e += G) { const int cnt = (int)__hip_atomic_load(ctl + CW_CNT + 64 * e, __ATOMIC_RELAXED, __HIP_MEMORY_SCOPE_AGENT);
            for (int r = PADSTART[e] + cnt + tid; r < PADSTART[e + 1]; r += NTHREADS) { RTOK[r] = 0; RSLOT[r] = -1; RW[r] = 0.f; } }
#if MK_BG && MK_ONE_LAUNCH
        if (BOTH(7)) GRID_BAR_X(true);
#else
        if (BOTH(7)) GRID_BAR();
#endif
#if MK_PHT
        if (MK_PHT == 8) phtk = __builtin_amdgcn_s_memrealtime() - pht0;
#endif
    }

    if (IN(8)) for (int rep_ = 0; rep_ < 1 + ((MK_REPEAT >> 8) & 1); ++rep_) { PHASE_ARGS();
        gm::MoeOrder S{ntiles, 2048 / 256, G, bid, TILE_E}; gm::GatherA AM{D, WSP(int, WS_RTOK), 1}; gm::EpiSwiglu E{ARG(I_B1), WSP(unsigned char, WS_ACT), ctl + CW_TP};
        gm::gemm_phase<true>(wave_sg, lds, (const char*)WSP(char, WS_U2Q), (const char*)WSP(char, WS_W1), D, 2048, 0u, S, E, AM);
        if (BOTH(8)) GRID_BAR();
#if MK_PHT
        if (MK_PHT == 9) phtk = __builtin_amdgcn_s_memrealtime() - pht0;
#endif
    }

    if (IN(9)) for (int rep_ = 0; rep_ < 1 + ((MK_REPEAT >> 9) & 1); ++rep_) { PHASE_ARGS();
        gm::MoeOrder S{ntiles, D / 256, G, bid, TILE_E}; gm::DenseA AM{DFF, 0u, 1}; gm::EpiMoeOut E{ARG(I_B2), WSP(float, WS_RW), WSP(unsigned char, WS_YA)};
        gm::gemm_phase<true>(wave_sg, lds, (const char*)WSP(char, WS_ACT), (const char*)WSP(char, WS_W2), DFF, D, 0u, S, E, AM);
        if (BOTH(9)) GRID_BAR();
#if MK_PHT
        if (MK_PHT == 10) phtk = __builtin_amdgcn_s_memrealtime() - pht0;
#endif
    }

#if MK_PROBE
    if (lo == 100) { PHASE_IDS(); PHASE_ARGS();
        float* out = ap->out;
        const bf16_t* src = MK_PROBE == 1 ? WSP(bf16_t, WS_U) : MK_PROBE == 3 ? WSP(bf16_t, WS_O) : MK_PROBE == 4 ? WSP(bf16_t, WS_U) : MK_PROBE == 5 ? WSP(bf16_t, WS_H) : WSP(bf16_t, WS_U);
        for (size_t i = (size_t)bid * NTHREADS + tid; i < (size_t)NTOK * D; i += (size_t)G * NTHREADS) {
            float v;
            if (MK_PROBE == 3) { const size_t t = i >> 10, c = i & 1023; v = bf1(src[t * 1024 + c]); }
            else if (MK_PROBE == 2) { const size_t t = i >> 10, c = i & 1023; const bf16_t* P = WSP(bf16_t, WS_PROJ) + t * PROJ_LD; v = bf1(P[c]) + bf1(P[c + 1024]) + bf1(P[c + 2048]) + (c < 512 ? bf1(P[c + 3072]) : 0.f); }
            else if (MK_PROBE == 6) { const size_t t = i >> 10, c = i & 1023; v = bf1(src[i]) + (c < 4 ? (float)WSP(int, WS_TOPI)[t * 4 + c] : c < 8 ? WSP(float, WS_TOPP)[t * 4 + (c - 4)] : 0.f); }
            else v = bf1(src[i]);
            out[i] = v; }
    }
#endif
    if (IN(10)) { PHASE_IDS(); PHASE_ARGS();
#if MK_TPROBE
        const float tscale = 1.0f;
#elif MK_FP8TEST
        float tscale = 1.0f;
        {
            typedef int v8i __attribute__((ext_vector_type(8)));
            const int fr = lane & 15, fq = lane >> 4;
            v8i ta, tb;
#pragma unroll
            for (int d = 0; d < 8; ++d) { float av[4], bv[4];
#pragma unroll
                for (int e = 0; e < 4; ++e) { const int k = 32 * fq + 4 * d + e; av[e] = (float)(((fr * 7 + k * 3) % 5) - 2); bv[e] = (float)(((k * 5 + fr * 11) % 7) - 3); }
                int w = __builtin_amdgcn_cvt_pk_fp8_f32(av[0], av[1], 0, false); w = __builtin_amdgcn_cvt_pk_fp8_f32(av[2], av[3], w, true); ta[d] = w;
                w = __builtin_amdgcn_cvt_pk_fp8_f32(bv[0], bv[1], 0, false); w = __builtin_amdgcn_cvt_pk_fp8_f32(bv[2], bv[3], w, true); tb[d] = w; }
            f32x4 tc = {0.f, 0.f, 0.f, 0.f};
            tc = __builtin_amdgcn_mfma_scale_f32_16x16x128_f8f6f4(ta, tb, tc, 0, 0, 0, 0x7A7A7A7A, 0, 0x7F7F7F7F);
            bool bad = false;
#pragma unroll
            for (int r = 0; r < 4; ++r) { const int i = 4 * fq + r, j = fr; float ref = 0.f;
                for (int k = 0; k < 128; ++k) ref += (float)(((i * 7 + k * 3) % 5) - 2) * (float)(((k * 5 + j * 11) % 7) - 3);
                ref *= (1.0f / 32.0f); if (fabsf(tc[r] - ref) > 1e-3f) bad = true; }
            if (__any(bad)) tscale = 4.0f;
        }
#endif
        const float* norm_final_w = ARG(I_NFIN); const float* MOD = WSP(float, WS_MOD); const bf16_t* HB = WSP(bf16_t, WS_H); const unsigned char* YA = WSP(unsigned char, WS_YA); const int* ASROW = WSP(int, WS_POS); float* out = ap->out;
        for (int m0 = gw * 32; m0 < NTOK; m0 += NGW * 32) {
            const int b = m0 >> 11;
            f32x4 gf[4], nf[4];
#pragma unroll
            for (int j = 0; j < 4; ++j) { const int k = 4 * lane + 256 * j; gf[j] = *(const f32x4*)(MOD + (size_t)b * 6144 + 5120 + k); nf[j] = *(const f32x4*)(norm_final_w + k); }
            for (int r = 0; r < 32; ++r) {
                const size_t tok = (size_t)(m0 + r);
                const bf16_t* hr = HB + tok * D;
                typedef int i32x4 __attribute__((ext_vector_type(4)));
                const i32x4 rr = *(const i32x4*)(ASROW + tok * 4);
                const unsigned char* y0 = YA + (size_t)rr[0] * D; const unsigned char* y1 = YA + (size_t)rr[1] * D; const unsigned char* y2 = YA + (size_t)rr[2] * D; const unsigned char* y3 = YA + (size_t)rr[3] * D;
                f32x4 v[4]; float s = 0.f;
#pragma unroll
                for (int j = 0; j < 4; ++j) { const int k = 4 * lane + 256 * j;
                    const u32x2 hw = *(const u32x2*)(hr + k); const unsigned ya = *(const unsigned*)(y0 + k), yb = *(const unsigned*)(y1 + k), yc = *(const unsigned*)(y2 + k), yd = *(const unsigned*)(y3 + k);
                    f32x4 y = fp8x4_to_f32(ya); y += fp8x4_to_f32(yb); y += fp8x4_to_f32(yc); y += fp8x4_to_f32(yd);
                    v[j] = (f32x4){bf_lo(hw.x), bf_hi(hw.x), bf_lo(hw.y), bf_hi(hw.y)} + gf[j] * y;
                    s += (v[j][0] * v[j][0] + v[j][1] * v[j][1]) + (v[j][2] * v[j][2] + v[j][3] * v[j][3]); }
                const float rs = __builtin_amdgcn_rsqf(wave_sum(s) * (1.0f / D) + EPS);
                float* orow = out + tok * D;
#pragma unroll
                #if MK_FP8TEST || MK_TPROBE
                for (int j = 0; j < 4; ++j) *(f32x4*)(orow + 4 * lane + 256 * j) = v[j] * rs * nf[j] * tscale;
#else
                for (int j = 0; j < 4; ++j) *(f32x4*)(orow + 4 * lane + 256 * j) = v[j] * rs * nf[j];
#endif
            }
        }
    }
#if MK_PHT
    if (bid == 0) { const unsigned long long t1 = __builtin_amdgcn_s_memrealtime(); while (__builtin_amdgcn_s_memrealtime() - t1 < phtk) __builtin_amdgcn_s_sleep(8); }
#endif
#undef IN
#undef BOTH
}

extern "C" void kernel_launch(void* const* d_in, const int* in_sizes, int n_in, void* d_out, int out_size, void* d_ws, size_t ws_size, hipStream_t stream) {
    static int grid = 0;
    if (grid == 0) {
        if (n_in != 20 || out_size != NTOK * D || ws_size < WS_END) { fprintf(stderr, "kernel_launch: unexpected shapes (n_in %d out %d ws %zu)\n", n_in, out_size, ws_size); grid = -1; return; }
        if (hipFuncSetAttribute((const void*)fwd_kernel, hipFuncAttributeMaxDynamicSharedMemorySize, LDS_BYTES) != hipSuccess) { fprintf(stderr, "kernel_launch: hipFuncSetAttribute failed\n"); grid = -1; return; }
        int dev = 0, cus = 0, per_cu = 0;
        (void)hipGetDevice(&dev); (void)hipDeviceGetAttribute(&cus, hipDeviceAttributeMultiprocessorCount, dev);
        if (hipOccupancyMaxActiveBlocksPerMultiprocessor(&per_cu, (const void*)fwd_kernel, NTHREADS, LDS_BYTES) != hipSuccess || per_cu < 1) fprintf(stderr, "kernel_launch: occupancy query says %d\n", per_cu);
        (void)hipGetLastError();
        grid = cus > 0 ? cus : 256;
    }
    if (grid < 0) return;
    (void)hipMemsetAsync((char*)d_ws + WS_CTL, 0, CTL_ZERO_BYTES, stream);
    Args a{};
    for (int i = 0; i < 20; ++i) a.in[i] = (const float*)d_in[i];
    a.out = (float*)d_out; a.ws = (unsigned char*)d_ws;
#if MK_ONE_LAUNCH
    a.ph_lo = 0; a.ph_hi = NPHASE;
    hipLaunchKernelGGL(fwd_kernel, dim3(grid), dim3(NTHREADS), LDS_BYTES, stream, a);
#else
#if MK_PROBE
    for (int p = 0; p <= MK_PROBE; ++p) { a.ph_lo = p; a.ph_hi = p + 1; hipLaunchKernelGGL(fwd_kernel, dim3(grid), dim3(NTHREADS), LDS_BYTES, stream, a); }
    a.ph_lo = 100; a.ph_hi = 101; hipLaunchKernelGGL(fwd_kernel, dim3(grid), dim3(NTHREADS), LDS_BYTES, stream, a);
#else
    for (int p = 0; p < NPHASE; ++p) { a.ph_lo = p; a.ph_hi = p + 1; hipLaunchKernelGGL(fwd_kernel, dim3(grid), dim3(NTHREADS), LDS_BYTES, stream, a); }
#endif
#endif
}
```

```cpp
#include <hip/hip_runtime.h>
#include <cstdio>
#include <cstdint>

#ifndef MK_PROBE
#define MK_PROBE 0
#endif
#ifndef MK_REPEAT
#define MK_REPEAT 0
#endif
#ifndef MK_FP8TEST
#define MK_FP8TEST 0
#endif
#ifndef MK_STAGGER
#define MK_STAGGER 0
#endif
#ifndef MK_TPROBE
#define MK_TPROBE 0
#endif
#ifndef MK_PHT
#define MK_PHT 0
#endif
#ifndef MK_P2FP8
#define MK_P2FP8 0
#endif
#ifndef MK_BG
#define MK_BG 0
#endif
#ifndef MK_ONE_LAUNCH
#define MK_ONE_LAUNCH 1
#endif

#define LAS __attribute__((address_space(3)))
#define GAS __attribute__((address_space(1)))
typedef unsigned short bf16_t;
typedef short bf16x8 __attribute__((ext_vector_type(8)));
typedef float f32x4 __attribute__((ext_vector_type(4)));
typedef float f32x2 __attribute__((ext_vector_type(2)));
typedef unsigned u32x4 __attribute__((ext_vector_type(4)));
typedef unsigned u32x2 __attribute__((ext_vector_type(2)));
typedef int v8i __attribute__((ext_vector_type(8)));

constexpr int D = 1024, BATCH = 32, SEQ = 2048, NTOK = BATCH * SEQ;
constexpr int HW = 512, NHEAD = 4, DK = 128, CHUNK = 64, NCHUNK = SEQ / CHUNK;
constexpr int INC = 5632, PROJ_LD = 3584, GATE_LD = 2048;
constexpr int NE = 32, TOPK = 4, DFF = 1024, NASSIGN = NTOK * TOPK;
constexpr int MAXTILES = NASSIGN / 256 + NE;
constexpr int MAXROWS = MAXTILES * 256;
constexpr float EPS = 1e-6f, SW_LIMIT = 7.0f, SW_ALPHA = 1.702f;
constexpr int NWAVES = 8, NTHREADS = 512;
constexpr int NPHASE = 11;

constexpr size_t MiB = 1u << 20;
constexpr size_t WS_CTL = 0, CTL_ZERO_BYTES = 65536;
constexpr size_t WS_MOD = 1 * MiB;
constexpr size_t WS_LB = WS_MOD + 32 * 6144 * 4;
constexpr size_t WS_WIN = 2 * MiB;
constexpr size_t WS_WHG = 13 * MiB, WS_WCV = 14 * MiB, WS_WMIX = 15 * MiB;
constexpr size_t WS_W2 = 18 * MiB;
constexpr size_t WS_W1 = 50 * MiB;
constexpr size_t WS_U2Q = 114 * MiB;
constexpr size_t WS_U = 210 * MiB;
constexpr size_t WS_PROJ = 338 * MiB;
constexpr size_t WS_O = 786 * MiB;
constexpr size_t WS_CV = 850 * MiB;
constexpr size_t WS_H = 338 * MiB;
constexpr size_t WS_ACT = 466 * MiB;
constexpr size_t WS_TOPI = 994 * MiB, WS_TOPP = 995 * MiB, WS_POS = 996 * MiB;
constexpr size_t WS_RTOK = 997 * MiB, WS_RSLOT = 997 * MiB + 1081344 + 0, WS_RW = WS_RSLOT + 1081344;
constexpr size_t WS_YA = 50 * MiB, WS_YB = 730 * MiB; constexpr int YSPLIT = 147456;
constexpr size_t WS_YO23_UNUSED = 730 * MiB;
constexpr size_t WS_END = 1001 * MiB;
static_assert(WS_RW + 1081344 <= WS_END && MAXROWS * 4 == 1081344, "tables");
static_assert(WS_ACT + (size_t)MAXROWS * 1024 <= WS_YB && WS_YB + (size_t)(MAXROWS - YSPLIT) * 2048 <= WS_TOPI && WS_YA + (size_t)YSPLIT * 2048 <= WS_H && YSPLIT % 256 == 0, "expert output map");
constexpr int CW_TMO = 0, CW_BAR = 4096, CW_CNT = 8192, CW_TP = 12288, CW_Q = 12544;

constexpr int LDS_BYTES = 163840;
constexpr int MISC_OFF = LDS_BYTES - 256;
constexpr int TBL_OFF = 135168;
constexpr int SIDE_OFF = TBL_OFF + 8192;

#define LDS_WAIT() asm volatile("s_waitcnt lgkmcnt(0)" ::: "memory")
#define VM_WAIT() asm volatile("s_waitcnt vmcnt(0)" ::: "memory")
typedef __bf16 bf16x2_t __attribute__((ext_vector_type(2)));
__device__ __forceinline__ unsigned cvt_pk_bf16(float lo, float hi) { const f32x2 v = {lo, hi}; const bf16x2_t b = __builtin_convertvector(v, bf16x2_t); return __builtin_bit_cast(unsigned, b); }
__device__ __forceinline__ unsigned pk4_fp8(float a, float b, float c, float d) {
    a = fminf(fmaxf(a, -448.f), 448.f); b = fminf(fmaxf(b, -448.f), 448.f); c = fminf(fmaxf(c, -448.f), 448.f); d = fminf(fmaxf(d, -448.f), 448.f);
    int w = __builtin_amdgcn_cvt_pk_fp8_f32(a, b, 0, false); w = __builtin_amdgcn_cvt_pk_fp8_f32(c, d, w, true); return (unsigned)w; }
__device__ __forceinline__ f32x4 fp8x4_to_f32(unsigned w) {
    const f32x2 lo = __builtin_amdgcn_cvt_pk_f32_fp8((int)w, false), hi = __builtin_amdgcn_cvt_pk_f32_fp8((int)w, true); return (f32x4){lo[0], lo[1], hi[0], hi[1]}; }
__device__ __forceinline__ unsigned pk4_fp8_nc(float a, float b, float c, float d) {
    int w = __builtin_amdgcn_cvt_pk_fp8_f32(a, b, 0, false); w = __builtin_amdgcn_cvt_pk_fp8_f32(c, d, w, true); return (unsigned)w; }
__device__ __forceinline__ float bf_lo(unsigned u) { return __uint_as_float(u << 16); }
__device__ __forceinline__ float bf_hi(unsigned u) { return __uint_as_float(u & 0xffff0000u); }
__device__ __forceinline__ float bf1(bf16_t u) { return __uint_as_float(((unsigned)u) << 16); }
__device__ __forceinline__ float fast_rcp(float x) { return __builtin_amdgcn_rcpf(x); }
__device__ __forceinline__ float fast_exp(float x) { return __builtin_amdgcn_exp2f(x * 1.44269504089f); }
__device__ __forceinline__ float fast_log(float x) { return __builtin_amdgcn_logf(x) * 0.69314718056f; }
__device__ __forceinline__ float sigmoidf_(float x) { return fast_rcp(1.0f + fast_exp(-x)); }
__device__ __forceinline__ float wave_sum(float v) {
#pragma unroll
    for (int o = 1; o < 64; o <<= 1) v += __shfl_xor(v, o);
    return v;
}

#define XB_TMO      128
#define XB_XCNT(j)  (256  + 64 * (j))
#define XB_XSUB(j)  (1280 + 64 * (j))
#define XB_XGEN(j)  (2304 + 64 * (j))
#define XB_TOP      3328
#define XB_TOPGEN   3392
#define XCD_BAR_WORDS 3456
#define XB_SPIN_CAP (1u << 20)
__device__ __forceinline__ unsigned xb_ld(unsigned* p)              { return __hip_atomic_load(p, __ATOMIC_RELAXED, __HIP_MEMORY_SCOPE_AGENT); }
__device__ __forceinline__ unsigned xb_add(unsigned* p, unsigned v) { return __hip_atomic_fetch_add(p, v, __ATOMIC_RELAXED, __HIP_MEMORY_SCOPE_AGENT); }
__device__ __forceinline__ unsigned xb_xcc_id() { return (unsigned)__builtin_amdgcn_s_getreg((3 << 11) | 20) & 0xFu; }
#define XB_SPIN(cond, bar) do { unsigned _sp = 0; while (cond) { __builtin_amdgcn_s_sleep(1); \
    if ((++_sp & 255u) == 0u) { if (xb_ld(&(bar)[XB_TMO])) break; if (_sp > XB_SPIN_CAP) { atomicAdd(&(bar)[XB_TMO], 1u); break; } } } } while (0)
struct XcdBarrier { unsigned* bar; unsigned x; volatile LAS unsigned* st; };
__device__ __forceinline__ XcdBarrier xcd_barrier_post(unsigned* bar, volatile LAS unsigned* st) {
    XcdBarrier b; b.bar = bar; b.x = xb_xcc_id(); b.st = st;
    if (threadIdx.x == 0) (void)xb_add(&bar[XB_XCNT(b.x)], 1u);
    return b;
}
__device__ __forceinline__ void xcd_barrier_complete(unsigned* bar, unsigned x, unsigned& nloc, unsigned& nx) {
    const unsigned G = gridDim.x * gridDim.y * gridDim.z;
    unsigned sum, cnt, mine, sp = 0u;
    for (;;) {
        sum = 0u; cnt = 0u; mine = 0u;
#pragma unroll
        for (unsigned j = 0; j < 16; ++j) { const unsigned c = xb_ld(&bar[XB_XCNT(j)]); sum += c; cnt += (c > 0u) ? 1u : 0u; mine = (j == x) ? c : mine; }
        if (sum == G) break;
        __builtin_amdgcn_s_sleep(1);
        if ((++sp & 255u) == 0u) { if (xb_ld(&bar[XB_TMO])) break; if (sp > XB_SPIN_CAP) { atomicAdd(&bar[XB_TMO], 1u); break; } }
    }
    nloc = mine > 0u ? mine : 1u; nx = cnt > 0u ? cnt : 1u;
}
__device__ __forceinline__ void xcd_barrier(const XcdBarrier& b) {
    asm volatile("s_waitcnt vmcnt(0)" ::: "memory");
    __syncthreads();
    if (threadIdx.x == 0) {
        unsigned* bar = b.bar;
        __builtin_amdgcn_s_waitcnt(0);
        unsigned nloc = b.st[0], nx = b.st[1];
        if (nloc == 0u) { xcd_barrier_complete(bar, b.x, nloc, nx); b.st[0] = nloc; b.st[1] = nx; }
        const unsigned old = xb_add(&bar[XB_XSUB(b.x)], 1u);
        const unsigned gen = old / nloc;
        if (old + 1u == (gen + 1u) * nloc) {
            __builtin_amdgcn_fence(__ATOMIC_RELEASE, "agent");
            asm volatile("s_waitcnt vmcnt(0)" ::: "memory");
            const unsigned og = xb_add(&bar[XB_TOP], 1u);
            const unsigned tg = og / nx;
            if (og + 1u == (tg + 1u) * nx) xb_add(&bar[XB_TOPGEN], 1u);
            else XB_SPIN(xb_ld(&bar[XB_TOPGEN]) == tg, bar);
            __builtin_amdgcn_fence(__ATOMIC_ACQUIRE, "agent");
            xb_add(&bar[XB_XGEN(b.x)], 1u);
            asm volatile("s_waitcnt vmcnt(0)" ::: "memory");
        } else {
            XB_SPIN(xb_ld(&bar[XB_XGEN(b.x)]) == gen, bar);
            __builtin_amdgcn_fence(__ATOMIC_ACQUIRE, "agent");
            asm volatile("s_waitcnt vmcnt(0)" ::: "memory");
        }
    }
    __syncthreads();
}

namespace gm {
constexpr int BM = 256, BK = 64, HALF = 128, HTB = HALF * BK * 2, STAGE_BYTES = 8 * HTB, NXCD = 8, WGM = 8;
__device__ __forceinline__ int lds_byte(int r, int c) { const int st = (r >> 4) * 2 + (c >> 5), rr = r & 15, cc = c & 31, ob = rr * 64 + cc * 2; return st * 1024 + (ob ^ (((ob >> 9) & 1) << 5)); }
__device__ __forceinline__ void stage_rc(int b, int& R, int& C) { const int st = b / 1024, sb = b % 1024, swz = sb ^ (((sb >> 9) & 1) << 5); R = (st >> 1) * 16 + swz / 64; C = (st & 1) * 32 + (swz % 64) / 2; }
__device__ __forceinline__ int perm32(int rho) { const int n = rho >> 4, i = rho & 15; return 8 * (i >> 2) + 4 * n + (i & 3); }

struct Unit { int pm, pn, e, sub; };

__device__ __forceinline__ bool tile_order(int nM, int nN, long L, int& pm, int& pn) {
    const int nwg = nM * nN; if (L >= nwg) return false;
    int wgid = (int)L; { const int q = nwg / NXCD, r = nwg % NXCD, xcd = wgid % NXCD, off = wgid / NXCD; wgid = (xcd < r ? xcd * (q + 1) : r * (q + 1) + (xcd - r) * q) + off; }
    const int nig = WGM * nN, gid = wgid / nig, fm = gid * WGM, gsz = (nM - fm) < WGM ? (nM - fm) : WGM;
    pm = fm + ((wgid % nig) % gsz); pn = (wgid % nig) / gsz; return true;
}
struct DenseOrder {
    int nM, nN, G, c, nsub;
    __device__ __forceinline__ bool next(int i, Unit& u) const { const int ti = i / nsub; u.sub = i - ti * nsub; u.e = 0; return tile_order(nM, nN, (long)ti * G + c, u.pm, u.pn); }
};
struct MoeOrder {
    int nM, nN, G, c; const LAS int* tile_e;
    __device__ __forceinline__ bool next(int i, Unit& u) const { u.sub = 0; if (!tile_order(nM, nN, (long)i * G + c, u.pm, u.pn)) return false; u.e = tile_e[u.pm]; return true; }
};
struct DenseA { int K; unsigned sub_stride; int ES;
    __device__ __forceinline__ void offsets(const Unit& u, int tid, unsigned (&o)[2][2]) const {
#pragma unroll
        for (int i = 0; i < 2; ++i) { int R, C; stage_rc(tid * 16 + i * 8192, R, C);
#pragma unroll
            for (int h = 0; h < 2; ++h) o[h][i] = (unsigned)((u.pm * BM + h * HALF + R) * K * ES + C * 2) + (unsigned)u.sub * sub_stride; } }
    static constexpr bool GATHER = false;
    __device__ __forceinline__ const char* tok_ptr(const Unit&) const { return nullptr; }
    __device__ __forceinline__ void next_offsets(const Unit& u, int tid, unsigned (&o)[2][2], const LAS int*) const { offsets(u, tid, o); } };
struct GatherA { int K; const int* row_tok; int ES;
    __device__ __forceinline__ void offsets(const Unit& u, int tid, unsigned (&o)[2][2]) const {
#pragma unroll
        for (int i = 0; i < 2; ++i) { int R, C; stage_rc(tid * 16 + i * 8192, R, C);
#pragma unroll
            for (int h = 0; h < 2; ++h) { const int tok = row_tok[u.pm * BM + h * HALF + R]; o[h][i] = (unsigned)(tok * K * ES + C * 2); } } }
    static constexpr bool GATHER = true;
    __device__ __forceinline__ const char* tok_ptr(const Unit& u) const { return (const char*)(row_tok + u.pm * BM); }
    __device__ __forceinline__ void next_offsets(const Unit&, int tid, unsigned (&o)[2][2], const LAS int* stok) const {
#pragma unroll
        for (int i = 0; i < 2; ++i) { int R, C; stage_rc(tid * 16 + i * 8192, R, C);
#pragma unroll
            for (int h = 0; h < 2; ++h) { const int tok = stok[h * HALF + R]; o[h][i] = (unsigned)(tok * K * ES + C * 2); } } } };

template <bool FP8, class Epi, class Sched, class AMap>
__device__ __forceinline__ void gemm_phase(int wave_sg, LAS unsigned char* lds, const char* Abase, const char* Bbase, int K, int Nb, unsigned b_sub_stride, const Sched& S, const Epi& E, const AMap& AM) {
    int lane; asm volatile("v_mbcnt_lo_u32_b32 %0, -1, 0\n\tv_mbcnt_hi_u32_b32 %0, -1, %0" : "=v"(lane));
    const int wid = wave_sg, tid = wid * 64 + lane, wr = wid >> 2, wc = wid & 3, fr = lane & 15, fq = lane >> 4;
    constexpr int ES = FP8 ? 1 : 2;
    const int nt = K * ES / (BK * 2);
    unsigned voffB[2];
#pragma unroll
    for (int i = 0; i < 2; ++i) { int R, C; stage_rc(tid * 16 + i * 8192, R, C); const int Rb = (R & ~31) + perm32(R & 31); voffB[i] = (unsigned)(Rb * K * ES + C * 2); }
    const size_t kstep = (size_t)(BK * 2);
    const size_t hstep = (size_t)HALF * K * ES;
    const unsigned ldsw = (unsigned)wid * 1024u;
    const int aoff = lds_byte(wr * 64 + fr, fq * 8), boff = lds_byte(wc * 32 + fr, fq * 8);
#define G_SA(b, h) (((b) * 2 + (h)) * HTB)
#define G_SB(b, h) ((4 + (b) * 2 + (h)) * HTB)
#define G_STAGE(bufoff, gbase, voff) do { _Pragma("unroll") for (int _i = 0; _i < 2; ++_i) \
        __builtin_amdgcn_global_load_lds((const unsigned*)((const char*)(gbase) + (voff)[_i]), (LAS unsigned*)(lds + (bufoff) + ldsw + _i * 8192), 16, 0, 0); } while (0)
#define G_LDA(dst, b, h) do { _Pragma("unroll") for (int m = 0; m < 4; ++m) _Pragma("unroll") for (int k = 0; k < 2; ++k) dst[m][k] = *(const LAS bf16x8*)(lds + G_SA(b, h) + aoff + m * 2048 + k * 1024); } while (0)
#define G_LDB(dst, b, h) do { _Pragma("unroll") for (int n = 0; n < 2; ++n) _Pragma("unroll") for (int k = 0; k < 2; ++k) dst[n][k] = *(const LAS bf16x8*)(lds + G_SB(b, h) + boff + n * 2048 + k * 1024); } while (0)
#define G_MMA(ai, bj, At, Bt) do { __builtin_amdgcn_s_setprio(1); _Pragma("unroll") for (int m = 0; m < 4; ++m) _Pragma("unroll") for (int n = 0; n < 2; ++n) _Pragma("unroll") for (int k = 0; k < 2; ++k) \
        acc[ai][bj][m][n] = __builtin_amdgcn_mfma_f32_16x16x32_bf16(Bt[n][k], At[m][k], acc[ai][bj][m][n], 0, 0, 0); __builtin_amdgcn_s_setprio(0); } while (0)
#define G_LD8(dst, off) do { const u32x4 _l = *(const LAS u32x4*)(lds + (off)), _h = *(const LAS u32x4*)(lds + (off) + 1024); dst = (v8i){(int)_l.x, (int)_l.y, (int)_l.z, (int)_l.w, (int)_h.x, (int)_h.y, (int)_h.z, (int)_h.w}; } while (0)
#define G_LDA8(dst, b, h) do { _Pragma("unroll") for (int m = 0; m < 4; ++m) G_LD8(dst[m], G_SA(b, h) + aoff + m * 2048); } while (0)
#define G_LDB8(dst, b, h) do { _Pragma("unroll") for (int n = 0; n < 2; ++n) G_LD8(dst[n], G_SB(b, h) + boff + n * 2048); } while (0)
#define G_MMA8(ai, bj, At, Bt) do { __builtin_amdgcn_s_setprio(1); _Pragma("unroll") for (int m = 0; m < 4; ++m) _Pragma("unroll") for (int n = 0; n < 2; ++n) \
        acc[ai][bj][m][n] = __builtin_amdgcn_mfma_scale_f32_16x16x128_f8f6f4(Bt[n], At[m], acc[ai][bj][m][n], 0, 0, 0, 0x7F7F7F7F, 0, 0x7F7F7F7F); __builtin_amdgcn_s_setprio(0); } while (0)
#define G_PIN(ai, bj) asm volatile("" :: "v"(acc[ai][bj][0][0][0]), "v"(acc[ai][bj][0][1][0]), "v"(acc[ai][bj][1][0][0]), "v"(acc[ai][bj][1][1][0]), "v"(acc[ai][bj][2][0][0]), "v"(acc[ai][bj][2][1][0]), "v"(acc[ai][bj][3][0][0]), "v"(acc[ai][bj][3][1][0]) : "memory")
#define G_WAIT_V(n) asm volatile("s_waitcnt vmcnt(" #n ")" ::: "memory")
#define G_WAIT_L(n) asm volatile("s_waitcnt lgkmcnt(" #n ")" ::: "memory")
#define G_WAIT_VS() do { if (fi) { if (Epi::NST == 16) G_WAIT_V(24); else if (Epi::NST == 8) G_WAIT_V(16); else G_WAIT_V(8); } else G_WAIT_V(8); } while (0)
#define G_BAR __builtin_amdgcn_s_barrier()
#define G_SCHED __builtin_amdgcn_sched_barrier(0)
    Unit cur, nxt; int ui = 0;
#if MK_TPROBE
    unsigned long long tp_c = 0; const unsigned long long tp_c0 = __builtin_amdgcn_s_memtime(), tp_r0 = __builtin_amdgcn_s_memrealtime();
#endif
    if (!S.next(0, cur)) return;
#if MK_STAGGER
    {
        const unsigned long long t0 = __builtin_amdgcn_s_memrealtime(); const unsigned long long dly = (unsigned long long)(blockIdx.x & 7) * MK_STAGGER;
        while (__builtin_amdgcn_s_memrealtime() - t0 < dly) __builtin_amdgcn_s_sleep(8);
    }
#endif
    unsigned rA[2][2];
    AM.offsets(cur, tid, rA);
    const char* cB = Bbase + ((size_t)cur.e * Nb + (size_t)cur.pn * BM) * K * ES + (size_t)cur.sub * b_sub_stride;
    G_STAGE(G_SB(0, 0), cB, voffB); G_STAGE(G_SB(0, 1), cB + hstep, voffB); G_STAGE(G_SA(0, 0), Abase, rA[0]); G_STAGE(G_SA(0, 1), Abase, rA[1]);
    if (wr == 1) G_BAR;
    G_WAIT_V(2); G_BAR;
    G_STAGE(G_SB(1, 0), cB + kstep, voffB); G_STAGE(G_SA(1, 0), Abase + kstep, rA[0]); G_STAGE(G_SB(1, 1), cB + hstep + kstep, voffB);
    G_WAIT_V(6); G_BAR;
    f32x4 acc[2][2][4][2];
#pragma unroll
    for (int a = 0; a < 2; ++a)
#pragma unroll
        for (int b = 0; b < 2; ++b)
#pragma unroll
            for (int m = 0; m < 4; ++m)
#pragma unroll
                for (int n = 0; n < 2; ++n) acc[a][b][m][n] = (f32x4){0.f, 0.f, 0.f, 0.f};
    for (;;) {
        const bool has_next = S.next(ui + 1, nxt);
        const char* nB = has_next ? Bbase + ((size_t)nxt.e * Nb + (size_t)nxt.pn * BM) * K * ES + (size_t)nxt.sub * b_sub_stride : cB;
#if MK_TPROBE
        unsigned long long tp_a = 0; if (Epi::TPROBE && wid == 0) { tp_a = __builtin_amdgcn_s_memrealtime(); if (ui > 0 && lane == 0) { volatile LAS unsigned* M = (volatile LAS unsigned*)(lds + MISC_OFF); M[19] += (unsigned)(tp_a - tp_c); } }
#endif
        if (wid == 0) {
            int l16 = lane * 16; asm volatile("" : "+v"(l16));
#pragma unroll
            for (int k = 0; k < Epi::NSB; ++k) { const char* sp = E.sb_ptr(cur, k); if (l16 < 16 * E.sb_lanes(k)) __builtin_amdgcn_global_load_lds((const unsigned*)(sp + l16), (LAS unsigned*)(lds + SIDE_OFF + (ui & 1) * 4096 + 1024 * (k + 1)), 16, 0, 0); }
            if (AMap::GATHER && has_next) __builtin_amdgcn_global_load_lds((const unsigned*)(AM.tok_ptr(nxt) + l16), (LAS unsigned*)(lds + SIDE_OFF + ((ui + 1) & 1) * 4096), 16, 0, 0);
        }
#pragma nounroll
        for (int t = 0; t < nt; t += 2) {
            if constexpr (Epi::HAS_MID) { if (t == nt / 2) { int lz = lane; asm volatile("" : "+v"(lz)); E.mid(acc, cur, wr, wc, lz & 15, lz >> 4); } }
            bf16x8 At[4][2], B0[2][2], B1[2][2];
            v8i At8[4], B08[2], B18[2];
            const bool last = (t == nt - 2);
            constexpr bool fi = false;
            const char* b2 = last ? nB : cB + (size_t)(t + 2) * kstep; const char* b3 = b2 + kstep;
            if constexpr (FP8) { G_LDB8(B08, 0, 0); G_LDB8(B18, 0, 1); G_SCHED; G_LDA8(At8, 0, 0); } else { G_LDB(B0, 0, 0); G_LDB(B1, 0, 1); G_SCHED; G_LDA(At, 0, 0); }
            G_STAGE(G_SA(1, 1), Abase + (size_t)(t + 1) * kstep, rA[1]);
            G_WAIT_VS(); G_WAIT_L(0); G_BAR;
            if constexpr (FP8) { G_MMA8(0, 0, At8, B08); G_MMA8(0, 1, At8, B18); } else { G_MMA(0, 0, At, B0); G_MMA(0, 1, At, B1); }
            if constexpr (FP8) { G_PIN(0, 0); G_PIN(0, 1); }
            G_BAR; G_SCHED;
            if (last && has_next) { int tz = tid; asm volatile("" : "+v"(tz)); AM.next_offsets(nxt, tz, rA, (const LAS int*)(lds + SIDE_OFF + ((ui + 1) & 1) * 4096)); }
            const char* a2 = Abase + (last ? (size_t)0 : (size_t)(t + 2) * kstep);
            if constexpr (FP8) { G_LDA8(At8, 0, 1); } else { G_LDA(At, 0, 1); }
            G_STAGE(G_SB(0, 0), b2, voffB); G_STAGE(G_SB(0, 1), b2 + hstep, voffB); G_STAGE(G_SA(0, 0), a2, rA[0]);
            G_WAIT_VS(); G_WAIT_L(0); G_BAR;
            if constexpr (FP8) { G_MMA8(1, 0, At8, B08); G_MMA8(1, 1, At8, B18); } else { G_MMA(1, 0, At, B0); G_MMA(1, 1, At, B1); }
            if constexpr (FP8) { G_PIN(1, 0); G_PIN(1, 1); }
            G_BAR; G_SCHED;
            if constexpr (FP8) { G_LDB8(B08, 1, 0); G_LDB8(B18, 1, 1); G_SCHED; G_LDA8(At8, 1, 0); } else { G_LDB(B0, 1, 0); G_LDB(B1, 1, 1); G_SCHED; G_LDA(At, 1, 0); }
            G_STAGE(G_SA(0, 1), a2, rA[1]);
            G_WAIT_VS(); G_WAIT_L(0); G_BAR;
            if constexpr (FP8) { G_MMA8(0, 0, At8, B08); G_MMA8(0, 1, At8, B18); } else { G_MMA(0, 0, At, B0); G_MMA(0, 1, At, B1); }
            if constexpr (FP8) { G_PIN(0, 0); G_PIN(0, 1); }
            G_BAR; G_SCHED;
            if constexpr (FP8) { G_LDA8(At8, 1, 1); } else { G_LDA(At, 1, 1); }
            G_STAGE(G_SB(1, 0), b3, voffB); G_STAGE(G_SB(1, 1), b3 + hstep, voffB); G_STAGE(G_SA(1, 0), a2 + kstep, rA[0]);
            G_WAIT_VS(); G_WAIT_L(0); G_BAR;
            if constexpr (FP8) { G_MMA8(1, 0, At8, B08); G_MMA8(1, 1, At8, B18); } else { G_MMA(1, 0, At, B0); G_MMA(1, 1, At, B1); }
            if constexpr (FP8) { G_PIN(1, 0); G_PIN(1, 1); }
            G_BAR; G_SCHED;
        }
#if MK_TPROBE
        unsigned long long tp_b = 0; if (Epi::TPROBE && wid == 0) tp_b = __builtin_amdgcn_s_memrealtime();
#endif
        if (wr == 0) G_BAR;
        { int lz = lane; asm volatile("" : "+v"(lz));
          E(acc, cur, wr, wc, lz & 15, lz >> 4, (const LAS unsigned char*)(lds + SIDE_OFF + (ui & 1) * 4096 + 1024)); }
#if MK_TPROBE
        if (Epi::TPROBE && wid == 0) { tp_c = __builtin_amdgcn_s_memrealtime(); if (lane == 0) { volatile LAS unsigned* M = (volatile LAS unsigned*)(lds + MISC_OFF); M[16] += (unsigned)(tp_b - tp_a); M[17] += (unsigned)(tp_c - tp_b); M[18] += 1u; } }
#endif
        if (!has_next) break;
        if (!E.keep(cur)) {
#pragma unroll
            for (int a = 0; a < 2; ++a)
#pragma unroll
                for (int b = 0; b < 2; ++b)
#pragma unroll
                    for (int m = 0; m < 4; ++m)
#pragma unroll
                        for (int n = 0; n < 2; ++n) acc[a][b][m][n] = (f32x4){0.f, 0.f, 0.f, 0.f};
        }
        cur = nxt; cB = nB; ++ui;
        if (wr == 1) G_BAR;
    }
    G_WAIT_V(0);
    G_BAR;
#if MK_TPROBE
    if constexpr (Epi::TPROBE) if (wid == 0) { volatile LAS unsigned* M = (volatile LAS unsigned*)(lds + MISC_OFF);
        const unsigned long long t0 = __builtin_amdgcn_s_memrealtime();
        const unsigned long long d = MK_TPROBE == 4 ? 10000ull * (__builtin_amdgcn_s_memtime() - tp_c0) / (t0 - tp_r0)
                                   : 4ull * (unsigned long long)(MK_TPROBE == 1 ? M[16] : MK_TPROBE == 2 ? M[17] : M[19]);
        while (__builtin_amdgcn_s_memrealtime() - t0 < d) __builtin_amdgcn_s_sleep(8); }
#endif
#undef G_SA
#undef G_SB
#undef G_STAGE
#undef G_LDA
#undef G_LDB
#undef G_MMA
#undef G_LD8
#undef G_LDA8
#undef G_LDB8
#undef G_MMA8
#undef G_WAIT_V
#undef G_PIN
#undef G_WAIT_VS
#undef G_WAIT_L
#undef G_BAR
#undef G_SCHED
}

__device__ __forceinline__ u32x4 pack8(const f32x4& v0, const f32x4& v1) { u32x4 w; w.x = cvt_pk_bf16(v0[0], v0[1]); w.y = cvt_pk_bf16(v0[2], v0[3]); w.z = cvt_pk_bf16(v1[0], v1[1]); w.w = cvt_pk_bf16(v1[2], v1[3]); return w; }
__device__ __forceinline__ void unpack8(const u32x4& w, f32x4& v0, f32x4& v1) { v0 = (f32x4){bf_lo(w.x), bf_hi(w.x), bf_lo(w.y), bf_hi(w.y)}; v1 = (f32x4){bf_lo(w.z), bf_hi(w.z), bf_lo(w.w), bf_hi(w.w)}; }

struct EpiProj {
    static constexpr bool HAS_MID = false;
    static constexpr float PSC = MK_P2FP8 ? (1.0f / 32.0f) : 1.0f;
    bf16_t* proj; bf16_t* gates; const float* lb;
    static constexpr int NSB = 0, NST = 16; static constexpr bool TPROBE = true;
    __device__ __forceinline__ const char* sb_ptr(const Unit&, int) const { return nullptr; }
    __device__ __forceinline__ int sb_lanes(int) const { return 0; }
    __device__ __forceinline__ bool keep(const Unit&) const { return false; }
    __device__ __forceinline__ void operator()(f32x4 (&acc)[2][2][4][2], const Unit& u, int wr, int wc, int fr, int fq, const LAS unsigned char* side) const {
        const int row0 = u.pm * BM + wr * 64 + fr, pn = u.pn;
        if (pn >= 10) {
            const bool isg = pn >= 14; const int q = isg ? pn - 14 : pn - 10; const int c0 = q * HALF + wc * 32 + 8 * fq;
#pragma unroll
            for (int ai = 0; ai < 2; ++ai)
#pragma unroll
                for (int m = 0; m < 4; ++m) { const size_t r = (size_t)(row0 + ai * HALF + m * 16);
                    f32x4 a0 = acc[ai][0][m][0] * PSC, a1 = acc[ai][0][m][1] * PSC, b0 = acc[ai][1][m][0] * PSC, b1 = acc[ai][1][m][1] * PSC;
                    if (isg) {
#pragma unroll
                        for (int j = 0; j < 4; ++j) { b0[j] = sigmoidf_(b0[j]); b1[j] = sigmoidf_(b1[j]); a0[j] = sigmoidf_(a0[j]) * fast_rcp(fmaxf(b0[j], 1e-30f)); a1[j] = sigmoidf_(a1[j]) * fast_rcp(fmaxf(b1[j], 1e-30f)); }
                        *(u32x4*)(gates + r * GATE_LD + c0) = pack8(a0, a1); *(u32x4*)(gates + r * GATE_LD + 1024 + c0) = pack8(b0, b1);
                    } else {
                        *(u32x4*)(proj + r * PROJ_LD + 2560 + c0) = pack8(a0 * b0, a1 * b1);
                    } }
            return;
        }
        bf16_t* base = proj; const int ldc = PROJ_LD, colt = pn * BM, kind = (pn == 2 || pn == 3) ? 1 : 0;
        const int col0 = colt + wc * 32 + 8 * fq;
        f32x4 lbv[2][2];
        if (kind == 1) {
#pragma unroll
            for (int bj = 0; bj < 2; ++bj) { const float* lp = lb + (pn - 2) * BM + bj * HALF + wc * 32 + 8 * fq; lbv[bj][0] = *(const f32x4*)lp; lbv[bj][1] = *(const f32x4*)(lp + 4); }
        }
#pragma unroll
        for (int ai = 0; ai < 2; ++ai)
#pragma unroll
            for (int m = 0; m < 4; ++m) { bf16_t* rowp = base + (size_t)(row0 + ai * HALF + m * 16) * ldc + col0;
#pragma unroll
                for (int bj = 0; bj < 2; ++bj) { f32x4 v0 = acc[ai][bj][m][0] * PSC, v1 = acc[ai][bj][m][1] * PSC;
                    if (kind == 1) {
#pragma unroll
                        for (int j = 0; j < 4; ++j) { const float l0 = lbv[bj][0][j], l1 = lbv[bj][1][j];
                            v0[j] = fast_log(l0 + (1.0f - l0) * sigmoidf_(v0[j])); v1[j] = fast_log(l1 + (1.0f - l1) * sigmoidf_(v1[j])); }
                    }
                    *(u32x4*)(rowp + bj * HALF) = pack8(v0, v1); } }
    }
};
struct EpiMerge {
    static constexpr bool HAS_MID = true;
    const bf16_t* gates; bf16_t* out;
    static constexpr int NSB = 0, NST = 0; static constexpr bool TPROBE = false;
    __device__ __forceinline__ const char* sb_ptr(const Unit&, int) const { return nullptr; }
    __device__ __forceinline__ int sb_lanes(int) const { return 0; }
    __device__ __forceinline__ bool keep(const Unit&) const { return false; }
    __device__ __forceinline__ void mid(f32x4 (&acc)[2][2][4][2], const Unit& u, int wr, int wc, int fr, int fq) const {
        const int row0 = u.pm * BM + wr * 64 + fr, col0 = u.pn * BM + wc * 32 + 8 * fq;
#pragma unroll
        for (int ai = 0; ai < 2; ++ai) {
            u32x4 ga[4][2];
#pragma unroll
            for (int m = 0; m < 4; ++m) { const bf16_t* gp = gates + (size_t)(row0 + ai * HALF + m * 16) * GATE_LD + col0;
#pragma unroll
                for (int bj = 0; bj < 2; ++bj) ga[m][bj] = *(const u32x4*)(gp + bj * HALF); }
#pragma unroll
            for (int m = 0; m < 4; ++m)
#pragma unroll
                for (int bj = 0; bj < 2; ++bj) { f32x4 a0, a1; unpack8(ga[m][bj], a0, a1); acc[ai][bj][m][0] *= a0; acc[ai][bj][m][1] *= a1; }
            asm volatile("" ::: "memory"); }
    }
    __device__ __forceinline__ void operator()(f32x4 (&acc)[2][2][4][2], const Unit& u, int wr, int wc, int fr, int fq, const LAS unsigned char* side) const {
        const int row0 = u.pm * BM + wr * 64 + fr, col0 = u.pn * BM + wc * 32 + 8 * fq;
#pragma unroll
        for (int ai = 0; ai < 2; ++ai) {
            u32x4 gb[4][2];
#pragma unroll
            for (int m = 0; m < 4; ++m) { const bf16_t* gp = gates + (size_t)(row0 + ai * HALF + m * 16) * GATE_LD + col0;
#pragma unroll
                for (int bj = 0; bj < 2; ++bj) gb[m][bj] = *(const u32x4*)(gp + 1024 + bj * HALF); }
#pragma unroll
            for (int m = 0; m < 4; ++m) { const size_t r = (size_t)(row0 + ai * HALF + m * 16);
#pragma unroll
                for (int bj = 0; bj < 2; ++bj) { f32x4 b0, b1; unpack8(gb[m][bj], b0, b1); *(u32x4*)(out + r * D + col0 + bj * HALF) = pack8(acc[ai][bj][m][0] * b0, acc[ai][bj][m][1] * b1); } }
            asm volatile("" ::: "memory"); }
    }
};
struct EpiMix {
    static constexpr bool HAS_MID = false;
    const float* x; const float* mod; bf16_t* h;
    static constexpr int NSB = 0, NST = 0; static constexpr bool TPROBE = false;
    __device__ __forceinline__ const char* sb_ptr(const Unit&, int) const { return nullptr; }
    __device__ __forceinline__ int sb_lanes(int) const { return 0; }
    __device__ __forceinline__ bool keep(const Unit&) const { return false; }
    __device__ __forceinline__ void operator()(f32x4 (&acc)[2][2][4][2], const Unit& u, int wr, int wc, int fr, int fq, const LAS unsigned char* side) const {
        const int row0 = u.pm * BM + wr * 64 + fr, col0 = u.pn * BM + wc * 32 + 8 * fq, b = u.pm >> 3;
        f32x4 g[2][2];
#pragma unroll
        for (int bj = 0; bj < 2; ++bj) { const float* gp = mod + (size_t)b * 6144 + 2048 + col0 + bj * HALF; g[bj][0] = *(const f32x4*)gp; g[bj][1] = *(const f32x4*)(gp + 4); }
#pragma unroll
        for (int ai = 0; ai < 2; ++ai) {
            f32x4 xv[4][2][2];
#pragma unroll
            for (int m = 0; m < 4; ++m)
#pragma unroll
                for (int bj = 0; bj < 2; ++bj) { const float* xp = x + (size_t)(row0 + ai * HALF + m * 16) * D + col0 + bj * HALF; xv[m][bj][0] = *(const f32x4*)xp; xv[m][bj][1] = *(const f32x4*)(xp + 4); }
#pragma unroll
            for (int m = 0; m < 4; ++m) { const size_t r = (size_t)(row0 + ai * HALF + m * 16);
#pragma unroll
                for (int bj = 0; bj < 2; ++bj) *(u32x4*)(h + r * D + col0 + bj * HALF) = pack8(xv[m][bj][0] + g[bj][0] * acc[ai][bj][m][0], xv[m][bj][1] + g[bj][1] * acc[ai][bj][m][1]); }
            asm volatile("" ::: "memory"); }
    }
};
struct EpiSwiglu {
    static constexpr bool HAS_MID = false;
    static constexpr float WSC = 1.0f / 32.0f;
    const float* b1; unsigned char* act; unsigned* tpw;
    __device__ __forceinline__ unsigned* tp_words() const { return tpw; }
    static constexpr bool TPROBE = false;
    static constexpr int NSB = 2, NST = 8;
    __device__ __forceinline__ const char* sb_ptr(const Unit& u, int k) const { return (const char*)(b1 + (size_t)u.e * 2048 + k * 1024 + u.pn * HALF); }
    __device__ __forceinline__ int sb_lanes(int) const { return 32; }
    __device__ __forceinline__ bool keep(const Unit&) const { return false; }
    __device__ __forceinline__ void operator()(f32x4 (&acc)[2][2][4][2], const Unit& u, int wr, int wc, int fr, int fq, const LAS unsigned char* side) const {
        const int row0 = u.pm * BM + wr * 64 + fr, hc0 = u.pn * HALF + wc * 32 + 8 * fq;
        const LAS float* bp = (const LAS float*)side + wc * 32 + 8 * fq;
        const f32x4 bg[2] = {*(const LAS f32x4*)bp, *(const LAS f32x4*)(bp + 4)}; const f32x4 bl1[2] = {*(const LAS f32x4*)(bp + 256) + 1.0f, *(const LAS f32x4*)(bp + 260) + 1.0f};
#pragma unroll
        for (int ai = 0; ai < 2; ++ai)
#pragma unroll
            for (int m = 0; m < 4; ++m) { const size_t r = (size_t)(row0 + ai * HALF + m * 16);
                f32x4 o[2];
#pragma unroll
                for (int n = 0; n < 2; ++n) {
                    f32x4 g = acc[ai][0][m][n] * WSC + bg[n], l = acc[ai][1][m][n] * WSC + bl1[n];
#pragma unroll
                    for (int j = 0; j < 4; ++j) { g[j] = fminf(g[j], SW_LIMIT); l[j] = fminf(fmaxf(l[j], 1.0f - SW_LIMIT), 1.0f + SW_LIMIT); }
                    const f32x4 t = g * (-SW_ALPHA * 1.44269504089f); f32x4 e;
#pragma unroll
                    for (int j = 0; j < 4; ++j) e[j] = __builtin_amdgcn_exp2f(t[j]);
                    const f32x4 d = e + 1.0f; f32x4 rc;
#pragma unroll
                    for (int j = 0; j < 4; ++j) rc[j] = fast_rcp(d[j]);
                    o[n] = (g * rc) * l; }
                *(u32x2*)(act + r * DFF + hc0) = (u32x2){pk4_fp8_nc(o[0][0], o[0][1], o[0][2], o[0][3]), pk4_fp8_nc(o[1][0], o[1][1], o[1][2], o[1][3])}; }
    }
};
struct EpiMoeOut {
    static constexpr bool HAS_MID = false;
    const float* b2; const float* rw; unsigned char* ya;
    static constexpr bool TPROBE = false;
    static constexpr int NSB = 2, NST = 16;
    __device__ __forceinline__ const char* sb_ptr(const Unit& u, int k) const { return k == 0 ? (const char*)(b2 + (size_t)u.e * D + u.pn * BM) : (const char*)(rw + u.pm * BM); }
    __device__ __forceinline__ int sb_lanes(int) const { return 64; }
    __device__ __forceinline__ bool keep(const Unit&) const { return false; }
    __device__ __forceinline__ void operator()(f32x4 (&acc)[2][2][4][2], const Unit& u, int wr, int wc, int fr, int fq, const LAS unsigned char* side) const {
        const int lrow0 = wr * 64 + fr, col0 = u.pn * BM + wc * 32 + 8 * fq, row_t = u.pm * BM;
        unsigned char* tbase = ya + (size_t)row_t * D + col0;
        const LAS float* sb = (const LAS float*)side; const LAS float* srw = (const LAS float*)(side + 1024);
        f32x4 bv[2][2];
#pragma unroll
        for (int bj = 0; bj < 2; ++bj) { const LAS float* bp = sb + bj * HALF + wc * 32 + 8 * fq; bv[bj][0] = *(const LAS f32x4*)bp; bv[bj][1] = *(const LAS f32x4*)(bp + 4); }
#pragma unroll
        for (int ai = 0; ai < 2; ++ai)
#pragma unroll
            for (int m = 0; m < 4; ++m) { const int lr = lrow0 + ai * HALF + m * 16; const float w = srw[lr]; unsigned char* dst = tbase + (size_t)lr * D;
#pragma unroll
                for (int bj = 0; bj < 2; ++bj) { const f32x4 o0 = (acc[ai][bj][m][0] * (1.0f / 32.0f) + bv[bj][0]) * w, o1 = (acc[ai][bj][m][1] * (1.0f / 32.0f) + bv[bj][1]) * w;
                    *(u32x2*)(dst + bj * HALF) = (u32x2){pk4_fp8(o0[0], o0[1], o0[2], o0[3]), pk4_fp8(o1[0], o1[1], o1[2], o1[3])}; } }
    }
};
}

struct Args { const float* in[20]; float* out; unsigned char* ws; int ph_lo, ph_hi; };

__device__ __forceinline__ void transpose_item(const float* W, int N, bf16_t* WT, int ldwt, int k0, int n0, int dst_row0, LAS float* scr, int lane) {
    const int ks = lane >> 4, n4 = (lane & 15) * 4;
    f32x4 v[16];
#pragma unroll
    for (int i = 0; i < 16; ++i) v[i] = *(const f32x4*)(W + (size_t)(k0 + 4 * i + ks) * N + n0 + n4);
#pragma unroll
    for (int i = 0; i < 16; ++i) { LAS float* s = scr + (4 * i + ks) * 65 + n4; s[0] = v[i][0]; s[1] = v[i][1]; s[2] = v[i][2]; s[3] = v[i][3]; }
    LDS_WAIT(); asm volatile("" ::: "memory");
    const int kc = lane & 7;
#pragma unroll
    for (int p = 0; p < 8; ++p) { const int n = (lane >> 3) + 8 * p; const LAS float* s = scr + (8 * kc) * 65 + n;
        u32x4 o; o.x = cvt_pk_bf16(s[0], s[65]); o.y = cvt_pk_bf16(s[2 * 65], s[3 * 65]); o.z = cvt_pk_bf16(s[4 * 65], s[5 * 65]); o.w = cvt_pk_bf16(s[6 * 65], s[7 * 65]);
        *(u32x4*)(WT + (size_t)(dst_row0 + n) * ldwt + k0 + 8 * kc) = o; }
    LDS_WAIT(); asm volatile("" ::: "memory");
}

template <bool NT = false>
__device__ __forceinline__ void transpose_item_fp8(const float* W, int N, unsigned char* WT, int ldwt, int k0, int n0, int dst_row0, LAS float* scr, int lane) {
    const int ks = lane >> 3, n4 = (lane & 7) * 4;
    f32x4 v[16];
#pragma unroll
    for (int i = 0; i < 16; ++i) { const f32x4* p = (const f32x4*)(W + (size_t)(k0 + 8 * i + ks) * N + n0 + n4); v[i] = NT ? __builtin_nontemporal_load(p) : *p; }
#pragma unroll
    for (int i = 0; i < 16; ++i) { LAS float* s = scr + (8 * i + ks) * 33 + n4; s[0] = v[i][0]; s[1] = v[i][1]; s[2] = v[i][2]; s[3] = v[i][3]; }
    LDS_WAIT(); asm volatile("" ::: "memory");
    const int kc = lane & 7;
#pragma unroll
    for (int p = 0; p < 4; ++p) { const int n = (lane >> 3) + 8 * p; const LAS float* s = scr + (16 * kc) * 33 + n;
        u32x4 o;
        o.x = pk4_fp8(32.f * s[0], 32.f * s[33], 32.f * s[2 * 33], 32.f * s[3 * 33]); o.y = pk4_fp8(32.f * s[4 * 33], 32.f * s[5 * 33], 32.f * s[6 * 33], 32.f * s[7 * 33]);
        o.z = pk4_fp8(32.f * s[8 * 33], 32.f * s[9 * 33], 32.f * s[10 * 33], 32.f * s[11 * 33]); o.w = pk4_fp8(32.f * s[12 * 33], 32.f * s[13 * 33], 32.f * s[14 * 33], 32.f * s[15 * 33]);
        u32x4* q = (u32x4*)(WT + (size_t)(dst_row0 + n) * ldwt + k0 + 16 * kc); if (NT) __builtin_nontemporal_store(o, q); else *q = o; }
    LDS_WAIT(); asm volatile("" ::: "memory");
}

constexpr int BG_W1 = 32 * 8 * 64, BG_W2 = 32 * 8 * 32, BG_N = BG_W1 + BG_W2;
struct BgCtx { const float* w1; const float* w2; unsigned char* W1q; unsigned char* W2q; unsigned* qhead; };
__device__ __forceinline__ bool bg_item(const BgCtx& c, LAS float* scr, int lane) {
    unsigned it = 0; if (lane == 0) it = __hip_atomic_fetch_add(c.qhead, 1u, __ATOMIC_RELAXED, __HIP_MEMORY_SCOPE_AGENT);
    it = (unsigned)__builtin_amdgcn_readfirstlane((int)it);
    if (it >= (unsigned)BG_N) return false;
    if (it < (unsigned)BG_W1) { const int r = (int)it, e = r / 512, q = r % 512, kb = q / 64, nb = q % 64;
        const int pn = nb >> 3, wi = (nb & 7) * 32; const int src = wi < 128 ? pn * 128 + wi : 1024 + pn * 128 + (wi - 128);
        transpose_item_fp8<true>(c.w1 + (size_t)e * D * 2048, 2048, c.W1q + (size_t)e * 2048 * D, D, kb * 128, src, nb * 32, scr, lane); }
    else { const int r = (int)it - BG_W1, e = r / 256, q = r % 256, kb = q / 32, nb = q % 32;
        transpose_item_fp8<true>(c.w2 + (size_t)e * DFF * D, D, c.W2q + (size_t)e * D * DFF, DFF, kb * 128, nb * 32, nb * 32, scr, lane); }
    return true;
}
__device__ __forceinline__ void xcd_barrier_bg(const XcdBarrier& b, const BgCtx& c, LAS unsigned char* lds, int wave, int lane, bool drain) {
    volatile LAS unsigned* M = (volatile LAS unsigned*)(lds + MISC_OFF);
    LAS float* scr = (LAS float*)(lds + wave * 16896);
    if (drain) { while (bg_item(c, scr, lane)) { } }
    asm volatile("s_waitcnt vmcnt(0)" ::: "memory");
    __syncthreads();
    if (threadIdx.x == 0) {
        unsigned* bar = b.bar;
        __builtin_amdgcn_s_waitcnt(0);
        unsigned nloc = b.st[0], nx = b.st[1];
        if (nloc == 0u) { xcd_barrier_complete(bar, b.x, nloc, nx); b.st[0] = nloc; b.st[1] = nx; }
        const unsigned old = xb_add(&bar[XB_XSUB(b.x)], 1u);
        const unsigned gen = old / nloc;
        if (old + 1u == (gen + 1u) * nloc) {
            __builtin_amdgcn_fence(__ATOMIC_RELEASE, "agent");
            asm volatile("s_waitcnt vmcnt(0)" ::: "memory");
            const unsigned og = xb_add(&bar[XB_TOP], 1u);
            const unsigned tg = og / nx;
            if (og + 1u == (tg + 1u) * nx) { xb_add(&bar[XB_TOPGEN], 1u); M[10] = 2u; } else M[10] = 1u;
            M[11] = tg;
        } else { M[10] = 0u; M[11] = gen; }
    }
    unsigned spins = 0;
    for (;;) {
        if (threadIdx.x == 0) { const unsigned role = M[10], g = M[11]; unsigned* bar = b.bar;
            bool rel = role == 2u ? true : role == 1u ? (xb_ld(&bar[XB_TOPGEN]) != g) : (xb_ld(&bar[XB_XGEN(b.x)]) != g);
            if (!rel && (++spins & 255u) == 0u) { if (xb_ld(&bar[XB_TMO])) rel = true; else if (spins > XB_SPIN_CAP) { atomicAdd(&bar[XB_TMO], 1u); rel = true; } }
            M[12] = rel ? 1u : 0u; }
        asm volatile("s_waitcnt lgkmcnt(0)" ::: "memory"); __syncthreads();
        const bool rel = M[12] != 0u;
        asm volatile("s_waitcnt lgkmcnt(0)" ::: "memory"); __syncthreads();
        if (rel) break;
        if (M[13] != 0u || !bg_item(c, scr, lane)) { M[13] = 1u; __builtin_amdgcn_s_sleep(16); }
    }
    if (threadIdx.x == 0) {
        __builtin_amdgcn_fence(__ATOMIC_ACQUIRE, "agent");
        if (M[10] != 0u) xb_add(&b.bar[XB_XGEN(b.x)], 1u);
        asm volatile("s_waitcnt vmcnt(0)" ::: "memory");
    }
    __syncthreads();
}

__global__ void __launch_bounds__(NTHREADS, 2) fwd_kernel(Args args) {
    extern __shared__ __attribute__((aligned(16))) unsigned char lds_raw[];
    LAS unsigned char* lds = (LAS unsigned char*)lds_raw;
    volatile LAS unsigned* MISC = (volatile LAS unsigned*)(lds + MISC_OFF);
    const int G = gridDim.x, bid = blockIdx.x;
    const int wave_sg = __builtin_amdgcn_readfirstlane((int)threadIdx.x >> 6);
#define PHASE_IDS() int lane; asm volatile("v_mbcnt_lo_u32_b32 %0, -1, 0\n\tv_mbcnt_hi_u32_b32 %0, -1, %0" : "=v"(lane)); const int wave = wave_sg; const int tid = wave * 64 + lane; const int gw = bid * NWAVES + wave, NGW = G * NWAVES; (void)lane; (void)wave; (void)gw; (void)NGW
#define CAS __attribute__((address_space(4)))
#define PHASE_ARGS() const CAS Args* ap = (const CAS Args*)__builtin_amdgcn_kernarg_segment_ptr(); asm volatile("" : "+s"(ap)); unsigned char* const ws = ap->ws; unsigned* const ctl = (unsigned*)(ws + WS_CTL); (void)ctl
#define ARG(i) (ap->in[i])
#define WSP(T, off) ((T*)(ws + (off)))
    enum { I_X = 0, I_C, I_WADA, I_BADA, I_NMIX, I_WIN, I_LBT, I_HGNW, I_CONVW, I_WHG, I_WCV, I_WMIX, I_NFFN, I_WR, I_BR, I_W1, I_B1, I_W2, I_B2, I_NFIN };
    { PHASE_IDS(); for (int u = tid; u < 64; u += NTHREADS) MISC[u] = 0u; }
    __syncthreads();
    XcdBarrier bar; bar.bar = nullptr; bar.x = 0; bar.st = nullptr;
#if MK_ONE_LAUNCH
    { PHASE_ARGS(); bar = xcd_barrier_post(ctl + CW_BAR, MISC + 8); }
#if MK_BG
#define GRID_BAR_X(drain) do { PHASE_IDS(); PHASE_ARGS(); const BgCtx bgc{ARG(I_W1), ARG(I_W2), WSP(unsigned char, WS_W1), WSP(unsigned char, WS_W2), ctl + CW_Q}; xcd_barrier_bg(bar, bgc, lds, wave, lane, drain); } while (0)
#define GRID_BAR() GRID_BAR_X(false)
#else
#define GRID_BAR() xcd_barrier(bar)
#endif
#else
#define GRID_BAR() do { } while (0)
#endif
    const int lo = args.ph_lo, hi = args.ph_hi;
#if MK_PHT
    const unsigned long long pht0 = __builtin_amdgcn_s_memrealtime(); unsigned long long phtk = 0;
#endif
#ifndef PH_MASK
#define PH_MASK 0x7ff
#endif
#define IN(k) (((PH_MASK >> (k)) & 1) && lo <= (k) && (k) < hi)
#define BOTH(k) (IN(k) && IN((k) + 1))

    if (IN(0)) for (int rep_ = 0; rep_ < 1 + ((MK_REPEAT >> 0) & 1); ++rep_) { PHASE_IDS(); PHASE_ARGS();
        const float* cvec = ARG(I_C); const float* w_ada = ARG(I_WADA); const float* b_ada = ARG(I_BADA); const float* lbtab = ARG(I_LBT);
        const float* w_in = ARG(I_WIN); const float* w_hg = ARG(I_WHG); const float* w_cv = ARG(I_WCV); const float* w_mix = ARG(I_WMIX); const float* w1 = ARG(I_W1); const float* w2 = ARG(I_W2);
        float* MOD = WSP(float, WS_MOD); float* LB = WSP(float, WS_LB);
        bf16_t* Win_t = WSP(bf16_t, WS_WIN); bf16_t* Whg_t = WSP(bf16_t, WS_WHG); bf16_t* Wcv_t = WSP(bf16_t, WS_WHG) + 512;        bf16_t* Wmix_t = WSP(bf16_t, WS_WMIX); unsigned char* W1_t = WSP(unsigned char, WS_W1); unsigned char* W2_t = WSP(unsigned char, WS_W2);
        LAS float* scr = (LAS float*)(lds + wave * 16896);
        const int nmod_w = NGW >= 768 ? 384 : 0;
        for (int it = (nmod_w ? gw - (NGW - nmod_w) : gw); it >= 0 && it < 384; it += (nmod_w ? 384 : NGW)) {
            const int n0 = it * 16, cl = lane & 15, kq = lane >> 4;
            float acc[32];
#pragma unroll
            for (int b = 0; b < 32; ++b) acc[b] = 0.f;
            for (int ch = 0; ch < 16; ++ch) {
                { const int b = lane >> 1, part = lane & 1;
#pragma unroll
                    for (int q = 0; q < 4; ++q) {
                        const float* cp = cvec + (size_t)b * D + q * 256 + ch * 16 + part * 8;
                        const f32x4 c0 = *(const f32x4*)cp, c1 = *(const f32x4*)(cp + 4);
#pragma unroll
                        for (int j = 0; j < 4; ++j) { scr[(q * 16 + part * 8 + j) * 32 + b] = c0[j] * sigmoidf_(c0[j]); scr[(q * 16 + part * 8 + 4 + j) * 32 + b] = c1[j] * sigmoidf_(c1[j]); }
                    } }
                float wv[16];
#pragma unroll
                for (int kk = 0; kk < 16; ++kk) wv[kk] = w_ada[(size_t)(kq * 256 + ch * 16 + kk) * 6144 + n0 + cl];
                LDS_WAIT(); asm volatile("" ::: "memory");
#pragma unroll
                for (int kk = 0; kk < 16; ++kk) {
                    const LAS f32x4* sp = (const LAS f32x4*)(scr + (kq * 16 + kk) * 32);
#pragma unroll
                    for (int b4 = 0; b4 < 8; ++b4) { const f32x4 s = sp[b4]; acc[4 * b4] += wv[kk] * s[0]; acc[4 * b4 + 1] += wv[kk] * s[1]; acc[4 * b4 + 2] += wv[kk] * s[2]; acc[4 * b4 + 3] += wv[kk] * s[3]; }
                }
                LDS_WAIT(); asm volatile("" ::: "memory");
            }
            const float bias = b_ada[n0 + cl];
#pragma unroll
            for (int b = 0; b < 32; ++b) { float v = acc[b]; v += __shfl_xor(v, 16); v += __shfl_xor(v, 32); if (kq == 0) MOD[(size_t)b * 6144 + n0 + cl] = v + bias; }
        }
        if (bid == (G > 1 ? 1 : 0)) { const int k = tid; const float l0 = lbtab[k], l1 = lbtab[HW + k]; LB[k] = fast_rcp(1.0f + fast_exp(l1 - l0)); }
        {
            constexpr int I_IN = 16 * 88, I_HG = 8 * 16, I_CV = 8 * 16, I_MIX = 16 * 16, I_W1 = 32 * 8 * 64, I_W2 = 32 * 8 * 32;
            constexpr int NITEMS = I_IN + I_HG + I_CV + I_MIX + ((MK_BG && MK_ONE_LAUNCH) ? 0 : I_W1 + I_W2);
            const int n_nm = NGW - nmod_w, base2 = 2 * n_nm, nfull = (NITEMS - base2) / NGW, base3 = base2 + nfull * NGW;
            for (int rr = 0; rr < nfull + 3; ++rr) {
                int it;
                if (rr < 2) { if (gw >= n_nm) continue; it = rr * n_nm + gw; }
                else if (rr < 2 + nfull) it = base2 + (rr - 2) * NGW + gw;
                else { if (gw >= n_nm) continue; it = base3 + gw; }
                if (it >= NITEMS) continue;
                int r = it;
#if MK_P2FP8
                if (r < I_IN) { const int kb = r / 176, nb = r % 176; transpose_item_fp8(w_in, INC, (unsigned char*)Win_t, D, kb * 128, nb * 32, nb * 32, scr, lane); continue; } r -= I_IN;
#else
                if (r < I_IN) { const int kb = r / 88, nb = r % 88; const int pn = nb >> 2, wi = (nb & 3) * 64;
                    const int src = pn < 10 ? nb * 64 : pn < 14 ? (wi < 128 ? 2560 + (pn - 10) * 128 + wi : 3072 + (pn - 10) * 128 + (wi - 128)) : (wi < 128 ? 3584 + (pn - 14) * 128 + wi : 4608 + (pn - 14) * 128 + (wi - 128));
                    transpose_item(w_in, INC, Win_t, D, kb * 64, src, nb * 64, scr, lane); continue; } r -= I_IN;
#endif
                if (r < I_HG) { const int kb = r / 16, nb = r % 16; transpose_item(w_hg, D, Whg_t, D, kb * 64, nb * 64, nb * 64, scr, lane); continue; } r -= I_HG;
                if (r < I_CV) { const int kb = r / 16, nb = r % 16; transpose_item(w_cv, D, Wcv_t, D, kb * 64, nb * 64, nb * 64, scr, lane); continue; } r -= I_CV;
                if (r < I_MIX) { const int kb = r / 16, nb = r % 16; transpose_item(w_mix, D, Wmix_t, D, kb * 64, nb * 64, nb * 64, scr, lane); continue; } r -= I_MIX;
                if (r < I_W1) { const int e = r / 512, q = r % 512, kb = q / 64, nb = q % 64;
                    const int pn = nb >> 3, wi = (nb & 7) * 32; const int src = wi < 128 ? pn * 128 + wi : 1024 + pn * 128 + (wi - 128);
                    transpose_item_fp8(w1 + (size_t)e * D * 2048, 2048, W1_t + (size_t)e * 2048 * D, D, kb * 128, src, nb * 32, scr, lane); continue; } r -= I_W1;
                { const int e = r / 256, q = r % 256, kb = q / 32, nb = q % 32;
                    transpose_item_fp8(w2 + (size_t)e * DFF * D, D, W2_t + (size_t)e * D * DFF, DFF, kb * 128, nb * 32, nb * 32, scr, lane); }
            }
        }
        if (BOTH(0)) GRID_BAR();
#if MK_PHT
        if (MK_PHT == 1) phtk = __builtin_amdgcn_s_memrealtime() - pht0;
#endif
    }

    if (IN(1)) for (int rep_ = 0; rep_ < 1 + ((MK_REPEAT >> 1) & 1); ++rep_) { PHASE_IDS(); PHASE_ARGS();
        const float* x = ARG(I_X); const float* norm_mix_w = ARG(I_NMIX); const float* MOD = WSP(float, WS_MOD); bf16_t* U = WSP(bf16_t, WS_U);
        for (int m0 = gw * 32; m0 < NTOK; m0 += NGW * 32) {
            const int b = m0 >> 11;
            f32x4 A[4], Sh[4];
#pragma unroll
            for (int j = 0; j < 4; ++j) { const int k = 4 * lane + 256 * j; const f32x4 w = *(const f32x4*)(norm_mix_w + k), sc = *(const f32x4*)(MOD + (size_t)b * 6144 + 1024 + k);
                A[j] = w * (sc + 1.0f); Sh[j] = *(const f32x4*)(MOD + (size_t)b * 6144 + k); }
            for (int r = 0; r < 32; r += 4) {
                f32x4 v[4][4]; float ss[4];
#pragma unroll
                for (int q = 0; q < 4; ++q) { const float* xr = x + (size_t)(m0 + r + q) * D; ss[q] = 0.f;
#pragma unroll
                    for (int j = 0; j < 4; ++j) v[q][j] = *(const f32x4*)(xr + 4 * lane + 256 * j); }
#pragma unroll
                for (int q = 0; q < 4; ++q) {
#pragma unroll
                    for (int j = 0; j < 4; ++j) ss[q] += (v[q][j][0] * v[q][j][0] + v[q][j][1] * v[q][j][1]) + (v[q][j][2] * v[q][j][2] + v[q][j][3] * v[q][j][3]);
                    const float rs = __builtin_amdgcn_rsqf(wave_sum(ss[q]) * (1.0f / D) + EPS);
#if MK_P2FP8
                    unsigned char* ur = (unsigned char*)U + (size_t)(m0 + r + q) * D;
#pragma unroll
                    for (int j = 0; j < 4; ++j) { const f32x4 o = v[q][j] * rs * A[j] + Sh[j]; *(unsigned*)(ur + 4 * lane + 256 * j) = pk4_fp8(o[0], o[1], o[2], o[3]); }
#else
                    bf16_t* ur = U + (size_t)(m0 + r + q) * D;
#pragma unroll
                    for (int j = 0; j < 4; ++j) { const f32x4 o = v[q][j] * rs * A[j] + Sh[j]; u32x2 w; w.x = cvt_pk_bf16(o[0], o[1]); w.y = cvt_pk_bf16(o[2], o[3]); *(u32x2*)(ur + 4 * lane + 256 * j) = w; }
#endif
                }
            }
        }
        if (BOTH(1)) GRID_BAR();
#if MK_PHT
        if (MK_PHT == 2) phtk = __builtin_amdgcn_s_memrealtime() - pht0;
#endif
    }

    if (IN(2)) for (int rep_ = 0; rep_ < 1 + ((MK_REPEAT >> 2) & 1); ++rep_) { PHASE_ARGS();
        gm::DenseOrder S{NTOK / 256, INC / 256, G, bid, 1}; gm::DenseA AM{D, 0u, MK_P2FP8 ? 1 : 2}; gm::EpiProj E{WSP(bf16_t, WS_PROJ), (bf16_t*)ap->out, WSP(float, WS_LB)};
        gm::gemm_phase<(MK_P2FP8 != 0)>(wave_sg, lds, (const char*)WSP(bf16_t, WS_U), (const char*)WSP(bf16_t, WS_WIN), D, 0, 0u, S, E, AM);
        if (BOTH(2)) GRID_BAR();
#if MK_PHT
        if (MK_PHT == 3) phtk = __builtin_amdgcn_s_memrealtime() - pht0;
#endif
    }

    if (IN(3)) for (int rep_ = 0; rep_ < 1 + ((MK_REPEAT >> 3) & 1); ++rep_) { PHASE_IDS(); PHASE_ARGS();
        const float* hg_norm_w = ARG(I_HGNW); const float* conv_w = ARG(I_CONVW); const bf16_t* PROJ = WSP(bf16_t, WS_PROJ); bf16_t* OB = WSP(bf16_t, WS_O); bf16_t* CVB = WSP(bf16_t, WS_O) + 512;
        const int nchainblk = (G >= 256) ? 128 : (G >= 2 ? G / 2 : 1);
        if (bid < nchainblk) {
            constexpr int LDQ = 136, LDT = 72;
            LAS bf16_t* QT = (LAS bf16_t*)(lds);
            LAS bf16_t* KT = QT + 64 * LDQ;
            LAS bf16_t* QB = KT + 64 * LDQ;
            LAS bf16_t* KBT = QB + 64 * LDQ;
            LAS bf16_t* VT = KBT + 128 * LDT;
            LAS bf16_t* PM = VT + 128 * LDT;
            LAS bf16_t* ST = PM + 64 * LDT;
            LAS bf16_t* OS = ST + 128 * LDQ;
            LAS float* SEG = (LAS float*)(OS + 64 * LDQ);
            LAS float* DEC = SEG + 8 * 128;
            const int fr = lane & 15, fq = lane >> 4, w = wave;
            for (int chain = bid; chain < BATCH * NHEAD; chain += nchainblk) {
                const int b = chain >> 2, h = chain & 3;
                __syncthreads();
                for (int i = tid; i < 128 * LDQ / 2; i += NTHREADS) ((LAS unsigned*)ST)[i] = 0u;
                f32x4 Sacc[8];
#pragma unroll
                for (int i = 0; i < 8; ++i) Sacc[i] = (f32x4){0.f, 0.f, 0.f, 0.f};
                const int ot = tid >> 3, ocg = tid & 7;
                f32x4 nwv[4];
#pragma unroll
                for (int q = 0; q < 2; ++q) { nwv[2 * q] = *(const f32x4*)(hg_norm_w + q * 64 + 8 * ocg); nwv[2 * q + 1] = *(const f32x4*)(hg_norm_w + q * 64 + 8 * ocg + 4); }
                const bf16_t* pbase = PROJ + (size_t)(b * SEQ) * PROJ_LD + h * DK;
                unsigned rq[8], rl[8], rv[8];
#pragma unroll
                for (int r = 0; r < 8; ++r) { const bf16_t* p = pbase + (size_t)(8 * w + r) * PROJ_LD + 2 * lane; rq[r] = *(const unsigned*)p; rl[r] = *(const unsigned*)(p + 512); rv[r] = *(const unsigned*)(p + 1024); }
                for (int c = 0; c < NCHUNK; ++c) {
                    const int m0 = c * CHUNK;
                    float cs0[8], cs1[8]; { float a0 = 0.f, a1 = 0.f;
#pragma unroll
                        for (int r = 0; r < 8; ++r) { a0 += bf_lo(rl[r]); a1 += bf_hi(rl[r]); cs0[r] = a0; cs1[r] = a1; }
                        *(LAS f32x2*)(SEG + w * 128 + 2 * lane) = (f32x2){a0, a1}; }
                    LDS_WAIT(); __builtin_amdgcn_s_barrier(); asm volatile("" ::: "memory");
                    float pre0 = 0.f, pre1 = 0.f, bm0 = 0.f, bm1 = 0.f, bl0 = 0.f, bl1 = 0.f;
#pragma unroll
                    for (int s = 0; s < 8; ++s) { const f32x2 t2 = *(const LAS f32x2*)(SEG + s * 128 + 2 * lane); if (s < w) { pre0 += t2[0]; pre1 += t2[1]; } if (s < 4) { bm0 += t2[0]; bm1 += t2[1]; } bl0 += t2[0]; bl1 += t2[1]; }
                    const float em0 = fast_exp(fmaxf(bm0, -80.f)), em1 = fast_exp(fmaxf(bm1, -80.f));
                    const float el0 = fast_exp(fmaxf(bl0 - bm0, -80.f)), el1 = fast_exp(fmaxf(bl1 - bm1, -80.f));
                    if (w == 0) *(LAS f32x2*)(DEC + 2 * lane) = (f32x2){fast_exp(fmaxf(bl0, -80.f)), fast_exp(fmaxf(bl1, -80.f))};
                    unsigned kb0[4], kb1[4], vt0[4], vt1[4];
#pragma unroll
                    for (int r = 0; r < 8; ++r) {
                        const int t = 8 * w + r;
                        const float lf0 = bf_lo(rl[r]), lf1 = bf_hi(rl[r]);
                        const float d0 = fminf(fmaxf(pre0 + cs0[r] - bm0, -80.f), 80.f), d1 = fminf(fmaxf(pre1 + cs1[r] - bm1, -80.f), 80.f);
                        const float e0 = fast_exp(d0), e1 = fast_exp(d1), i0 = fast_exp(-d0), i1 = fast_exp(-d1);
                        const float kk0 = 1.0f - fast_exp(lf0), kk1 = 1.0f - fast_exp(lf1);
                        const float qt0 = bf_lo(rq[r]) * e0, qt1 = bf_hi(rq[r]) * e1, kt0 = kk0 * i0, kt1 = kk1 * i1;
                        *(LAS unsigned*)(QT + t * LDQ + 2 * lane) = cvt_pk_bf16(qt0, qt1);
                        *(LAS unsigned*)(KT + t * LDQ + 2 * lane) = cvt_pk_bf16(kt0, kt1);
                        *(LAS unsigned*)(QB + t * LDQ + 2 * lane) = cvt_pk_bf16(qt0 * em0, qt1 * em1);
                        const unsigned kbp = cvt_pk_bf16(kt0 * el0, kt1 * el1);
                        if (r & 1) { kb0[r >> 1] |= (kbp << 16); kb1[r >> 1] |= (kbp & 0xffff0000u); vt0[r >> 1] |= (rv[r] << 16); vt1[r >> 1] |= (rv[r] & 0xffff0000u); }
                        else { kb0[r >> 1] = kbp & 0xffffu; kb1[r >> 1] = kbp >> 16; vt0[r >> 1] = rv[r] & 0xffffu; vt1[r >> 1] = rv[r] >> 16; }
                    }
                    *(LAS u32x4*)(KBT + (2 * lane) * LDT + 8 * w) = (u32x4){kb0[0], kb0[1], kb0[2], kb0[3]};
                    *(LAS u32x4*)(KBT + (2 * lane + 1) * LDT + 8 * w) = (u32x4){kb1[0], kb1[1], kb1[2], kb1[3]};
                    *(LAS u32x4*)(VT + (2 * lane) * LDT + 8 * w) = (u32x4){vt0[0], vt0[1], vt0[2], vt0[3]};
                    *(LAS u32x4*)(VT + (2 * lane + 1) * LDT + 8 * w) = (u32x4){vt1[0], vt1[1], vt1[2], vt1[3]};
                    LDS_WAIT(); __builtin_amdgcn_s_barrier(); asm volatile("" ::: "memory");
                    u32x4 gg[2];
                    { const bf16_t* gp = pbase + (size_t)(m0 + ot) * PROJ_LD + 1536 + 8 * ocg; gg[0] = *(const u32x4*)gp; gg[1] = *(const u32x4*)(gp + 64); }
                    if (c + 1 < NCHUNK) {
#pragma unroll
                        for (int r = 0; r < 8; ++r) { const bf16_t* p = pbase + (size_t)(m0 + CHUNK + 8 * w + r) * PROJ_LD + 2 * lane; rq[r] = *(const unsigned*)p; rl[r] = *(const unsigned*)(p + 512); rv[r] = *(const unsigned*)(p + 1024); }
                    }
#pragma unroll
                    for (int x2 = 0; x2 < 2; ++x2) { const int id = 2 * w + x2, si = id >> 2, ti = id & 3;
                        f32x4 sc = (f32x4){0.f, 0.f, 0.f, 0.f};
                        if (si <= ti) {
#pragma unroll
                            for (int ks = 0; ks < 4; ++ks) { const bf16x8 a = *(const LAS bf16x8*)(KT + (16 * si + fr) * LDQ + 32 * ks + 8 * fq), bb = *(const LAS bf16x8*)(QT + (16 * ti + fr) * LDQ + 32 * ks + 8 * fq);
                                sc = __builtin_amdgcn_mfma_f32_16x16x32_bf16(a, bb, sc, 0, 0, 0); }
                            const int t = 16 * ti + fr, s0 = 16 * si + 4 * fq;
#pragma unroll
                            for (int j = 0; j < 4; ++j) sc[j] = (s0 + j <= t) ? sc[j] : 0.f;
                        }
                        *(LAS u32x2*)(PM + (16 * ti + fr) * LDT + 16 * si + 4 * fq) = (u32x2){cvt_pk_bf16(sc[0], sc[1]), cvt_pk_bf16(sc[2], sc[3])};
                    }
                    f32x4 oacc[4];
                    { bf16x8 sa[4];
#pragma unroll
                        for (int ks = 0; ks < 4; ++ks) sa[ks] = *(const LAS bf16x8*)(ST + (16 * w + fr) * LDQ + 32 * ks + 8 * fq);
#pragma unroll
                        for (int ti = 0; ti < 4; ++ti) { oacc[ti] = (f32x4){0.f, 0.f, 0.f, 0.f};
#pragma unroll
                            for (int ks = 0; ks < 4; ++ks) { const bf16x8 bb = *(const LAS bf16x8*)(QB + (16 * ti + fr) * LDQ + 32 * ks + 8 * fq); oacc[ti] = __builtin_amdgcn_mfma_f32_16x16x32_bf16(sa[ks], bb, oacc[ti], 0, 0, 0); } } }
                    LDS_WAIT(); __builtin_amdgcn_s_barrier(); asm volatile("" ::: "memory");
                    { bf16x8 va[2];
#pragma unroll
                        for (int ks = 0; ks < 2; ++ks) va[ks] = *(const LAS bf16x8*)(VT + (16 * w + fr) * LDT + 32 * ks + 8 * fq);
#pragma unroll
                        for (int ti = 0; ti < 4; ++ti)
#pragma unroll
                            for (int ks = 0; ks < 2; ++ks) { const bf16x8 bb = *(const LAS bf16x8*)(PM + (16 * ti + fr) * LDT + 32 * ks + 8 * fq); oacc[ti] = __builtin_amdgcn_mfma_f32_16x16x32_bf16(va[ks], bb, oacc[ti], 0, 0, 0); }
#pragma unroll
                        for (int i = 0; i < 8; ++i) { const f32x4 dv = *(const LAS f32x4*)(DEC + 16 * i + 4 * fq); Sacc[i] = Sacc[i] * dv;
#pragma unroll
                            for (int ks = 0; ks < 2; ++ks) { const bf16x8 a = *(const LAS bf16x8*)(KBT + (16 * i + fr) * LDT + 32 * ks + 8 * fq); Sacc[i] = __builtin_amdgcn_mfma_f32_16x16x32_bf16(a, va[ks], Sacc[i], 0, 0, 0); } } }
#pragma unroll
                    for (int ti = 0; ti < 4; ++ti) *(LAS u32x2*)(OS + (16 * ti + fr) * LDQ + 16 * w + 4 * fq) = (u32x2){cvt_pk_bf16(oacc[ti][0], oacc[ti][1]), cvt_pk_bf16(oacc[ti][2], oacc[ti][3])};
#pragma unroll
                    for (int i = 0; i < 8; ++i) *(LAS u32x2*)(ST + (16 * w + fr) * LDQ + 16 * i + 4 * fq) = (u32x2){cvt_pk_bf16(Sacc[i][0], Sacc[i][1]), cvt_pk_bf16(Sacc[i][2], Sacc[i][3])};
                    LDS_WAIT(); __builtin_amdgcn_s_barrier(); asm volatile("" ::: "memory");
                    { f32x4 o[4]; const u32x4 ow0 = *(const LAS u32x4*)(OS + ot * LDQ + 8 * ocg), ow1 = *(const LAS u32x4*)(OS + ot * LDQ + 64 + 8 * ocg); gm::unpack8(ow0, o[0], o[1]); gm::unpack8(ow1, o[2], o[3]);
                        float ss = 0.f;
#pragma unroll
                        for (int q = 0; q < 4; ++q) ss += (o[q][0] * o[q][0] + o[q][1] * o[q][1]) + (o[q][2] * o[q][2] + o[q][3] * o[q][3]);
                        ss += __shfl_xor(ss, 1); ss += __shfl_xor(ss, 2); ss += __shfl_xor(ss, 4);
                        const float rn = __builtin_amdgcn_rsqf(ss * (1.0f / 128.0f) + EPS);
                        bf16_t* op = OB + (size_t)(b * SEQ + m0 + ot) * D + h * DK + 8 * ocg;
#pragma unroll
                        for (int q = 0; q < 2; ++q) { f32x4 g0, g1; gm::unpack8(gg[q], g0, g1);
#pragma unroll
                            for (int j = 0; j < 4; ++j) { g0[j] = g0[j] * sigmoidf_(g0[j]); g1[j] = g1[j] * sigmoidf_(g1[j]); }
                            *(u32x4*)(op + 64 * q) = gm::pack8(o[2 * q] * rn * nwv[2 * q] * g0, o[2 * q + 1] * rn * nwv[2 * q + 1] * g1); } }
                }
            }
        } else {
            const int nconv = G - nchainblk;
            f32x4 cw[3][2];
#pragma unroll
            for (int j = 0; j < 3; ++j) { cw[j][0] = *(const f32x4*)(conv_w + j * 512 + 8 * lane); cw[j][1] = *(const f32x4*)(conv_w + j * 512 + 8 * lane + 4); }
            for (int it = bid - nchainblk; it < BATCH * 8; it += nconv) {
                const int b = it >> 3, t0 = (it & 7) * 256 + wave * 32;
                const bf16_t* pb = PROJ + (size_t)(b * SEQ) * PROJ_LD + 2048 + 8 * lane;
                f32x4 p1[2], p2[2];
#pragma unroll
                for (int q = 0; q < 2; ++q) { p1[q] = (f32x4){0.f, 0.f, 0.f, 0.f}; p2[q] = p1[q]; }
                if (t0 > 0) { gm::unpack8(*(const u32x4*)(pb + (size_t)(t0 - 2) * PROJ_LD + 512), p2[0], p2[1]); gm::unpack8(*(const u32x4*)(pb + (size_t)(t0 - 1) * PROJ_LD + 512), p1[0], p1[1]); }
                for (int r = 0; r < 32; ++r) { const size_t ro = (size_t)(t0 + r) * PROJ_LD;
                    f32x4 q0, q1, g0, g1;
                    gm::unpack8(*(const u32x4*)(pb + ro + 512), q0, q1); gm::unpack8(*(const u32x4*)(pb + ro), g0, g1);
                    const f32x4 y0 = g0 * (cw[0][0] * p2[0] + cw[1][0] * p1[0] + cw[2][0] * q0), y1 = g1 * (cw[0][1] * p2[1] + cw[1][1] * p1[1] + cw[2][1] * q1);
                    *(u32x4*)(CVB + (size_t)(b * SEQ + t0 + r) * D + 8 * lane) = gm::pack8(y0, y1);
                    p2[0] = p1[0]; p2[1] = p1[1]; p1[0] = q0; p1[1] = q1; }
            }
        }
        if (BOTH(3)) GRID_BAR();
#if MK_PHT
        if (MK_PHT == 4) phtk = __builtin_amdgcn_s_memrealtime() - pht0;
#endif
    }

    if (IN(4)) for (int rep_ = 0; rep_ < 1 + ((MK_REPEAT >> 4) & 1); ++rep_) { PHASE_ARGS();
        gm::DenseOrder S{NTOK / 256, D / 256, G, bid, 1}; gm::DenseA AM{D, 0u, 2}; gm::EpiMerge E{(const bf16_t*)ap->out, WSP(bf16_t, WS_U)};
        gm::gemm_phase<false>(wave_sg, lds, (const char*)WSP(bf16_t, WS_O), (const char*)WSP(bf16_t, WS_WHG), D, 0, 0u, S, E, AM);
        if (BOTH(4)) GRID_BAR();
#if MK_PHT
        if (MK_PHT == 5) phtk = __builtin_amdgcn_s_memrealtime() - pht0;
#endif
    }

    if (IN(5)) for (int rep_ = 0; rep_ < 1 + ((MK_REPEAT >> 5) & 1); ++rep_) { PHASE_ARGS();
        gm::DenseOrder S{NTOK / 256, D / 256, G, bid, 1}; gm::DenseA AM{D, 0u, 2}; gm::EpiMix E{ARG(I_X), WSP(float, WS_MOD), WSP(bf16_t, WS_H)};
        gm::gemm_phase<false>(wave_sg, lds, (const char*)WSP(bf16_t, WS_U), (const char*)WSP(bf16_t, WS_WMIX), D, 0, 0u, S, E, AM);
        if (BOTH(5)) GRID_BAR();
#if MK_PHT
        if (MK_PHT == 6) phtk = __builtin_amdgcn_s_memrealtime() - pht0;
#endif
    }

    if (IN(6)) { PHASE_IDS(); PHASE_ARGS();
        typedef float f32x16 __attribute__((ext_vector_type(16)));
        const float* norm_ffn_w = ARG(I_NFFN); const float* w_router = ARG(I_WR); const float* b_router = ARG(I_BR); const float* MOD = WSP(float, WS_MOD);
        const bf16_t* HB = WSP(bf16_t, WS_H); unsigned char* U2Q = WSP(unsigned char, WS_U2Q); int* TOPI = WSP(int, WS_TOPI); float* TOPP = WSP(float, WS_TOPP); int* POS = WSP(int, WS_POS);
        constexpr int WRS = 1032;
        LAS bf16_t* WRH = (LAS bf16_t*)lds; LAS bf16_t* WRL = WRH + 32 * WRS;
        LAS float* LG = (LAS float*)(lds + 132096) + wave * (16 * 36);
        LAS unsigned* LCNT = (LAS unsigned*)(lds + 150528);
        LAS unsigned* LBASE = LCNT + 32;
        LAS unsigned* LASS = LCNT + 64;
        LAS float* A2 = (LAS float*)(lds + 154880); LAS float* SH2 = A2 + 1024;
        for (int i = tid; i < 32 * 1024; i += NTHREADS) { const int e = i & 31, k = i >> 5; const float w = w_router[i];
            const unsigned hi = cvt_pk_bf16(w, 0.f) & 0xffffu; const unsigned lo = cvt_pk_bf16(w - bf_lo(hi), 0.f) & 0xffffu;
            WRH[e * WRS + k] = (bf16_t)hi; WRL[e * WRS + k] = (bf16_t)lo; }
        for (int tb = bid; tb < NTOK / 256; tb += G) {
            const int b = (tb * 256) >> 11;
            if (tid < 32) LCNT[tid] = 0u;
            for (int k = tid; k < 1024; k += NTHREADS) { A2[k] = norm_ffn_w[k] * (1.0f + MOD[(size_t)b * 6144 + 4096 + k]); SH2[k] = MOD[(size_t)b * 6144 + 3072 + k]; }
            LDS_WAIT(); __syncthreads();
            const int trow = lane & 31, half = lane >> 5, ltok0 = wave * 32, tok = tb * 256 + ltok0 + trow;
            const bf16_t* hrow = HB + (size_t)tok * D + 8 * half;
            float ssq = 0.f;
#pragma unroll 8
            for (int st = 0; st < 64; ++st) { const u32x4 hv = *(const u32x4*)(hrow + 16 * st); f32x4 x0, x1; gm::unpack8(hv, x0, x1);
                ssq += (x0[0] * x0[0] + x0[1] * x0[1]) + (x0[2] * x0[2] + x0[3] * x0[3]) + (x1[0] * x1[0] + x1[1] * x1[1]) + (x1[2] * x1[2] + x1[3] * x1[3]); }
            ssq += __shfl_xor(ssq, 32);
            const float rs = __builtin_amdgcn_rsqf(ssq * (1.0f / D) + EPS);
            f32x16 dacc;
#pragma unroll
            for (int q = 0; q < 16; ++q) dacc[q] = 0.f;
            unsigned char* urow = U2Q + (size_t)tok * D + 8 * half;
            const LAS bf16_t* wh = WRH + trow * WRS + 8 * half; const LAS bf16_t* wl = WRL + trow * WRS + 8 * half;
#pragma unroll 2
            for (int st = 0; st < 64; ++st) {
                const u32x4 hv = *(const u32x4*)(hrow + 16 * st); f32x4 x0, x1; gm::unpack8(hv, x0, x1);
                const int k0 = 16 * st + 8 * half;
                const f32x4 a0 = *(const LAS f32x4*)(A2 + k0), a1 = *(const LAS f32x4*)(A2 + k0 + 4), s0 = *(const LAS f32x4*)(SH2 + k0), s1 = *(const LAS f32x4*)(SH2 + k0 + 4);
                const f32x4 u0 = x0 * rs * a0 + s0, u1 = x1 * rs * a1 + s1;
                *(u32x2*)(urow + 16 * st) = (u32x2){pk4_fp8(u0[0], u0[1], u0[2], u0[3]), pk4_fp8(u1[0], u1[1], u1[2], u1[3])};
                u32x4 hh; hh.x = cvt_pk_bf16(u0[0], u0[1]); hh.y = cvt_pk_bf16(u0[2], u0[3]); hh.z = cvt_pk_bf16(u1[0], u1[1]); hh.w = cvt_pk_bf16(u1[2], u1[3]);
                u32x4 ll; ll.x = cvt_pk_bf16(u0[0] - bf_lo(hh.x), u0[1] - bf_hi(hh.x)); ll.y = cvt_pk_bf16(u0[2] - bf_lo(hh.y), u0[3] - bf_hi(hh.y));
                ll.z = cvt_pk_bf16(u1[0] - bf_lo(hh.z), u1[1] - bf_hi(hh.z)); ll.w = cvt_pk_bf16(u1[2] - bf_lo(hh.w), u1[3] - bf_hi(hh.w));
                const bf16x8 ah = __builtin_bit_cast(bf16x8, hh), al = __builtin_bit_cast(bf16x8, ll);
                const bf16x8 bh = *(const LAS bf16x8*)(wh + 16 * st), bl = *(const LAS bf16x8*)(wl + 16 * st);
                dacc = __builtin_amdgcn_mfma_f32_32x32x16_bf16(ah, bh, dacc, 0, 0, 0);
                dacc = __builtin_amdgcn_mfma_f32_32x32x16_bf16(ah, bl, dacc, 0, 0, 0);
                dacc = __builtin_amdgcn_mfma_f32_32x32x16_bf16(al, bh, dacc, 0, 0, 0);
            }
            const float br = b_router[trow];
#pragma unroll
            for (int g = 0; g < 2; ++g) {
#pragma unroll
                for (int q = 0; q < 8; ++q) { const int r16 = (q & 3) + 8 * (q >> 2) + 4 * half; LG[r16 * 36 + trow] = dacc[8 * g + q] + br; }
                LDS_WAIT(); asm volatile("" ::: "memory");
                if (lane < 16) {
                    float v0 = -3.0e38f, v1 = -3.0e38f, v2 = -3.0e38f, v3 = -3.0e38f; int i0 = 0, i1 = 0, i2 = 0, i3 = 0;
#pragma unroll
                    for (int e4 = 0; e4 < 8; ++e4) { const f32x4 lv = *(const LAS f32x4*)(LG + lane * 36 + 4 * e4);
#pragma unroll
                        for (int j = 0; j < 4; ++j) { const float x = lv[j]; const int e = 4 * e4 + j;
                            const bool c0 = x > v0, c1 = x > v1, c2 = x > v2, c3 = x > v3;
                            v3 = c2 ? v2 : (c3 ? x : v3); i3 = c2 ? i2 : (c3 ? e : i3);
                            v2 = c1 ? v1 : (c2 ? x : v2); i2 = c1 ? i1 : (c2 ? e : i2);
                            v1 = c0 ? v0 : (c1 ? x : v1); i1 = c0 ? i0 : (c1 ? e : i1);
                            v0 = c0 ? x : v0; i0 = c0 ? e : i0; } }
                    const float e1 = fast_exp(v1 - v0), e2 = fast_exp(v2 - v0), e3 = fast_exp(v3 - v0); const float inv = fast_rcp(1.0f + e1 + e2 + e3);
                    const int lt = ltok0 + 16 * g + lane; const size_t gt = (size_t)tb * 256 + lt;
                    typedef int i32x4 __attribute__((ext_vector_type(4)));
                    *(i32x4*)(TOPI + gt * 4) = (i32x4){i0, i1, i2, i3}; *(f32x4*)(TOPP + gt * 4) = (f32x4){inv, e1 * inv, e2 * inv, e3 * inv};
                    const unsigned r0 = __hip_atomic_fetch_add(LCNT + i0, 1u, __ATOMIC_RELAXED, __HIP_MEMORY_SCOPE_WORKGROUP), r1 = __hip_atomic_fetch_add(LCNT + i1, 1u, __ATOMIC_RELAXED, __HIP_MEMORY_SCOPE_WORKGROUP);
                    const unsigned r2 = __hip_atomic_fetch_add(LCNT + i2, 1u, __ATOMIC_RELAXED, __HIP_MEMORY_SCOPE_WORKGROUP), r3 = __hip_atomic_fetch_add(LCNT + i3, 1u, __ATOMIC_RELAXED, __HIP_MEMORY_SCOPE_WORKGROUP);
                    *(LAS u32x4*)(LASS + lt * 4) = (u32x4){((unsigned)i0 << 16) | r0, ((unsigned)i1 << 16) | r1, ((unsigned)i2 << 16) | r2, ((unsigned)i3 << 16) | r3};
                }
                LDS_WAIT(); asm volatile("" ::: "memory");
            }
            LDS_WAIT(); __syncthreads();
            if (tid < 32) LBASE[tid] = atomicAdd(ctl + CW_CNT + 64 * tid, (unsigned)LCNT[tid]);
            LDS_WAIT(); __syncthreads();
            for (int i = tid; i < 1024; i += NTHREADS) { const unsigned v = LASS[i]; POS[(size_t)tb * 1024 + i] = (int)(LBASE[v >> 16] + (v & 0xffffu)); }
            __syncthreads();
        }
        if (BOTH(6)) GRID_BAR();
#if MK_PHT
        if (MK_PHT == 7) phtk = __builtin_amdgcn_s_memrealtime() - pht0;
#endif
    }

    LAS int* PADSTART = (LAS int*)(lds + TBL_OFF); LAS int* TILE_E = PADSTART + 64;
    int ntiles = 0;
    {
        if (lo <= 9 && hi > 7) { PHASE_IDS(); PHASE_ARGS();
            __syncthreads();
            if (wave == 0) {
                const int cnt = lane < NE ? (int)__hip_atomic_load(ctl + CW_CNT + 64 * lane, __ATOMIC_RELAXED, __HIP_MEMORY_SCOPE_AGENT) : 0;
                const int padded = ((cnt + 255) >> 8) << 8; int incl = padded;
#pragma unroll
                for (int o = 1; o < 32; o <<= 1) { const int v = __shfl_up(incl, o); if ((lane & 31) >= o) incl += v; }
                if (lane < NE) PADSTART[lane] = incl - padded;
                if (lane == NE - 1) PADSTART[NE] = incl;
            }
            LDS_WAIT(); __syncthreads();
            for (int t = tid; t < (PADSTART[NE] >> 8); t += NTHREADS) { int e = 0;
#pragma unroll
                for (int q = 1; q < NE; ++q) e += ((PADSTART[q] >> 8) <= t) ? 1 : 0;
                TILE_E[t] = e; }
            LDS_WAIT(); __syncthreads();
            ntiles = PADSTART[NE] >> 8;
        }
    }

    if (IN(7)) for (int rep_ = 0; rep_ < 1 + ((MK_REPEAT >> 7) & 1); ++rep_) { PHASE_IDS(); PHASE_ARGS();
        const int* TOPI = WSP(int, WS_TOPI); const float* TOPP = WSP(float, WS_TOPP); int* POS = WSP(int, WS_POS); int* RTOK = WSP(int, WS_RTOK); int* RSLOT = WSP(int, WS_RSLOT); float* RW = WSP(float, WS_RW);
        for (int i = bid * NTHREADS + tid; i < NASSIGN; i += G * NTHREADS) { const int e = TOPI[i]; const int row = PADSTART[e] + POS[i]; RTOK[row] = i >> 2; RSLOT[row] = i; RW[row] = TOPP[i]; POS[i] = row; }
        for (int e = bid; e < NE; e += G) { const int cnt = (int)__hip_atomic_load(ctl + CW_CNT + 64 * e, __ATOMIC_RELAXED, __HIP_MEMORY_SCOPE_AGENT);
            for (int r = PADSTART[e] + cnt + tid; r < PADSTART[e + 1]; r += NTHREADS) { RTOK[r] = 0; RSLOT[r] = -1; RW[r] = 0.f; } }
#if MK_BG && MK_ONE_LAUNCH
        if (BOTH(7)) GRID_BAR_X(true);
#else
        if (BOTH(7)) GRID_BAR();
#endif
#if MK_PHT
        if (MK_PHT == 8) phtk = __builtin_amdgcn_s_memrealtime() - pht0;
#endif
    }

    if (IN(8)) for (int rep_ = 0; rep_ < 1 + ((MK_REPEAT >> 8) & 1); ++rep_) { PHASE_ARGS();
        gm::MoeOrder S{ntiles, 2048 / 256, G, bid, TILE_E}; gm::GatherA AM{D, WSP(int, WS_RTOK), 1}; gm::EpiSwiglu E{ARG(I_B1), WSP(unsigned char, WS_ACT), ctl + CW_TP};
        gm::gemm_phase<true>(wave_sg, lds, (const char*)WSP(char, WS_U2Q), (const char*)WSP(char, WS_W1), D, 2048, 0u, S, E, AM);
        if (BOTH(8)) GRID_BAR();
#if MK_PHT
        if (MK_PHT == 9) phtk = __builtin_amdgcn_s_memrealtime() - pht0;
#endif
    }

    if (IN(9)) for (int rep_ = 0; rep_ < 1 + ((MK_REPEAT >> 9) & 1); ++rep_) { PHASE_ARGS();
        gm::MoeOrder S{ntiles, D / 256, G, bid, TILE_E}; gm::DenseA AM{DFF, 0u, 1}; gm::EpiMoeOut E{ARG(I_B2), WSP(float, WS_RW), WSP(unsigned char, WS_YA)};
        gm::gemm_phase<true>(wave_sg, lds, (const char*)WSP(char, WS_ACT), (const char*)WSP(char, WS_W2), DFF, D, 0u, S, E, AM);
        if (BOTH(9)) GRID_BAR();
#if MK_PHT
        if (MK_PHT == 10) phtk = __builtin_amdgcn_s_memrealtime() - pht0;
#endif
    }

#if MK_PROBE
    if (lo == 100) { PHASE_IDS(); PHASE_ARGS();
        float* out = ap->out;
        const bf16_t* src = MK_PROBE == 1 ? WSP(bf16_t, WS_U) : MK_PROBE == 3 ? WSP(bf16_t, WS_O) : MK_PROBE == 4 ? WSP(bf16_t, WS_U) : MK_PROBE == 5 ? WSP(bf16_t, WS_H) : WSP(bf16_t, WS_U);
        for (size_t i = (size_t)bid * NTHREADS + tid; i < (size_t)NTOK * D; i += (size_t)G * NTHREADS) {
            float v;
            if (MK_PROBE == 3) { const size_t t = i >> 10, c = i & 1023; v = bf1(src[t * 1024 + c]); }
            else if (MK_PROBE == 2) { const size_t t = i >> 10, c = i & 1023; const bf16_t* P = WSP(bf16_t, WS_PROJ) + t * PROJ_LD; v = bf1(P[c]) + bf1(P[c + 1024]) + bf1(P[c + 2048]) + (c < 512 ? bf1(P[c + 3072]) : 0.f); }
            else if (MK_PROBE == 6) { const size_t t = i >> 10, c = i & 1023; v = bf1(src[i]) + (c < 4 ? (float)WSP(int, WS_TOPI)[t * 4 + c] : c < 8 ? WSP(float, WS_TOPP)[t * 4 + (c - 4)] : 0.f); }
            else v = bf1(src[i]);
            out[i] = v; }
    }
#endif
    if (IN(10)) { PHASE_IDS(); PHASE_ARGS();
#if MK_TPROBE
        const float tscale = 1.0f;
#elif MK_FP8TEST
        float tscale = 1.0f;
        {
            typedef int v8i __attribute__((ext_vector_type(8)));
            const int fr = lane & 15, fq = lane >> 4;
            v8i ta, tb;
#pragma unroll
            for (int d = 0; d < 8; ++d) { float av[4], bv[4];
#pragma unroll
                for (int e = 0; e < 4; ++e) { const int k = 32 * fq + 4 * d + e; av[e] = (float)(((fr * 7 + k * 3) % 5) - 2); bv[e] = (float)(((k * 5 + fr * 11) % 7) - 3); }
                int w = __builtin_amdgcn_cvt_pk_fp8_f32(av[0], av[1], 0, false); w = __builtin_amdgcn_cvt_pk_fp8_f32(av[2], av[3], w, true); ta[d] = w;
                w = __builtin_amdgcn_cvt_pk_fp8_f32(bv[0], bv[1], 0, false); w = __builtin_amdgcn_cvt_pk_fp8_f32(bv[2], bv[3], w, true); tb[d] = w; }
            f32x4 tc = {0.f, 0.f, 0.f, 0.f};
            tc = __builtin_amdgcn_mfma_scale_f32_16x16x128_f8f6f4(ta, tb, tc, 0, 0, 0, 0x7A7A7A7A, 0, 0x7F7F7F7F);
            bool bad = false;
#pragma unroll
            for (int r = 0; r < 4; ++r) { const int i = 4 * fq + r, j = fr; float ref = 0.f;
                for (int k = 0; k < 128; ++k) ref += (float)(((i * 7 + k * 3) % 5) - 2) * (float)(((k * 5 + j * 11) % 7) - 3);
                ref *= (1.0f / 32.0f); if (fabsf(tc[r] - ref) > 1e-3f) bad = true; }
            if (__any(bad)) tscale = 4.0f;
        }
#endif
        const float* norm_final_w = ARG(I_NFIN); const float* MOD = WSP(float, WS_MOD); const bf16_t* HB = WSP(bf16_t, WS_H); const unsigned char* YA = WSP(unsigned char, WS_YA); const int* ASROW = WSP(int, WS_POS); float* out = ap->out;
        for (int m0 = gw * 32; m0 < NTOK; m0 += NGW * 32) {
            const int b = m0 >> 11;
            f32x4 gf[4], nf[4];
#pragma unroll
            for (int j = 0; j < 4; ++j) { const int k = 4 * lane + 256 * j; gf[j] = *(const f32x4*)(MOD + (size_t)b * 6144 + 5120 + k); nf[j] = *(const f32x4*)(norm_final_w + k); }
            for (int r = 0; r < 32; ++r) {
                const size_t tok = (size_t)(m0 + r);
                const bf16_t* hr = HB + tok * D;
                typedef int i32x4 __attribute__((ext_vector_type(4)));
                const i32x4 rr = *(const i32x4*)(ASROW + tok * 4);
                const unsigned char* y0 = YA + (size_t)rr[0] * D; const unsigned char* y1 = YA + (size_t)rr[1] * D; const unsigned char* y2 = YA + (size_t)rr[2] * D; const unsigned char* y3 = YA + (size_t)rr[3] * D;
                f32x4 v[4]; float s = 0.f;
#pragma unroll
                for (int j = 0; j < 4; ++j) { const int k = 4 * lane + 256 * j;
                    const u32x2 hw = *(const u32x2*)(hr + k); const unsigned ya = *(const unsigned*)(y0 + k), yb = *(const unsigned*)(y1 + k), yc = *(const unsigned*)(y2 + k), yd = *(const unsigned*)(y3 + k);
                    f32x4 y = fp8x4_to_f32(ya); y += fp8x4_to_f32(yb); y += fp8x4_to_f32(yc); y += fp8x4_to_f32(yd);
                    v[j] = (f32x4){bf_lo(hw.x), bf_hi(hw.x), bf_lo(hw.y), bf_hi(hw.y)} + gf[j] * y;
                    s += (v[j][0] * v[j][0] + v[j][1] * v[j][1]) + (v[j][2] * v[j][2] + v[j][3] * v[j][3]); }
                const float rs = __builtin_amdgcn_rsqf(wave_sum(s) * (1.0f / D) + EPS);
                float* orow = out + tok * D;
#pragma unroll
                #if MK_FP8TEST || MK_TPROBE
                for (int j = 0; j < 4; ++j) *(f32x4*)(orow + 4 * lane + 256 * j) = v[j] * rs * nf[j] * tscale;
#else
                for (int j = 0; j < 4; ++j) *(f32x4*)(orow + 4 * lane + 256 * j) = v[j] * rs * nf[j];
#endif
            }
        }
    }
#if MK_PHT
    if (bid == 0) { const unsigned long long t1 = __builtin_amdgcn_s_memrealtime(); while (__builtin_amdgcn_s_memrealtime() - t1 < phtk) __builtin_amdgcn_s_sleep(8); }
#endif
#undef IN
#undef BOTH
}

extern "C" void kernel_launch(void* const* d_in, const int* in_sizes, int n_in, void* d_out, int out_size, void* d_ws, size_t ws_size, hipStream_t stream) {
    static int grid = 0;
    if (grid == 0) {
        if (n_in != 20 || out_size != NTOK * D || ws_size < WS_END) { fprintf(stderr, "kernel_launch: unexpected shapes (n_in %d out %d ws %zu)\n", n_in, out_size, ws_size); grid = -1; return; }
        if (hipFuncSetAttribute((const void*)fwd_kernel, hipFuncAttributeMaxDynamicSharedMemorySize, LDS_BYTES) != hipSuccess) { fprintf(stderr, "kernel_launch: hipFuncSetAttribute failed\n"); grid = -1; return; }
        int dev = 0, cus = 0, per_cu = 0;
        (void)hipGetDevice(&dev); (void)hipDeviceGetAttribute(&cus, hipDeviceAttributeMultiprocessorCount, dev);
        if (hipOccupancyMaxActiveBlocksPerMultiprocessor(&per_cu, (const void*)fwd_kernel, NTHREADS, LDS_BYTES) != hipSuccess || per_cu < 1) fprintf(stderr, "kernel_launch: occupancy query says %d\n", per_cu);
        (void)hipGetLastError();
        grid = cus > 0 ? cus : 256;
    }
    if (grid < 0) return;
    (void)hipMemsetAsync((char*)d_ws + WS_CTL, 0, CTL_ZERO_BYTES, stream);
    Args a{};
    for (int i = 0; i < 20; ++i) a.in[i] = (const float*)d_in[i];
    a.out = (float*)d_out; a.ws = (unsigned char*)d_ws;
#if MK_ONE_LAUNCH
    a.ph_lo = 0; a.ph_hi = NPHASE;
    hipLaunchKernelGGL(fwd_kernel, dim3(grid), dim3(NTHREADS), LDS_BYTES, stream, a);
#else
#if MK_PROBE
    for (int p = 0; p <= MK_PROBE; ++p) { a.ph_lo = p; a.ph_hi = p + 1; hipLaunchKernelGGL(fwd_kernel, dim3(grid), dim3(NTHREADS), LDS_BYTES, stream, a); }
    a.ph_lo = 100; a.ph_hi = 101; hipLaunchKernelGGL(fwd_kernel, dim3(grid), dim3(NTHREADS), LDS_BYTES, stream, a);
#else
    for (int p = 0; p < NPHASE; ++p) { a.ph_lo = p; a.ph_hi = p + 1; hipLaunchKernelGGL(fwd_kernel, dim3(grid), dim3(NTHREADS), LDS_BYTES, stream, a); }
#endif
#endif
}
```

```cpp
#include <hip/hip_runtime.h>
#include <cstdio>
#include <cstdint>

#ifndef MK_PROBE
#define MK_PROBE 0
#endif
#ifndef MK_REPEAT
#define MK_REPEAT 0
#endif
#ifndef MK_FP8TEST
#define MK_FP8TEST 0
#endif
#ifndef MK_STAGGER
#define MK_STAGGER 0
#endif
#ifndef MK_TPROBE
#define MK_TPROBE 0
#endif
#ifndef MK_PHT
#define MK_PHT 0
#endif
#ifndef MK_PN8
#define MK_PN8 14
#endif
#ifndef MK_P2FP8
#define MK_P2FP8 0
#endif
#ifndef MK_BG
#define MK_BG 0
#endif
#ifndef MK_ONE_LAUNCH
#define MK_ONE_LAUNCH 1
#endif

#define LAS __attribute__((address_space(3)))
#define GAS __attribute__((address_space(1)))
typedef unsigned short bf16_t;
typedef short bf16x8 __attribute__((ext_vector_type(8)));
typedef float f32x4 __attribute__((ext_vector_type(4)));
typedef float f32x2 __attribute__((ext_vector_type(2)));
typedef unsigned u32x4 __attribute__((ext_vector_type(4)));
typedef unsigned u32x2 __attribute__((ext_vector_type(2)));
typedef int v8i __attribute__((ext_vector_type(8)));

constexpr int D = 1024, BATCH = 32, SEQ = 2048, NTOK = BATCH * SEQ;
constexpr int HW = 512, NHEAD = 4, DK = 128, CHUNK = 64, NCHUNK = SEQ / CHUNK;
constexpr int INC = 5632, PROJ_LD = 3584, GATE_LD = 2048;
constexpr int NE = 32, TOPK = 4, DFF = 1024, NASSIGN = NTOK * TOPK;
constexpr int MAXTILES = NASSIGN / 256 + NE;
constexpr int MAXROWS = MAXTILES * 256;
constexpr float EPS = 1e-6f, SW_LIMIT = 7.0f, SW_ALPHA = 1.702f;
constexpr int NWAVES = 8, NTHREADS = 512;
constexpr int NPHASE = 11;

constexpr size_t MiB = 1u << 20;
constexpr size_t WS_CTL = 0, CTL_ZERO_BYTES = 65536;
constexpr size_t WS_MOD = 1 * MiB;
constexpr size_t WS_LB = WS_MOD + 32 * 6144 * 4;
constexpr size_t WS_WIN = 2 * MiB;
constexpr size_t WS_WHG = 13 * MiB, WS_WCV = 14 * MiB, WS_WMIX = 15 * MiB;
constexpr size_t WS_W2 = 18 * MiB;
constexpr size_t WS_W1 = 50 * MiB;
constexpr size_t WS_U2Q = 114 * MiB;
constexpr size_t WS_U = 210 * MiB;
constexpr size_t WS_PROJ = 338 * MiB;
constexpr size_t WS_O = 786 * MiB;
constexpr size_t WS_CV = 850 * MiB;
constexpr size_t WS_H = 338 * MiB;
constexpr size_t WS_ACT = 466 * MiB;
constexpr size_t WS_TOPI = 994 * MiB, WS_TOPP = 995 * MiB, WS_POS = 996 * MiB;
constexpr size_t WS_RTOK = 997 * MiB, WS_RSLOT = 997 * MiB + 1081344 + 0, WS_RW = WS_RSLOT + 1081344;
constexpr size_t WS_YA = 50 * MiB, WS_YB = 730 * MiB; constexpr int YSPLIT = 147456;
constexpr size_t WS_YO23_UNUSED = 730 * MiB;
constexpr int PN8 = MK_PN8, NQ8 = 22 - PN8;
constexpr size_t WS_WIN8 = 914 * MiB;
constexpr size_t WS_U8 = 920 * MiB;
constexpr size_t WS_END = 1001 * MiB;
static_assert(WS_RW + 1081344 <= WS_END && MAXROWS * 4 == 1081344, "tables");
static_assert(WS_ACT + (size_t)MAXROWS * 1024 <= WS_YB && WS_YB + (size_t)(MAXROWS - YSPLIT) * 2048 <= WS_TOPI && WS_YA + (size_t)YSPLIT * 2048 <= WS_H && YSPLIT % 256 == 0, "expert output map");
constexpr int CW_TMO = 0, CW_BAR = 4096, CW_CNT = 8192, CW_TP = 12288, CW_Q = 12544;

constexpr int LDS_BYTES = 163840;
constexpr int MISC_OFF = LDS_BYTES - 256;
constexpr int TBL_OFF = 135168;
constexpr int SIDE_OFF = TBL_OFF + 8192;

#define LDS_WAIT() asm volatile("s_waitcnt lgkmcnt(0)" ::: "memory")
#define VM_WAIT() asm volatile("s_waitcnt vmcnt(0)" ::: "memory")
typedef __bf16 bf16x2_t __attribute__((ext_vector_type(2)));
__device__ __forceinline__ unsigned cvt_pk_bf16(float lo, float hi) { const f32x2 v = {lo, hi}; const bf16x2_t b = __builtin_convertvector(v, bf16x2_t); return __builtin_bit_cast(unsigned, b); }
__device__ __forceinline__ unsigned pk4_fp8(float a, float b, float c, float d) {
    a = fminf(fmaxf(a, -448.f), 448.f); b = fminf(fmaxf(b, -448.f), 448.f); c = fminf(fmaxf(c, -448.f), 448.f); d = fminf(fmaxf(d, -448.f), 448.f);
    int w = __builtin_amdgcn_cvt_pk_fp8_f32(a, b, 0, false); w = __builtin_amdgcn_cvt_pk_fp8_f32(c, d, w, true); return (unsigned)w; }
__device__ __forceinline__ f32x4 fp8x4_to_f32(unsigned w) {
    const f32x2 lo = __builtin_amdgcn_cvt_pk_f32_fp8((int)w, false), hi = __builtin_amdgcn_cvt_pk_f32_fp8((int)w, true); return (f32x4){lo[0], lo[1], hi[0], hi[1]}; }
__device__ __forceinline__ unsigned pk4_fp8_nc(float a, float b, float c, float d) {
    int w = __builtin_amdgcn_cvt_pk_fp8_f32(a, b, 0, false); w = __builtin_amdgcn_cvt_pk_fp8_f32(c, d, w, true); return (unsigned)w; }
__device__ __forceinline__ float bf_lo(unsigned u) { return __uint_as_float(u << 16); }
__device__ __forceinline__ float bf_hi(unsigned u) { return __uint_as_float(u & 0xffff0000u); }
__device__ __forceinline__ float bf1(bf16_t u) { return __uint_as_float(((unsigned)u) << 16); }
__device__ __forceinline__ float fast_rcp(float x) { return __builtin_amdgcn_rcpf(x); }
__device__ __forceinline__ float fast_exp(float x) { return __builtin_amdgcn_exp2f(x * 1.44269504089f); }
__device__ __forceinline__ float fast_log(float x) { return __builtin_amdgcn_logf(x) * 0.69314718056f; }
__device__ __forceinline__ float sigmoidf_(float x) { return fast_rcp(1.0f + fast_exp(-x)); }
__device__ __forceinline__ float wave_sum(float v) {
#pragma unroll
    for (int o = 1; o < 64; o <<= 1) v += __shfl_xor(v, o);
    return v;
}

#define XB_TMO      128
#define XB_XCNT(j)  (256  + 64 * (j))
#define XB_XSUB(j)  (1280 + 64 * (j))
#define XB_XGEN(j)  (2304 + 64 * (j))
#define XB_TOP      3328
#define XB_TOPGEN   3392
#define XCD_BAR_WORDS 3456
#define XB_SPIN_CAP (1u << 20)
__device__ __forceinline__ unsigned xb_ld(unsigned* p)              { return __hip_atomic_load(p, __ATOMIC_RELAXED, __HIP_MEMORY_SCOPE_AGENT); }
__device__ __forceinline__ unsigned xb_add(unsigned* p, unsigned v) { return __hip_atomic_fetch_add(p, v, __ATOMIC_RELAXED, __HIP_MEMORY_SCOPE_AGENT); }
__device__ __forceinline__ unsigned xb_xcc_id() { return (unsigned)__builtin_amdgcn_s_getreg((3 << 11) | 20) & 0xFu; }
#define XB_SPIN(cond, bar) do { unsigned _sp = 0; while (cond) { __builtin_amdgcn_s_sleep(1); \
    if ((++_sp & 255u) == 0u) { if (xb_ld(&(bar)[XB_TMO])) break; if (_sp > XB_SPIN_CAP) { atomicAdd(&(bar)[XB_TMO], 1u); break; } } } } while (0)
struct XcdBarrier { unsigned* bar; unsigned x; volatile LAS unsigned* st; };
__device__ __forceinline__ XcdBarrier xcd_barrier_post(unsigned* bar, volatile LAS unsigned* st) {
    XcdBarrier b; b.bar = bar; b.x = xb_xcc_id(); b.st = st;
    if (threadIdx.x == 0) (void)xb_add(&bar[XB_XCNT(b.x)], 1u);
    return b;
}
__device__ __forceinline__ void xcd_barrier_complete(unsigned* bar, unsigned x, unsigned& nloc, unsigned& nx) {
    const unsigned G = gridDim.x * gridDim.y * gridDim.z;
    unsigned sum, cnt, mine, sp = 0u;
    for (;;) {
        sum = 0u; cnt = 0u; mine = 0u;
#pragma unroll
        for (unsigned j = 0; j < 16; ++j) { const unsigned c = xb_ld(&bar[XB_XCNT(j)]); sum += c; cnt += (c > 0u) ? 1u : 0u; mine = (j == x) ? c : mine; }
        if (sum == G) break;
        __builtin_amdgcn_s_sleep(1);
        if ((++sp & 255u) == 0u) { if (xb_ld(&bar[XB_TMO])) break; if (sp > XB_SPIN_CAP) { atomicAdd(&bar[XB_TMO], 1u); break; } }
    }
    nloc = mine > 0u ? mine : 1u; nx = cnt > 0u ? cnt : 1u;
}
__device__ __forceinline__ void xcd_barrier(const XcdBarrier& b) {
    asm volatile("s_waitcnt vmcnt(0)" ::: "memory");
    __syncthreads();
    if (threadIdx.x == 0) {
        unsigned* bar = b.bar;
        __builtin_amdgcn_s_waitcnt(0);
        unsigned nloc = b.st[0], nx = b.st[1];
        if (nloc == 0u) { xcd_barrier_complete(bar, b.x, nloc, nx); b.st[0] = nloc; b.st[1] = nx; }
        const unsigned old = xb_add(&bar[XB_XSUB(b.x)], 1u);
        const unsigned gen = old / nloc;
        if (old + 1u == (gen + 1u) * nloc) {
            __builtin_amdgcn_fence(__ATOMIC_RELEASE, "agent");
            asm volatile("s_waitcnt vmcnt(0)" ::: "memory");
            const unsigned og = xb_add(&bar[XB_TOP], 1u);
            const unsigned tg = og / nx;
            if (og + 1u == (tg + 1u) * nx) xb_add(&bar[XB_TOPGEN], 1u);
            else XB_SPIN(xb_ld(&bar[XB_TOPGEN]) == tg, bar);
            __builtin_amdgcn_fence(__ATOMIC_ACQUIRE, "agent");
            xb_add(&bar[XB_XGEN(b.x)], 1u);
            asm volatile("s_waitcnt vmcnt(0)" ::: "memory");
        } else {
            XB_SPIN(xb_ld(&bar[XB_XGEN(b.x)]) == gen, bar);
            __builtin_amdgcn_fence(__ATOMIC_ACQUIRE, "agent");
            asm volatile("s_waitcnt vmcnt(0)" ::: "memory");
        }
    }
    __syncthreads();
}

namespace gm {
constexpr int BM = 256, BK = 64, HALF = 128, HTB = HALF * BK * 2, STAGE_BYTES = 8 * HTB, NXCD = 8, WGM = 8;
__device__ __forceinline__ int lds_byte(int r, int c) { const int st = (r >> 4) * 2 + (c >> 5), rr = r & 15, cc = c & 31, ob = rr * 64 + cc * 2; return st * 1024 + (ob ^ (((ob >> 9) & 1) << 5)); }
__device__ __forceinline__ void stage_rc(int b, int& R, int& C) { const int st = b / 1024, sb = b % 1024, swz = sb ^ (((sb >> 9) & 1) << 5); R = (st >> 1) * 16 + swz / 64; C = (st & 1) * 32 + (swz % 64) / 2; }
__device__ __forceinline__ int perm32(int rho) { const int n = rho >> 4, i = rho & 15; return 8 * (i >> 2) + 4 * n + (i & 3); }

struct Unit { int pm, pn, e, sub; };

__device__ __forceinline__ bool tile_order(int nM, int nN, long L, int& pm, int& pn) {
    const int nwg = nM * nN; if (L >= nwg) return false;
    int wgid = (int)L; { const int q = nwg / NXCD, r = nwg % NXCD, xcd = wgid % NXCD, off = wgid / NXCD; wgid = (xcd < r ? xcd * (q + 1) : r * (q + 1) + (xcd - r) * q) + off; }
    const int nig = WGM * nN, gid = wgid / nig, fm = gid * WGM, gsz = (nM - fm) < WGM ? (nM - fm) : WGM;
    pm = fm + ((wgid % nig) % gsz); pn = (wgid % nig) / gsz; return true;
}
struct DenseOrder {
    int nM, nN, G, c, nsub;
    __device__ __forceinline__ bool next(int i, Unit& u) const { const int ti = i / nsub; u.sub = i - ti * nsub; u.e = 0; return tile_order(nM, nN, (long)ti * G + c, u.pm, u.pn); }
};
struct MoeOrder {
    int nM, nN, G, c; const LAS int* tile_e;
    __device__ __forceinline__ bool next(int i, Unit& u) const { u.sub = 0; if (!tile_order(nM, nN, (long)i * G + c, u.pm, u.pn)) return false; u.e = tile_e[u.pm]; return true; }
};
struct DenseA { int K; unsigned sub_stride; int ES;
    __device__ __forceinline__ void offsets(const Unit& u, int tid, unsigned (&o)[2][2]) const {
#pragma unroll
        for (int i = 0; i < 2; ++i) { int R, C; stage_rc(tid * 16 + i * 8192, R, C);
#pragma unroll
            for (int h = 0; h < 2; ++h) o[h][i] = (unsigned)((u.pm * BM + h * HALF + R) * K * ES + C * 2) + (unsigned)u.sub * sub_stride; } }
    static constexpr bool GATHER = false;
    __device__ __forceinline__ const char* tok_ptr(const Unit&) const { return nullptr; }
    __device__ __forceinline__ void next_offsets(const Unit& u, int tid, unsigned (&o)[2][2], const LAS int*) const { offsets(u, tid, o); } };
struct GatherA { int K; const int* row_tok; int ES;
    __device__ __forceinline__ void offsets(const Unit& u, int tid, unsigned (&o)[2][2]) const {
#pragma unroll
        for (int i = 0; i < 2; ++i) { int R, C; stage_rc(tid * 16 + i * 8192, R, C);
#pragma unroll
            for (int h = 0; h < 2; ++h) { const int tok = row_tok[u.pm * BM + h * HALF + R]; o[h][i] = (unsigned)(tok * K * ES + C * 2); } } }
    static constexpr bool GATHER = true;
    __device__ __forceinline__ const char* tok_ptr(const Unit& u) const { return (const char*)(row_tok + u.pm * BM); }
    __device__ __forceinline__ void next_offsets(const Unit&, int tid, unsigned (&o)[2][2], const LAS int* stok) const {
#pragma unroll
        for (int i = 0; i < 2; ++i) { int R, C; stage_rc(tid * 16 + i * 8192, R, C);
#pragma unroll
            for (int h = 0; h < 2; ++h) { const int tok = stok[h * HALF + R]; o[h][i] = (unsigned)(tok * K * ES + C * 2); } } } };

template <bool FP8, class Epi, class Sched, class AMap>
__device__ __forceinline__ void gemm_phase(int wave_sg, LAS unsigned char* lds, const char* Abase, const char* Bbase, int K, int Nb, unsigned b_sub_stride, const Sched& S, const Epi& E, const AMap& AM) {
    int lane; asm volatile("v_mbcnt_lo_u32_b32 %0, -1, 0\n\tv_mbcnt_hi_u32_b32 %0, -1, %0" : "=v"(lane));
    const int wid = wave_sg, tid = wid * 64 + lane, wr = wid >> 2, wc = wid & 3, fr = lane & 15, fq = lane >> 4;
    constexpr int ES = FP8 ? 1 : 2;
    const int nt = K * ES / (BK * 2);
    unsigned voffB[2];
#pragma unroll
    for (int i = 0; i < 2; ++i) { int R, C; stage_rc(tid * 16 + i * 8192, R, C); const int Rb = (R & ~31) + perm32(R & 31); voffB[i] = (unsigned)(Rb * K * ES + C * 2); }
    const size_t kstep = (size_t)(BK * 2);
    const size_t hstep = (size_t)HALF * K * ES;
    const unsigned ldsw = (unsigned)wid * 1024u;
    const int aoff = lds_byte(wr * 64 + fr, fq * 8), boff = lds_byte(wc * 32 + fr, fq * 8);
#define G_SA(b, h) (((b) * 2 + (h)) * HTB)
#define G_SB(b, h) ((4 + (b) * 2 + (h)) * HTB)
#define G_STAGE(bufoff, gbase, voff) do { _Pragma("unroll") for (int _i = 0; _i < 2; ++_i) \
        __builtin_amdgcn_global_load_lds((const unsigned*)((const char*)(gbase) + (voff)[_i]), (LAS unsigned*)(lds + (bufoff) + ldsw + _i * 8192), 16, 0, 0); } while (0)
#define G_LDA(dst, b, h) do { _Pragma("unroll") for (int m = 0; m < 4; ++m) _Pragma("unroll") for (int k = 0; k < 2; ++k) dst[m][k] = *(const LAS bf16x8*)(lds + G_SA(b, h) + aoff + m * 2048 + k * 1024); } while (0)
#define G_LDB(dst, b, h) do { _Pragma("unroll") for (int n = 0; n < 2; ++n) _Pragma("unroll") for (int k = 0; k < 2; ++k) dst[n][k] = *(const LAS bf16x8*)(lds + G_SB(b, h) + boff + n * 2048 + k * 1024); } while (0)
#define G_MMA(ai, bj, At, Bt) do { __builtin_amdgcn_s_setprio(1); _Pragma("unroll") for (int m = 0; m < 4; ++m) _Pragma("unroll") for (int n = 0; n < 2; ++n) _Pragma("unroll") for (int k = 0; k < 2; ++k) \
        acc[ai][bj][m][n] = __builtin_amdgcn_mfma_f32_16x16x32_bf16(Bt[n][k], At[m][k], acc[ai][bj][m][n], 0, 0, 0); __builtin_amdgcn_s_setprio(0); } while (0)
#define G_LD8(dst, off) do { const u32x4 _l = *(const LAS u32x4*)(lds + (off)), _h = *(const LAS u32x4*)(lds + (off) + 1024); dst = (v8i){(int)_l.x, (int)_l.y, (int)_l.z, (int)_l.w, (int)_h.x, (int)_h.y, (int)_h.z, (int)_h.w}; } while (0)
#define G_LDA8(dst, b, h) do { _Pragma("unroll") for (int m = 0; m < 4; ++m) G_LD8(dst[m], G_SA(b, h) + aoff + m * 2048); } while (0)
#define G_LDB8(dst, b, h) do { _Pragma("unroll") for (int n = 0; n < 2; ++n) G_LD8(dst[n], G_SB(b, h) + boff + n * 2048); } while (0)
#define G_MMA8(ai, bj, At, Bt) do { __builtin_amdgcn_s_setprio(1); _Pragma("unroll") for (int m = 0; m < 4; ++m) _Pragma("unroll") for (int n = 0; n < 2; ++n) \
        acc[ai][bj][m][n] = __builtin_amdgcn_mfma_scale_f32_16x16x128_f8f6f4(Bt[n], At[m], acc[ai][bj][m][n], 0, 0, 0, 0x7F7F7F7F, 0, 0x7F7F7F7F); __builtin_amdgcn_s_setprio(0); } while (0)
#define G_PIN(ai, bj) asm volatile("" :: "v"(acc[ai][bj][0][0][0]), "v"(acc[ai][bj][0][1][0]), "v"(acc[ai][bj][1][0][0]), "v"(acc[ai][bj][1][1][0]), "v"(acc[ai][bj][2][0][0]), "v"(acc[ai][bj][2][1][0]), "v"(acc[ai][bj][3][0][0]), "v"(acc[ai][bj][3][1][0]) : "memory")
#define G_WAIT_V(n) asm volatile("s_waitcnt vmcnt(" #n ")" ::: "memory")
#define G_WAIT_L(n) asm volatile("s_waitcnt lgkmcnt(" #n ")" ::: "memory")
#define G_WAIT_VS() do { if (fi) { if (Epi::NST == 16) G_WAIT_V(24); else if (Epi::NST == 8) G_WAIT_V(16); else G_WAIT_V(8); } else G_WAIT_V(8); } while (0)
#define G_BAR __builtin_amdgcn_s_barrier()
#define G_SCHED __builtin_amdgcn_sched_barrier(0)
    Unit cur, nxt; int ui = 0;
#if MK_TPROBE
    unsigned long long tp_c = 0; const unsigned long long tp_c0 = __builtin_amdgcn_s_memtime(), tp_r0 = __builtin_amdgcn_s_memrealtime();
#endif
    if (!S.next(0, cur)) return;
#if MK_STAGGER
    {
        const unsigned long long t0 = __builtin_amdgcn_s_memrealtime(); const unsigned long long dly = (unsigned long long)(blockIdx.x & 7) * MK_STAGGER;
        while (__builtin_amdgcn_s_memrealtime() - t0 < dly) __builtin_amdgcn_s_sleep(8);
    }
#endif
    unsigned rA[2][2];
    AM.offsets(cur, tid, rA);
    const char* cB = Bbase + ((size_t)cur.e * Nb + (size_t)cur.pn * BM) * K * ES + (size_t)cur.sub * b_sub_stride;
    G_STAGE(G_SB(0, 0), cB, voffB); G_STAGE(G_SB(0, 1), cB + hstep, voffB); G_STAGE(G_SA(0, 0), Abase, rA[0]); G_STAGE(G_SA(0, 1), Abase, rA[1]);
    if (wr == 1) G_BAR;
    G_WAIT_V(2); G_BAR;
    G_STAGE(G_SB(1, 0), cB + kstep, voffB); G_STAGE(G_SA(1, 0), Abase + kstep, rA[0]); G_STAGE(G_SB(1, 1), cB + hstep + kstep, voffB);
    G_WAIT_V(6); G_BAR;
    f32x4 acc[2][2][4][2];
#pragma unroll
    for (int a = 0; a < 2; ++a)
#pragma unroll
        for (int b = 0; b < 2; ++b)
#pragma unroll
            for (int m = 0; m < 4; ++m)
#pragma unroll
                for (int n = 0; n < 2; ++n) acc[a][b][m][n] = (f32x4){0.f, 0.f, 0.f, 0.f};
    for (;;) {
        const bool has_next = S.next(ui + 1, nxt);
        const char* nB = has_next ? Bbase + ((size_t)nxt.e * Nb + (size_t)nxt.pn * BM) * K * ES + (size_t)nxt.sub * b_sub_stride : cB;
#if MK_TPROBE
        unsigned long long tp_a = 0; if (Epi::TPROBE && wid == 0) { tp_a = __builtin_amdgcn_s_memrealtime(); if (ui > 0 && lane == 0) { volatile LAS unsigned* M = (volatile LAS unsigned*)(lds + MISC_OFF); M[19] += (unsigned)(tp_a - tp_c); } }
#endif
        if (wid == 0) {
            int l16 = lane * 16; asm volatile("" : "+v"(l16));
#pragma unroll
            for (int k = 0; k < Epi::NSB; ++k) { const char* sp = E.sb_ptr(cur, k); if (l16 < 16 * E.sb_lanes(k)) __builtin_amdgcn_global_load_lds((const unsigned*)(sp + l16), (LAS unsigned*)(lds + SIDE_OFF + (ui & 1) * 4096 + 1024 * (k + 1)), 16, 0, 0); }
            if (AMap::GATHER && has_next) __builtin_amdgcn_global_load_lds((const unsigned*)(AM.tok_ptr(nxt) + l16), (LAS unsigned*)(lds + SIDE_OFF + ((ui + 1) & 1) * 4096), 16, 0, 0);
        }
#pragma nounroll
        for (int t = 0; t < nt; t += 2) {
            if constexpr (Epi::HAS_MID) { if (t == nt / 2) { int lz = lane; asm volatile("" : "+v"(lz)); E.mid(acc, cur, wr, wc, lz & 15, lz >> 4); } }
            bf16x8 At[4][2], B0[2][2], B1[2][2];
            v8i At8[4], B08[2], B18[2];
            const bool last = (t == nt - 2);
            constexpr bool fi = false;
            const char* b2 = last ? nB : cB + (size_t)(t + 2) * kstep; const char* b3 = b2 + kstep;
            if constexpr (FP8) { G_LDB8(B08, 0, 0); G_LDB8(B18, 0, 1); G_SCHED; G_LDA8(At8, 0, 0); } else { G_LDB(B0, 0, 0); G_LDB(B1, 0, 1); G_SCHED; G_LDA(At, 0, 0); }
            G_STAGE(G_SA(1, 1), Abase + (size_t)(t + 1) * kstep, rA[1]);
            G_WAIT_VS(); G_WAIT_L(0); G_BAR;
            if constexpr (FP8) { G_MMA8(0, 0, At8, B08); G_MMA8(0, 1, At8, B18); } else { G_MMA(0, 0, At, B0); G_MMA(0, 1, At, B1); }
            if constexpr (FP8) { G_PIN(0, 0); G_PIN(0, 1); }
            G_BAR; G_SCHED;
            if (last && has_next) { int tz = tid; asm volatile("" : "+v"(tz)); AM.next_offsets(nxt, tz, rA, (const LAS int*)(lds + SIDE_OFF + ((ui + 1) & 1) * 4096)); }
            const char* a2 = Abase + (last ? (size_t)0 : (size_t)(t + 2) * kstep);
            if constexpr (FP8) { G_LDA8(At8, 0, 1); } else { G_LDA(At, 0, 1); }
            G_STAGE(G_SB(0, 0), b2, voffB); G_STAGE(G_SB(0, 1), b2 + hstep, voffB); G_STAGE(G_SA(0, 0), a2, rA[0]);
            G_WAIT_VS(); G_WAIT_L(0); G_BAR;
            if constexpr (FP8) { G_MMA8(1, 0, At8, B08); G_MMA8(1, 1, At8, B18); } else { G_MMA(1, 0, At, B0); G_MMA(1, 1, At, B1); }
            if constexpr (FP8) { G_PIN(1, 0); G_PIN(1, 1); }
            G_BAR; G_SCHED;
            if constexpr (FP8) { G_LDB8(B08, 1, 0); G_LDB8(B18, 1, 1); G_SCHED; G_LDA8(At8, 1, 0); } else { G_LDB(B0, 1, 0); G_LDB(B1, 1, 1); G_SCHED; G_LDA(At, 1, 0); }
            G_STAGE(G_SA(0, 1), a2, rA[1]);
            G_WAIT_VS(); G_WAIT_L(0); G_BAR;
            if constexpr (FP8) { G_MMA8(0, 0, At8, B08); G_MMA8(0, 1, At8, B18); } else { G_MMA(0, 0, At, B0); G_MMA(0, 1, At, B1); }
            if constexpr (FP8) { G_PIN(0, 0); G_PIN(0, 1); }
            G_BAR; G_SCHED;
            if constexpr (FP8) { G_LDA8(At8, 1, 1); } else { G_LDA(At, 1, 1); }
            G_STAGE(G_SB(1, 0), b3, voffB); G_STAGE(G_SB(1, 1), b3 + hstep, voffB); G_STAGE(G_SA(1, 0), a2 + kstep, rA[0]);
            G_WAIT_VS(); G_WAIT_L(0); G_BAR;
            if constexpr (FP8) { G_MMA8(1, 0, At8, B08); G_MMA8(1, 1, At8, B18); } else { G_MMA(1, 0, At, B0); G_MMA(1, 1, At, B1); }
            if constexpr (FP8) { G_PIN(1, 0); G_PIN(1, 1); }
            G_BAR; G_SCHED;
        }
#if MK_TPROBE
        unsigned long long tp_b = 0; if (Epi::TPROBE && wid == 0) tp_b = __builtin_amdgcn_s_memrealtime();
#endif
        if (wr == 0) G_BAR;
        { int lz = lane; asm volatile("" : "+v"(lz));
          E(acc, cur, wr, wc, lz & 15, lz >> 4, (const LAS unsigned char*)(lds + SIDE_OFF + (ui & 1) * 4096 + 1024)); }
#if MK_TPROBE
        if (Epi::TPROBE && wid == 0) { tp_c = __builtin_amdgcn_s_memrealtime(); if (lane == 0) { volatile LAS unsigned* M = (volatile LAS unsigned*)(lds + MISC_OFF); M[16] += (unsigned)(tp_b - tp_a); M[17] += (unsigned)(tp_c - tp_b); M[18] += 1u; } }
#endif
        if (!has_next) break;
        if (!E.keep(cur)) {
#pragma unroll
            for (int a = 0; a < 2; ++a)
#pragma unroll
                for (int b = 0; b < 2; ++b)
#pragma unroll
                    for (int m = 0; m < 4; ++m)
#pragma unroll
                        for (int n = 0; n < 2; ++n) acc[a][b][m][n] = (f32x4){0.f, 0.f, 0.f, 0.f};
        }
        cur = nxt; cB = nB; ++ui;
        if (wr == 1) G_BAR;
    }
    G_WAIT_V(0);
    G_BAR;
#if MK_TPROBE
    if constexpr (Epi::TPROBE) if (wid == 0) { volatile LAS unsigned* M = (volatile LAS unsigned*)(lds + MISC_OFF);
        const unsigned long long t0 = __builtin_amdgcn_s_memrealtime();
        const unsigned long long d = MK_TPROBE == 4 ? 10000ull * (__builtin_amdgcn_s_memtime() - tp_c0) / (t0 - tp_r0)
                                   : 4ull * (unsigned long long)(MK_TPROBE == 1 ? M[16] : MK_TPROBE == 2 ? M[17] : M[19]);
        while (__builtin_amdgcn_s_memrealtime() - t0 < d) __builtin_amdgcn_s_sleep(8); }
#endif
#undef G_SA
#undef G_SB
#undef G_STAGE
#undef G_LDA
#undef G_LDB
#undef G_MMA
#undef G_LD8
#undef G_LDA8
#undef G_LDB8
#undef G_MMA8
#undef G_WAIT_V
#undef G_PIN
#undef G_WAIT_VS
#undef G_WAIT_L
#undef G_BAR
#undef G_SCHED
}

__device__ __forceinline__ u32x4 pack8(const f32x4& v0, const f32x4& v1) { u32x4 w; w.x = cvt_pk_bf16(v0[0], v0[1]); w.y = cvt_pk_bf16(v0[2], v0[3]); w.z = cvt_pk_bf16(v1[0], v1[1]); w.w = cvt_pk_bf16(v1[2], v1[3]); return w; }
__device__ __forceinline__ void unpack8(const u32x4& w, f32x4& v0, f32x4& v1) { v0 = (f32x4){bf_lo(w.x), bf_hi(w.x), bf_lo(w.y), bf_hi(w.y)}; v1 = (f32x4){bf_lo(w.z), bf_hi(w.z), bf_lo(w.w), bf_hi(w.w)}; }

template <int PN0, bool F8>
struct EpiProjT {
    static constexpr bool HAS_MID = false;
    static constexpr float PSC = F8 ? (1.0f / 32.0f) : 1.0f;
    bf16_t* proj; bf16_t* gates; const float* lb;
    static constexpr int NSB = 0, NST = 16; static constexpr bool TPROBE = false;
    __device__ __forceinline__ const char* sb_ptr(const Unit&, int) const { return nullptr; }
    __device__ __forceinline__ int sb_lanes(int) const { return 0; }
    __device__ __forceinline__ bool keep(const Unit&) const { return false; }
    __device__ __forceinline__ void operator()(f32x4 (&acc)[2][2][4][2], const Unit& u, int wr, int wc, int fr, int fq, const LAS unsigned char* side) const {
        const int row0 = u.pm * BM + wr * 64 + fr, pn = u.pn + PN0;
        if (pn >= 10) {
            const bool isg = pn >= 14; const int q = isg ? pn - 14 : pn - 10; const int c0 = q * HALF + wc * 32 + 8 * fq;
#pragma unroll
            for (int ai = 0; ai < 2; ++ai)
#pragma unroll
                for (int m = 0; m < 4; ++m) { const size_t r = (size_t)(row0 + ai * HALF + m * 16);
                    f32x4 a0 = acc[ai][0][m][0] * PSC, a1 = acc[ai][0][m][1] * PSC, b0 = acc[ai][1][m][0] * PSC, b1 = acc[ai][1][m][1] * PSC;
                    if (isg) {
#pragma unroll
                        for (int j = 0; j < 4; ++j) { b0[j] = sigmoidf_(b0[j]); b1[j] = sigmoidf_(b1[j]); a0[j] = sigmoidf_(a0[j]) * fast_rcp(fmaxf(b0[j], 1e-30f)); a1[j] = sigmoidf_(a1[j]) * fast_rcp(fmaxf(b1[j], 1e-30f)); }
                        *(u32x4*)(gates + r * GATE_LD + c0) = pack8(a0, a1); *(u32x4*)(gates + r * GATE_LD + 1024 + c0) = pack8(b0, b1);
                    } else {
                        *(u32x4*)(proj + r * PROJ_LD + 2560 + c0) = pack8(a0 * b0, a1 * b1);
                    } }
            return;
        }
        bf16_t* base = proj; const int ldc = PROJ_LD, colt = pn * BM, kind = (pn == 2 || pn == 3) ? 1 : 0;
        const int col0 = colt + wc * 32 + 8 * fq;
        f32x4 lbv[2][2];
        if (kind == 1) {
#pragma unroll
            for (int bj = 0; bj < 2; ++bj) { const float* lp = lb + (pn - 2) * BM + bj * HALF + wc * 32 + 8 * fq; lbv[bj][0] = *(const f32x4*)lp; lbv[bj][1] = *(const f32x4*)(lp + 4); }
        }
#pragma unroll
        for (int ai = 0; ai < 2; ++ai)
#pragma unroll
            for (int m = 0; m < 4; ++m) { bf16_t* rowp = base + (size_t)(row0 + ai * HALF + m * 16) * ldc + col0;
#pragma unroll
                for (int bj = 0; bj < 2; ++bj) { f32x4 v0 = acc[ai][bj][m][0] * PSC, v1 = acc[ai][bj][m][1] * PSC;
                    if (kind == 1) {
#pragma unroll
                        for (int j = 0; j < 4; ++j) { const float l0 = lbv[bj][0][j], l1 = lbv[bj][1][j];
                            v0[j] = fast_log(l0 + (1.0f - l0) * sigmoidf_(v0[j])); v1[j] = fast_log(l1 + (1.0f - l1) * sigmoidf_(v1[j])); }
                    }
                    *(u32x4*)(rowp + bj * HALF) = pack8(v0, v1); } }
    }
};
struct EpiMerge {
    static constexpr bool HAS_MID = true;
    const bf16_t* gates; bf16_t* out;
    static constexpr int NSB = 0, NST = 0; static constexpr bool TPROBE = false;
    __device__ __forceinline__ const char* sb_ptr(const Unit&, int) const { return nullptr; }
    __device__ __forceinline__ int sb_lanes(int) const { return 0; }
    __device__ __forceinline__ bool keep(const Unit&) const { return false; }
    __device__ __forceinline__ void mid(f32x4 (&acc)[2][2][4][2], const Unit& u, int wr, int wc, int fr, int fq) const {
        const int row0 = u.pm * BM + wr * 64 + fr, col0 = u.pn * BM + wc * 32 + 8 * fq;
#pragma unroll
        for (int ai = 0; ai < 2; ++ai) {
            u32x4 ga[4][2];
#pragma unroll
            for (int m = 0; m < 4; ++m) { const bf16_t* gp = gates + (size_t)(row0 + ai * HALF + m * 16) * GATE_LD + col0;
#pragma unroll
                for (int bj = 0; bj < 2; ++bj) ga[m][bj] = *(const u32x4*)(gp + bj * HALF); }
#pragma unroll
            for (int m = 0; m < 4; ++m)
#pragma unroll
                for (int bj = 0; bj < 2; ++bj) { f32x4 a0, a1; unpack8(ga[m][bj], a0, a1); acc[ai][bj][m][0] *= a0; acc[ai][bj][m][1] *= a1; }
            asm volatile("" ::: "memory"); }
    }
    __device__ __forceinline__ void operator()(f32x4 (&acc)[2][2][4][2], const Unit& u, int wr, int wc, int fr, int fq, const LAS unsigned char* side) const {
        const int row0 = u.pm * BM + wr * 64 + fr, col0 = u.pn * BM + wc * 32 + 8 * fq;
#pragma unroll
        for (int ai = 0; ai < 2; ++ai) {
            u32x4 gb[4][2];
#pragma unroll
            for (int m = 0; m < 4; ++m) { const bf16_t* gp = gates + (size_t)(row0 + ai * HALF + m * 16) * GATE_LD + col0;
#pragma unroll
                for (int bj = 0; bj < 2; ++bj) gb[m][bj] = *(const u32x4*)(gp + 1024 + bj * HALF); }
#pragma unroll
            for (int m = 0; m < 4; ++m) { const size_t r = (size_t)(row0 + ai * HALF + m * 16);
#pragma unroll
                for (int bj = 0; bj < 2; ++bj) { f32x4 b0, b1; unpack8(gb[m][bj], b0, b1); *(u32x4*)(out + r * D + col0 + bj * HALF) = pack8(acc[ai][bj][m][0] * b0, acc[ai][bj][m][1] * b1); } }
            asm volatile("" ::: "memory"); }
    }
};
struct EpiMix {
    static constexpr bool HAS_MID = false;
    const float* x; const float* mod; bf16_t* h;
    static constexpr int NSB = 0, NST = 0; static constexpr bool TPROBE = false;
    __device__ __forceinline__ const char* sb_ptr(const Unit&, int) const { return nullptr; }
    __device__ __forceinline__ int sb_lanes(int) const { return 0; }
    __device__ __forceinline__ bool keep(const Unit&) const { return false; }
    __device__ __forceinline__ void operator()(f32x4 (&acc)[2][2][4][2], const Unit& u, int wr, int wc, int fr, int fq, const LAS unsigned char* side) const {
        const int row0 = u.pm * BM + wr * 64 + fr, col0 = u.pn * BM + wc * 32 + 8 * fq, b = u.pm >> 3;
        f32x4 g[2][2];
#pragma unroll
        for (int bj = 0; bj < 2; ++bj) { const float* gp = mod + (size_t)b * 6144 + 2048 + col0 + bj * HALF; g[bj][0] = *(const f32x4*)gp; g[bj][1] = *(const f32x4*)(gp + 4); }
#pragma unroll
        for (int ai = 0; ai < 2; ++ai) {
            f32x4 xv[4][2][2];
#pragma unroll
            for (int m = 0; m < 4; ++m)
#pragma unroll
                for (int bj = 0; bj < 2; ++bj) { const float* xp = x + (size_t)(row0 + ai * HALF + m * 16) * D + col0 + bj * HALF; xv[m][bj][0] = *(const f32x4*)xp; xv[m][bj][1] = *(const f32x4*)(xp + 4); }
#pragma unroll
            for (int m = 0; m < 4; ++m) { const size_t r = (size_t)(row0 + ai * HALF + m * 16);
#pragma unroll
                for (int bj = 0; bj < 2; ++bj) *(u32x4*)(h + r * D + col0 + bj * HALF) = pack8(xv[m][bj][0] + g[bj][0] * acc[ai][bj][m][0], xv[m][bj][1] + g[bj][1] * acc[ai][bj][m][1]); }
            asm volatile("" ::: "memory"); }
    }
};
struct EpiSwiglu {
    static constexpr bool HAS_MID = false;
    static constexpr float WSC = 1.0f / 32.0f;
    const float* b1; unsigned char* act; unsigned* tpw;
    __device__ __forceinline__ unsigned* tp_words() const { return tpw; }
    static constexpr bool TPROBE = false;
    static constexpr int NSB = 2, NST = 8;
    __device__ __forceinline__ const char* sb_ptr(const Unit& u, int k) const { return (const char*)(b1 + (size_t)u.e * 2048 + k * 1024 + u.pn * HALF); }
    __device__ __forceinline__ int sb_lanes(int) const { return 32; }
    __device__ __forceinline__ bool keep(const Unit&) const { return false; }
    __device__ __forceinline__ void operator()(f32x4 (&acc)[2][2][4][2], const Unit& u, int wr, int wc, int fr, int fq, const LAS unsigned char* side) const {
        const int row0 = u.pm * BM + wr * 64 + fr, hc0 = u.pn * HALF + wc * 32 + 8 * fq;
        const LAS float* bp = (const LAS float*)side + wc * 32 + 8 * fq;
        const f32x4 bg[2] = {*(const LAS f32x4*)bp, *(const LAS f32x4*)(bp + 4)}; const f32x4 bl1[2] = {*(const LAS f32x4*)(bp + 256) + 1.0f, *(const LAS f32x4*)(bp + 260) + 1.0f};
#pragma unroll
        for (int ai = 0; ai < 2; ++ai)
#pragma unroll
            for (int m = 0; m < 4; ++m) { const size_t r = (size_t)(row0 + ai * HALF + m * 16);
                f32x4 o[2];
#pragma unroll
                for (int n = 0; n < 2; ++n) {
                    f32x4 g = acc[ai][0][m][n] * WSC + bg[n], l = acc[ai][1][m][n] * WSC + bl1[n];
#pragma unroll
                    for (int j = 0; j < 4; ++j) { g[j] = fminf(g[j], SW_LIMIT); l[j] = fminf(fmaxf(l[j], 1.0f - SW_LIMIT), 1.0f + SW_LIMIT); }
                    const f32x4 t = g * (-SW_ALPHA * 1.44269504089f); f32x4 e;
#pragma unroll
                    for (int j = 0; j < 4; ++j) e[j] = __builtin_amdgcn_exp2f(t[j]);
                    const f32x4 d = e + 1.0f; f32x4 rc;
#pragma unroll
                    for (int j = 0; j < 4; ++j) rc[j] = fast_rcp(d[j]);
                    o[n] = (g * rc) * l; }
                *(u32x2*)(act + r * DFF + hc0) = (u32x2){pk4_fp8_nc(o[0][0], o[0][1], o[0][2], o[0][3]), pk4_fp8_nc(o[1][0], o[1][1], o[1][2], o[1][3])}; }
    }
};
struct EpiMoeOut {
    static constexpr bool HAS_MID = false;
    const float* b2; const float* rw; unsigned char* ya;
    static constexpr bool TPROBE = false;
    static constexpr int NSB = 2, NST = 16;
    __device__ __forceinline__ const char* sb_ptr(const Unit& u, int k) const { return k == 0 ? (const char*)(b2 + (size_t)u.e * D + u.pn * BM) : (const char*)(rw + u.pm * BM); }
    __device__ __forceinline__ int sb_lanes(int) const { return 64; }
    __device__ __forceinline__ bool keep(const Unit&) const { return false; }
    __device__ __forceinline__ void operator()(f32x4 (&acc)[2][2][4][2], const Unit& u, int wr, int wc, int fr, int fq, const LAS unsigned char* side) const {
        const int lrow0 = wr * 64 + fr, col0 = u.pn * BM + wc * 32 + 8 * fq, row_t = u.pm * BM;
        unsigned char* tbase = ya + (size_t)row_t * D + col0;
        const LAS float* sb = (const LAS float*)side; const LAS float* srw = (const LAS float*)(side + 1024);
        f32x4 bv[2][2];
#pragma unroll
        for (int bj = 0; bj < 2; ++bj) { const LAS float* bp = sb + bj * HALF + wc * 32 + 8 * fq; bv[bj][0] = *(const LAS f32x4*)bp; bv[bj][1] = *(const LAS f32x4*)(bp + 4); }
#pragma unroll
        for (int ai = 0; ai < 2; ++ai)
#pragma unroll
            for (int m = 0; m < 4; ++m) { const int lr = lrow0 + ai * HALF + m * 16; const float w = srw[lr]; unsigned char* dst = tbase + (size_t)lr * D;
#pragma unroll
                for (int bj = 0; bj < 2; ++bj) { const f32x4 o0 = (acc[ai][bj][m][0] * (1.0f / 32.0f) + bv[bj][0]) * w, o1 = (acc[ai][bj][m][1] * (1.0f / 32.0f) + bv[bj][1]) * w;
                    *(u32x2*)(dst + bj * HALF) = (u32x2){pk4_fp8(o0[0], o0[1], o0[2], o0[3]), pk4_fp8(o1[0], o1[1], o1[2], o1[3])}; } }
    }
};
}

struct Args { const float* in[20]; float* out; unsigned char* ws; int ph_lo, ph_hi; };

__device__ __forceinline__ void transpose_item(const float* W, int N, bf16_t* WT, int ldwt, int k0, int n0, int dst_row0, LAS float* scr, int lane) {
    const int ks = lane >> 4, n4 = (lane & 15) * 4;
    f32x4 v[16];
#pragma unroll
    for (int i = 0; i < 16; ++i) v[i] = *(const f32x4*)(W + (size_t)(k0 + 4 * i + ks) * N + n0 + n4);
#pragma unroll
    for (int i = 0; i < 16; ++i) { LAS float* s = scr + (4 * i + ks) * 65 + n4; s[0] = v[i][0]; s[1] = v[i][1]; s[2] = v[i][2]; s[3] = v[i][3]; }
    LDS_WAIT(); asm volatile("" ::: "memory");
    const int kc = lane & 7;
#pragma unroll
    for (int p = 0; p < 8; ++p) { const int n = (lane >> 3) + 8 * p; const LAS float* s = scr + (8 * kc) * 65 + n;
        u32x4 o; o.x = cvt_pk_bf16(s[0], s[65]); o.y = cvt_pk_bf16(s[2 * 65], s[3 * 65]); o.z = cvt_pk_bf16(s[4 * 65], s[5 * 65]); o.w = cvt_pk_bf16(s[6 * 65], s[7 * 65]);
        *(u32x4*)(WT + (size_t)(dst_row0 + n) * ldwt + k0 + 8 * kc) = o; }
    LDS_WAIT(); asm volatile("" ::: "memory");
}

template <bool NT = false>
__device__ __forceinline__ void transpose_item_fp8(const float* W, int N, unsigned char* WT, int ldwt, int k0, int n0, int dst_row0, LAS float* scr, int lane) {
    const int ks = lane >> 3, n4 = (lane & 7) * 4;
    f32x4 v[16];
#pragma unroll
    for (int i = 0; i < 16; ++i) { const f32x4* p = (const f32x4*)(W + (size_t)(k0 + 8 * i + ks) * N + n0 + n4); v[i] = NT ? __builtin_nontemporal_load(p) : *p; }
#pragma unroll
    for (int i = 0; i < 16; ++i) { LAS float* s = scr + (8 * i + ks) * 33 + n4; s[0] = v[i][0]; s[1] = v[i][1]; s[2] = v[i][2]; s[3] = v[i][3]; }
    LDS_WAIT(); asm volatile("" ::: "memory");
    const int kc = lane & 7;
#pragma unroll
    for (int p = 0; p < 4; ++p) { const int n = (lane >> 3) + 8 * p; const LAS float* s = scr + (16 * kc) * 33 + n;
        u32x4 o;
        o.x = pk4_fp8(32.f * s[0], 32.f * s[33], 32.f * s[2 * 33], 32.f * s[3 * 33]); o.y = pk4_fp8(32.f * s[4 * 33], 32.f * s[5 * 33], 32.f * s[6 * 33], 32.f * s[7 * 33]);
        o.z = pk4_fp8(32.f * s[8 * 33], 32.f * s[9 * 33], 32.f * s[10 * 33], 32.f * s[11 * 33]); o.w = pk4_fp8(32.f * s[12 * 33], 32.f * s[13 * 33], 32.f * s[14 * 33], 32.f * s[15 * 33]);
        u32x4* q = (u32x4*)(WT + (size_t)(dst_row0 + n) * ldwt + k0 + 16 * kc); if (NT) __builtin_nontemporal_store(o, q); else *q = o; }
    LDS_WAIT(); asm volatile("" ::: "memory");
}

constexpr int BG_W1 = 32 * 8 * 64, BG_W2 = 32 * 8 * 32, BG_N = BG_W1 + BG_W2;
struct BgCtx { const float* w1; const float* w2; unsigned char* W1q; unsigned char* W2q; unsigned* qhead; };
__device__ __forceinline__ bool bg_item(const BgCtx& c, LAS float* scr, int lane) {
    unsigned it = 0; if (lane == 0) it = __hip_atomic_fetch_add(c.qhead, 1u, __ATOMIC_RELAXED, __HIP_MEMORY_SCOPE_AGENT);
    it = (unsigned)__builtin_amdgcn_readfirstlane((int)it);
    if (it >= (unsigned)BG_N) return false;
    if (it < (unsigned)BG_W1) { const int r = (int)it, e = r / 512, q = r % 512, kb = q / 64, nb = q % 64;
        const int pn = nb >> 3, wi = (nb & 7) * 32; const int src = wi < 128 ? pn * 128 + wi : 1024 + pn * 128 + (wi - 128);
        transpose_item_fp8<true>(c.w1 + (size_t)e * D * 2048, 2048, c.W1q + (size_t)e * 2048 * D, D, kb * 128, src, nb * 32, scr, lane); }
    else { const int r = (int)it - BG_W1, e = r / 256, q = r % 256, kb = q / 32, nb = q % 32;
        transpose_item_fp8<true>(c.w2 + (size_t)e * DFF * D, D, c.W2q + (size_t)e * D * DFF, DFF, kb * 128, nb * 32, nb * 32, scr, lane); }
    return true;
}
__device__ __forceinline__ void xcd_barrier_bg(const XcdBarrier& b, const BgCtx& c, LAS unsigned char* lds, int wave, int lane, bool drain) {
    volatile LAS unsigned* M = (volatile LAS unsigned*)(lds + MISC_OFF);
    LAS float* scr = (LAS float*)(lds + wave * 16896);
    if (drain) { while (bg_item(c, scr, lane)) { } }
    asm volatile("s_waitcnt vmcnt(0)" ::: "memory");
    __syncthreads();
    if (threadIdx.x == 0) {
        unsigned* bar = b.bar;
        __builtin_amdgcn_s_waitcnt(0);
        unsigned nloc = b.st[0], nx = b.st[1];
        if (nloc == 0u) { xcd_barrier_complete(bar, b.x, nloc, nx); b.st[0] = nloc; b.st[1] = nx; }
        const unsigned old = xb_add(&bar[XB_XSUB(b.x)], 1u);
        const unsigned gen = old / nloc;
        if (old + 1u == (gen + 1u) * nloc) {
            __builtin_amdgcn_fence(__ATOMIC_RELEASE, "agent");
            asm volatile("s_waitcnt vmcnt(0)" ::: "memory");
            const unsigned og = xb_add(&bar[XB_TOP], 1u);
            const unsigned tg = og / nx;
            if (og + 1u == (tg + 1u) * nx) { xb_add(&bar[XB_TOPGEN], 1u); M[10] = 2u; } else M[10] = 1u;
            M[11] = tg;
        } else { M[10] = 0u; M[11] = gen; }
    }
    unsigned spins = 0;
    for (;;) {
        if (threadIdx.x == 0) { const unsigned role = M[10], g = M[11]; unsigned* bar = b.bar;
            bool rel = role == 2u ? true : role == 1u ? (xb_ld(&bar[XB_TOPGEN]) != g) : (xb_ld(&bar[XB_XGEN(b.x)]) != g);
            if (!rel && (++spins & 255u) == 0u) { if (xb_ld(&bar[XB_TMO])) rel = true; else if (spins > XB_SPIN_CAP) { atomicAdd(&bar[XB_TMO], 1u); rel = true; } }
            M[12] = rel ? 1u : 0u; }
        asm volatile("s_waitcnt lgkmcnt(0)" ::: "memory"); __syncthreads();
        const bool rel = M[12] != 0u;
        asm volatile("s_waitcnt lgkmcnt(0)" ::: "memory"); __syncthreads();
        if (rel) break;
        if (M[13] != 0u || !bg_item(c, scr, lane)) { M[13] = 1u; __builtin_amdgcn_s_sleep(16); }
    }
    if (threadIdx.x == 0) {
        __builtin_amdgcn_fence(__ATOMIC_ACQUIRE, "agent");
        if (M[10] != 0u) xb_add(&b.bar[XB_XGEN(b.x)], 1u);
        asm volatile("s_waitcnt vmcnt(0)" ::: "memory");
    }
    __syncthreads();
}

__global__ void __launch_bounds__(NTHREADS, 2) fwd_kernel(Args args) {
    extern __shared__ __attribute__((aligned(16))) unsigned char lds_raw[];
    LAS unsigned char* lds = (LAS unsigned char*)lds_raw;
    volatile LAS unsigned* MISC = (volatile LAS unsigned*)(lds + MISC_OFF);
    const int G = gridDim.x, bid = blockIdx.x;
    const int wave_sg = __builtin_amdgcn_readfirstlane((int)threadIdx.x >> 6);
#define PHASE_IDS() int lane; asm volatile("v_mbcnt_lo_u32_b32 %0, -1, 0\n\tv_mbcnt_hi_u32_b32 %0, -1, %0" : "=v"(lane)); const int wave = wave_sg; const int tid = wave * 64 + lane; const int gw = bid * NWAVES + wave, NGW = G * NWAVES; (void)lane; (void)wave; (void)gw; (void)NGW
#define CAS __attribute__((address_space(4)))
#define PHASE_ARGS() const CAS Args* ap = (const CAS Args*)__builtin_amdgcn_kernarg_segment_ptr(); asm volatile("" : "+s"(ap)); unsigned char* const ws = ap->ws; unsigned* const ctl = (unsigned*)(ws + WS_CTL); (void)ctl
#define ARG(i) (ap->in[i])
#define WSP(T, off) ((T*)(ws + (off)))
    enum { I_X = 0, I_C, I_WADA, I_BADA, I_NMIX, I_WIN, I_LBT, I_HGNW, I_CONVW, I_WHG, I_WCV, I_WMIX, I_NFFN, I_WR, I_BR, I_W1, I_B1, I_W2, I_B2, I_NFIN };
    { PHASE_IDS(); for (int u = tid; u < 64; u += NTHREADS) MISC[u] = 0u; }
    __syncthreads();
    XcdBarrier bar; bar.bar = nullptr; bar.x = 0; bar.st = nullptr;
#if MK_ONE_LAUNCH
    { PHASE_ARGS(); bar = xcd_barrier_post(ctl + CW_BAR, MISC + 8); }
#if MK_BG
#define GRID_BAR_X(drain) do { PHASE_IDS(); PHASE_ARGS(); const BgCtx bgc{ARG(I_W1), ARG(I_W2), WSP(unsigned char, WS_W1), WSP(unsigned char, WS_W2), ctl + CW_Q}; xcd_barrier_bg(bar, bgc, lds, wave, lane, drain); } while (0)
#define GRID_BAR() GRID_BAR_X(false)
#else
#define GRID_BAR() xcd_barrier(bar)
#endif
#else
#define GRID_BAR() do { } while (0)
#endif
    const int lo = args.ph_lo, hi = args.ph_hi;
#if MK_PHT
    const unsigned long long pht0 = __builtin_amdgcn_s_memrealtime(); unsigned long long phtk = 0;
#endif
#ifndef PH_MASK
#define PH_MASK 0x7ff
#endif
#define IN(k) (((PH_MASK >> (k)) & 1) && lo <= (k) && (k) < hi)
#define BOTH(k) (IN(k) && IN((k) + 1))

    if (IN(0)) for (int rep_ = 0; rep_ < 1 + ((MK_REPEAT >> 0) & 1); ++rep_) { PHASE_IDS(); PHASE_ARGS();
        const float* cvec = ARG(I_C); const float* w_ada = ARG(I_WADA); const float* b_ada = ARG(I_BADA); const float* lbtab = ARG(I_LBT);
        const float* w_in = ARG(I_WIN); const float* w_hg = ARG(I_WHG); const float* w_cv = ARG(I_WCV); const float* w_mix = ARG(I_WMIX); const float* w1 = ARG(I_W1); const float* w2 = ARG(I_W2);
        float* MOD = WSP(float, WS_MOD); float* LB = WSP(float, WS_LB);
        bf16_t* Win_t = WSP(bf16_t, WS_WIN); bf16_t* Whg_t = WSP(bf16_t, WS_WHG); bf16_t* Wcv_t = WSP(bf16_t, WS_WHG) + 512;        bf16_t* Wmix_t = WSP(bf16_t, WS_WMIX); unsigned char* W1_t = WSP(unsigned char, WS_W1); unsigned char* W2_t = WSP(unsigned char, WS_W2);
        LAS float* scr = (LAS float*)(lds + wave * 16896);
        const int nmod_w = NGW >= 768 ? 384 : 0;
        for (int it = (nmod_w ? gw - (NGW - nmod_w) : gw); it >= 0 && it < 384; it += (nmod_w ? 384 : NGW)) {
            const int n0 = it * 16, cl = lane & 15, kq = lane >> 4;
            float acc[32];
#pragma unroll
            for (int b = 0; b < 32; ++b) acc[b] = 0.f;
            for (int ch = 0; ch < 16; ++ch) {
                { const int b = lane >> 1, part = lane & 1;
#pragma unroll
                    for (int q = 0; q < 4; ++q) {
                        const float* cp = cvec + (size_t)b * D + q * 256 + ch * 16 + part * 8;
                        const f32x4 c0 = *(const f32x4*)cp, c1 = *(const f32x4*)(cp + 4);
#pragma unroll
                        for (int j = 0; j < 4; ++j) { scr[(q * 16 + part * 8 + j) * 32 + b] = c0[j] * sigmoidf_(c0[j]); scr[(q * 16 + part * 8 + 4 + j) * 32 + b] = c1[j] * sigmoidf_(c1[j]); }
                    } }
                float wv[16];
#pragma unroll
                for (int kk = 0; kk < 16; ++kk) wv[kk] = w_ada[(size_t)(kq * 256 + ch * 16 + kk) * 6144 + n0 + cl];
                LDS_WAIT(); asm volatile("" ::: "memory");
#pragma unroll
                for (int kk = 0; kk < 16; ++kk) {
                    const LAS f32x4* sp = (const LAS f32x4*)(scr + (kq * 16 + kk) * 32);
#pragma unroll
                    for (int b4 = 0; b4 < 8; ++b4) { const f32x4 s = sp[b4]; acc[4 * b4] += wv[kk] * s[0]; acc[4 * b4 + 1] += wv[kk] * s[1]; acc[4 * b4 + 2] += wv[kk] * s[2]; acc[4 * b4 + 3] += wv[kk] * s[3]; }
                }
                LDS_WAIT(); asm volatile("" ::: "memory");
            }
            const float bias = b_ada[n0 + cl];
#pragma unroll
            for (int b = 0; b < 32; ++b) { float v = acc[b]; v += __shfl_xor(v, 16); v += __shfl_xor(v, 32); if (kq == 0) MOD[(size_t)b * 6144 + n0 + cl] = v + bias; }
        }
        if (bid == (G > 1 ? 1 : 0)) { const int k = tid; const float l0 = lbtab[k], l1 = lbtab[HW + k]; LB[k] = fast_rcp(1.0f + fast_exp(l1 - l0)); }
        {
            constexpr int I_IN = 16 * PN8 * 4, I_IN8 = 8 * NQ8 * 8, I_HG = 8 * 16, I_CV = 8 * 16, I_MIX = 16 * 16, I_W1 = 32 * 8 * 64, I_W2 = 32 * 8 * 32;
            constexpr int NITEMS = I_IN + I_IN8 + I_HG + I_CV + I_MIX + ((MK_BG && MK_ONE_LAUNCH) ? 0 : I_W1 + I_W2);
            const int n_nm = NGW - nmod_w, base2 = 2 * n_nm, nfull = (NITEMS - base2) / NGW, base3 = base2 + nfull * NGW;
            for (int rr = 0; rr < nfull + 3; ++rr) {
                int it;
                if (rr < 2) { if (gw >= n_nm) continue; it = rr * n_nm + gw; }
                else if (rr < 2 + nfull) it = base2 + (rr - 2) * NGW + gw;
                else { if (gw >= n_nm) continue; it = base3 + gw; }
                if (it >= NITEMS) continue;
                int r = it;
#if MK_P2FP8
                if (r < I_IN) { const int kb = r / 176, nb = r % 176; transpose_item_fp8(w_in, INC, (unsigned char*)Win_t, D, kb * 128, nb * 32, nb * 32, scr, lane); continue; } r -= I_IN;
#else
                if (r < I_IN) { const int kb = r / (PN8 * 4), nb = r % (PN8 * 4); const int pn = nb >> 2, wi = (nb & 3) * 64;
                    const int src = pn < 10 ? nb * 64 : pn < 14 ? (wi < 128 ? 2560 + (pn - 10) * 128 + wi : 3072 + (pn - 10) * 128 + (wi - 128)) : (wi < 128 ? 3584 + (pn - 14) * 128 + wi : 4608 + (pn - 14) * 128 + (wi - 128));
                    transpose_item(w_in, INC, Win_t, D, kb * 64, src, nb * 64, scr, lane); continue; } r -= I_IN;
                if (r < I_IN8) { const int kb = r / (NQ8 * 8), nb = r % (NQ8 * 8); const int pn = PN8 + (nb >> 3), wi = (nb & 7) * 32;
                    const int src = pn < 10 ? pn * 256 + wi : pn < 14 ? (wi < 128 ? 2560 + (pn - 10) * 128 + wi : 3072 + (pn - 10) * 128 + (wi - 128)) : (wi < 128 ? 3584 + (pn - 14) * 128 + wi : 4608 + (pn - 14) * 128 + (wi - 128));
                    transpose_item_fp8(w_in, INC, WSP(unsigned char, WS_WIN8), D, kb * 128, src, nb * 32, scr, lane); continue; } r -= I_IN8;
#endif
                if (r < I_HG) { const int kb = r / 16, nb = r % 16; transpose_item(w_hg, D, Whg_t, D, kb * 64, nb * 64, nb * 64, scr, lane); continue; } r -= I_HG;
                if (r < I_CV) { const int kb = r / 16, nb = r % 16; transpose_item(w_cv, D, Wcv_t, D, kb * 64, nb * 64, nb * 64, scr, lane); continue; } r -= I_CV;
                if (r < I_MIX) { const int kb = r / 16, nb = r % 16; transpose_item(w_mix, D, Wmix_t, D, kb * 64, nb * 64, nb * 64, scr, lane); continue; } r -= I_MIX;
                if (r < I_W1) { const int e = r / 512, q = r % 512, kb = q / 64, nb = q % 64;
                    const int pn = nb >> 3, wi = (nb & 7) * 32; const int src = wi < 128 ? pn * 128 + wi : 1024 + pn * 128 + (wi - 128);
                    transpose_item_fp8(w1 + (size_t)e * D * 2048, 2048, W1_t + (size_t)e * 2048 * D, D, kb * 128, src, nb * 32, scr, lane); continue; } r -= I_W1;
                { const int e = r / 256, q = r % 256, kb = q / 32, nb = q % 32;
                    transpose_item_fp8(w2 + (size_t)e * DFF * D, D, W2_t + (size_t)e * D * DFF, DFF, kb * 128, nb * 32, nb * 32, scr, lane); }
            }
        }
        if (BOTH(0)) GRID_BAR();
#if MK_PHT
        if (MK_PHT == 1) phtk = __builtin_amdgcn_s_memrealtime() - pht0;
#endif
    }

    if (IN(1)) for (int rep_ = 0; rep_ < 1 + ((MK_REPEAT >> 1) & 1); ++rep_) { PHASE_IDS(); PHASE_ARGS();
        const float* x = ARG(I_X); const float* norm_mix_w = ARG(I_NMIX); const float* MOD = WSP(float, WS_MOD); bf16_t* U = WSP(bf16_t, WS_U); unsigned char* U8 = WSP(unsigned char, WS_U8);
        for (int m0 = gw * 32; m0 < NTOK; m0 += NGW * 32) {
            const int b = m0 >> 11;
            f32x4 A[4], Sh[4];
#pragma unroll
            for (int j = 0; j < 4; ++j) { const int k = 4 * lane + 256 * j; const f32x4 w = *(const f32x4*)(norm_mix_w + k), sc = *(const f32x4*)(MOD + (size_t)b * 6144 + 1024 + k);
                A[j] = w * (sc + 1.0f); Sh[j] = *(const f32x4*)(MOD + (size_t)b * 6144 + k); }
            for (int r = 0; r < 32; r += 4) {
                f32x4 v[4][4]; float ss[4];
#pragma unroll
                for (int q = 0; q < 4; ++q) { const float* xr = x + (size_t)(m0 + r + q) * D; ss[q] = 0.f;
#pragma unroll
                    for (int j = 0; j < 4; ++j) v[q][j] = *(const f32x4*)(xr + 4 * lane + 256 * j); }
#pragma unroll
                for (int q = 0; q < 4; ++q) {
#pragma unroll
                    for (int j = 0; j < 4; ++j) ss[q] += (v[q][j][0] * v[q][j][0] + v[q][j][1] * v[q][j][1]) + (v[q][j][2] * v[q][j][2] + v[q][j][3] * v[q][j][3]);
                    const float rs = __builtin_amdgcn_rsqf(wave_sum(ss[q]) * (1.0f / D) + EPS);
#if MK_P2FP8
                    unsigned char* ur = (unsigned char*)U + (size_t)(m0 + r + q) * D;
#pragma unroll
                    for (int j = 0; j < 4; ++j) { const f32x4 o = v[q][j] * rs * A[j] + Sh[j]; *(unsigned*)(ur + 4 * lane + 256 * j) = pk4_fp8(o[0], o[1], o[2], o[3]); }
#else
                    bf16_t* ur = U + (size_t)(m0 + r + q) * D; unsigned char* u8r = U8 + (size_t)(m0 + r + q) * D;
#pragma unroll
                    for (int j = 0; j < 4; ++j) { const f32x4 o = v[q][j] * rs * A[j] + Sh[j]; u32x2 w; w.x = cvt_pk_bf16(o[0], o[1]); w.y = cvt_pk_bf16(o[2], o[3]); *(u32x2*)(ur + 4 * lane + 256 * j) = w;
                        if (NQ8 > 0) *(unsigned*)(u8r + 4 * lane + 256 * j) = pk4_fp8(o[0], o[1], o[2], o[3]); }
#endif
                }
            }
        }
        if (BOTH(1)) GRID_BAR();
#if MK_PHT
        if (MK_PHT == 2) phtk = __builtin_amdgcn_s_memrealtime() - pht0;
#endif
    }

    if (IN(2)) for (int rep_ = 0; rep_ < 1 + ((MK_REPEAT >> 2) & 1); ++rep_) { PHASE_ARGS();
        if (PN8 > 0) { gm::DenseOrder S{NTOK / 256, PN8, G, bid, 1}; gm::DenseA AM{D, 0u, 2}; gm::EpiProjT<0, false> E{WSP(bf16_t, WS_PROJ), (bf16_t*)ap->out, WSP(float, WS_LB)};
            gm::gemm_phase<false>(wave_sg, lds, (const char*)WSP(bf16_t, WS_U), (const char*)WSP(bf16_t, WS_WIN), D, 0, 0u, S, E, AM); }
        if (NQ8 > 0) { gm::DenseOrder S{NTOK / 256, NQ8, G, bid, 1}; gm::DenseA AM{D, 0u, 1}; gm::EpiProjT<PN8, true> E{WSP(bf16_t, WS_PROJ), (bf16_t*)ap->out, WSP(float, WS_LB)};
            gm::gemm_phase<true>(wave_sg, lds, (const char*)WSP(unsigned char, WS_U8), (const char*)WSP(unsigned char, WS_WIN8), D, 0, 0u, S, E, AM); }
        if (BOTH(2)) GRID_BAR();
#if MK_PHT
        if (MK_PHT == 3) phtk = __builtin_amdgcn_s_memrealtime() - pht0;
#endif
    }

    if (IN(3)) for (int rep_ = 0; rep_ < 1 + ((MK_REPEAT >> 3) & 1); ++rep_) { PHASE_IDS(); PHASE_ARGS();
        const float* hg_norm_w = ARG(I_HGNW); const float* conv_w = ARG(I_CONVW); const bf16_t* PROJ = WSP(bf16_t, WS_PROJ); bf16_t* OB = WSP(bf16_t, WS_O); bf16_t* CVB = WSP(bf16_t, WS_O) + 512;
        const int nchainblk = (G >= 256) ? 128 : (G >= 2 ? G / 2 : 1);
        if (bid < nchainblk) {
            constexpr int LDQ = 136, LDT = 72;
            LAS bf16_t* QT = (LAS bf16_t*)(lds);
            LAS bf16_t* KT = QT + 64 * LDQ;
            LAS bf16_t* QB = KT + 64 * LDQ;
            LAS bf16_t* KBT = QB + 64 * LDQ;
            LAS bf16_t* VT = KBT + 128 * LDT;
            LAS bf16_t* PM = VT + 128 * LDT;
            LAS bf16_t* ST = PM + 64 * LDT;
            LAS bf16_t* OS = ST + 128 * LDQ;
            LAS float* SEG = (LAS float*)(OS + 64 * LDQ);
            LAS float* DEC = SEG + 8 * 128;
            const int fr = lane & 15, fq = lane >> 4, w = wave;
            for (int chain = bid; chain < BATCH * NHEAD; chain += nchainblk) {
                const int b = chain >> 2, h = chain & 3;
                __syncthreads();
                for (int i = tid; i < 128 * LDQ / 2; i += NTHREADS) ((LAS unsigned*)ST)[i] = 0u;
                f32x4 Sacc[8];
#pragma unroll
                for (int i = 0; i < 8; ++i) Sacc[i] = (f32x4){0.f, 0.f, 0.f, 0.f};
                const int ot = tid >> 3, ocg = tid & 7;
                f32x4 nwv[4];
#pragma unroll
                for (int q = 0; q < 2; ++q) { nwv[2 * q] = *(const f32x4*)(hg_norm_w + q * 64 + 8 * ocg); nwv[2 * q + 1] = *(const f32x4*)(hg_norm_w + q * 64 + 8 * ocg + 4); }
                const bf16_t* pbase = PROJ + (size_t)(b * SEQ) * PROJ_LD + h * DK;
                unsigned rq[8], rl[8], rv[8];
#pragma unroll
                for (int r = 0; r < 8; ++r) { const bf16_t* p = pbase + (size_t)(8 * w + r) * PROJ_LD + 2 * lane; rq[r] = *(const unsigned*)p; rl[r] = *(const unsigned*)(p + 512); rv[r] = *(const unsigned*)(p + 1024); }
                for (int c = 0; c < NCHUNK; ++c) {
                    const int m0 = c * CHUNK;
                    float cs0[8], cs1[8]; { float a0 = 0.f, a1 = 0.f;
#pragma unroll
                        for (int r = 0; r < 8; ++r) { a0 += bf_lo(rl[r]); a1 += bf_hi(rl[r]); cs0[r] = a0; cs1[r] = a1; }
                        *(LAS f32x2*)(SEG + w * 128 + 2 * lane) = (f32x2){a0, a1}; }
                    LDS_WAIT(); __builtin_amdgcn_s_barrier(); asm volatile("" ::: "memory");
                    float pre0 = 0.f, pre1 = 0.f, bm0 = 0.f, bm1 = 0.f, bl0 = 0.f, bl1 = 0.f;
#pragma unroll
                    for (int s = 0; s < 8; ++s) { const f32x2 t2 = *(const LAS f32x2*)(SEG + s * 128 + 2 * lane); if (s < w) { pre0 += t2[0]; pre1 += t2[1]; } if (s < 4) { bm0 += t2[0]; bm1 += t2[1]; } bl0 += t2[0]; bl1 += t2[1]; }
                    const float em0 = fast_exp(fmaxf(bm0, -80.f)), em1 = fast_exp(fmaxf(bm1, -80.f));
                    const float el0 = fast_exp(fmaxf(bl0 - bm0, -80.f)), el1 = fast_exp(fmaxf(bl1 - bm1, -80.f));
                    if (w == 0) *(LAS f32x2*)(DEC + 2 * lane) = (f32x2){fast_exp(fmaxf(bl0, -80.f)), fast_exp(fmaxf(bl1, -80.f))};
                    unsigned kb0[4], kb1[4], vt0[4], vt1[4];
#pragma unroll
                    for (int r = 0; r < 8; ++r) {
                        const int t = 8 * w + r;
                        const float lf0 = bf_lo(rl[r]), lf1 = bf_hi(rl[r]);
                        const float d0 = fminf(fmaxf(pre0 + cs0[r] - bm0, -80.f), 80.f), d1 = fminf(fmaxf(pre1 + cs1[r] - bm1, -80.f), 80.f);
                        const float e0 = fast_exp(d0), e1 = fast_exp(d1), i0 = fast_exp(-d0), i1 = fast_exp(-d1);
                        const float kk0 = 1.0f - fast_exp(lf0), kk1 = 1.0f - fast_exp(lf1);
                        const float qt0 = bf_lo(rq[r]) * e0, qt1 = bf_hi(rq[r]) * e1, kt0 = kk0 * i0, kt1 = kk1 * i1;
                        *(LAS unsigned*)(QT + t * LDQ + 2 * lane) = cvt_pk_bf16(qt0, qt1);
                        *(LAS unsigned*)(KT + t * LDQ + 2 * lane) = cvt_pk_bf16(kt0, kt1);
                        *(LAS unsigned*)(QB + t * LDQ + 2 * lane) = cvt_pk_bf16(qt0 * em0, qt1 * em1);
                        const unsigned kbp = cvt_pk_bf16(kt0 * el0, kt1 * el1);
                        if (r & 1) { kb0[r >> 1] |= (kbp << 16); kb1[r >> 1] |= (kbp & 0xffff0000u); vt0[r >> 1] |= (rv[r] << 16); vt1[r >> 1] |= (rv[r] & 0xffff0000u); }
                        else { kb0[r >> 1] = kbp & 0xffffu; kb1[r >> 1] = kbp >> 16; vt0[r >> 1] = rv[r] & 0xffffu; vt1[r >> 1] = rv[r] >> 16; }
                    }
                    *(LAS u32x4*)(KBT + (2 * lane) * LDT + 8 * w) = (u32x4){kb0[0], kb0[1], kb0[2], kb0[3]};
                    *(LAS u32x4*)(KBT + (2 * lane + 1) * LDT + 8 * w) = (u32x4){kb1[0], kb1[1], kb1[2], kb1[3]};
                    *(LAS u32x4*)(VT + (2 * lane) * LDT + 8 * w) = (u32x4){vt0[0], vt0[1], vt0[2], vt0[3]};
                    *(LAS u32x4*)(VT + (2 * lane + 1) * LDT + 8 * w) = (u32x4){vt1[0], vt1[1], vt1[2], vt1[3]};
                    LDS_WAIT(); __builtin_amdgcn_s_barrier(); asm volatile("" ::: "memory");
                    u32x4 gg[2];
                    { const bf16_t* gp = pbase + (size_t)(m0 + ot) * PROJ_LD + 1536 + 8 * ocg; gg[0] = *(const u32x4*)gp; gg[1] = *(const u32x4*)(gp + 64); }
                    if (c + 1 < NCHUNK) {
#pragma unroll
                        for (int r = 0; r < 8; ++r) { const bf16_t* p = pbase + (size_t)(m0 + CHUNK + 8 * w + r) * PROJ_LD + 2 * lane; rq[r] = *(const unsigned*)p; rl[r] = *(const unsigned*)(p + 512); rv[r] = *(const unsigned*)(p + 1024); }
                    }
#pragma unroll
                    for (int x2 = 0; x2 < 2; ++x2) { const int id = 2 * w + x2, si = id >> 2, ti = id & 3;
                        f32x4 sc = (f32x4){0.f, 0.f, 0.f, 0.f};
                        if (si <= ti) {
#pragma unroll
                            for (int ks = 0; ks < 4; ++ks) { const bf16x8 a = *(const LAS bf16x8*)(KT + (16 * si + fr) * LDQ + 32 * ks + 8 * fq), bb = *(const LAS bf16x8*)(QT + (16 * ti + fr) * LDQ + 32 * ks + 8 * fq);
                                sc = __builtin_amdgcn_mfma_f32_16x16x32_bf16(a, bb, sc, 0, 0, 0); }
                            const int t = 16 * ti + fr, s0 = 16 * si + 4 * fq;
#pragma unroll
                            for (int j = 0; j < 4; ++j) sc[j] = (s0 + j <= t) ? sc[j] : 0.f;
                        }
                        *(LAS u32x2*)(PM + (16 * ti + fr) * LDT + 16 * si + 4 * fq) = (u32x2){cvt_pk_bf16(sc[0], sc[1]), cvt_pk_bf16(sc[2], sc[3])};
                    }
                    f32x4 oacc[4];
                    { bf16x8 sa[4];
#pragma unroll
                        for (int ks = 0; ks < 4; ++ks) sa[ks] = *(const LAS bf16x8*)(ST + (16 * w + fr) * LDQ + 32 * ks + 8 * fq);
#pragma unroll
                        for (int ti = 0; ti < 4; ++ti) { oacc[ti] = (f32x4){0.f, 0.f, 0.f, 0.f};
#pragma unroll
                            for (int ks = 0; ks < 4; ++ks) { const bf16x8 bb = *(const LAS bf16x8*)(QB + (16 * ti + fr) * LDQ + 32 * ks + 8 * fq); oacc[ti] = __builtin_amdgcn_mfma_f32_16x16x32_bf16(sa[ks], bb, oacc[ti], 0, 0, 0); } } }
                    LDS_WAIT(); __builtin_amdgcn_s_barrier(); asm volatile("" ::: "memory");
                    { bf16x8 va[2];
#pragma unroll
                        for (int ks = 0; ks < 2; ++ks) va[ks] = *(const LAS bf16x8*)(VT + (16 * w + fr) * LDT + 32 * ks + 8 * fq);
#pragma unroll
                        for (int ti = 0; ti < 4; ++ti)
#pragma unroll
                            for (int ks = 0; ks < 2; ++ks) { const bf16x8 bb = *(const LAS bf16x8*)(PM + (16 * ti + fr) * LDT + 32 * ks + 8 * fq); oacc[ti] = __builtin_amdgcn_mfma_f32_16x16x32_bf16(va[ks], bb, oacc[ti], 0, 0, 0); }
#pragma unroll
                        for (int i = 0; i < 8; ++i) { const f32x4 dv = *(const LAS f32x4*)(DEC + 16 * i + 4 * fq); Sacc[i] = Sacc[i] * dv;
#pragma unroll
                            for (int ks = 0; ks < 2; ++ks) { const bf16x8 a = *(const LAS bf16x8*)(KBT + (16 * i + fr) * LDT + 32 * ks + 8 * fq); Sacc[i] = __builtin_amdgcn_mfma_f32_16x16x32_bf16(a, va[ks], Sacc[i], 0, 0, 0); } } }
#pragma unroll
                    for (int ti = 0; ti < 4; ++ti) *(LAS u32x2*)(OS + (16 * ti + fr) * LDQ + 16 * w + 4 * fq) = (u32x2){cvt_pk_bf16(oacc[ti][0], oacc[ti][1]), cvt_pk_bf16(oacc[ti][2], oacc[ti][3])};
#pragma unroll
                    for (int i = 0; i < 8; ++i) *(LAS u32x2*)(ST + (16 * w + fr) * LDQ + 16 * i + 4 * fq) = (u32x2){cvt_pk_bf16(Sacc[i][0], Sacc[i][1]), cvt_pk_bf16(Sacc[i][2], Sacc[i][3])};
                    LDS_WAIT(); __builtin_amdgcn_s_barrier(); asm volatile("" ::: "memory");
                    { f32x4 o[4]; const u32x4 ow0 = *(const LAS u32x4*)(OS + ot * LDQ + 8 * ocg), ow1 = *(const LAS u32x4*)(OS + ot * LDQ + 64 + 8 * ocg); gm::unpack8(ow0, o[0], o[1]); gm::unpack8(ow1, o[2], o[3]);
                        float ss = 0.f;
#pragma unroll
                        for (int q = 0; q < 4; ++q) ss += (o[q][0] * o[q][0] + o[q][1] * o[q][1]) + (o[q][2] * o[q][2] + o[q][3] * o[q][3]);
                        ss += __shfl_xor(ss, 1); ss += __shfl_xor(ss, 2); ss += __shfl_xor(ss, 4);
                        const float rn = __builtin_amdgcn_rsqf(ss * (1.0f / 128.0f) + EPS);
                        bf16_t* op = OB + (size_t)(b * SEQ + m0 + ot) * D + h * DK + 8 * ocg;
#pragma unroll
                        for (int q = 0; q < 2; ++q) { f32x4 g0, g1; gm::unpack8(gg[q], g0, g1);
#pragma unroll
                            for (int j = 0; j < 4; ++j) { g0[j] = g0[j] * sigmoidf_(g0[j]); g1[j] = g1[j] * sigmoidf_(g1[j]); }
                            *(u32x4*)(op + 64 * q) = gm::pack8(o[2 * q] * rn * nwv[2 * q] * g0, o[2 * q + 1] * rn * nwv[2 * q + 1] * g1); } }
                }
            }
        } else {
            const int nconv = G - nchainblk;
            f32x4 cw[3][2];
#pragma unroll
            for (int j = 0; j < 3; ++j) { cw[j][0] = *(const f32x4*)(conv_w + j * 512 + 8 * lane); cw[j][1] = *(const f32x4*)(conv_w + j * 512 + 8 * lane + 4); }
            for (int it = bid - nchainblk; it < BATCH * 8; it += nconv) {
                const int b = it >> 3, t0 = (it & 7) * 256 + wave * 32;
                const bf16_t* pb = PROJ + (size_t)(b * SEQ) * PROJ_LD + 2048 + 8 * lane;
                f32x4 p1[2], p2[2];
#pragma unroll
                for (int q = 0; q < 2; ++q) { p1[q] = (f32x4){0.f, 0.f, 0.f, 0.f}; p2[q] = p1[q]; }
                if (t0 > 0) { gm::unpack8(*(const u32x4*)(pb + (size_t)(t0 - 2) * PROJ_LD + 512), p2[0], p2[1]); gm::unpack8(*(const u32x4*)(pb + (size_t)(t0 - 1) * PROJ_LD + 512), p1[0], p1[1]); }
                for (int r = 0; r < 32; ++r) { const size_t ro = (size_t)(t0 + r) * PROJ_LD;
                    f32x4 q0, q1, g0, g1;
                    gm::unpack8(*(const u32x4*)(pb + ro + 512), q0, q1); gm::unpack8(*(const u32x4*)(pb + ro), g0, g1);
                    const f32x4 y0 = g0 * (cw[0][0] * p2[0] + cw[1][0] * p1[0] + cw[2][0] * q0), y1 = g1 * (cw[0][1] * p2[1] + cw[1][1] * p1[1] + cw[2][1] * q1);
                    *(u32x4*)(CVB + (size_t)(b * SEQ + t0 + r) * D + 8 * lane) = gm::pack8(y0, y1);
                    p2[0] = p1[0]; p2[1] = p1[1]; p1[0] = q0; p1[1] = q1; }
            }
        }
        if (BOTH(3)) GRID_BAR();
#if MK_PHT
        if (MK_PHT == 4) phtk = __builtin_amdgcn_s_memrealtime() - pht0;
#endif
    }

    if (IN(4)) for (int rep_ = 0; rep_ < 1 + ((MK_REPEAT >> 4) & 1); ++rep_) { PHASE_ARGS();
        gm::DenseOrder S{NTOK / 256, D / 256, G, bid, 1}; gm::DenseA AM{D, 0u, 2}; gm::EpiMerge E{(const bf16_t*)ap->out, WSP(bf16_t, WS_U)};
        gm::gemm_phase<false>(wave_sg, lds, (const char*)WSP(bf16_t, WS_O), (const char*)WSP(bf16_t, WS_WHG), D, 0, 0u, S, E, AM);
        if (BOTH(4)) GRID_BAR();
#if MK_PHT
        if (MK_PHT == 5) phtk = __builtin_amdgcn_s_memrealtime() - pht0;
#endif
    }

    if (IN(5)) for (int rep_ = 0; rep_ < 1 + ((MK_REPEAT >> 5) & 1); ++rep_) { PHASE_ARGS();
        gm::DenseOrder S{NTOK / 256, D / 256, G, bid, 1}; gm::DenseA AM{D, 0u, 2}; gm::EpiMix E{ARG(I_X), WSP(float, WS_MOD), WSP(bf16_t, WS_H)};
        gm::gemm_phase<false>(wave_sg, lds, (const char*)WSP(bf16_t, WS_U), (const char*)WSP(bf16_t, WS_WMIX), D, 0, 0u, S, E, AM);
        if (BOTH(5)) GRID_BAR();
#if MK_PHT
        if (MK_PHT == 6) phtk = __builtin_amdgcn_s_memrealtime() - pht0;
#endif
    }

    if (IN(6)) { PHASE_IDS(); PHASE_ARGS();
        typedef float f32x16 __attribute__((ext_vector_type(16)));
        const float* norm_ffn_w = ARG(I_NFFN); const float* w_router = ARG(I_WR); const float* b_router = ARG(I_BR); const float* MOD = WSP(float, WS_MOD);
        const bf16_t* HB = WSP(bf16_t, WS_H); unsigned char* U2Q = WSP(unsigned char, WS_U2Q); int* TOPI = WSP(int, WS_TOPI); float* TOPP = WSP(float, WS_TOPP); int* POS = WSP(int, WS_POS);
        constexpr int WRS = 1032;
        LAS bf16_t* WRH = (LAS bf16_t*)lds; LAS bf16_t* WRL = WRH + 32 * WRS;
        LAS float* LG = (LAS float*)(lds + 132096) + wave * (16 * 36);
        LAS unsigned* LCNT = (LAS unsigned*)(lds + 150528);
        LAS unsigned* LBASE = LCNT + 32;
        LAS unsigned* LASS = LCNT + 64;
        LAS float* A2 = (LAS float*)(lds + 154880); LAS float* SH2 = A2 + 1024;
        for (int i = tid; i < 32 * 1024; i += NTHREADS) { const int e = i & 31, k = i >> 5; const float w = w_router[i];
            const unsigned hi = cvt_pk_bf16(w, 0.f) & 0xffffu; const unsigned lo = cvt_pk_bf16(w - bf_lo(hi), 0.f) & 0xffffu;
            WRH[e * WRS + k] = (bf16_t)hi; WRL[e * WRS + k] = (bf16_t)lo; }
        for (int tb = bid; tb < NTOK / 256; tb += G) {
            const int b = (tb * 256) >> 11;
            if (tid < 32) LCNT[tid] = 0u;
            for (int k = tid; k < 1024; k += NTHREADS) { A2[k] = norm_ffn_w[k] * (1.0f + MOD[(size_t)b * 6144 + 4096 + k]); SH2[k] = MOD[(size_t)b * 6144 + 3072 + k]; }
            LDS_WAIT(); __syncthreads();
            const int trow = lane & 31, half = lane >> 5, ltok0 = wave * 32, tok = tb * 256 + ltok0 + trow;
            const bf16_t* hrow = HB + (size_t)tok * D + 8 * half;
            float ssq = 0.f;
#pragma unroll 8
            for (int st = 0; st < 64; ++st) { const u32x4 hv = *(const u32x4*)(hrow + 16 * st); f32x4 x0, x1; gm::unpack8(hv, x0, x1);
                ssq += (x0[0] * x0[0] + x0[1] * x0[1]) + (x0[2] * x0[2] + x0[3] * x0[3]) + (x1[0] * x1[0] + x1[1] * x1[1]) + (x1[2] * x1[2] + x1[3] * x1[3]); }
            ssq += __shfl_xor(ssq, 32);
            const float rs = __builtin_amdgcn_rsqf(ssq * (1.0f / D) + EPS);
            f32x16 dacc;
#pragma unroll
            for (int q = 0; q < 16; ++q) dacc[q] = 0.f;
            unsigned char* urow = U2Q + (size_t)tok * D + 8 * half;
            const LAS bf16_t* wh = WRH + trow * WRS + 8 * half; const LAS bf16_t* wl = WRL + trow * WRS + 8 * half;
#pragma unroll 2
            for (int st = 0; st < 64; ++st) {
                const u32x4 hv = *(const u32x4*)(hrow + 16 * st); f32x4 x0, x1; gm::unpack8(hv, x0, x1);
                const int k0 = 16 * st + 8 * half;
                const f32x4 a0 = *(const LAS f32x4*)(A2 + k0), a1 = *(const LAS f32x4*)(A2 + k0 + 4), s0 = *(const LAS f32x4*)(SH2 + k0), s1 = *(const LAS f32x4*)(SH2 + k0 + 4);
                const f32x4 u0 = x0 * rs * a0 + s0, u1 = x1 * rs * a1 + s1;
                *(u32x2*)(urow + 16 * st) = (u32x2){pk4_fp8(u0[0], u0[1], u0[2], u0[3]), pk4_fp8(u1[0], u1[1], u1[2], u1[3])};
                u32x4 hh; hh.x = cvt_pk_bf16(u0[0], u0[1]); hh.y = cvt_pk_bf16(u0[2], u0[3]); hh.z = cvt_pk_bf16(u1[0], u1[1]); hh.w = cvt_pk_bf16(u1[2], u1[3]);
                u32x4 ll; ll.x = cvt_pk_bf16(u0[0] - bf_lo(hh.x), u0[1] - bf_hi(hh.x)); ll.y = cvt_pk_bf16(u0[2] - bf_lo(hh.y), u0[3] - bf_hi(hh.y));
                ll.z = cvt_pk_bf16(u1[0] - bf_lo(hh.z), u1[1] - bf_hi(hh.z)); ll.w = cvt_pk_bf16(u1[2] - bf_lo(hh.w), u1[3] - bf_hi(hh.w));
                const bf16x8 ah = __builtin_bit_cast(bf16x8, hh), al = __builtin_bit_cast(bf16x8, ll);
                const bf16x8 bh = *(const LAS bf16x8*)(wh + 16 * st), bl = *(const LAS bf16x8*)(wl + 16 * st);
                dacc = __builtin_amdgcn_mfma_f32_32x32x16_bf16(ah, bh, dacc, 0, 0, 0);
                dacc = __builtin_amdgcn_mfma_f32_32x32x16_bf16(ah, bl, dacc, 0, 0, 0);
                dacc = __builtin_amdgcn_mfma_f32_32x32x16_bf16(al, bh, dacc, 0, 0, 0);
            }
            const float br = b_router[trow];
#pragma unroll
            for (int g = 0; g < 2; ++g) {
#pragma unroll
                for (int q = 0; q < 8; ++q) { const int r16 = (q & 3) + 8 * (q >> 2) + 4 * half; LG[r16 * 36 + trow] = dacc[8 * g + q] + br; }
                LDS_WAIT(); asm volatile("" ::: "memory");
                if (lane < 16) {
                    float v0 = -3.0e38f, v1 = -3.0e38f, v2 = -3.0e38f, v3 = -3.0e38f; int i0 = 0, i1 = 0, i2 = 0, i3 = 0;
#pragma unroll
                    for (int e4 = 0; e4 < 8; ++e4) { const f32x4 lv = *(const LAS f32x4*)(LG + lane * 36 + 4 * e4);
#pragma unroll
                        for (int j = 0; j < 4; ++j) { const float x = lv[j]; const int e = 4 * e4 + j;
                            const bool c0 = x > v0, c1 = x > v1, c2 = x > v2, c3 = x > v3;
                            v3 = c2 ? v2 : (c3 ? x : v3); i3 = c2 ? i2 : (c3 ? e : i3);
                            v2 = c1 ? v1 : (c2 ? x : v2); i2 = c1 ? i1 : (c2 ? e : i2);
                            v1 = c0 ? v0 : (c1 ? x : v1); i1 = c0 ? i0 : (c1 ? e : i1);
                            v0 = c0 ? x : v0; i0 = c0 ? e : i0; } }
                    const float e1 = fast_exp(v1 - v0), e2 = fast_exp(v2 - v0), e3 = fast_exp(v3 - v0); const float inv = fast_rcp(1.0f + e1 + e2 + e3);
                    const int lt = ltok0 + 16 * g + lane; const size_t gt = (size_t)tb * 256 + lt;
                    typedef int i32x4 __attribute__((ext_vector_type(4)));
                    *(i32x4*)(TOPI + gt * 4) = (i32x4){i0, i1, i2, i3}; *(f32x4*)(TOPP + gt * 4) = (f32x4){inv, e1 * inv, e2 * inv, e3 * inv};
                    const unsigned r0 = __hip_atomic_fetch_add(LCNT + i0, 1u, __ATOMIC_RELAXED, __HIP_MEMORY_SCOPE_WORKGROUP), r1 = __hip_atomic_fetch_add(LCNT + i1, 1u, __ATOMIC_RELAXED, __HIP_MEMORY_SCOPE_WORKGROUP);
                    const unsigned r2 = __hip_atomic_fetch_add(LCNT + i2, 1u, __ATOMIC_RELAXED, __HIP_MEMORY_SCOPE_WORKGROUP), r3 = __hip_atomic_fetch_add(LCNT + i3, 1u, __ATOMIC_RELAXED, __HIP_MEMORY_SCOPE_WORKGROUP);
                    *(LAS u32x4*)(LASS + lt * 4) = (u32x4){((unsigned)i0 << 16) | r0, ((unsigned)i1 << 16) | r1, ((unsigned)i2 << 16) | r2, ((unsigned)i3 << 16) | r3};
                }
                LDS_WAIT(); asm volatile("" ::: "memory");
            }
            LDS_WAIT(); __syncthreads();
            if (tid < 32) LBASE[tid] = atomicAdd(ctl + CW_CNT + 64 * tid, (unsigned)LCNT[tid]);
            LDS_WAIT(); __syncthreads();
            for (int i = tid; i < 1024; i += NTHREADS) { const unsigned v = LASS[i]; POS[(size_t)tb * 1024 + i] = (int)(LBASE[v >> 16] + (v & 0xffffu)); }
            __syncthreads();
        }
        if (BOTH(6)) GRID_BAR();
#if MK_PHT
        if (MK_PHT == 7) phtk = __builtin_amdgcn_s_memrealtime() - pht0;
#endif
    }

    LAS int* PADSTART = (LAS int*)(lds + TBL_OFF); LAS int* TILE_E = PADSTART + 64;
    int ntiles = 0;
    {
        if (lo <= 9 && hi > 7) { PHASE_IDS(); PHASE_ARGS();
            __syncthreads();
            if (wave == 0) {
                const int cnt = lane < NE ? (int)__hip_atomic_load(ctl + CW_CNT + 64 * lane, __ATOMIC_RELAXED, __HIP_MEMORY_SCOPE_AGENT) : 0;
                const int padded = ((cnt + 255) >> 8) << 8; int incl = padded;
#pragma unroll
                for (int o = 1; o < 32; o <<= 1) { const int v = __shfl_up(incl, o); if ((lane & 31) >= o) incl += v; }
                if (lane < NE) PADSTART[lane] = incl - padded;
                if (lane == NE - 1) PADSTART[NE] = incl;
            }
            LDS_WAIT(); __syncthreads();
            for (int t = tid; t < (PADSTART[NE] >> 8); t += NTHREADS) { int e = 0;
#pragma unroll
                for (int q = 1; q < NE; ++q) e += ((PADSTART[q] >> 8) <= t) ? 1 : 0;
                TILE_E[t] = e; }
            LDS_WAIT(); __syncthreads();
            ntiles = PADSTART[NE] >> 8;
        }
    }

    if (IN(7)) for (int rep_ = 0; rep_ < 1 + ((MK_REPEAT >> 7) & 1); ++rep_) { PHASE_IDS(); PHASE_ARGS();
        const int* TOPI = WSP(int, WS_TOPI); const float* TOPP = WSP(float, WS_TOPP); int* POS = WSP(int, WS_POS); int* RTOK = WSP(int, WS_RTOK); int* RSLOT = WSP(int, WS_RSLOT); float* RW = WSP(float, WS_RW);
        for (int i = bid * NTHREADS + tid; i < NASSIGN; i += G * NTHREADS) { const int e = TOPI[i]; const int row = PADSTART[e] + POS[i]; RTOK[row] = i >> 2; RSLOT[row] = i; RW[row] = TOPP[i]; POS[i] = row; }
        for (int e = bid; e < NE; e += G) { const int cnt = (int)__hip_atomic_load(ctl + CW_CNT + 64 * e, __ATOMIC_RELAXED, __HIP_MEMORY_SCOPE_AGENT);
            for (int r = PADSTART[e] + cnt + tid; r < PADSTART[e + 1]; r += NTHREADS) { RTOK[r] = 0; RSLOT[r] = -1; RW[r] = 0.f; } }
#if MK_BG && MK_ONE_LAUNCH
        if (BOTH(7)) GRID_BAR_X(true);
#else
        if (BOTH(7)) GRID_BAR();
#endif
#if MK_PHT
        if (MK_PHT == 8) phtk = __builtin_amdgcn_s_memrealtime() - pht0;
#endif
    }

    if (IN(8)) for (int rep_ = 0; rep_ < 1 + ((MK_REPEAT >> 8) & 1); ++rep_) { PHASE_ARGS();
        gm::MoeOrder S{ntiles, 2048 / 256, G, bid, TILE_E}; gm::GatherA AM{D, WSP(int, WS_RTOK), 1}; gm::EpiSwiglu E{ARG(I_B1), WSP(unsigned char, WS_ACT), ctl + CW_TP};
        gm::gemm_phase<true>(wave_sg, lds, (const char*)WSP(char, WS_U2Q), (const char*)WSP(char, WS_W1), D, 2048, 0u, S, E, AM);
        if (BOTH(8)) GRID_BAR();
#if MK_PHT
        if (MK_PHT == 9) phtk = __builtin_amdgcn_s_memrealtime() - pht0;
#endif
    }

    if (IN(9)) for (int rep_ = 0; rep_ < 1 + ((MK_REPEAT >> 9) & 1); ++rep_) { PHASE_ARGS();
        gm::MoeOrder S{ntiles, D / 256, G, bid, TILE_E}; gm::DenseA AM{DFF, 0u, 1}; gm::EpiMoeOut E{ARG(I_B2), WSP(float, WS_RW), WSP(unsigned char, WS_YA)};
        gm::gemm_phase<true>(wave_sg, lds, (const char*)WSP(char, WS_ACT), (const char*)WSP(char, WS_W2), DFF, D, 0u, S, E, AM);
        if (BOTH(9)) GRID_BAR();
#if MK_PHT
        if (MK_PHT == 10) phtk = __builtin_amdgcn_s_memrealtime() - pht0;
#endif
    }

#if MK_PROBE
    if (lo == 100) { PHASE_IDS(); PHASE_ARGS();
        float* out = ap->out;
        const bf16_t* src = MK_PROBE == 1 ? WSP(bf16_t, WS_U) : MK_PROBE == 3 ? WSP(bf16_t, WS_O) : MK_PROBE == 4 ? WSP(bf16_t, WS_U) : MK_PROBE == 5 ? WSP(bf16_t, WS_H) : WSP(bf16_t, WS_U);
        for (size_t i = (size_t)bid * NTHREADS + tid; i < (size_t)NTOK * D; i += (size_t)G * NTHREADS) {
            float v;
            if (MK_PROBE == 3) { const size_t t = i >> 10, c = i & 1023; v = bf1(src[t * 1024 + c]); }
            else if (MK_PROBE == 2) { const size_t t = i >> 10, c = i & 1023; const bf16_t* P = WSP(bf16_t, WS_PROJ) + t * PROJ_LD; v = bf1(P[c]) + bf1(P[c + 1024]) + bf1(P[c + 2048]) + (c < 512 ? bf1(P[c + 3072]) : 0.f); }
            else if (MK_PROBE == 6) { const size_t t = i >> 10, c = i & 1023; v = bf1(src[i]) + (c < 4 ? (float)WSP(int, WS_TOPI)[t * 4 + c] : c < 8 ? WSP(float, WS_TOPP)[t * 4 + (c - 4)] : 0.f); }
            else v = bf1(src[i]);
            out[i] = v; }
    }
#endif
    if (IN(10)) { PHASE_IDS(); PHASE_ARGS();
#if MK_TPROBE
        const float tscale = 1.0f;
#elif MK_FP8TEST
        float tscale = 1.0f;
        {
            typedef int v8i __attribute__((ext_vector_type(8)));
            const int fr = lane & 15, fq = lane >> 4;
            v8i ta, tb;
#pragma unroll
            for (int d = 0; d < 8; ++d) { float av[4], bv[4];
#pragma unroll
                for (int e = 0; e < 4; ++e) { const int k = 32 * fq + 4 * d + e; av[e] = (float)(((fr * 7 + k * 3) % 5) - 2); bv[e] = (float)(((k * 5 + fr * 11) % 7) - 3); }
                int w = __builtin_amdgcn_cvt_pk_fp8_f32(av[0], av[1], 0, false); w = __builtin_amdgcn_cvt_pk_fp8_f32(av[2], av[3], w, true); ta[d] = w;
                w = __builtin_amdgcn_cvt_pk_fp8_f32(bv[0], bv[1], 0, false); w = __builtin_amdgcn_cvt_pk_fp8_f32(bv[2], bv[3], w, true); tb[d] = w; }
            f32x4 tc = {0.f, 0.f, 0.f, 0.f};
            tc = __builtin_amdgcn_mfma_scale_f32_16x16x128_f8f6f4(ta, tb, tc, 0, 0, 0, 0x7A7A7A7A, 0, 0x7F7F7F7F);
            bool bad = false;
#pragma unroll
            for (int r = 0; r < 4; ++r) { const int i = 4 * fq + r, j = fr; float ref = 0.f;
                for (int k = 0; k < 128; ++k) ref += (float)(((i * 7 + k * 3) % 5) - 2) * (float)(((k * 5 + j * 11) % 7) - 3);
                ref *= (1.0f / 32.0f); if (fabsf(tc[r] - ref) > 1e-3f) bad = true; }
            if (__any(bad)) tscale = 4.0f;
        }
#endif
        const float* norm_final_w = ARG(I_NFIN); const float* MOD = WSP(float, WS_MOD); const bf16_t* HB = WSP(bf16_t, WS_H); const unsigned char* YA = WSP(unsigned char, WS_YA); const int* ASROW = WSP(int, WS_POS); float* out = ap->out;
        for (int m0 = gw * 32; m0 < NTOK; m0 += NGW * 32) {
            const int b = m0 >> 11;
            f32x4 gf[4], nf[4];
#pragma unroll
            for (int j = 0; j < 4; ++j) { const int k = 4 * lane + 256 * j; gf[j] = *(const f32x4*)(MOD + (size_t)b * 6144 + 5120 + k); nf[j] = *(const f32x4*)(norm_final_w + k); }
            for (int r = 0; r < 32; ++r) {
                const size_t tok = (size_t)(m0 + r);
                const bf16_t* hr = HB + tok * D;
                typedef int i32x4 __attribute__((ext_vector_type(4)));
                const i32x4 rr = *(const i32x4*)(ASROW + tok * 4);
                const unsigned char* y0 = YA + (size_t)rr[0] * D; const unsigned char* y1 = YA + (size_t)rr[1] * D; const unsigned char* y2 = YA + (size_t)rr[2] * D; const unsigned char* y3 = YA + (size_t)rr[3] * D;
                f32x4 v[4]; float s = 0.f;
#pragma unroll
                for (int j = 0; j < 4; ++j) { const int k = 4 * lane + 256 * j;
                    const u32x2 hw = *(const u32x2*)(hr + k); const unsigned ya = *(const unsigned*)(y0 + k), yb = *(const unsigned*)(y1 + k), yc = *(const unsigned*)(y2 + k), yd = *(const unsigned*)(y3 + k);
                    f32x4 y = fp8x4_to_f32(ya); y += fp8x4_to_f32(yb); y += fp8x4_to_f32(yc); y += fp8x4_to_f32(yd);
                    v[j] = (f32x4){bf_lo(hw.x), bf_hi(hw.x), bf_lo(hw.y), bf_hi(hw.y)} + gf[j] * y;
                    s += (v[j][0] * v[j][0] + v[j][1] * v[j][1]) + (v[j][2] * v[j][2] + v[j][3] * v[j][3]); }
                const float rs = __builtin_amdgcn_rsqf(wave_sum(s) * (1.0f / D) + EPS);
                float* orow = out + tok * D;
#pragma unroll
                #if MK_FP8TEST || MK_TPROBE
                for (int j = 0; j < 4; ++j) *(f32x4*)(orow + 4 * lane + 256 * j) = v[j] * rs * nf[j] * tscale;
#else
                for (int j = 0; j < 4; ++j) *(f32x4*)(orow + 4 * lane + 256 * j) = v[j] * rs * nf[j];
#endif
            }
        }
    }
#if MK_PHT
    if (bid == 0) { const unsigned long long t1 = __builtin_amdgcn_s_memrealtime(); while (__builtin_amdgcn_s_memrealtime() - t1 < phtk) __builtin_amdgcn_s_sleep(8); }
#endif
#undef IN
#undef BOTH
}

extern "C" void kernel_launch(void* const* d_in, const int* in_sizes, int n_in, void* d_out, int out_size, void* d_ws, size_t ws_size, hipStream_t stream) {
    static int grid = 0;
    if (grid == 0) {
        if (n_in != 20 || out_size != NTOK * D || ws_size < WS_END) { fprintf(stderr, "kernel_launch: unexpected shapes (n_in %d out %d ws %zu)\n", n_in, out_size, ws_size); grid = -1; return; }
        if (hipFuncSetAttribute((const void*)fwd_kernel, hipFuncAttributeMaxDynamicSharedMemorySize, LDS_BYTES) != hipSuccess) { fprintf(stderr, "kernel_launch: hipFuncSetAttribute failed\n"); grid = -1; return; }
        int dev = 0, cus = 0, per_cu = 0;
        (void)hipGetDevice(&dev); (void)hipDeviceGetAttribute(&cus, hipDeviceAttributeMultiprocessorCount, dev);
        if (hipOccupancyMaxActiveBlocksPerMultiprocessor(&per_cu, (const void*)fwd_kernel, NTHREADS, LDS_BYTES) != hipSuccess || per_cu < 1) fprintf(stderr, "kernel_launch: occupancy query says %d\n", per_cu);
        (void)hipGetLastError();
        grid = cus > 0 ? cus : 256;
    }
    if (grid < 0) return;
    (void)hipMemsetAsync((char*)d_ws + WS_CTL, 0, CTL_ZERO_BYTES, stream);
    Args a{};
    for (int i = 0; i < 20; ++i) a.in[i] = (const float*)d_in[i];
    a.out = (float*)d_out; a.ws = (unsigned char*)d_ws;
#if MK_ONE_LAUNCH
    a.ph_lo = 0; a.ph_hi = NPHASE;
    hipLaunchKernelGGL(fwd_kernel, dim3(grid), dim3(NTHREADS), LDS_BYTES, stream, a);
#else
#if MK_PROBE
    for (int p = 0; p <= MK_PROBE; ++p) { a.ph_lo = p; a.ph_hi = p + 1; hipLaunchKernelGGL(fwd_kernel, dim3(grid), dim3(NTHREADS), LDS_BYTES, stream, a); }
    a.ph_lo = 100; a.ph_hi = 101; hipLaunchKernelGGL(fwd_kernel, dim3(grid), dim3(NTHREADS), LDS_BYTES, stream, a);
#else
    for (int p = 0; p < NPHASE; ++p) { a.ph_lo = p; a.ph_hi = p + 1; hipLaunchKernelGGL(fwd_kernel, dim3(grid), dim3(NTHREADS), LDS_BYTES, stream, a); }
#endif
#endif
}
```

```cpp
#include <hip/hip_runtime.h>
#include <cstdio>
#include <cstdint>

#ifndef MK_PROBE
#define MK_PROBE 0
#endif
#ifndef MK_REPEAT
#define MK_REPEAT 0
#endif
#ifndef MK_FP8TEST
#define MK_FP8TEST 0
#endif
#ifndef MK_STAGGER
#define MK_STAGGER 0
#endif
#ifndef MK_TPROBE
#define MK_TPROBE 0
#endif
#ifndef MK_PHT
#define MK_PHT 0
#endif
#ifndef MK_PN8
#define MK_PN8 14
#endif
#ifndef MK_GO8
#define MK_GO8 4
#endif
#ifndef MK_S08
#define MK_S08 4
#endif
#ifndef MK_Q8
#define MK_Q8 1
#endif
#ifndef MK_P2FP8
#define MK_P2FP8 0
#endif
#ifndef MK_BG
#define MK_BG 0
#endif
#ifndef MK_ONE_LAUNCH
#define MK_ONE_LAUNCH 1
#endif

#define LAS __attribute__((address_space(3)))
#define GAS __attribute__((address_space(1)))
typedef unsigned short bf16_t;
typedef short bf16x8 __attribute__((ext_vector_type(8)));
typedef float f32x4 __attribute__((ext_vector_type(4)));
typedef float f32x2 __attribute__((ext_vector_type(2)));
typedef unsigned u32x4 __attribute__((ext_vector_type(4)));
typedef unsigned u32x2 __attribute__((ext_vector_type(2)));
typedef int v8i __attribute__((ext_vector_type(8)));

constexpr int D = 1024, BATCH = 32, SEQ = 2048, NTOK = BATCH * SEQ;
constexpr int HW = 512, NHEAD = 4, DK = 128, CHUNK = 64, NCHUNK = SEQ / CHUNK;
constexpr int INC = 5632, PROJ_LD = 3584, GATE_LD = 2048;
constexpr int NE = 32, TOPK = 4, DFF = 1024, NASSIGN = NTOK * TOPK;
constexpr int MAXTILES = NASSIGN / 256 + NE;
constexpr int MAXROWS = MAXTILES * 256;
constexpr float EPS = 1e-6f, SW_LIMIT = 7.0f, SW_ALPHA = 1.702f;
constexpr int NWAVES = 8, NTHREADS = 512;
constexpr int NPHASE = 11;

constexpr size_t MiB = 1u << 20;
constexpr size_t WS_CTL = 0, CTL_ZERO_BYTES = 65536;
constexpr size_t WS_MOD = 1 * MiB;
constexpr size_t WS_LB = WS_MOD + 32 * 6144 * 4;
constexpr size_t WS_WIN = 2 * MiB;
constexpr size_t WS_WHG = 13 * MiB, WS_WCV = 14 * MiB, WS_WMIX = 15 * MiB;
constexpr size_t WS_W2 = 18 * MiB;
constexpr size_t WS_W1 = 50 * MiB;
constexpr size_t WS_U2Q = 114 * MiB;
constexpr size_t WS_U = 210 * MiB;
constexpr size_t WS_PROJ = 338 * MiB;
constexpr size_t WS_O = 786 * MiB;
constexpr size_t WS_CV = 850 * MiB;
constexpr size_t WS_H = 338 * MiB;
constexpr size_t WS_ACT = 466 * MiB;
constexpr size_t WS_TOPI = 994 * MiB, WS_TOPP = 995 * MiB, WS_POS = 996 * MiB;
constexpr size_t WS_RTOK = 997 * MiB, WS_RSLOT = 997 * MiB + 1081344 + 0, WS_RW = WS_RSLOT + 1081344;
constexpr size_t WS_YA = 50 * MiB, WS_YB = 730 * MiB; constexpr int YSPLIT = 147456;
constexpr size_t WS_YO23_UNUSED = 730 * MiB;
constexpr int PN8 = MK_PN8 - MK_GO8 - (MK_Q8 ? 2 : 0), NQ8 = 22 - PN8;
__host__ __device__ constexpr int map16(int j) { return MK_Q8 ? (j < 2 ? 2 + j : 6 + j) : (j >= MK_S08 ? j + MK_GO8 : j); }
__host__ __device__ constexpr int map8(int j) { return MK_Q8 ? (j < 2 ? j : j < 6 ? j + 2 : j + 8) : (j < MK_GO8 ? MK_S08 + j : MK_PN8 - MK_GO8 + j); }
constexpr size_t WS_WIN8 = 914 * MiB;
constexpr size_t WS_U8 = 920 * MiB;
constexpr size_t WS_END = 1001 * MiB;
static_assert(WS_RW + 1081344 <= WS_END && MAXROWS * 4 == 1081344, "tables");
static_assert(WS_ACT + (size_t)MAXROWS * 1024 <= WS_YB && WS_YB + (size_t)(MAXROWS - YSPLIT) * 2048 <= WS_TOPI && WS_YA + (size_t)YSPLIT * 2048 <= WS_H && YSPLIT % 256 == 0, "expert output map");
constexpr int CW_TMO = 0, CW_BAR = 4096, CW_CNT = 8192, CW_TP = 12288, CW_Q = 12544;

constexpr int LDS_BYTES = 163840;
constexpr int MISC_OFF = LDS_BYTES - 256;
constexpr int TBL_OFF = 135168;
constexpr int SIDE_OFF = TBL_OFF + 8192;

#define LDS_WAIT() asm volatile("s_waitcnt lgkmcnt(0)" ::: "memory")
#define VM_WAIT() asm volatile("s_waitcnt vmcnt(0)" ::: "memory")
typedef __bf16 bf16x2_t __attribute__((ext_vector_type(2)));
__device__ __forceinline__ unsigned cvt_pk_bf16(float lo, float hi) { const f32x2 v = {lo, hi}; const bf16x2_t b = __builtin_convertvector(v, bf16x2_t); return __builtin_bit_cast(unsigned, b); }
__device__ __forceinline__ unsigned pk4_fp8(float a, float b, float c, float d) {
    a = fminf(fmaxf(a, -448.f), 448.f); b = fminf(fmaxf(b, -448.f), 448.f); c = fminf(fmaxf(c, -448.f), 448.f); d = fminf(fmaxf(d, -448.f), 448.f);
    int w = __builtin_amdgcn_cvt_pk_fp8_f32(a, b, 0, false); w = __builtin_amdgcn_cvt_pk_fp8_f32(c, d, w, true); return (unsigned)w; }
__device__ __forceinline__ f32x4 fp8x4_to_f32(unsigned w) {
    const f32x2 lo = __builtin_amdgcn_cvt_pk_f32_fp8((int)w, false), hi = __builtin_amdgcn_cvt_pk_f32_fp8((int)w, true); return (f32x4){lo[0], lo[1], hi[0], hi[1]}; }
__device__ __forceinline__ unsigned pk4_fp8_nc(float a, float b, float c, float d) {
    int w = __builtin_amdgcn_cvt_pk_fp8_f32(a, b, 0, false); w = __builtin_amdgcn_cvt_pk_fp8_f32(c, d, w, true); return (unsigned)w; }
__device__ __forceinline__ float bf_lo(unsigned u) { return __uint_as_float(u << 16); }
__device__ __forceinline__ float bf_hi(unsigned u) { return __uint_as_float(u & 0xffff0000u); }
__device__ __forceinline__ float bf1(bf16_t u) { return __uint_as_float(((unsigned)u) << 16); }
__device__ __forceinline__ float fast_rcp(float x) { return __builtin_amdgcn_rcpf(x); }
__device__ __forceinline__ float fast_exp(float x) { return __builtin_amdgcn_exp2f(x * 1.44269504089f); }
__device__ __forceinline__ float fast_log(float x) { return __builtin_amdgcn_logf(x) * 0.69314718056f; }
__device__ __forceinline__ float sigmoidf_(float x) { return fast_rcp(1.0f + fast_exp(-x)); }
__device__ __forceinline__ float wave_sum(float v) {
#pragma unroll
    for (int o = 1; o < 64; o <<= 1) v += __shfl_xor(v, o);
    return v;
}

#define XB_TMO      128
#define XB_XCNT(j)  (256  + 64 * (j))
#define XB_XSUB(j)  (1280 + 64 * (j))
#define XB_XGEN(j)  (2304 + 64 * (j))
#define XB_TOP      3328
#define XB_TOPGEN   3392
#define XCD_BAR_WORDS 3456
#define XB_SPIN_CAP (1u << 20)
__device__ __forceinline__ unsigned xb_ld(unsigned* p)              { return __hip_atomic_load(p, __ATOMIC_RELAXED, __HIP_MEMORY_SCOPE_AGENT); }
__device__ __forceinline__ unsigned xb_add(unsigned* p, unsigned v) { return __hip_atomic_fetch_add(p, v, __ATOMIC_RELAXED, __HIP_MEMORY_SCOPE_AGENT); }
__device__ __forceinline__ unsigned xb_xcc_id() { return (unsigned)__builtin_amdgcn_s_getreg((3 << 11) | 20) & 0xFu; }
#define XB_SPIN(cond, bar) do { unsigned _sp = 0; while (cond) { __builtin_amdgcn_s_sleep(1); \
    if ((++_sp & 255u) == 0u) { if (xb_ld(&(bar)[XB_TMO])) break; if (_sp > XB_SPIN_CAP) { atomicAdd(&(bar)[XB_TMO], 1u); break; } } } } while (0)
struct XcdBarrier { unsigned* bar; unsigned x; volatile LAS unsigned* st; };
__device__ __forceinline__ XcdBarrier xcd_barrier_post(unsigned* bar, volatile LAS unsigned* st) {
    XcdBarrier b; b.bar = bar; b.x = xb_xcc_id(); b.st = st;
    if (threadIdx.x == 0) (void)xb_add(&bar[XB_XCNT(b.x)], 1u);
    return b;
}
__device__ __forceinline__ void xcd_barrier_complete(unsigned* bar, unsigned x, unsigned& nloc, unsigned& nx) {
    const unsigned G = gridDim.x * gridDim.y * gridDim.z;
    unsigned sum, cnt, mine, sp = 0u;
    for (;;) {
        sum = 0u; cnt = 0u; mine = 0u;
#pragma unroll
        for (unsigned j = 0; j < 16; ++j) { const unsigned c = xb_ld(&bar[XB_XCNT(j)]); sum += c; cnt += (c > 0u) ? 1u : 0u; mine = (j == x) ? c : mine; }
        if (sum == G) break;
        __builtin_amdgcn_s_sleep(1);
        if ((++sp & 255u) == 0u) { if (xb_ld(&bar[XB_TMO])) break; if (sp > XB_SPIN_CAP) { atomicAdd(&bar[XB_TMO], 1u); break; } }
    }
    nloc = mine > 0u ? mine : 1u; nx = cnt > 0u ? cnt : 1u;
}
__device__ __forceinline__ void xcd_barrier(const XcdBarrier& b) {
    asm volatile("s_waitcnt vmcnt(0)" ::: "memory");
    __syncthreads();
    if (threadIdx.x == 0) {
        unsigned* bar = b.bar;
        __builtin_amdgcn_s_waitcnt(0);
        unsigned nloc = b.st[0], nx = b.st[1];
        if (nloc == 0u) { xcd_barrier_complete(bar, b.x, nloc, nx); b.st[0] = nloc; b.st[1] = nx; }
        const unsigned old = xb_add(&bar[XB_XSUB(b.x)], 1u);
        const unsigned gen = old / nloc;
        if (old + 1u == (gen + 1u) * nloc) {
            __builtin_amdgcn_fence(__ATOMIC_RELEASE, "agent");
            asm volatile("s_waitcnt vmcnt(0)" ::: "memory");
            const unsigned og = xb_add(&bar[XB_TOP], 1u);
            const unsigned tg = og / nx;
            if (og + 1u == (tg + 1u) * nx) xb_add(&bar[XB_TOPGEN], 1u);
            else XB_SPIN(xb_ld(&bar[XB_TOPGEN]) == tg, bar);
            __builtin_amdgcn_fence(__ATOMIC_ACQUIRE, "agent");
            xb_add(&bar[XB_XGEN(b.x)], 1u);
            asm volatile("s_waitcnt vmcnt(0)" ::: "memory");
        } else {
            XB_SPIN(xb_ld(&bar[XB_XGEN(b.x)]) == gen, bar);
            __builtin_amdgcn_fence(__ATOMIC_ACQUIRE, "agent");
            asm volatile("s_waitcnt vmcnt(0)" ::: "memory");
        }
    }
    __syncthreads();
}

namespace gm {
constexpr int BM = 256, BK = 64, HALF = 128, HTB = HALF * BK * 2, STAGE_BYTES = 8 * HTB, NXCD = 8, WGM = 8;
__device__ __forceinline__ int lds_byte(int r, int c) { const int st = (r >> 4) * 2 + (c >> 5), rr = r & 15, cc = c & 31, ob = rr * 64 + cc * 2; return st * 1024 + (ob ^ (((ob >> 9) & 1) << 5)); }
__device__ __forceinline__ void stage_rc(int b, int& R, int& C) { const int st = b / 1024, sb = b % 1024, swz = sb ^ (((sb >> 9) & 1) << 5); R = (st >> 1) * 16 + swz / 64; C = (st & 1) * 32 + (swz % 64) / 2; }
__device__ __forceinline__ int perm32(int rho) { const int n = rho >> 4, i = rho & 15; return 8 * (i >> 2) + 4 * n + (i & 3); }

struct Unit { int pm, pn, e, sub; };

__device__ __forceinline__ bool tile_order(int nM, int nN, long L, int& pm, int& pn) {
    const int nwg = nM * nN; if (L >= nwg) return false;
    int wgid = (int)L; { const int q = nwg / NXCD, r = nwg % NXCD, xcd = wgid % NXCD, off = wgid / NXCD; wgid = (xcd < r ? xcd * (q + 1) : r * (q + 1) + (xcd - r) * q) + off; }
    const int nig = WGM * nN, gid = wgid / nig, fm = gid * WGM, gsz = (nM - fm) < WGM ? (nM - fm) : WGM;
    pm = fm + ((wgid % nig) % gsz); pn = (wgid % nig) / gsz; return true;
}
struct DenseOrder {
    int nM, nN, G, c, nsub;
    __device__ __forceinline__ bool next(int i, Unit& u) const { const int ti = i / nsub; u.sub = i - ti * nsub; u.e = 0; return tile_order(nM, nN, (long)ti * G + c, u.pm, u.pn); }
};
struct MoeOrder {
    int nM, nN, G, c; const LAS int* tile_e;
    __device__ __forceinline__ bool next(int i, Unit& u) const { u.sub = 0; if (!tile_order(nM, nN, (long)i * G + c, u.pm, u.pn)) return false; u.e = tile_e[u.pm]; return true; }
};
struct DenseA { int K; unsigned sub_stride; int ES;
    __device__ __forceinline__ void offsets(const Unit& u, int tid, unsigned (&o)[2][2]) const {
#pragma unroll
        for (int i = 0; i < 2; ++i) { int R, C; stage_rc(tid * 16 + i * 8192, R, C);
#pragma unroll
            for (int h = 0; h < 2; ++h) o[h][i] = (unsigned)((u.pm * BM + h * HALF + R) * K * ES + C * 2) + (unsigned)u.sub * sub_stride; } }
    static constexpr bool GATHER = false;
    __device__ __forceinline__ const char* tok_ptr(const Unit&) const { return nullptr; }
    __device__ __forceinline__ void next_offsets(const Unit& u, int tid, unsigned (&o)[2][2], const LAS int*) const { offsets(u, tid, o); } };
struct GatherA { int K; const int* row_tok; int ES;
    __device__ __forceinline__ void offsets(const Unit& u, int tid, unsigned (&o)[2][2]) const {
#pragma unroll
        for (int i = 0; i < 2; ++i) { int R, C; stage_rc(tid * 16 + i * 8192, R, C);
#pragma unroll
            for (int h = 0; h < 2; ++h) { const int tok = row_tok[u.pm * BM + h * HALF + R]; o[h][i] = (unsigned)(tok * K * ES + C * 2); } } }
    static constexpr bool GATHER = true;
    __device__ __forceinline__ const char* tok_ptr(const Unit& u) const { return (const char*)(row_tok + u.pm * BM); }
    __device__ __forceinline__ void next_offsets(const Unit&, int tid, unsigned (&o)[2][2], const LAS int* stok) const {
#pragma unroll
        for (int i = 0; i < 2; ++i) { int R, C; stage_rc(tid * 16 + i * 8192, R, C);
#pragma unroll
            for (int h = 0; h < 2; ++h) { const int tok = stok[h * HALF + R]; o[h][i] = (unsigned)(tok * K * ES + C * 2); } } } };

template <bool FP8, class Epi, class Sched, class AMap>
__device__ __forceinline__ void gemm_phase(int wave_sg, LAS unsigned char* lds, const char* Abase, const char* Bbase, int K, int Nb, unsigned b_sub_stride, const Sched& S, const Epi& E, const AMap& AM) {
    int lane; asm volatile("v_mbcnt_lo_u32_b32 %0, -1, 0\n\tv_mbcnt_hi_u32_b32 %0, -1, %0" : "=v"(lane));
    const int wid = wave_sg, tid = wid * 64 + lane, wr = wid >> 2, wc = wid & 3, fr = lane & 15, fq = lane >> 4;
    constexpr int ES = FP8 ? 1 : 2;
    const int nt = K * ES / (BK * 2);
    unsigned voffB[2];
#pragma unroll
    for (int i = 0; i < 2; ++i) { int R, C; stage_rc(tid * 16 + i * 8192, R, C); const int Rb = (R & ~31) + perm32(R & 31); voffB[i] = (unsigned)(Rb * K * ES + C * 2); }
    const size_t kstep = (size_t)(BK * 2);
    const size_t hstep = (size_t)HALF * K * ES;
    const unsigned ldsw = (unsigned)wid * 1024u;
    const int aoff = lds_byte(wr * 64 + fr, fq * 8), boff = lds_byte(wc * 32 + fr, fq * 8);
#define G_SA(b, h) (((b) * 2 + (h)) * HTB)
#define G_SB(b, h) ((4 + (b) * 2 + (h)) * HTB)
#define G_STAGE(bufoff, gbase, voff) do { _Pragma("unroll") for (int _i = 0; _i < 2; ++_i) \
        __builtin_amdgcn_global_load_lds((const unsigned*)((const char*)(gbase) + (voff)[_i]), (LAS unsigned*)(lds + (bufoff) + ldsw + _i * 8192), 16, 0, 0); } while (0)
#define G_LDA(dst, b, h) do { _Pragma("unroll") for (int m = 0; m < 4; ++m) _Pragma("unroll") for (int k = 0; k < 2; ++k) dst[m][k] = *(const LAS bf16x8*)(lds + G_SA(b, h) + aoff + m * 2048 + k * 1024); } while (0)
#define G_LDB(dst, b, h) do { _Pragma("unroll") for (int n = 0; n < 2; ++n) _Pragma("unroll") for (int k = 0; k < 2; ++k) dst[n][k] = *(const LAS bf16x8*)(lds + G_SB(b, h) + boff + n * 2048 + k * 1024); } while (0)
#define G_MMA(ai, bj, At, Bt) do { __builtin_amdgcn_s_setprio(1); _Pragma("unroll") for (int m = 0; m < 4; ++m) _Pragma("unroll") for (int n = 0; n < 2; ++n) _Pragma("unroll") for (int k = 0; k < 2; ++k) \
        acc[ai][bj][m][n] = __builtin_amdgcn_mfma_f32_16x16x32_bf16(Bt[n][k], At[m][k], acc[ai][bj][m][n], 0, 0, 0); __builtin_amdgcn_s_setprio(0); } while (0)
#define G_LD8(dst, off) do { const u32x4 _l = *(const LAS u32x4*)(lds + (off)), _h = *(const LAS u32x4*)(lds + (off) + 1024); dst = (v8i){(int)_l.x, (int)_l.y, (int)_l.z, (int)_l.w, (int)_h.x, (int)_h.y, (int)_h.z, (int)_h.w}; } while (0)
#define G_LDA8(dst, b, h) do { _Pragma("unroll") for (int m = 0; m < 4; ++m) G_LD8(dst[m], G_SA(b, h) + aoff + m * 2048); } while (0)
#define G_LDB8(dst, b, h) do { _Pragma("unroll") for (int n = 0; n < 2; ++n) G_LD8(dst[n], G_SB(b, h) + boff + n * 2048); } while (0)
#define G_MMA8(ai, bj, At, Bt) do { __builtin_amdgcn_s_setprio(1); _Pragma("unroll") for (int m = 0; m < 4; ++m) _Pragma("unroll") for (int n = 0; n < 2; ++n) \
        acc[ai][bj][m][n] = __builtin_amdgcn_mfma_scale_f32_16x16x128_f8f6f4(Bt[n], At[m], acc[ai][bj][m][n], 0, 0, 0, 0x7F7F7F7F, 0, 0x7F7F7F7F); __builtin_amdgcn_s_setprio(0); } while (0)
#define G_PIN(ai, bj) asm volatile("" :: "v"(acc[ai][bj][0][0][0]), "v"(acc[ai][bj][0][1][0]), "v"(acc[ai][bj][1][0][0]), "v"(acc[ai][bj][1][1][0]), "v"(acc[ai][bj][2][0][0]), "v"(acc[ai][bj][2][1][0]), "v"(acc[ai][bj][3][0][0]), "v"(acc[ai][bj][3][1][0]) : "memory")
#define G_WAIT_V(n) asm volatile("s_waitcnt vmcnt(" #n ")" ::: "memory")
#define G_WAIT_L(n) asm volatile("s_waitcnt lgkmcnt(" #n ")" ::: "memory")
#define G_WAIT_VS() do { if (fi) { if (Epi::NST == 16) G_WAIT_V(24); else if (Epi::NST == 8) G_WAIT_V(16); else G_WAIT_V(8); } else G_WAIT_V(8); } while (0)
#define G_BAR __builtin_amdgcn_s_barrier()
#define G_SCHED __builtin_amdgcn_sched_barrier(0)
    Unit cur, nxt; int ui = 0;
#if MK_TPROBE
    unsigned long long tp_c = 0; const unsigned long long tp_c0 = __builtin_amdgcn_s_memtime(), tp_r0 = __builtin_amdgcn_s_memrealtime();
#endif
    if (!S.next(0, cur)) return;
#if MK_STAGGER
    {
        const unsigned long long t0 = __builtin_amdgcn_s_memrealtime(); const unsigned long long dly = (unsigned long long)(blockIdx.x & 7) * MK_STAGGER;
        while (__builtin_amdgcn_s_memrealtime() - t0 < dly) __builtin_amdgcn_s_sleep(8);
    }
#endif
    unsigned rA[2][2];
    AM.offsets(cur, tid, rA);
    const char* cB = Bbase + ((size_t)cur.e * Nb + (size_t)cur.pn * BM) * K * ES + (size_t)cur.sub * b_sub_stride;
    G_STAGE(G_SB(0, 0), cB, voffB); G_STAGE(G_SB(0, 1), cB + hstep, voffB); G_STAGE(G_SA(0, 0), Abase, rA[0]); G_STAGE(G_SA(0, 1), Abase, rA[1]);
    if (wr == 1) G_BAR;
    G_WAIT_V(2); G_BAR;
    G_STAGE(G_SB(1, 0), cB + kstep, voffB); G_STAGE(G_SA(1, 0), Abase + kstep, rA[0]); G_STAGE(G_SB(1, 1), cB + hstep + kstep, voffB);
    G_WAIT_V(6); G_BAR;
    f32x4 acc[2][2][4][2];
#pragma unroll
    for (int a = 0; a < 2; ++a)
#pragma unroll
        for (int b = 0; b < 2; ++b)
#pragma unroll
            for (int m = 0; m < 4; ++m)
#pragma unroll
                for (int n = 0; n < 2; ++n) acc[a][b][m][n] = (f32x4){0.f, 0.f, 0.f, 0.f};
    for (;;) {
        const bool has_next = S.next(ui + 1, nxt);
        const char* nB = has_next ? Bbase + ((size_t)nxt.e * Nb + (size_t)nxt.pn * BM) * K * ES + (size_t)nxt.sub * b_sub_stride : cB;
#if MK_TPROBE
        unsigned long long tp_a = 0; if (Epi::TPROBE && wid == 0) { tp_a = __builtin_amdgcn_s_memrealtime(); if (ui > 0 && lane == 0) { volatile LAS unsigned* M = (volatile LAS unsigned*)(lds + MISC_OFF); M[19] += (unsigned)(tp_a - tp_c); } }
#endif
        if (wid == 0) {
            int l16 = lane * 16; asm volatile("" : "+v"(l16));
#pragma unroll
            for (int k = 0; k < Epi::NSB; ++k) { const char* sp = E.sb_ptr(cur, k); if (l16 < 16 * E.sb_lanes(k)) __builtin_amdgcn_global_load_lds((const unsigned*)(sp + l16), (LAS unsigned*)(lds + SIDE_OFF + (ui & 1) * 4096 + 1024 * (k + 1)), 16, 0, 0); }
            if (AMap::GATHER && has_next) __builtin_amdgcn_global_load_lds((const unsigned*)(AM.tok_ptr(nxt) + l16), (LAS unsigned*)(lds + SIDE_OFF + ((ui + 1) & 1) * 4096), 16, 0, 0);
        }
#pragma nounroll
        for (int t = 0; t < nt; t += 2) {
            if constexpr (Epi::HAS_MID) { if (t == nt / 2) { int lz = lane; asm volatile("" : "+v"(lz)); E.mid(acc, cur, wr, wc, lz & 15, lz >> 4); } }
            bf16x8 At[4][2], B0[2][2], B1[2][2];
            v8i At8[4], B08[2], B18[2];
            const bool last = (t == nt - 2);
            constexpr bool fi = false;
            const char* b2 = last ? nB : cB + (size_t)(t + 2) * kstep; const char* b3 = b2 + kstep;
            if constexpr (FP8) { G_LDB8(B08, 0, 0); G_LDB8(B18, 0, 1); G_SCHED; G_LDA8(At8, 0, 0); } else { G_LDB(B0, 0, 0); G_LDB(B1, 0, 1); G_SCHED; G_LDA(At, 0, 0); }
            G_STAGE(G_SA(1, 1), Abase + (size_t)(t + 1) * kstep, rA[1]);
            G_WAIT_VS(); G_WAIT_L(0); G_BAR;
            if constexpr (FP8) { G_MMA8(0, 0, At8, B08); G_MMA8(0, 1, At8, B18); } else { G_MMA(0, 0, At, B0); G_MMA(0, 1, At, B1); }
            if constexpr (FP8) { G_PIN(0, 0); G_PIN(0, 1); }
            G_BAR; G_SCHED;
            if (last && has_next) { int tz = tid; asm volatile("" : "+v"(tz)); AM.next_offsets(nxt, tz, rA, (const LAS int*)(lds + SIDE_OFF + ((ui + 1) & 1) * 4096)); }
            const char* a2 = Abase + (last ? (size_t)0 : (size_t)(t + 2) * kstep);
            if constexpr (FP8) { G_LDA8(At8, 0, 1); } else { G_LDA(At, 0, 1); }
            G_STAGE(G_SB(0, 0), b2, voffB); G_STAGE(G_SB(0, 1), b2 + hstep, voffB); G_STAGE(G_SA(0, 0), a2, rA[0]);
            G_WAIT_VS(); G_WAIT_L(0); G_BAR;
            if constexpr (FP8) { G_MMA8(1, 0, At8, B08); G_MMA8(1, 1, At8, B18); } else { G_MMA(1, 0, At, B0); G_MMA(1, 1, At, B1); }
            if constexpr (FP8) { G_PIN(1, 0); G_PIN(1, 1); }
            G_BAR; G_SCHED;
            if constexpr (FP8) { G_LDB8(B08, 1, 0); G_LDB8(B18, 1, 1); G_SCHED; G_LDA8(At8, 1, 0); } else { G_LDB(B0, 1, 0); G_LDB(B1, 1, 1); G_SCHED; G_LDA(At, 1, 0); }
            G_STAGE(G_SA(0, 1), a2, rA[1]);
            G_WAIT_VS(); G_WAIT_L(0); G_BAR;
            if constexpr (FP8) { G_MMA8(0, 0, At8, B08); G_MMA8(0, 1, At8, B18); } else { G_MMA(0, 0, At, B0); G_MMA(0, 1, At, B1); }
            if constexpr (FP8) { G_PIN(0, 0); G_PIN(0, 1); }
            G_BAR; G_SCHED;
            if constexpr (FP8) { G_LDA8(At8, 1, 1); } else { G_LDA(At, 1, 1); }
            G_STAGE(G_SB(1, 0), b3, voffB); G_STAGE(G_SB(1, 1), b3 + hstep, voffB); G_STAGE(G_SA(1, 0), a2 + kstep, rA[0]);
            G_WAIT_VS(); G_WAIT_L(0); G_BAR;
            if constexpr (FP8) { G_MMA8(1, 0, At8, B08); G_MMA8(1, 1, At8, B18); } else { G_MMA(1, 0, At, B0); G_MMA(1, 1, At, B1); }
            if constexpr (FP8) { G_PIN(1, 0); G_PIN(1, 1); }
            G_BAR; G_SCHED;
        }
#if MK_TPROBE
        unsigned long long tp_b = 0; if (Epi::TPROBE && wid == 0) tp_b = __builtin_amdgcn_s_memrealtime();
#endif
        if (wr == 0) G_BAR;
        { int lz = lane; asm volatile("" : "+v"(lz));
          E(acc, cur, wr, wc, lz & 15, lz >> 4, (const LAS unsigned char*)(lds + SIDE_OFF + (ui & 1) * 4096 + 1024)); }
#if MK_TPROBE
        if (Epi::TPROBE && wid == 0) { tp_c = __builtin_amdgcn_s_memrealtime(); if (lane == 0) { volatile LAS unsigned* M = (volatile LAS unsigned*)(lds + MISC_OFF); M[16] += (unsigned)(tp_b - tp_a); M[17] += (unsigned)(tp_c - tp_b); M[18] += 1u; } }
#endif
        if (!has_next) break;
        if (!E.keep(cur)) {
#pragma unroll
            for (int a = 0; a < 2; ++a)
#pragma unroll
                for (int b = 0; b < 2; ++b)
#pragma unroll
                    for (int m = 0; m < 4; ++m)
#pragma unroll
                        for (int n = 0; n < 2; ++n) acc[a][b][m][n] = (f32x4){0.f, 0.f, 0.f, 0.f};
        }
        cur = nxt; cB = nB; ++ui;
        if (wr == 1) G_BAR;
    }
    G_WAIT_V(0);
    G_BAR;
#if MK_TPROBE
    if constexpr (Epi::TPROBE) if (wid == 0) { volatile LAS unsigned* M = (volatile LAS unsigned*)(lds + MISC_OFF);
        const unsigned long long t0 = __builtin_amdgcn_s_memrealtime();
        const unsigned long long d = MK_TPROBE == 4 ? 10000ull * (__builtin_amdgcn_s_memtime() - tp_c0) / (t0 - tp_r0)
                                   : 4ull * (unsigned long long)(MK_TPROBE == 1 ? M[16] : MK_TPROBE == 2 ? M[17] : M[19]);
        while (__builtin_amdgcn_s_memrealtime() - t0 < d) __builtin_amdgcn_s_sleep(8); }
#endif
#undef G_SA
#undef G_SB
#undef G_STAGE
#undef G_LDA
#undef G_LDB
#undef G_MMA
#undef G_LD8
#undef G_LDA8
#undef G_LDB8
#undef G_MMA8
#undef G_WAIT_V
#undef G_PIN
#undef G_WAIT_VS
#undef G_WAIT_L
#undef G_BAR
#undef G_SCHED
}

__device__ __forceinline__ u32x4 pack8(const f32x4& v0, const f32x4& v1) { u32x4 w; w.x = cvt_pk_bf16(v0[0], v0[1]); w.y = cvt_pk_bf16(v0[2], v0[3]); w.z = cvt_pk_bf16(v1[0], v1[1]); w.w = cvt_pk_bf16(v1[2], v1[3]); return w; }
__device__ __forceinline__ void unpack8(const u32x4& w, f32x4& v0, f32x4& v1) { v0 = (f32x4){bf_lo(w.x), bf_hi(w.x), bf_lo(w.y), bf_hi(w.y)}; v1 = (f32x4){bf_lo(w.z), bf_hi(w.z), bf_lo(w.w), bf_hi(w.w)}; }

template <bool F8>
struct EpiProjT {
    static constexpr bool HAS_MID = false;
    static constexpr float PSC = F8 ? (1.0f / 32.0f) : 1.0f;
    bf16_t* proj; bf16_t* gates; const float* lb;
    static constexpr int NSB = 0, NST = 16; static constexpr bool TPROBE = false;
    __device__ __forceinline__ const char* sb_ptr(const Unit&, int) const { return nullptr; }
    __device__ __forceinline__ int sb_lanes(int) const { return 0; }
    __device__ __forceinline__ bool keep(const Unit&) const { return false; }
    __device__ __forceinline__ void operator()(f32x4 (&acc)[2][2][4][2], const Unit& u, int wr, int wc, int fr, int fq, const LAS unsigned char* side) const {
        const int row0 = u.pm * BM + wr * 64 + fr, pn = F8 ? map8(u.pn) : map16(u.pn);
        if (pn >= 10) {
            const bool isg = pn >= 14; const int q = isg ? pn - 14 : pn - 10; const int c0 = q * HALF + wc * 32 + 8 * fq;
#pragma unroll
            for (int ai = 0; ai < 2; ++ai)
#pragma unroll
                for (int m = 0; m < 4; ++m) { const size_t r = (size_t)(row0 + ai * HALF + m * 16);
                    f32x4 a0 = acc[ai][0][m][0] * PSC, a1 = acc[ai][0][m][1] * PSC, b0 = acc[ai][1][m][0] * PSC, b1 = acc[ai][1][m][1] * PSC;
                    if (isg) {
#pragma unroll
                        for (int j = 0; j < 4; ++j) { b0[j] = sigmoidf_(b0[j]); b1[j] = sigmoidf_(b1[j]); a0[j] = sigmoidf_(a0[j]) * fast_rcp(fmaxf(b0[j], 1e-30f)); a1[j] = sigmoidf_(a1[j]) * fast_rcp(fmaxf(b1[j], 1e-30f)); }
                        *(u32x4*)(gates + r * GATE_LD + c0) = pack8(a0, a1); *(u32x4*)(gates + r * GATE_LD + 1024 + c0) = pack8(b0, b1);
                    } else {
                        *(u32x4*)(proj + r * PROJ_LD + 2560 + c0) = pack8(a0 * b0, a1 * b1);
                    } }
            return;
        }
        bf16_t* base = proj; const int ldc = PROJ_LD, colt = pn * BM, kind = (pn == 2 || pn == 3) ? 1 : 0;
        const int col0 = colt + wc * 32 + 8 * fq;
        f32x4 lbv[2][2];
        if (kind == 1) {
#pragma unroll
            for (int bj = 0; bj < 2; ++bj) { const float* lp = lb + (pn - 2) * BM + bj * HALF + wc * 32 + 8 * fq; lbv[bj][0] = *(const f32x4*)lp; lbv[bj][1] = *(const f32x4*)(lp + 4); }
        }
#pragma unroll
        for (int ai = 0; ai < 2; ++ai)
#pragma unroll
            for (int m = 0; m < 4; ++m) { bf16_t* rowp = base + (size_t)(row0 + ai * HALF + m * 16) * ldc + col0;
#pragma unroll
                for (int bj = 0; bj < 2; ++bj) { f32x4 v0 = acc[ai][bj][m][0] * PSC, v1 = acc[ai][bj][m][1] * PSC;
                    if (kind == 1) {
#pragma unroll
                        for (int j = 0; j < 4; ++j) { const float l0 = lbv[bj][0][j], l1 = lbv[bj][1][j];
                            v0[j] = fast_log(l0 + (1.0f - l0) * sigmoidf_(v0[j])); v1[j] = fast_log(l1 + (1.0f - l1) * sigmoidf_(v1[j])); }
                    }
                    *(u32x4*)(rowp + bj * HALF) = pack8(v0, v1); } }
    }
};
struct EpiMerge {
    static constexpr bool HAS_MID = true;
    const bf16_t* gates; bf16_t* out;
    static constexpr int NSB = 0, NST = 0; static constexpr bool TPROBE = false;
    __device__ __forceinline__ const char* sb_ptr(const Unit&, int) const { return nullptr; }
    __device__ __forceinline__ int sb_lanes(int) const { return 0; }
    __device__ __forceinline__ bool keep(const Unit&) const { return false; }
    __device__ __forceinline__ void mid(f32x4 (&acc)[2][2][4][2], const Unit& u, int wr, int wc, int fr, int fq) const {
        const int row0 = u.pm * BM + wr * 64 + fr, col0 = u.pn * BM + wc * 32 + 8 * fq;
#pragma unroll
        for (int ai = 0; ai < 2; ++ai) {
            u32x4 ga[4][2];
#pragma unroll
            for (int m = 0; m < 4; ++m) { const bf16_t* gp = gates + (size_t)(row0 + ai * HALF + m * 16) * GATE_LD + col0;
#pragma unroll
                for (int bj = 0; bj < 2; ++bj) ga[m][bj] = *(const u32x4*)(gp + bj * HALF); }
#pragma unroll
            for (int m = 0; m < 4; ++m)
#pragma unroll
                for (int bj = 0; bj < 2; ++bj) { f32x4 a0, a1; unpack8(ga[m][bj], a0, a1); acc[ai][bj][m][0] *= a0; acc[ai][bj][m][1] *= a1; }
            asm volatile("" ::: "memory"); }
    }
    __device__ __forceinline__ void operator()(f32x4 (&acc)[2][2][4][2], const Unit& u, int wr, int wc, int fr, int fq, const LAS unsigned char* side) const {
        const int row0 = u.pm * BM + wr * 64 + fr, col0 = u.pn * BM + wc * 32 + 8 * fq;
#pragma unroll
        for (int ai = 0; ai < 2; ++ai) {
            u32x4 gb[4][2];
#pragma unroll
            for (int m = 0; m < 4; ++m) { const bf16_t* gp = gates + (size_t)(row0 + ai * HALF + m * 16) * GATE_LD + col0;
#pragma unroll
                for (int bj = 0; bj < 2; ++bj) gb[m][bj] = *(const u32x4*)(gp + 1024 + bj * HALF); }
#pragma unroll
            for (int m = 0; m < 4; ++m) { const size_t r = (size_t)(row0 + ai * HALF + m * 16);
#pragma unroll
                for (int bj = 0; bj < 2; ++bj) { f32x4 b0, b1; unpack8(gb[m][bj], b0, b1); *(u32x4*)(out + r * D + col0 + bj * HALF) = pack8(acc[ai][bj][m][0] * b0, acc[ai][bj][m][1] * b1); } }
            asm volatile("" ::: "memory"); }
    }
};
struct EpiMix {
    static constexpr bool HAS_MID = false;
    const float* x; const float* mod; bf16_t* h;
    static constexpr int NSB = 0, NST = 0; static constexpr bool TPROBE = false;
    __device__ __forceinline__ const char* sb_ptr(const Unit&, int) const { return nullptr; }
    __device__ __forceinline__ int sb_lanes(int) const { return 0; }
    __device__ __forceinline__ bool keep(const Unit&) const { return false; }
    __device__ __forceinline__ void operator()(f32x4 (&acc)[2][2][4][2], const Unit& u, int wr, int wc, int fr, int fq, const LAS unsigned char* side) const {
        const int row0 = u.pm * BM + wr * 64 + fr, col0 = u.pn * BM + wc * 32 + 8 * fq, b = u.pm >> 3;
        f32x4 g[2][2];
#pragma unroll
        for (int bj = 0; bj < 2; ++bj) { const float* gp = mod + (size_t)b * 6144 + 2048 + col0 + bj * HALF; g[bj][0] = *(const f32x4*)gp; g[bj][1] = *(const f32x4*)(gp + 4); }
#pragma unroll
        for (int ai = 0; ai < 2; ++ai) {
            f32x4 xv[4][2][2];
#pragma unroll
            for (int m = 0; m < 4; ++m)
#pragma unroll
                for (int bj = 0; bj < 2; ++bj) { const float* xp = x + (size_t)(row0 + ai * HALF + m * 16) * D + col0 + bj * HALF; xv[m][bj][0] = *(const f32x4*)xp; xv[m][bj][1] = *(const f32x4*)(xp + 4); }
#pragma unroll
            for (int m = 0; m < 4; ++m) { const size_t r = (size_t)(row0 + ai * HALF + m * 16);
#pragma unroll
                for (int bj = 0; bj < 2; ++bj) *(u32x4*)(h + r * D + col0 + bj * HALF) = pack8(xv[m][bj][0] + g[bj][0] * acc[ai][bj][m][0], xv[m][bj][1] + g[bj][1] * acc[ai][bj][m][1]); }
            asm volatile("" ::: "memory"); }
    }
};
struct EpiSwiglu {
    static constexpr bool HAS_MID = false;
    static constexpr float WSC = 1.0f / 32.0f;
    const float* b1; unsigned char* act; unsigned* tpw;
    __device__ __forceinline__ unsigned* tp_words() const { return tpw; }
    static constexpr bool TPROBE = false;
    static constexpr int NSB = 2, NST = 8;
    __device__ __forceinline__ const char* sb_ptr(const Unit& u, int k) const { return (const char*)(b1 + (size_t)u.e * 2048 + k * 1024 + u.pn * HALF); }
    __device__ __forceinline__ int sb_lanes(int) const { return 32; }
    __device__ __forceinline__ bool keep(const Unit&) const { return false; }
    __device__ __forceinline__ void operator()(f32x4 (&acc)[2][2][4][2], const Unit& u, int wr, int wc, int fr, int fq, const LAS unsigned char* side) const {
        const int row0 = u.pm * BM + wr * 64 + fr, hc0 = u.pn * HALF + wc * 32 + 8 * fq;
        const LAS float* bp = (const LAS float*)side + wc * 32 + 8 * fq;
        const f32x4 bg[2] = {*(const LAS f32x4*)bp, *(const LAS f32x4*)(bp + 4)}; const f32x4 bl1[2] = {*(const LAS f32x4*)(bp + 256) + 1.0f, *(const LAS f32x4*)(bp + 260) + 1.0f};
#pragma unroll
        for (int ai = 0; ai < 2; ++ai)
#pragma unroll
            for (int m = 0; m < 4; ++m) { const size_t r = (size_t)(row0 + ai * HALF + m * 16);
                f32x4 o[2];
#pragma unroll
                for (int n = 0; n < 2; ++n) {
                    f32x4 g = acc[ai][0][m][n] * WSC + bg[n], l = acc[ai][1][m][n] * WSC + bl1[n];
#pragma unroll
                    for (int j = 0; j < 4; ++j) { g[j] = fminf(g[j], SW_LIMIT); l[j] = fminf(fmaxf(l[j], 1.0f - SW_LIMIT), 1.0f + SW_LIMIT); }
                    const f32x4 t = g * (-SW_ALPHA * 1.44269504089f); f32x4 e;
#pragma unroll
                    for (int j = 0; j < 4; ++j) e[j] = __builtin_amdgcn_exp2f(t[j]);
                    const f32x4 d = e + 1.0f; f32x4 rc;
#pragma unroll
                    for (int j = 0; j < 4; ++j) rc[j] = fast_rcp(d[j]);
                    o[n] = (g * rc) * l; }
                *(u32x2*)(act + r * DFF + hc0) = (u32x2){pk4_fp8_nc(o[0][0], o[0][1], o[0][2], o[0][3]), pk4_fp8_nc(o[1][0], o[1][1], o[1][2], o[1][3])}; }
    }
};
struct EpiMoeOut {
    static constexpr bool HAS_MID = false;
    const float* b2; const float* rw; unsigned char* ya;
    static constexpr bool TPROBE = false;
    static constexpr int NSB = 2, NST = 16;
    __device__ __forceinline__ const char* sb_ptr(const Unit& u, int k) const { return k == 0 ? (const char*)(b2 + (size_t)u.e * D + u.pn * BM) : (const char*)(rw + u.pm * BM); }
    __device__ __forceinline__ int sb_lanes(int) const { return 64; }
    __device__ __forceinline__ bool keep(const Unit&) const { return false; }
    __device__ __forceinline__ void operator()(f32x4 (&acc)[2][2][4][2], const Unit& u, int wr, int wc, int fr, int fq, const LAS unsigned char* side) const {
        const int lrow0 = wr * 64 + fr, col0 = u.pn * BM + wc * 32 + 8 * fq, row_t = u.pm * BM;
        unsigned char* tbase = ya + (size_t)row_t * D + col0;
        const LAS float* sb = (const LAS float*)side; const LAS float* srw = (const LAS float*)(side + 1024);
        f32x4 bv[2][2];
#pragma unroll
        for (int bj = 0; bj < 2; ++bj) { const LAS float* bp = sb + bj * HALF + wc * 32 + 8 * fq; bv[bj][0] = *(const LAS f32x4*)bp; bv[bj][1] = *(const LAS f32x4*)(bp + 4); }
#pragma unroll
        for (int ai = 0; ai < 2; ++ai)
#pragma unroll
            for (int m = 0; m < 4; ++m) { const int lr = lrow0 + ai * HALF + m * 16; const float w = srw[lr]; unsigned char* dst = tbase + (size_t)lr * D;
#pragma unroll
                for (int bj = 0; bj < 2; ++bj) { const f32x4 o0 = (acc[ai][bj][m][0] * (1.0f / 32.0f) + bv[bj][0]) * w, o1 = (acc[ai][bj][m][1] * (1.0f / 32.0f) + bv[bj][1]) * w;
                    *(u32x2*)(dst + bj * HALF) = (u32x2){pk4_fp8(o0[0], o0[1], o0[2], o0[3]), pk4_fp8(o1[0], o1[1], o1[2], o1[3])}; } }
    }
};
}

struct Args { const float* in[20]; float* out; unsigned char* ws; int ph_lo, ph_hi; };

__device__ __forceinline__ void transpose_item(const float* W, int N, bf16_t* WT, int ldwt, int k0, int n0, int dst_row0, LAS float* scr, int lane) {
    const int ks = lane >> 4, n4 = (lane & 15) * 4;
    f32x4 v[16];
#pragma unroll
    for (int i = 0; i < 16; ++i) v[i] = *(const f32x4*)(W + (size_t)(k0 + 4 * i + ks) * N + n0 + n4);
#pragma unroll
    for (int i = 0; i < 16; ++i) { LAS float* s = scr + (4 * i + ks) * 65 + n4; s[0] = v[i][0]; s[1] = v[i][1]; s[2] = v[i][2]; s[3] = v[i][3]; }
    LDS_WAIT(); asm volatile("" ::: "memory");
    const int kc = lane & 7;
#pragma unroll
    for (int p = 0; p < 8; ++p) { const int n = (lane >> 3) + 8 * p; const LAS float* s = scr + (8 * kc) * 65 + n;
        u32x4 o; o.x = cvt_pk_bf16(s[0], s[65]); o.y = cvt_pk_bf16(s[2 * 65], s[3 * 65]); o.z = cvt_pk_bf16(s[4 * 65], s[5 * 65]); o.w = cvt_pk_bf16(s[6 * 65], s[7 * 65]);
        *(u32x4*)(WT + (size_t)(dst_row0 + n) * ldwt + k0 + 8 * kc) = o; }
    LDS_WAIT(); asm volatile("" ::: "memory");
}

template <bool NT = false>
__device__ __forceinline__ void transpose_item_fp8(const float* W, int N, unsigned char* WT, int ldwt, int k0, int n0, int dst_row0, LAS float* scr, int lane) {
    const int ks = lane >> 3, n4 = (lane & 7) * 4;
    f32x4 v[16];
#pragma unroll
    for (int i = 0; i < 16; ++i) { const f32x4* p = (const f32x4*)(W + (size_t)(k0 + 8 * i + ks) * N + n0 + n4); v[i] = NT ? __builtin_nontemporal_load(p) : *p; }
#pragma unroll
    for (int i = 0; i < 16; ++i) { LAS float* s = scr + (8 * i + ks) * 33 + n4; s[0] = v[i][0]; s[1] = v[i][1]; s[2] = v[i][2]; s[3] = v[i][3]; }
    LDS_WAIT(); asm volatile("" ::: "memory");
    const int kc = lane & 7;
#pragma unroll
    for (int p = 0; p < 4; ++p) { const int n = (lane >> 3) + 8 * p; const LAS float* s = scr + (16 * kc) * 33 + n;
        u32x4 o;
        o.x = pk4_fp8(32.f * s[0], 32.f * s[33], 32.f * s[2 * 33], 32.f * s[3 * 33]); o.y = pk4_fp8(32.f * s[4 * 33], 32.f * s[5 * 33], 32.f * s[6 * 33], 32.f * s[7 * 33]);
        o.z = pk4_fp8(32.f * s[8 * 33], 32.f * s[9 * 33], 32.f * s[10 * 33], 32.f * s[11 * 33]); o.w = pk4_fp8(32.f * s[12 * 33], 32.f * s[13 * 33], 32.f * s[14 * 33], 32.f * s[15 * 33]);
        u32x4* q = (u32x4*)(WT + (size_t)(dst_row0 + n) * ldwt + k0 + 16 * kc); if (NT) __builtin_nontemporal_store(o, q); else *q = o; }
    LDS_WAIT(); asm volatile("" ::: "memory");
}

constexpr int BG_W1 = 32 * 8 * 64, BG_W2 = 32 * 8 * 32, BG_N = BG_W1 + BG_W2;
struct BgCtx { const float* w1; const float* w2; unsigned char* W1q; unsigned char* W2q; unsigned* qhead; };
__device__ __forceinline__ bool bg_item(const BgCtx& c, LAS float* scr, int lane) {
    unsigned it = 0; if (lane == 0) it = __hip_atomic_fetch_add(c.qhead, 1u, __ATOMIC_RELAXED, __HIP_MEMORY_SCOPE_AGENT);
    it = (unsigned)__builtin_amdgcn_readfirstlane((int)it);
    if (it >= (unsigned)BG_N) return false;
    if (it < (unsigned)BG_W1) { const int r = (int)it, e = r / 512, q = r % 512, kb = q / 64, nb = q % 64;
        const int pn = nb >> 3, wi = (nb & 7) * 32; const int src = wi < 128 ? pn * 128 + wi : 1024 + pn * 128 + (wi - 128);
        transpose_item_fp8<true>(c.w1 + (size_t)e * D * 2048, 2048, c.W1q + (size_t)e * 2048 * D, D, kb * 128, src, nb * 32, scr, lane); }
    else { const int r = (int)it - BG_W1, e = r / 256, q = r % 256, kb = q / 32, nb = q % 32;
        transpose_item_fp8<true>(c.w2 + (size_t)e * DFF * D, D, c.W2q + (size_t)e * D * DFF, DFF, kb * 128, nb * 32, nb * 32, scr, lane); }
    return true;
}
__device__ __forceinline__ void xcd_barrier_bg(const XcdBarrier& b, const BgCtx& c, LAS unsigned char* lds, int wave, int lane, bool drain) {
    volatile LAS unsigned* M = (volatile LAS unsigned*)(lds + MISC_OFF);
    LAS float* scr = (LAS float*)(lds + wave * 16896);
    if (drain) { while (bg_item(c, scr, lane)) { } }
    asm volatile("s_waitcnt vmcnt(0)" ::: "memory");
    __syncthreads();
    if (threadIdx.x == 0) {
        unsigned* bar = b.bar;
        __builtin_amdgcn_s_waitcnt(0);
        unsigned nloc = b.st[0], nx = b.st[1];
        if (nloc == 0u) { xcd_barrier_complete(bar, b.x, nloc, nx); b.st[0] = nloc; b.st[1] = nx; }
        const unsigned old = xb_add(&bar[XB_XSUB(b.x)], 1u);
        const unsigned gen = old / nloc;
        if (old + 1u == (gen + 1u) * nloc) {
            __builtin_amdgcn_fence(__ATOMIC_RELEASE, "agent");
            asm volatile("s_waitcnt vmcnt(0)" ::: "memory");
            const unsigned og = xb_add(&bar[XB_TOP], 1u);
            const unsigned tg = og / nx;
            if (og + 1u == (tg + 1u) * nx) { xb_add(&bar[XB_TOPGEN], 1u); M[10] = 2u; } else M[10] = 1u;
            M[11] = tg;
        } else { M[10] = 0u; M[11] = gen; }
    }
    unsigned spins = 0;
    for (;;) {
        if (threadIdx.x == 0) { const unsigned role = M[10], g = M[11]; unsigned* bar = b.bar;
            bool rel = role == 2u ? true : role == 1u ? (xb_ld(&bar[XB_TOPGEN]) != g) : (xb_ld(&bar[XB_XGEN(b.x)]) != g);
            if (!rel && (++spins & 255u) == 0u) { if (xb_ld(&bar[XB_TMO])) rel = true; else if (spins > XB_SPIN_CAP) { atomicAdd(&bar[XB_TMO], 1u); rel = true; } }
            M[12] = rel ? 1u : 0u; }
        asm volatile("s_waitcnt lgkmcnt(0)" ::: "memory"); __syncthreads();
        const bool rel = M[12] != 0u;
        asm volatile("s_waitcnt lgkmcnt(0)" ::: "memory"); __syncthreads();
        if (rel) break;
        if (M[13] != 0u || !bg_item(c, scr, lane)) { M[13] = 1u; __builtin_amdgcn_s_sleep(16); }
    }
    if (threadIdx.x == 0) {
        __builtin_amdgcn_fence(__ATOMIC_ACQUIRE, "agent");
        if (M[10] != 0u) xb_add(&b.bar[XB_XGEN(b.x)], 1u);
        asm volatile("s_waitcnt vmcnt(0)" ::: "memory");
    }
    __syncthreads();
}

__global__ void __launch_bounds__(NTHREADS, 2) fwd_kernel(Args args) {
    extern __shared__ __attribute__((aligned(16))) unsigned char lds_raw[];
    LAS unsigned char* lds = (LAS unsigned char*)lds_raw;
    volatile LAS unsigned* MISC = (volatile LAS unsigned*)(lds + MISC_OFF);
    const int G = gridDim.x, bid = blockIdx.x;
    const int wave_sg = __builtin_amdgcn_readfirstlane((int)threadIdx.x >> 6);
#define PHASE_IDS() int lane; asm volatile("v_mbcnt_lo_u32_b32 %0, -1, 0\n\tv_mbcnt_hi_u32_b32 %0, -1, %0" : "=v"(lane)); const int wave = wave_sg; const int tid = wave * 64 + lane; const int gw = bid * NWAVES + wave, NGW = G * NWAVES; (void)lane; (void)wave; (void)gw; (void)NGW
#define CAS __attribute__((address_space(4)))
#define PHASE_ARGS() const CAS Args* ap = (const CAS Args*)__builtin_amdgcn_kernarg_segment_ptr(); asm volatile("" : "+s"(ap)); unsigned char* const ws = ap->ws; unsigned* const ctl = (unsigned*)(ws + WS_CTL); (void)ctl
#define ARG(i) (ap->in[i])
#define WSP(T, off) ((T*)(ws + (off)))
    enum { I_X = 0, I_C, I_WADA, I_BADA, I_NMIX, I_WIN, I_LBT, I_HGNW, I_CONVW, I_WHG, I_WCV, I_WMIX, I_NFFN, I_WR, I_BR, I_W1, I_B1, I_W2, I_B2, I_NFIN };
    { PHASE_IDS(); for (int u = tid; u < 64; u += NTHREADS) MISC[u] = 0u; }
    __syncthreads();
    XcdBarrier bar; bar.bar = nullptr; bar.x = 0; bar.st = nullptr;
#if MK_ONE_LAUNCH
    { PHASE_ARGS(); bar = xcd_barrier_post(ctl + CW_BAR, MISC + 8); }
#if MK_BG
#define GRID_BAR_X(drain) do { PHASE_IDS(); PHASE_ARGS(); const BgCtx bgc{ARG(I_W1), ARG(I_W2), WSP(unsigned char, WS_W1), WSP(unsigned char, WS_W2), ctl + CW_Q}; xcd_barrier_bg(bar, bgc, lds, wave, lane, drain); } while (0)
#define GRID_BAR() GRID_BAR_X(false)
#else
#define GRID_BAR() xcd_barrier(bar)
#endif
#else
#define GRID_BAR() do { } while (0)
#endif
    const int lo = args.ph_lo, hi = args.ph_hi;
#if MK_PHT
    const unsigned long long pht0 = __builtin_amdgcn_s_memrealtime(); unsigned long long phtk = 0;
#endif
#ifndef PH_MASK
#define PH_MASK 0x7ff
#endif
#define IN(k) (((PH_MASK >> (k)) & 1) && lo <= (k) && (k) < hi)
#define BOTH(k) (IN(k) && IN((k) + 1))

    if (IN(0)) for (int rep_ = 0; rep_ < 1 + ((MK_REPEAT >> 0) & 1); ++rep_) { PHASE_IDS(); PHASE_ARGS();
        const float* cvec = ARG(I_C); const float* w_ada = ARG(I_WADA); const float* b_ada = ARG(I_BADA); const float* lbtab = ARG(I_LBT);
        const float* w_in = ARG(I_WIN); const float* w_hg = ARG(I_WHG); const float* w_cv = ARG(I_WCV); const float* w_mix = ARG(I_WMIX); const float* w1 = ARG(I_W1); const float* w2 = ARG(I_W2);
        float* MOD = WSP(float, WS_MOD); float* LB = WSP(float, WS_LB);
        bf16_t* Win_t = WSP(bf16_t, WS_WIN); bf16_t* Whg_t = WSP(bf16_t, WS_WHG); bf16_t* Wcv_t = WSP(bf16_t, WS_WHG) + 512;        bf16_t* Wmix_t = WSP(bf16_t, WS_WMIX); unsigned char* W1_t = WSP(unsigned char, WS_W1); unsigned char* W2_t = WSP(unsigned char, WS_W2);
        LAS float* scr = (LAS float*)(lds + wave * 16896);
        const int nmod_w = NGW >= 768 ? 384 : 0;
        for (int it = (nmod_w ? gw - (NGW - nmod_w) : gw); it >= 0 && it < 384; it += (nmod_w ? 384 : NGW)) {
            const int n0 = it * 16, cl = lane & 15, kq = lane >> 4;
            float acc[32];
#pragma unroll
            for (int b = 0; b < 32; ++b) acc[b] = 0.f;
            for (int ch = 0; ch < 16; ++ch) {
                { const int b = lane >> 1, part = lane & 1;
#pragma unroll
                    for (int q = 0; q < 4; ++q) {
                        const float* cp = cvec + (size_t)b * D + q * 256 + ch * 16 + part * 8;
                        const f32x4 c0 = *(const f32x4*)cp, c1 = *(const f32x4*)(cp + 4);
#pragma unroll
                        for (int j = 0; j < 4; ++j) { scr[(q * 16 + part * 8 + j) * 32 + b] = c0[j] * sigmoidf_(c0[j]); scr[(q * 16 + part * 8 + 4 + j) * 32 + b] = c1[j] * sigmoidf_(c1[j]); }
                    } }
                float wv[16];
#pragma unroll
                for (int kk = 0; kk < 16; ++kk) wv[kk] = w_ada[(size_t)(kq * 256 + ch * 16 + kk) * 6144 + n0 + cl];
                LDS_WAIT(); asm volatile("" ::: "memory");
#pragma unroll
                for (int kk = 0; kk < 16; ++kk) {
                    const LAS f32x4* sp = (const LAS f32x4*)(scr + (kq * 16 + kk) * 32);
#pragma unroll
                    for (int b4 = 0; b4 < 8; ++b4) { const f32x4 s = sp[b4]; acc[4 * b4] += wv[kk] * s[0]; acc[4 * b4 + 1] += wv[kk] * s[1]; acc[4 * b4 + 2] += wv[kk] * s[2]; acc[4 * b4 + 3] += wv[kk] * s[3]; }
                }
                LDS_WAIT(); asm volatile("" ::: "memory");
            }
            const float bias = b_ada[n0 + cl];
#pragma unroll
            for (int b = 0; b < 32; ++b) { float v = acc[b]; v += __shfl_xor(v, 16); v += __shfl_xor(v, 32); if (kq == 0) MOD[(size_t)b * 6144 + n0 + cl] = v + bias; }
        }
        if (bid == (G > 1 ? 1 : 0)) { const int k = tid; const float l0 = lbtab[k], l1 = lbtab[HW + k]; LB[k] = fast_rcp(1.0f + fast_exp(l1 - l0)); }
        {
            constexpr int I_IN = 16 * PN8 * 4, I_IN8 = 8 * NQ8 * 8, I_HG = 8 * 16, I_CV = 8 * 16, I_MIX = 16 * 16, I_W1 = 32 * 8 * 64, I_W2 = 32 * 8 * 32;
            constexpr int NITEMS = I_IN + I_IN8 + I_HG + I_CV + I_MIX + ((MK_BG && MK_ONE_LAUNCH) ? 0 : I_W1 + I_W2);
            const int n_nm = NGW - nmod_w, base2 = 2 * n_nm, nfull = (NITEMS - base2) / NGW, base3 = base2 + nfull * NGW;
            for (int rr = 0; rr < nfull + 3; ++rr) {
                int it;
                if (rr < 2) { if (gw >= n_nm) continue; it = rr * n_nm + gw; }
                else if (rr < 2 + nfull) it = base2 + (rr - 2) * NGW + gw;
                else { if (gw >= n_nm) continue; it = base3 + gw; }
                if (it >= NITEMS) continue;
                int r = it;
#if MK_P2FP8
                if (r < I_IN) { const int kb = r / 176, nb = r % 176; transpose_item_fp8(w_in, INC, (unsigned char*)Win_t, D, kb * 128, nb * 32, nb * 32, scr, lane); continue; } r -= I_IN;
#else
                if (r < I_IN) { const int kb = r / (PN8 * 4), nb = r % (PN8 * 4); const int pn = map16(nb >> 2), wi = (nb & 3) * 64;
                    const int src = pn < 10 ? pn * 256 + wi : pn < 14 ? (wi < 128 ? 2560 + (pn - 10) * 128 + wi : 3072 + (pn - 10) * 128 + (wi - 128)) : (wi < 128 ? 3584 + (pn - 14) * 128 + wi : 4608 + (pn - 14) * 128 + (wi - 128));
                    transpose_item(w_in, INC, Win_t, D, kb * 64, src, nb * 64, scr, lane); continue; } r -= I_IN;
                if (r < I_IN8) { const int kb = r / (NQ8 * 8), nb = r % (NQ8 * 8); const int pn = map8(nb >> 3), wi = (nb & 7) * 32;
                    const int src = pn < 10 ? pn * 256 + wi : pn < 14 ? (wi < 128 ? 2560 + (pn - 10) * 128 + wi : 3072 + (pn - 10) * 128 + (wi - 128)) : (wi < 128 ? 3584 + (pn - 14) * 128 + wi : 4608 + (pn - 14) * 128 + (wi - 128));
                    transpose_item_fp8(w_in, INC, WSP(unsigned char, WS_WIN8), D, kb * 128, src, nb * 32, scr, lane); continue; } r -= I_IN8;
#endif
                if (r < I_HG) { const int kb = r / 16, nb = r % 16; transpose_item(w_hg, D, Whg_t, D, kb * 64, nb * 64, nb * 64, scr, lane); continue; } r -= I_HG;
                if (r < I_CV) { const int kb = r / 16, nb = r % 16; transpose_item(w_cv, D, Wcv_t, D, kb * 64, nb * 64, nb * 64, scr, lane); continue; } r -= I_CV;
                if (r < I_MIX) { const int kb = r / 16, nb = r % 16; transpose_item(w_mix, D, Wmix_t, D, kb * 64, nb * 64, nb * 64, scr, lane); continue; } r -= I_MIX;
                if (r < I_W1) { const int e = r / 512, q = r % 512, kb = q / 64, nb = q % 64;
                    const int pn = nb >> 3, wi = (nb & 7) * 32; const int src = wi < 128 ? pn * 128 + wi : 1024 + pn * 128 + (wi - 128);
                    transpose_item_fp8(w1 + (size_t)e * D * 2048, 2048, W1_t + (size_t)e * 2048 * D, D, kb * 128, src, nb * 32, scr, lane); continue; } r -= I_W1;
                { const int e = r / 256, q = r % 256, kb = q / 32, nb = q % 32;
                    transpose_item_fp8(w2 + (size_t)e * DFF * D, D, W2_t + (size_t)e * D * DFF, DFF, kb * 128, nb * 32, nb * 32, scr, lane); }
            }
        }
        if (BOTH(0)) GRID_BAR();
#if MK_PHT
        if (MK_PHT == 1) phtk = __builtin_amdgcn_s_memrealtime() - pht0;
#endif
    }

    if (IN(1)) for (int rep_ = 0; rep_ < 1 + ((MK_REPEAT >> 1) & 1); ++rep_) { PHASE_IDS(); PHASE_ARGS();
        const float* x = ARG(I_X); const float* norm_mix_w = ARG(I_NMIX); const float* MOD = WSP(float, WS_MOD); bf16_t* U = WSP(bf16_t, WS_U); unsigned char* U8 = WSP(unsigned char, WS_U8);
        for (int m0 = gw * 32; m0 < NTOK; m0 += NGW * 32) {
            const int b = m0 >> 11;
            f32x4 A[4], Sh[4];
#pragma unroll
            for (int j = 0; j < 4; ++j) { const int k = 4 * lane + 256 * j; const f32x4 w = *(const f32x4*)(norm_mix_w + k), sc = *(const f32x4*)(MOD + (size_t)b * 6144 + 1024 + k);
                A[j] = w * (sc + 1.0f); Sh[j] = *(const f32x4*)(MOD + (size_t)b * 6144 + k); }
            for (int r = 0; r < 32; r += 4) {
                f32x4 v[4][4]; float ss[4];
#pragma unroll
                for (int q = 0; q < 4; ++q) { const float* xr = x + (size_t)(m0 + r + q) * D; ss[q] = 0.f;
#pragma unroll
                    for (int j = 0; j < 4; ++j) v[q][j] = *(const f32x4*)(xr + 4 * lane + 256 * j); }
#pragma unroll
                for (int q = 0; q < 4; ++q) {
#pragma unroll
                    for (int j = 0; j < 4; ++j) ss[q] += (v[q][j][0] * v[q][j][0] + v[q][j][1] * v[q][j][1]) + (v[q][j][2] * v[q][j][2] + v[q][j][3] * v[q][j][3]);
                    const float rs = __builtin_amdgcn_rsqf(wave_sum(ss[q]) * (1.0f / D) + EPS);
#if MK_P2FP8
                    unsigned char* ur = (unsigned char*)U + (size_t)(m0 + r + q) * D;
#pragma unroll
                    for (int j = 0; j < 4; ++j) { const f32x4 o = v[q][j] * rs * A[j] + Sh[j]; *(unsigned*)(ur + 4 * lane + 256 * j) = pk4_fp8(o[0], o[1], o[2], o[3]); }
#else
                    bf16_t* ur = U + (size_t)(m0 + r + q) * D; unsigned char* u8r = U8 + (size_t)(m0 + r + q) * D;
#pragma unroll
                    for (int j = 0; j < 4; ++j) { const f32x4 o = v[q][j] * rs * A[j] + Sh[j]; u32x2 w; w.x = cvt_pk_bf16(o[0], o[1]); w.y = cvt_pk_bf16(o[2], o[3]); *(u32x2*)(ur + 4 * lane + 256 * j) = w;
                        if (NQ8 > 0) *(unsigned*)(u8r + 4 * lane + 256 * j) = pk4_fp8(o[0], o[1], o[2], o[3]); }
#endif
                }
            }
        }
        if (BOTH(1)) GRID_BAR();
#if MK_PHT
        if (MK_PHT == 2) phtk = __builtin_amdgcn_s_memrealtime() - pht0;
#endif
    }

    if (IN(2)) for (int rep_ = 0; rep_ < 1 + ((MK_REPEAT >> 2) & 1); ++rep_) { PHASE_ARGS();
        if (PN8 > 0) { gm::DenseOrder S{NTOK / 256, PN8, G, bid, 1}; gm::DenseA AM{D, 0u, 2}; gm::EpiProjT<false> E{WSP(bf16_t, WS_PROJ), (bf16_t*)ap->out, WSP(float, WS_LB)};
            gm::gemm_phase<false>(wave_sg, lds, (const char*)WSP(bf16_t, WS_U), (const char*)WSP(bf16_t, WS_WIN), D, 0, 0u, S, E, AM); }
        if (NQ8 > 0) { gm::DenseOrder S{NTOK / 256, NQ8, G, bid, 1}; gm::DenseA AM{D, 0u, 1}; gm::EpiProjT<true> E{WSP(bf16_t, WS_PROJ), (bf16_t*)ap->out, WSP(float, WS_LB)};
            gm::gemm_phase<true>(wave_sg, lds, (const char*)WSP(unsigned char, WS_U8), (const char*)WSP(unsigned char, WS_WIN8), D, 0, 0u, S, E, AM); }
        if (BOTH(2)) GRID_BAR();
#if MK_PHT
        if (MK_PHT == 3) phtk = __builtin_amdgcn_s_memrealtime() - pht0;
#endif
    }

    if (IN(3)) for (int rep_ = 0; rep_ < 1 + ((MK_REPEAT >> 3) & 1); ++rep_) { PHASE_IDS(); PHASE_ARGS();
        const float* hg_norm_w = ARG(I_HGNW); const float* conv_w = ARG(I_CONVW); const bf16_t* PROJ = WSP(bf16_t, WS_PROJ); bf16_t* OB = WSP(bf16_t, WS_O); bf16_t* CVB = WSP(bf16_t, WS_O) + 512;
        const int nchainblk = (G >= 256) ? 128 : (G >= 2 ? G / 2 : 1);
        if (bid < nchainblk) {
            constexpr int LDQ = 136, LDT = 72;
            LAS bf16_t* QT = (LAS bf16_t*)(lds);
            LAS bf16_t* KT = QT + 64 * LDQ;
            LAS bf16_t* QB = KT + 64 * LDQ;
            LAS bf16_t* KBT = QB + 64 * LDQ;
            LAS bf16_t* VT = KBT + 128 * LDT;
            LAS bf16_t* PM = VT + 128 * LDT;
            LAS bf16_t* ST = PM + 64 * LDT;
            LAS bf16_t* OS = ST + 128 * LDQ;
            LAS float* SEG = (LAS float*)(OS + 64 * LDQ);
            LAS float* DEC = SEG + 8 * 128;
            const int fr = lane & 15, fq = lane >> 4, w = wave;
            for (int chain = bid; chain < BATCH * NHEAD; chain += nchainblk) {
                const int b = chain >> 2, h = chain & 3;
                __syncthreads();
                for (int i = tid; i < 128 * LDQ / 2; i += NTHREADS) ((LAS unsigned*)ST)[i] = 0u;
                f32x4 Sacc[8];
#pragma unroll
                for (int i = 0; i < 8; ++i) Sacc[i] = (f32x4){0.f, 0.f, 0.f, 0.f};
                const int ot = tid >> 3, ocg = tid & 7;
                f32x4 nwv[4];
#pragma unroll
                for (int q = 0; q < 2; ++q) { nwv[2 * q] = *(const f32x4*)(hg_norm_w + q * 64 + 8 * ocg); nwv[2 * q + 1] = *(const f32x4*)(hg_norm_w + q * 64 + 8 * ocg + 4); }
                const bf16_t* pbase = PROJ + (size_t)(b * SEQ) * PROJ_LD + h * DK;
                unsigned rq[8], rl[8], rv[8];
#pragma unroll
                for (int r = 0; r < 8; ++r) { const bf16_t* p = pbase + (size_t)(8 * w + r) * PROJ_LD + 2 * lane; rq[r] = *(const unsigned*)p; rl[r] = *(const unsigned*)(p + 512); rv[r] = *(const unsigned*)(p + 1024); }
                for (int c = 0; c < NCHUNK; ++c) {
                    const int m0 = c * CHUNK;
                    float cs0[8], cs1[8]; { float a0 = 0.f, a1 = 0.f;
#pragma unroll
                        for (int r = 0; r < 8; ++r) { a0 += bf_lo(rl[r]); a1 += bf_hi(rl[r]); cs0[r] = a0; cs1[r] = a1; }
                        *(LAS f32x2*)(SEG + w * 128 + 2 * lane) = (f32x2){a0, a1}; }
                    LDS_WAIT(); __builtin_amdgcn_s_barrier(); asm volatile("" ::: "memory");
                    float pre0 = 0.f, pre1 = 0.f, bm0 = 0.f, bm1 = 0.f, bl0 = 0.f, bl1 = 0.f;
#pragma unroll
                    for (int s = 0; s < 8; ++s) { const f32x2 t2 = *(const LAS f32x2*)(SEG + s * 128 + 2 * lane); if (s < w) { pre0 += t2[0]; pre1 += t2[1]; } if (s < 4) { bm0 += t2[0]; bm1 += t2[1]; } bl0 += t2[0]; bl1 += t2[1]; }
                    const float em0 = fast_exp(fmaxf(bm0, -80.f)), em1 = fast_exp(fmaxf(bm1, -80.f));
                    const float el0 = fast_exp(fmaxf(bl0 - bm0, -80.f)), el1 = fast_exp(fmaxf(bl1 - bm1, -80.f));
                    if (w == 0) *(LAS f32x2*)(DEC + 2 * lane) = (f32x2){fast_exp(fmaxf(bl0, -80.f)), fast_exp(fmaxf(bl1, -80.f))};
                    unsigned kb0[4], kb1[4], vt0[4], vt1[4];
#pragma unroll
                    for (int r = 0; r < 8; ++r) {
                        const int t = 8 * w + r;
                        const float lf0 = bf_lo(rl[r]), lf1 = bf_hi(rl[r]);
                        const float d0 = fminf(fmaxf(pre0 + cs0[r] - bm0, -80.f), 80.f), d1 = fminf(fmaxf(pre1 + cs1[r] - bm1, -80.f), 80.f);
                        const float e0 = fast_exp(d0), e1 = fast_exp(d1), i0 = fast_exp(-d0), i1 = fast_exp(-d1);
                        const float kk0 = 1.0f - fast_exp(lf0), kk1 = 1.0f - fast_exp(lf1);
                        const float qt0 = bf_lo(rq[r]) * e0, qt1 = bf_hi(rq[r]) * e1, kt0 = kk0 * i0, kt1 = kk1 * i1;
                        *(LAS unsigned*)(QT + t * LDQ + 2 * lane) = cvt_pk_bf16(qt0, qt1);
                        *(LAS unsigned*)(KT + t * LDQ + 2 * lane) = cvt_pk_bf16(kt0, kt1);
                        *(LAS unsigned*)(QB + t * LDQ + 2 * lane) = cvt_pk_bf16(qt0 * em0, qt1 * em1);
                        const unsigned kbp = cvt_pk_bf16(kt0 * el0, kt1 * el1);
                        if (r & 1) { kb0[r >> 1] |= (kbp << 16); kb1[r >> 1] |= (kbp & 0xffff0000u); vt0[r >> 1] |= (rv[r] << 16); vt1[r >> 1] |= (rv[r] & 0xffff0000u); }
                        else { kb0[r >> 1] = kbp & 0xffffu; kb1[r >> 1] = kbp >> 16; vt0[r >> 1] = rv[r] & 0xffffu; vt1[r >> 1] = rv[r] >> 16; }
                    }
                    *(LAS u32x4*)(KBT + (2 * lane) * LDT + 8 * w) = (u32x4){kb0[0], kb0[1], kb0[2], kb0[3]};
                    *(LAS u32x4*)(KBT + (2 * lane + 1) * LDT + 8 * w) = (u32x4){kb1[0], kb1[1], kb1[2], kb1[3]};
                    *(LAS u32x4*)(VT + (2 * lane) * LDT + 8 * w) = (u32x4){vt0[0], vt0[1], vt0[2], vt0[3]};
                    *(LAS u32x4*)(VT + (2 * lane + 1) * LDT + 8 * w) = (u32x4){vt1[0], vt1[1], vt1[2], vt1[3]};
                    LDS_WAIT(); __builtin_amdgcn_s_barrier(); asm volatile("" ::: "memory");
                    u32x4 gg[2];
                    { const bf16_t* gp = pbase + (size_t)(m0 + ot) * PROJ_LD + 1536 + 8 * ocg; gg[0] = *(const u32x4*)gp; gg[1] = *(const u32x4*)(gp + 64); }
                    if (c + 1 < NCHUNK) {
#pragma unroll
                        for (int r = 0; r < 8; ++r) { const bf16_t* p = pbase + (size_t)(m0 + CHUNK + 8 * w + r) * PROJ_LD + 2 * lane; rq[r] = *(const unsigned*)p; rl[r] = *(const unsigned*)(p + 512); rv[r] = *(const unsigned*)(p + 1024); }
                    }
#pragma unroll
                    for (int x2 = 0; x2 < 2; ++x2) { const int id = 2 * w + x2, si = id >> 2, ti = id & 3;
                        f32x4 sc = (f32x4){0.f, 0.f, 0.f, 0.f};
                        if (si <= ti) {
#pragma unroll
                            for (int ks = 0; ks < 4; ++ks) { const bf16x8 a = *(const LAS bf16x8*)(KT + (16 * si + fr) * LDQ + 32 * ks + 8 * fq), bb = *(const LAS bf16x8*)(QT + (16 * ti + fr) * LDQ + 32 * ks + 8 * fq);
                                sc = __builtin_amdgcn_mfma_f32_16x16x32_bf16(a, bb, sc, 0, 0, 0); }
                            const int t = 16 * ti + fr, s0 = 16 * si + 4 * fq;
#pragma unroll
                            for (int j = 0; j < 4; ++j) sc[j] = (s0 + j <= t) ? sc[j] : 0.f;
                        }
                        *(LAS u32x2*)(PM + (16 * ti + fr) * LDT + 16 * si + 4 * fq) = (u32x2){cvt_pk_bf16(sc[0], sc[1]), cvt_pk_bf16(sc[2], sc[3])};
                    }
                    f32x4 oacc[4];
                    { bf16x8 sa[4];
#pragma unroll
                        for (int ks = 0; ks < 4; ++ks) sa[ks] = *(const LAS bf16x8*)(ST + (16 * w + fr) * LDQ + 32 * ks + 8 * fq);
#pragma unroll
                        for (int ti = 0; ti < 4; ++ti) { oacc[ti] = (f32x4){0.f, 0.f, 0.f, 0.f};
#pragma unroll
                            for (int ks = 0; ks < 4; ++ks) { const bf16x8 bb = *(const LAS bf16x8*)(QB + (16 * ti + fr) * LDQ + 32 * ks + 8 * fq); oacc[ti] = __builtin_amdgcn_mfma_f32_16x16x32_bf16(sa[ks], bb, oacc[ti], 0, 0, 0); } } }
                    LDS_WAIT(); __builtin_amdgcn_s_barrier(); asm volatile("" ::: "memory");
                    { bf16x8 va[2];
#pragma unroll
                        for (int ks = 0; ks < 2; ++ks) va[ks] = *(const LAS bf16x8*)(VT + (16 * w + fr) * LDT + 32 * ks + 8 * fq);
#pragma unroll
                        for (int ti = 0; ti < 4; ++ti)
#pragma unroll
                            for (int ks = 0; ks < 2; ++ks) { const bf16x8 bb = *(const LAS bf16x8*)(PM + (16 * ti + fr) * LDT + 32 * ks + 8 * fq); oacc[ti] = __builtin_amdgcn_mfma_f32_16x16x32_bf16(va[ks], bb, oacc[ti], 0, 0, 0); }
#pragma unroll
                        for (int i = 0; i < 8; ++i) { const f32x4 dv = *(const LAS f32x4*)(DEC + 16 * i + 4 * fq); Sacc[i] = Sacc[i] * dv;
#pragma unroll
                            for (int ks = 0; ks < 2; ++ks) { const bf16x8 a = *(const LAS bf16x8*)(KBT + (16 * i + fr) * LDT + 32 * ks + 8 * fq); Sacc[i] = __builtin_amdgcn_mfma_f32_16x16x32_bf16(a, va[ks], Sacc[i], 0, 0, 0); } } }
#pragma unroll
                    for (int ti = 0; ti < 4; ++ti) *(LAS u32x2*)(OS + (16 * ti + fr) * LDQ + 16 * w + 4 * fq) = (u32x2){cvt_pk_bf16(oacc[ti][0], oacc[ti][1]), cvt_pk_bf16(oacc[ti][2], oacc[ti][3])};
#pragma unroll
                    for (int i = 0; i < 8; ++i) *(LAS u32x2*)(ST + (16 * w + fr) * LDQ + 16 * i + 4 * fq) = (u32x2){cvt_pk_bf16(Sacc[i][0], Sacc[i][1]), cvt_pk_bf16(Sacc[i][2], Sacc[i][3])};
                    LDS_WAIT(); __builtin_amdgcn_s_barrier(); asm volatile("" ::: "memory");
                    { f32x4 o[4]; const u32x4 ow0 = *(const LAS u32x4*)(OS + ot * LDQ + 8 * ocg), ow1 = *(const LAS u32x4*)(OS + ot * LDQ + 64 + 8 * ocg); gm::unpack8(ow0, o[0], o[1]); gm::unpack8(ow1, o[2], o[3]);
                        float ss = 0.f;
#pragma unroll
                        for (int q = 0; q < 4; ++q) ss += (o[q][0] * o[q][0] + o[q][1] * o[q][1]) + (o[q][2] * o[q][2] + o[q][3] * o[q][3]);
                        ss += __shfl_xor(ss, 1); ss += __shfl_xor(ss, 2); ss += __shfl_xor(ss, 4);
                        const float rn = __builtin_amdgcn_rsqf(ss * (1.0f / 128.0f) + EPS);
                        bf16_t* op = OB + (size_t)(b * SEQ + m0 + ot) * D + h * DK + 8 * ocg;
#pragma unroll
                        for (int q = 0; q < 2; ++q) { f32x4 g0, g1; gm::unpack8(gg[q], g0, g1);
#pragma unroll
                            for (int j = 0; j < 4; ++j) { g0[j] = g0[j] * sigmoidf_(g0[j]); g1[j] = g1[j] * sigmoidf_(g1[j]); }
                            *(u32x4*)(op + 64 * q) = gm::pack8(o[2 * q] * rn * nwv[2 * q] * g0, o[2 * q + 1] * rn * nwv[2 * q + 1] * g1); } }
                }
            }
        } else {
            const int nconv = G - nchainblk;
            f32x4 cw[3][2];
#pragma unroll
            for (int j = 0; j < 3; ++j) { cw[j][0] = *(const f32x4*)(conv_w + j * 512 + 8 * lane); cw[j][1] = *(const f32x4*)(conv_w + j * 512 + 8 * lane + 4); }
            for (int it = bid - nchainblk; it < BATCH * 8; it += nconv) {
                const int b = it >> 3, t0 = (it & 7) * 256 + wave * 32;
                const bf16_t* pb = PROJ + (size_t)(b * SEQ) * PROJ_LD + 2048 + 8 * lane;
                f32x4 p1[2], p2[2];
#pragma unroll
                for (int q = 0; q < 2; ++q) { p1[q] = (f32x4){0.f, 0.f, 0.f, 0.f}; p2[q] = p1[q]; }
                if (t0 > 0) { gm::unpack8(*(const u32x4*)(pb + (size_t)(t0 - 2) * PROJ_LD + 512), p2[0], p2[1]); gm::unpack8(*(const u32x4*)(pb + (size_t)(t0 - 1) * PROJ_LD + 512), p1[0], p1[1]); }
                for (int r = 0; r < 32; ++r) { const size_t ro = (size_t)(t0 + r) * PROJ_LD;
                    f32x4 q0, q1, g0, g1;
                    gm::unpack8(*(const u32x4*)(pb + ro + 512), q0, q1); gm::unpack8(*(const u32x4*)(pb + ro), g0, g1);
                    const f32x4 y0 = g0 * (cw[0][0] * p2[0] + cw[1][0] * p1[0] + cw[2][0] * q0), y1 = g1 * (cw[0][1] * p2[1] + cw[1][1] * p1[1] + cw[2][1] * q1);
                    *(u32x4*)(CVB + (size_t)(b * SEQ + t0 + r) * D + 8 * lane) = gm::pack8(y0, y1);
                    p2[0] = p1[0]; p2[1] = p1[1]; p1[0] = q0; p1[1] = q1; }
            }
        }
        if (BOTH(3)) GRID_BAR();
#if MK_PHT
        if (MK_PHT == 4) phtk = __builtin_amdgcn_s_memrealtime() - pht0;
#endif
    }

    if (IN(4)) for (int rep_ = 0; rep_ < 1 + ((MK_REPEAT >> 4) & 1); ++rep_) { PHASE_ARGS();
        gm::DenseOrder S{NTOK / 256, D / 256, G, bid, 1}; gm::DenseA AM{D, 0u, 2}; gm::EpiMerge E{(const bf16_t*)ap->out, WSP(bf16_t, WS_U)};
        gm::gemm_phase<false>(wave_sg, lds, (const char*)WSP(bf16_t, WS_O), (const char*)WSP(bf16_t, WS_WHG), D, 0, 0u, S, E, AM);
        if (BOTH(4)) GRID_BAR();
#if MK_PHT
        if (MK_PHT == 5) phtk = __builtin_amdgcn_s_memrealtime() - pht0;
#endif
    }

    if (IN(5)) for (int rep_ = 0; rep_ < 1 + ((MK_REPEAT >> 5) & 1); ++rep_) { PHASE_ARGS();
        gm::DenseOrder S{NTOK / 256, D / 256, G, bid, 1}; gm::DenseA AM{D, 0u, 2}; gm::EpiMix E{ARG(I_X), WSP(float, WS_MOD), WSP(bf16_t, WS_H)};
        gm::gemm_phase<false>(wave_sg, lds, (const char*)WSP(bf16_t, WS_U), (const char*)WSP(bf16_t, WS_WMIX), D, 0, 0u, S, E, AM);
        if (BOTH(5)) GRID_BAR();
#if MK_PHT
        if (MK_PHT == 6) phtk = __builtin_amdgcn_s_memrealtime() - pht0;
#endif
    }

    if (IN(6)) { PHASE_IDS(); PHASE_ARGS();
        typedef float f32x16 __attribute__((ext_vector_type(16)));
        const float* norm_ffn_w = ARG(I_NFFN); const float* w_router = ARG(I_WR); const float* b_router = ARG(I_BR); const float* MOD = WSP(float, WS_MOD);
        const bf16_t* HB = WSP(bf16_t, WS_H); unsigned char* U2Q = WSP(unsigned char, WS_U2Q); int* TOPI = WSP(int, WS_TOPI); float* TOPP = WSP(float, WS_TOPP); int* POS = WSP(int, WS_POS);
        constexpr int WRS = 1032;
        LAS bf16_t* WRH = (LAS bf16_t*)lds; LAS bf16_t* WRL = WRH + 32 * WRS;
        LAS float* LG = (LAS float*)(lds + 132096) + wave * (16 * 36);
        LAS unsigned* LCNT = (LAS unsigned*)(lds + 150528);
        LAS unsigned* LBASE = LCNT + 32;
        LAS unsigned* LASS = LCNT + 64;
        LAS float* A2 = (LAS float*)(lds + 154880); LAS float* SH2 = A2 + 1024;
        for (int i = tid; i < 32 * 1024; i += NTHREADS) { const int e = i & 31, k = i >> 5; const float w = w_router[i];
            const unsigned hi = cvt_pk_bf16(w, 0.f) & 0xffffu; const unsigned lo = cvt_pk_bf16(w - bf_lo(hi), 0.f) & 0xffffu;
            WRH[e * WRS + k] = (bf16_t)hi; WRL[e * WRS + k] = (bf16_t)lo; }
        for (int tb = bid; tb < NTOK / 256; tb += G) {
            const int b = (tb * 256) >> 11;
            if (tid < 32) LCNT[tid] = 0u;
            for (int k = tid; k < 1024; k += NTHREADS) { A2[k] = norm_ffn_w[k] * (1.0f + MOD[(size_t)b * 6144 + 4096 + k]); SH2[k] = MOD[(size_t)b * 6144 + 3072 + k]; }
            LDS_WAIT(); __syncthreads();
            const int trow = lane & 31, half = lane >> 5, ltok0 = wave * 32, tok = tb * 256 + ltok0 + trow;
            const bf16_t* hrow = HB + (size_t)tok * D + 8 * half;
            float ssq = 0.f;
#pragma unroll 8
            for (int st = 0; st < 64; ++st) { const u32x4 hv = *(const u32x4*)(hrow + 16 * st); f32x4 x0, x1; gm::unpack8(hv, x0, x1);
                ssq += (x0[0] * x0[0] + x0[1] * x0[1]) + (x0[2] * x0[2] + x0[3] * x0[3]) + (x1[0] * x1[0] + x1[1] * x1[1]) + (x1[2] * x1[2] + x1[3] * x1[3]); }
            ssq += __shfl_xor(ssq, 32);
            const float rs = __builtin_amdgcn_rsqf(ssq * (1.0f / D) + EPS);
            f32x16 dacc;
#pragma unroll
            for (int q = 0; q < 16; ++q) dacc[q] = 0.f;
            unsigned char* urow = U2Q + (size_t)tok * D + 8 * half;
            const LAS bf16_t* wh = WRH + trow * WRS + 8 * half; const LAS bf16_t* wl = WRL + trow * WRS + 8 * half;
#pragma unroll 2
            for (int st = 0; st < 64; ++st) {
                const u32x4 hv = *(const u32x4*)(hrow + 16 * st); f32x4 x0, x1; gm::unpack8(hv, x0, x1);
                const int k0 = 16 * st + 8 * half;
                const f32x4 a0 = *(const LAS f32x4*)(A2 + k0), a1 = *(const LAS f32x4*)(A2 + k0 + 4), s0 = *(const LAS f32x4*)(SH2 + k0), s1 = *(const LAS f32x4*)(SH2 + k0 + 4);
                const f32x4 u0 = x0 * rs * a0 + s0, u1 = x1 * rs * a1 + s1;
                *(u32x2*)(urow + 16 * st) = (u32x2){pk4_fp8(u0[0], u0[1], u0[2], u0[3]), pk4_fp8(u1[0], u1[1], u1[2], u1[3])};
                u32x4 hh; hh.x = cvt_pk_bf16(u0[0], u0[1]); hh.y = cvt_pk_bf16(u0[2], u0[3]); hh.z = cvt_pk_bf16(u1[0], u1[1]); hh.w = cvt_pk_bf16(u1[2], u1[3]);
                u32x4 ll; ll.x = cvt_pk_bf16(u0[0] - bf_lo(hh.x), u0[1] - bf_hi(hh.x)); ll.y = cvt_pk_bf16(u0[2] - bf_lo(hh.y), u0[3] - bf_hi(hh.y));
                ll.z = cvt_pk_bf16(u1[0] - bf_lo(hh.z), u1[1] - bf_hi(hh.z)); ll.w = cvt_pk_bf16(u1[2] - bf_lo(hh.w), u1[3] - bf_hi(hh.w));
                const bf16x8 ah = __builtin_bit_cast(bf16x8, hh), al = __builtin_bit_cast(bf16x8, ll);
                const bf16x8 bh = *(const LAS bf16x8*)(wh + 16 * st), bl = *(const LAS bf16x8*)(wl + 16 * st);
                dacc = __builtin_amdgcn_mfma_f32_32x32x16_bf16(ah, bh, dacc, 0, 0, 0);
                dacc = __builtin_amdgcn_mfma_f32_32x32x16_bf16(ah, bl, dacc, 0, 0, 0);
                dacc = __builtin_amdgcn_mfma_f32_32x32x16_bf16(al, bh, dacc, 0, 0, 0);
            }
            const float br = b_router[trow];
#pragma unroll
            for (int g = 0; g < 2; ++g) {
#pragma unroll
                for (int q = 0; q < 8; ++q) { const int r16 = (q & 3) + 8 * (q >> 2) + 4 * half; LG[r16 * 36 + trow] = dacc[8 * g + q] + br; }
                LDS_WAIT(); asm volatile("" ::: "memory");
                if (lane < 16) {
                    float v0 = -3.0e38f, v1 = -3.0e38f, v2 = -3.0e38f, v3 = -3.0e38f; int i0 = 0, i1 = 0, i2 = 0, i3 = 0;
#pragma unroll
                    for (int e4 = 0; e4 < 8; ++e4) { const f32x4 lv = *(const LAS f32x4*)(LG + lane * 36 + 4 * e4);
#pragma unroll
                        for (int j = 0; j < 4; ++j) { const float x = lv[j]; const int e = 4 * e4 + j;
                            const bool c0 = x > v0, c1 = x > v1, c2 = x > v2, c3 = x > v3;
                            v3 = c2 ? v2 : (c3 ? x : v3); i3 = c2 ? i2 : (c3 ? e : i3);
                            v2 = c1 ? v1 : (c2 ? x : v2); i2 = c1 ? i1 : (c2 ? e : i2);
                            v1 = c0 ? v0 : (c1 ? x : v1); i1 = c0 ? i0 : (c1 ? e : i1);
                            v0 = c0 ? x : v0; i0 = c0 ? e : i0; } }
                    const float e1 = fast_exp(v1 - v0), e2 = fast_exp(v2 - v0), e3 = fast_exp(v3 - v0); const float inv = fast_rcp(1.0f + e1 + e2 + e3);
                    const int lt = ltok0 + 16 * g + lane; const size_t gt = (size_t)tb * 256 + lt;
                    typedef int i32x4 __attribute__((ext_vector_type(4)));
                    *(i32x4*)(TOPI + gt * 4) = (i32x4){i0, i1, i2, i3}; *(f32x4*)(TOPP + gt * 4) = (f32x4){inv, e1 * inv, e2 * inv, e3 * inv};
                    const unsigned r0 = __hip_atomic_fetch_add(LCNT + i0, 1u, __ATOMIC_RELAXED, __HIP_MEMORY_SCOPE_WORKGROUP), r1 = __hip_atomic_fetch_add(LCNT + i1, 1u, __ATOMIC_RELAXED, __HIP_MEMORY_SCOPE_WORKGROUP);
                    const unsigned r2 = __hip_atomic_fetch_add(LCNT + i2, 1u, __ATOMIC_RELAXED, __HIP_MEMORY_SCOPE_WORKGROUP), r3 = __hip_atomic_fetch_add(LCNT + i3, 1u, __ATOMIC_RELAXED, __HIP_MEMORY_SCOPE_WORKGROUP);
                    *(LAS u32x4*)(LASS + lt * 4) = (u32x4){((unsigned)i0 << 16) | r0, ((unsigned)i1 << 16) | r1, ((unsigned)i2 << 16) | r2, ((unsigned)i3 << 16) | r3};
                }
                LDS_WAIT(); asm volatile("" ::: "memory");
            }
            LDS_WAIT(); __syncthreads();
            if (tid < 32) LBASE[tid] = atomicAdd(ctl + CW_CNT + 64 * tid, (unsigned)LCNT[tid]);
            LDS_WAIT(); __syncthreads();
            for (int i = tid; i < 1024; i += NTHREADS) { const unsigned v = LASS[i]; POS[(size_t)tb * 1024 + i] = (int)(LBASE[v >> 16] + (v & 0xffffu)); }
            __syncthreads();
        }
        if (BOTH(6)) GRID_BAR();
#if MK_PHT
        if (MK_PHT == 7) phtk = __builtin_amdgcn_s_memrealtime() - pht0;
#endif
    }

    LAS int* PADSTART = (LAS int*)(lds + TBL_OFF); LAS int* TILE_E = PADSTART + 64;
    int ntiles = 0;
    {
        if (lo <= 9 && hi > 7) { PHASE_IDS(); PHASE_ARGS();
            __syncthreads();
            if (wave == 0) {
                const int cnt = lane < NE ? (int)__hip_atomic_load(ctl + CW_CNT + 64 * lane, __ATOMIC_RELAXED, __HIP_MEMORY_SCOPE_AGENT) : 0;
                const int padded = ((cnt + 255) >> 8) << 8; int incl = padded;
#pragma unroll
                for (int o = 1; o < 32; o <<= 1) { const int v = __shfl_up(incl, o); if ((lane & 31) >= o) incl += v; }
                if (lane < NE) PADSTART[lane] = incl - padded;
                if (lane == NE - 1) PADSTART[NE] = incl;
            }
            LDS_WAIT(); __syncthreads();
            for (int t = tid; t < (PADSTART[NE] >> 8); t += NTHREADS) { int e = 0;
#pragma unroll
                for (int q = 1; q < NE; ++q) e += ((PADSTART[q] >> 8) <= t) ? 1 : 0;
                TILE_E[t] = e; }
            LDS_WAIT(); __syncthreads();
            ntiles = PADSTART[NE] >> 8;
        }
    }

    if (IN(7)) for (int rep_ = 0; rep_ < 1 + ((MK_REPEAT >> 7) & 1); ++rep_) { PHASE_IDS(); PHASE_ARGS();
        const int* TOPI = WSP(int, WS_TOPI); const float* TOPP = WSP(float, WS_TOPP); int* POS = WSP(int, WS_POS); int* RTOK = WSP(int, WS_RTOK); int* RSLOT = WSP(int, WS_RSLOT); float* RW = WSP(float, WS_RW);
        for (int i = bid * NTHREADS + tid; i < NASSIGN; i += G * NTHREADS) { const int e = TOPI[i]; const int row = PADSTART[e] + POS[i]; RTOK[row] = i >> 2; RSLOT[row] = i; RW[row] = TOPP[i]; POS[i] = row; }
        for (int e = bid; e < NE; e += G) { const int cnt = (int)__hip_atomic_load(ctl + CW_CNT + 64 * e, __ATOMIC_RELAXED, __HIP_MEMORY_SCOPE_AGENT);
            for (int r = PADSTART[e] + cnt + tid; r < PADSTART[e + 1]; r += NTHREADS) { RTOK[r] = 0; RSLOT[r] = -1; RW[r] = 0.f; } }
#if MK_BG && MK_ONE_LAUNCH
        if (BOTH(7)) GRID_BAR_X(true);
#else
        if (BOTH(7)) GRID_BAR();
#endif
#if MK_PHT
        if (MK_PHT == 8) phtk = __builtin_amdgcn_s_memrealtime() - pht0;
#endif
    }

    if (IN(8)) for (int rep_ = 0; rep_ < 1 + ((MK_REPEAT >> 8) & 1); ++rep_) { PHASE_ARGS();
        gm::MoeOrder S{ntiles, 2048 / 256, G, bid, TILE_E}; gm::GatherA AM{D, WSP(int, WS_RTOK), 1}; gm::EpiSwiglu E{ARG(I_B1), WSP(unsigned char, WS_ACT), ctl + CW_TP};
        gm::gemm_phase<true>(wave_sg, lds, (const char*)WSP(char, WS_U2Q), (const char*)WSP(char, WS_W1), D, 2048, 0u, S, E, AM);
        if (BOTH(8)) GRID_BAR();
#if MK_PHT
        if (MK_PHT == 9) phtk = __builtin_amdgcn_s_memrealtime() - pht0;
#endif
    }

    if (IN(9)) for (int rep_ = 0; rep_ < 1 + ((MK_REPEAT >> 9) & 1); ++rep_) { PHASE_ARGS();
        gm::MoeOrder S{ntiles, D / 256, G, bid, TILE_E}; gm::DenseA AM{DFF, 0u, 1}; gm::EpiMoeOut E{ARG(I_B2), WSP(float, WS_RW), WSP(unsigned char, WS_YA)};
        gm::gemm_phase<true>(wave_sg, lds, (const char*)WSP(char, WS_ACT), (const char*)WSP(char, WS_W2), DFF, D, 0u, S, E, AM);
        if (BOTH(9)) GRID_BAR();
#if MK_PHT
        if (MK_PHT == 10) phtk = __builtin_amdgcn_s_memrealtime() - pht0;
#endif
    }

#if MK_PROBE
    if (lo == 100) { PHASE_IDS(); PHASE_ARGS();
        float* out = ap->out;
        const bf16_t* src = MK_PROBE == 1 ? WSP(bf16_t, WS_U) : MK_PROBE == 3 ? WSP(bf16_t, WS_O) : MK_PROBE == 4 ? WSP(bf16_t, WS_U) : MK_PROBE == 5 ? WSP(bf16_t, WS_H) : WSP(bf16_t, WS_U);
        for (size_t i = (size_t)bid * NTHREADS + tid; i < (size_t)NTOK * D; i += (size_t)G * NTHREADS) {
            float v;
            if (MK_PROBE == 3) { const size_t t = i >> 10, c = i & 1023; v = bf1(src[t * 1024 + c]); }
            else if (MK_PROBE == 2) { const size_t t = i >> 10, c = i & 1023; const bf16_t* P = WSP(bf16_t, WS_PROJ) + t * PROJ_LD; v = bf1(P[c]) + bf1(P[c + 1024]) + bf1(P[c + 2048]) + (c < 512 ? bf1(P[c + 3072]) : 0.f); }
            else if (MK_PROBE == 6) { const size_t t = i >> 10, c = i & 1023; v = bf1(src[i]) + (c < 4 ? (float)WSP(int, WS_TOPI)[t * 4 + c] : c < 8 ? WSP(float, WS_TOPP)[t * 4 + (c - 4)] : 0.f); }
            else v = bf1(src[i]);
            out[i] = v; }
    }
#endif
    if (IN(10)) { PHASE_IDS(); PHASE_ARGS();
#if MK_TPROBE
        const float tscale = 1.0f;
#elif MK_FP8TEST
        float tscale = 1.0f;
        {
            typedef int v8i __attribute__((ext_vector_type(8)));
            const int fr = lane & 15, fq = lane >> 4;
            v8i ta, tb;
#pragma unroll
            for (int d = 0; d < 8; ++d) { float av[4], bv[4];
#pragma unroll
                for (int e = 0; e < 4; ++e) { const int k = 32 * fq + 4 * d + e; av[e] = (float)(((fr * 7 + k * 3) % 5) - 2); bv[e] = (float)(((k * 5 + fr * 11) % 7) - 3); }
                int w = __builtin_amdgcn_cvt_pk_fp8_f32(av[0], av[1], 0, false); w = __builtin_amdgcn_cvt_pk_fp8_f32(av[2], av[3], w, true); ta[d] = w;
                w = __builtin_amdgcn_cvt_pk_fp8_f32(bv[0], bv[1], 0, false); w = __builtin_amdgcn_cvt_pk_fp8_f32(bv[2], bv[3], w, true); tb[d] = w; }
            f32x4 tc = {0.f, 0.f, 0.f, 0.f};
            tc = __builtin_amdgcn_mfma_scale_f32_16x16x128_f8f6f4(ta, tb, tc, 0, 0, 0, 0x7A7A7A7A, 0, 0x7F7F7F7F);
            bool bad = false;
#pragma unroll
            for (int r = 0; r < 4; ++r) { const int i = 4 * fq + r, j = fr; float ref = 0.f;
                for (int k = 0; k < 128; ++k) ref += (float)(((i * 7 + k * 3) % 5) - 2) * (float)(((k * 5 + j * 11) % 7) - 3);
                ref *= (1.0f / 32.0f); if (fabsf(tc[r] - ref) > 1e-3f) bad = true; }
            if (__any(bad)) tscale = 4.0f;
        }
#endif
        const float* norm_final_w = ARG(I_NFIN); const float* MOD = WSP(float, WS_MOD); const bf16_t* HB = WSP(bf16_t, WS_H); const unsigned char* YA = WSP(unsigned char, WS_YA); const int* ASROW = WSP(int, WS_POS); float* out = ap->out;
        for (int m0 = gw * 32; m0 < NTOK; m0 += NGW * 32) {
            const int b = m0 >> 11;
            f32x4 gf[4], nf[4];
#pragma unroll
            for (int j = 0; j < 4; ++j) { const int k = 4 * lane + 256 * j; gf[j] = *(const f32x4*)(MOD + (size_t)b * 6144 + 5120 + k); nf[j] = *(const f32x4*)(norm_final_w + k); }
            for (int r = 0; r < 32; ++r) {
                const size_t tok = (size_t)(m0 + r);
                const bf16_t* hr = HB + tok * D;
                typedef int i32x4 __attribute__((ext_vector_type(4)));
                const i32x4 rr = *(const i32x4*)(ASROW + tok * 4);
                const unsigned char* y0 = YA + (size_t)rr[0] * D; const unsigned char* y1 = YA + (size_t)rr[1] * D; const unsigned char* y2 = YA + (size_t)rr[2] * D; const unsigned char* y3 = YA + (size_t)rr[3] * D;
                f32x4 v[4]; float s = 0.f;
#pragma unroll
                for (int j = 0; j < 4; ++j) { const int k = 4 * lane + 256 * j;
                    const u32x2 hw = *(const u32x2*)(hr + k); const unsigned ya = *(const unsigned*)(y0 + k), yb = *(const unsigned*)(y1 + k), yc = *(const unsigned*)(y2 + k), yd = *(const unsigned*)(y3 + k);
                    f32x4 y = fp8x4_to_f32(ya); y += fp8x4_to_f32(yb); y += fp8x4_to_f32(yc); y += fp8x4_to_f32(yd);
                    v[j] = (f32x4){bf_lo(hw.x), bf_hi(hw.x), bf_lo(hw.y), bf_hi(hw.y)} + gf[j] * y;
                    s += (v[j][0] * v[j][0] + v[j][1] * v[j][1]) + (v[j][2] * v[j][2] + v[j][3] * v[j][3]); }
                const float rs = __builtin_amdgcn_rsqf(wave_sum(s) * (1.0f / D) + EPS);
                float* orow = out + tok * D;
#pragma unroll
                #if MK_FP8TEST || MK_TPROBE
                for (int j = 0; j < 4; ++j) *(f32x4*)(orow + 4 * lane + 256 * j) = v[j] * rs * nf[j] * tscale;
#else
                for (int j = 0; j < 4; ++j) *(f32x4*)(orow + 4 * lane + 256 * j) = v[j] * rs * nf[j];
#endif
            }
        }
    }
#if MK_PHT
    if (bid == 0) { const unsigned long long t1 = __builtin_amdgcn_s_memrealtime(); while (__builtin_amdgcn_s_memrealtime() - t1 < phtk) __builtin_amdgcn_s_sleep(8); }
#endif
#undef IN
#undef BOTH
}

extern "C" void kernel_launch(void* const* d_in, const int* in_sizes, int n_in, void* d_out, int out_size, void* d_ws, size_t ws_size, hipStream_t stream) {
    static int grid = 0;
    if (grid == 0) {
        if (n_in != 20 || out_size != NTOK * D || ws_size < WS_END) { fprintf(stderr, "kernel_launch: unexpected shapes (n_in %d out %d ws %zu)\n", n_in, out_size, ws_size); grid = -1; return; }
        if (hipFuncSetAttribute((const void*)fwd_kernel, hipFuncAttributeMaxDynamicSharedMemorySize, LDS_BYTES) != hipSuccess) { fprintf(stderr, "kernel_launch: hipFuncSetAttribute failed\n"); grid = -1; return; }
        int dev = 0, cus = 0, per_cu = 0;
        (void)hipGetDevice(&dev); (void)hipDeviceGetAttribute(&cus, hipDeviceAttributeMultiprocessorCount, dev);
        if (hipOccupancyMaxActiveBlocksPerMultiprocessor(&per_cu, (const void*)fwd_kernel, NTHREADS, LDS_BYTES) != hipSuccess || per_cu < 1) fprintf(stderr, "kernel_launch: occupancy query says %d\n", per_cu);
        (void)hipGetLastError();
        grid = cus > 0 ? cus : 256;
    }
    if (grid < 0) return;
    (void)hipMemsetAsync((char*)d_ws + WS_CTL, 0, CTL_ZERO_BYTES, stream);
    Args a{};
    for (int i = 0; i < 20; ++i) a.in[i] = (const float*)d_in[i];
    a.out = (float*)d_out; a.ws = (unsigned char*)d_ws;
#if MK_ONE_LAUNCH
    a.ph_lo = 0; a.ph_hi = NPHASE;
    hipLaunchKernelGGL(fwd_kernel, dim3(grid), dim3(NTHREADS), LDS_BYTES, stream, a);
#else
#if MK_PROBE
    for (int p = 0; p <= MK_PROBE; ++p) { a.ph_lo = p; a.ph_hi = p + 1; hipLaunchKernelGGL(fwd_kernel, dim3(grid), dim3(NTHREADS), LDS_BYTES, stream, a); }
    a.ph_lo = 100; a.ph_hi = 101; hipLaunchKernelGGL(fwd_kernel, dim3(grid), dim3(NTHREADS), LDS_BYTES, stream, a);
#else
    for (int p = 0; p < NPHASE; ++p) { a.ph_lo = p; a.ph_hi = p + 1; hipLaunchKernelGGL(fwd_kernel, dim3(grid), dim3(NTHREADS), LDS_BYTES, stream, a); }
#endif
#endif
}
```

```cpp
#include <hip/hip_runtime.h>
#include <cstdio>
#include <cstdint>

#ifndef MK_PROBE
#define MK_PROBE 0
#endif
#ifndef MK_REPEAT
#define MK_REPEAT 0
#endif
#ifndef MK_FP8TEST
#define MK_FP8TEST 0
#endif
#ifndef MK_STAGGER
#define MK_STAGGER 0
#endif
#ifndef MK_TPROBE
#define MK_TPROBE 0
#endif
#ifndef MK_PHT
#define MK_PHT 0
#endif
#ifndef MK_PN8
#define MK_PN8 14
#endif
#ifndef MK_GO8
#define MK_GO8 4
#endif
#ifndef MK_S08
#define MK_S08 4
#endif
#ifndef MK_Q8
#define MK_Q8 1
#endif
#ifndef MK_CONV_NA
#define MK_CONV_NA 6
#endif
#ifndef MK_P2FP8
#define MK_P2FP8 0
#endif
#ifndef MK_BG
#define MK_BG 0
#endif
#ifndef MK_ONE_LAUNCH
#define MK_ONE_LAUNCH 1
#endif

#define LAS __attribute__((address_space(3)))
#define GAS __attribute__((address_space(1)))
typedef unsigned short bf16_t;
typedef short bf16x8 __attribute__((ext_vector_type(8)));
typedef float f32x4 __attribute__((ext_vector_type(4)));
typedef float f32x2 __attribute__((ext_vector_type(2)));
typedef unsigned u32x4 __attribute__((ext_vector_type(4)));
typedef unsigned u32x2 __attribute__((ext_vector_type(2)));
typedef int v8i __attribute__((ext_vector_type(8)));

constexpr int D = 1024, BATCH = 32, SEQ = 2048, NTOK = BATCH * SEQ;
constexpr int HW = 512, NHEAD = 4, DK = 128, CHUNK = 64, NCHUNK = SEQ / CHUNK;
constexpr int INC = 5632, PROJ_LD = 3584, GATE_LD = 2048;
constexpr int NE = 32, TOPK = 4, DFF = 1024, NASSIGN = NTOK * TOPK;
constexpr int MAXTILES = NASSIGN / 256 + NE;
constexpr int MAXROWS = MAXTILES * 256;
constexpr float EPS = 1e-6f, SW_LIMIT = 7.0f, SW_ALPHA = 1.702f;
constexpr int NWAVES = 8, NTHREADS = 512;
constexpr int NPHASE = 11;

constexpr size_t MiB = 1u << 20;
constexpr size_t WS_CTL = 0, CTL_ZERO_BYTES = 65536;
constexpr size_t WS_MOD = 1 * MiB;
constexpr size_t WS_LB = WS_MOD + 32 * 6144 * 4;
constexpr size_t WS_WIN = 2 * MiB;
constexpr size_t WS_WHG = 13 * MiB, WS_WCV = 14 * MiB, WS_WMIX = 15 * MiB;
constexpr size_t WS_W2 = 18 * MiB;
constexpr size_t WS_W1 = 50 * MiB;
constexpr size_t WS_U2Q = 114 * MiB;
constexpr size_t WS_U = 210 * MiB;
constexpr size_t WS_PROJ = 338 * MiB;
constexpr size_t WS_O = 786 * MiB;
constexpr size_t WS_CV = 850 * MiB;
constexpr size_t WS_H = 338 * MiB;
constexpr size_t WS_ACT = 466 * MiB;
constexpr size_t WS_TOPI = 994 * MiB, WS_TOPP = 995 * MiB, WS_POS = 996 * MiB;
constexpr size_t WS_RTOK = 997 * MiB, WS_RSLOT = 997 * MiB + 1081344 + 0, WS_RW = WS_RSLOT + 1081344;
constexpr size_t WS_YA = 50 * MiB, WS_YB = 730 * MiB; constexpr int YSPLIT = 147456;
constexpr size_t WS_YO23_UNUSED = 730 * MiB;
constexpr int PN8 = MK_PN8 - MK_GO8 - (MK_Q8 ? 2 : 0), NQ8 = 22 - PN8;
__host__ __device__ constexpr int map16(int j) { return MK_Q8 ? (j < 2 ? 2 + j : 6 + j) : (j >= MK_S08 ? j + MK_GO8 : j); }
__host__ __device__ constexpr int map8(int j) { return MK_Q8 ? (j < 2 ? j : j < 6 ? j + 2 : j + 8) : (j < MK_GO8 ? MK_S08 + j : MK_PN8 - MK_GO8 + j); }
constexpr size_t WS_WIN8 = 914 * MiB;
constexpr size_t WS_U8 = 920 * MiB;
constexpr size_t WS_RAW = WS_U, WS_QBG = WS_U + 64 * MiB, WS_STATE = WS_U + 96 * MiB, WS_DECG = WS_U + 104 * MiB;
constexpr size_t WS_END = 1001 * MiB;
static_assert(WS_RW + 1081344 <= WS_END && MAXROWS * 4 == 1081344, "tables");
static_assert(WS_ACT + (size_t)MAXROWS * 1024 <= WS_YB && WS_YB + (size_t)(MAXROWS - YSPLIT) * 2048 <= WS_TOPI && WS_YA + (size_t)YSPLIT * 2048 <= WS_H && YSPLIT % 256 == 0, "expert output map");
constexpr int CW_TMO = 0, CW_BAR = 4096, CW_CNT = 8192, CW_TP = 12288, CW_Q = 12544, CW_ST = 14336;

constexpr int LDS_BYTES = 163840;
constexpr int MISC_OFF = LDS_BYTES - 256;
constexpr int TBL_OFF = 135168;
constexpr int SIDE_OFF = TBL_OFF + 8192;

#define LDS_WAIT() asm volatile("s_waitcnt lgkmcnt(0)" ::: "memory")
#define VM_WAIT() asm volatile("s_waitcnt vmcnt(0)" ::: "memory")
typedef __bf16 bf16x2_t __attribute__((ext_vector_type(2)));
__device__ __forceinline__ unsigned cvt_pk_bf16(float lo, float hi) { const f32x2 v = {lo, hi}; const bf16x2_t b = __builtin_convertvector(v, bf16x2_t); return __builtin_bit_cast(unsigned, b); }
__device__ __forceinline__ unsigned pk4_fp8(float a, float b, float c, float d) {
    a = fminf(fmaxf(a, -448.f), 448.f); b = fminf(fmaxf(b, -448.f), 448.f); c = fminf(fmaxf(c, -448.f), 448.f); d = fminf(fmaxf(d, -448.f), 448.f);
    int w = __builtin_amdgcn_cvt_pk_fp8_f32(a, b, 0, false); w = __builtin_amdgcn_cvt_pk_fp8_f32(c, d, w, true); return (unsigned)w; }
__device__ __forceinline__ f32x4 fp8x4_to_f32(unsigned w) {
    const f32x2 lo = __builtin_amdgcn_cvt_pk_f32_fp8((int)w, false), hi = __builtin_amdgcn_cvt_pk_f32_fp8((int)w, true); return (f32x4){lo[0], lo[1], hi[0], hi[1]}; }
__device__ __forceinline__ unsigned pk4_fp8_nc(float a, float b, float c, float d) {
    int w = __builtin_amdgcn_cvt_pk_fp8_f32(a, b, 0, false); w = __builtin_amdgcn_cvt_pk_fp8_f32(c, d, w, true); return (unsigned)w; }
__device__ __forceinline__ float bf_lo(unsigned u) { return __uint_as_float(u << 16); }
__device__ __forceinline__ float bf_hi(unsigned u) { return __uint_as_float(u & 0xffff0000u); }
__device__ __forceinline__ float bf1(bf16_t u) { return __uint_as_float(((unsigned)u) << 16); }
__device__ __forceinline__ float fast_rcp(float x) { return __builtin_amdgcn_rcpf(x); }
__device__ __forceinline__ float fast_exp(float x) { return __builtin_amdgcn_exp2f(x * 1.44269504089f); }
__device__ __forceinline__ float fast_log(float x) { return __builtin_amdgcn_logf(x) * 0.69314718056f; }
__device__ __forceinline__ float sigmoidf_(float x) { return fast_rcp(1.0f + fast_exp(-x)); }
__device__ __forceinline__ float wave_sum(float v) {
#pragma unroll
    for (int o = 1; o < 64; o <<= 1) v += __shfl_xor(v, o);
    return v;
}

#define XB_TMO      128
#define XB_XCNT(j)  (256  + 64 * (j))
#define XB_XSUB(j)  (1280 + 64 * (j))
#define XB_XGEN(j)  (2304 + 64 * (j))
#define XB_TOP      3328
#define XB_TOPGEN   3392
#define XCD_BAR_WORDS 3456
#define XB_SPIN_CAP (1u << 20)
__device__ __forceinline__ unsigned xb_ld(unsigned* p)              { return __hip_atomic_load(p, __ATOMIC_RELAXED, __HIP_MEMORY_SCOPE_AGENT); }
__device__ __forceinline__ unsigned xb_add(unsigned* p, unsigned v) { return __hip_atomic_fetch_add(p, v, __ATOMIC_RELAXED, __HIP_MEMORY_SCOPE_AGENT); }
__device__ __forceinline__ unsigned xb_xcc_id() { return (unsigned)__builtin_amdgcn_s_getreg((3 << 11) | 20) & 0xFu; }
#define XB_SPIN(cond, bar) do { unsigned _sp = 0; while (cond) { __builtin_amdgcn_s_sleep(1); \
    if ((++_sp & 255u) == 0u) { if (xb_ld(&(bar)[XB_TMO])) break; if (_sp > XB_SPIN_CAP) { atomicAdd(&(bar)[XB_TMO], 1u); break; } } } } while (0)
struct XcdBarrier { unsigned* bar; unsigned x; volatile LAS unsigned* st; };
__device__ __forceinline__ XcdBarrier xcd_barrier_post(unsigned* bar, volatile LAS unsigned* st) {
    XcdBarrier b; b.bar = bar; b.x = xb_xcc_id(); b.st = st;
    if (threadIdx.x == 0) (void)xb_add(&bar[XB_XCNT(b.x)], 1u);
    return b;
}
__device__ __forceinline__ void xcd_barrier_complete(unsigned* bar, unsigned x, unsigned& nloc, unsigned& nx) {
    const unsigned G = gridDim.x * gridDim.y * gridDim.z;
    unsigned sum, cnt, mine, sp = 0u;
    for (;;) {
        sum = 0u; cnt = 0u; mine = 0u;
#pragma unroll
        for (unsigned j = 0; j < 16; ++j) { const unsigned c = xb_ld(&bar[XB_XCNT(j)]); sum += c; cnt += (c > 0u) ? 1u : 0u; mine = (j == x) ? c : mine; }
        if (sum == G) break;
        __builtin_amdgcn_s_sleep(1);
        if ((++sp & 255u) == 0u) { if (xb_ld(&bar[XB_TMO])) break; if (sp > XB_SPIN_CAP) { atomicAdd(&bar[XB_TMO], 1u); break; } }
    }
    nloc = mine > 0u ? mine : 1u; nx = cnt > 0u ? cnt : 1u;
}
__device__ __forceinline__ void xcd_barrier(const XcdBarrier& b) {
    asm volatile("s_waitcnt vmcnt(0)" ::: "memory");
    __syncthreads();
    if (threadIdx.x == 0) {
        unsigned* bar = b.bar;
        __builtin_amdgcn_s_waitcnt(0);
        unsigned nloc = b.st[0], nx = b.st[1];
        if (nloc == 0u) { xcd_barrier_complete(bar, b.x, nloc, nx); b.st[0] = nloc; b.st[1] = nx; }
        const unsigned old = xb_add(&bar[XB_XSUB(b.x)], 1u);
        const unsigned gen = old / nloc;
        if (old + 1u == (gen + 1u) * nloc) {
            __builtin_amdgcn_fence(__ATOMIC_RELEASE, "agent");
            asm volatile("s_waitcnt vmcnt(0)" ::: "memory");
            const unsigned og = xb_add(&bar[XB_TOP], 1u);
            const unsigned tg = og / nx;
            if (og + 1u == (tg + 1u) * nx) xb_add(&bar[XB_TOPGEN], 1u);
            else XB_SPIN(xb_ld(&bar[XB_TOPGEN]) == tg, bar);
            __builtin_amdgcn_fence(__ATOMIC_ACQUIRE, "agent");
            xb_add(&bar[XB_XGEN(b.x)], 1u);
            asm volatile("s_waitcnt vmcnt(0)" ::: "memory");
        } else {
            XB_SPIN(xb_ld(&bar[XB_XGEN(b.x)]) == gen, bar);
            __builtin_amdgcn_fence(__ATOMIC_ACQUIRE, "agent");
            asm volatile("s_waitcnt vmcnt(0)" ::: "memory");
        }
    }
    __syncthreads();
}

namespace gm {
constexpr int BM = 256, BK = 64, HALF = 128, HTB = HALF * BK * 2, STAGE_BYTES = 8 * HTB, NXCD = 8, WGM = 8;
__device__ __forceinline__ int lds_byte(int r, int c) { const int st = (r >> 4) * 2 + (c >> 5), rr = r & 15, cc = c & 31, ob = rr * 64 + cc * 2; return st * 1024 + (ob ^ (((ob >> 9) & 1) << 5)); }
__device__ __forceinline__ void stage_rc(int b, int& R, int& C) { const int st = b / 1024, sb = b % 1024, swz = sb ^ (((sb >> 9) & 1) << 5); R = (st >> 1) * 16 + swz / 64; C = (st & 1) * 32 + (swz % 64) / 2; }
__device__ __forceinline__ int perm32(int rho) { const int n = rho >> 4, i = rho & 15; return 8 * (i >> 2) + 4 * n + (i & 3); }

struct Unit { int pm, pn, e, sub; };

__device__ __forceinline__ bool tile_order(int nM, int nN, int L, int& pm, int& pn) {
    const int nwg = nM * nN; if (L >= nwg) return false;
    int wgid = (int)L; { const int q = nwg / NXCD, r = nwg % NXCD, xcd = wgid % NXCD, off = wgid / NXCD; wgid = (xcd < r ? xcd * (q + 1) : r * (q + 1) + (xcd - r) * q) + off; }
    const int nig = WGM * nN, gid = wgid / nig, fm = gid * WGM, gsz = (nM - fm) < WGM ? (nM - fm) : WGM;
    pm = fm + ((wgid % nig) % gsz); pn = (wgid % nig) / gsz; return true;
}
struct DenseOrder {
    int nM, nN, G, c, nsub;
    __device__ __forceinline__ bool next(int i, Unit& u) const { const int ti = i / nsub; u.sub = i - ti * nsub; u.e = 0; return tile_order(nM, nN, ti * G + c, u.pm, u.pn); }
};
struct MoeOrder {
    int nM, nN, G, c; const LAS int* tile_e;
    __device__ __forceinline__ bool next(int i, Unit& u) const { u.sub = 0; if (!tile_order(nM, nN, i * G + c, u.pm, u.pn)) return false; u.e = tile_e[u.pm]; return true; }
};
struct DenseA { int K; unsigned sub_stride; int ES;
    __device__ __forceinline__ void offsets(const Unit& u, int tid, unsigned (&o)[2][2]) const {
#pragma unroll
        for (int i = 0; i < 2; ++i) { int R, C; stage_rc(tid * 16 + i * 8192, R, C);
#pragma unroll
            for (int h = 0; h < 2; ++h) o[h][i] = (unsigned)((u.pm * BM + h * HALF + R) * K * ES + C * 2) + (unsigned)u.sub * sub_stride; } }
    static constexpr bool GATHER = false;
    __device__ __forceinline__ const char* tok_ptr(const Unit&) const { return nullptr; }
    __device__ __forceinline__ void next_offsets(const Unit& u, int tid, unsigned (&o)[2][2], const LAS int*) const { offsets(u, tid, o); } };
struct GatherA { int K; const int* row_tok; int ES;
    __device__ __forceinline__ void offsets(const Unit& u, int tid, unsigned (&o)[2][2]) const {
#pragma unroll
        for (int i = 0; i < 2; ++i) { int R, C; stage_rc(tid * 16 + i * 8192, R, C);
#pragma unroll
            for (int h = 0; h < 2; ++h) { const int tok = row_tok[u.pm * BM + h * HALF + R]; o[h][i] = (unsigned)(tok * K * ES + C * 2); } } }
    static constexpr bool GATHER = true;
    __device__ __forceinline__ const char* tok_ptr(const Unit& u) const { return (const char*)(row_tok + u.pm * BM); }
    __device__ __forceinline__ void next_offsets(const Unit&, int tid, unsigned (&o)[2][2], const LAS int* stok) const {
#pragma unroll
        for (int i = 0; i < 2; ++i) { int R, C; stage_rc(tid * 16 + i * 8192, R, C);
#pragma unroll
            for (int h = 0; h < 2; ++h) { const int tok = stok[h * HALF + R]; o[h][i] = (unsigned)(tok * K * ES + C * 2); } } } };

template <bool FP8, class Epi, class Sched, class AMap>
__device__ __forceinline__ void gemm_phase(int wave_sg, LAS unsigned char* lds, const char* Abase, const char* Bbase, int K, int Nb, unsigned b_sub_stride, const Sched& S, const Epi& E, const AMap& AM) {
    int lane; asm volatile("v_mbcnt_lo_u32_b32 %0, -1, 0\n\tv_mbcnt_hi_u32_b32 %0, -1, %0" : "=v"(lane));
    const int wid = wave_sg, tid = wid * 64 + lane, wr = wid >> 2, wc = wid & 3, fr = lane & 15, fq = lane >> 4;
    constexpr int ES = FP8 ? 1 : 2;
    const int nt = K * ES / (BK * 2);
    unsigned voffB[2];
#pragma unroll
    for (int i = 0; i < 2; ++i) { int R, C; stage_rc(tid * 16 + i * 8192, R, C); const int Rb = (R & ~31) + perm32(R & 31); voffB[i] = (unsigned)(Rb * K * ES + C * 2); }
    const size_t kstep = (size_t)(BK * 2);
    const size_t hstep = (size_t)HALF * K * ES;
    const unsigned ldsw = (unsigned)wid * 1024u;
    const int aoff = lds_byte(wr * 64 + fr, fq * 8), boff = lds_byte(wc * 32 + fr, fq * 8);
#define G_SA(b, h) (((b) * 2 + (h)) * HTB)
#define G_SB(b, h) ((4 + (b) * 2 + (h)) * HTB)
#define G_STAGE(bufoff, gbase, voff) do { _Pragma("unroll") for (int _i = 0; _i < 2; ++_i) \
        __builtin_amdgcn_global_load_lds((const unsigned*)((const char*)(gbase) + (voff)[_i]), (LAS unsigned*)(lds + (bufoff) + ldsw + _i * 8192), 16, 0, 0); } while (0)
#define G_LDA(dst, b, h) do { _Pragma("unroll") for (int m = 0; m < 4; ++m) _Pragma("unroll") for (int k = 0; k < 2; ++k) dst[m][k] = *(const LAS bf16x8*)(lds + G_SA(b, h) + aoff + m * 2048 + k * 1024); } while (0)
#define G_LDB(dst, b, h) do { _Pragma("unroll") for (int n = 0; n < 2; ++n) _Pragma("unroll") for (int k = 0; k < 2; ++k) dst[n][k] = *(const LAS bf16x8*)(lds + G_SB(b, h) + boff + n * 2048 + k * 1024); } while (0)
#define G_MMA(ai, bj, At, Bt) do { __builtin_amdgcn_s_setprio(1); _Pragma("unroll") for (int m = 0; m < 4; ++m) _Pragma("unroll") for (int n = 0; n < 2; ++n) _Pragma("unroll") for (int k = 0; k < 2; ++k) \
        acc[ai][bj][m][n] = __builtin_amdgcn_mfma_f32_16x16x32_bf16(Bt[n][k], At[m][k], acc[ai][bj][m][n], 0, 0, 0); __builtin_amdgcn_s_setprio(0); } while (0)
#define G_LD8(dst, off) do { const u32x4 _l = *(const LAS u32x4*)(lds + (off)), _h = *(const LAS u32x4*)(lds + (off) + 1024); dst = (v8i){(int)_l.x, (int)_l.y, (int)_l.z, (int)_l.w, (int)_h.x, (int)_h.y, (int)_h.z, (int)_h.w}; } while (0)
#define G_LDA8(dst, b, h) do { _Pragma("unroll") for (int m = 0; m < 4; ++m) G_LD8(dst[m], G_SA(b, h) + aoff + m * 2048); } while (0)
#define G_LDB8(dst, b, h) do { _Pragma("unroll") for (int n = 0; n < 2; ++n) G_LD8(dst[n], G_SB(b, h) + boff + n * 2048); } while (0)
#define G_MMA8(ai, bj, At, Bt) do { __builtin_amdgcn_s_setprio(1); _Pragma("unroll") for (int m = 0; m < 4; ++m) _Pragma("unroll") for (int n = 0; n < 2; ++n) \
        acc[ai][bj][m][n] = __builtin_amdgcn_mfma_scale_f32_16x16x128_f8f6f4(Bt[n], At[m], acc[ai][bj][m][n], 0, 0, 0, 0x7F7F7F7F, 0, 0x7F7F7F7F); __builtin_amdgcn_s_setprio(0); } while (0)
#define G_PIN(ai, bj) asm volatile("" :: "v"(acc[ai][bj][0][0][0]), "v"(acc[ai][bj][0][1][0]), "v"(acc[ai][bj][1][0][0]), "v"(acc[ai][bj][1][1][0]), "v"(acc[ai][bj][2][0][0]), "v"(acc[ai][bj][2][1][0]), "v"(acc[ai][bj][3][0][0]), "v"(acc[ai][bj][3][1][0]) : "memory")
#define G_WAIT_V(n) asm volatile("s_waitcnt vmcnt(" #n ")" ::: "memory")
#define G_WAIT_L(n) asm volatile("s_waitcnt lgkmcnt(" #n ")" ::: "memory")
#define G_WAIT_VS() do { if (fi) { if (Epi::NST == 16) G_WAIT_V(24); else if (Epi::NST == 8) G_WAIT_V(16); else G_WAIT_V(8); } else G_WAIT_V(8); } while (0)
#define G_BAR __builtin_amdgcn_s_barrier()
#define G_SCHED __builtin_amdgcn_sched_barrier(0)
    Unit cur, nxt; int ui = 0;
#if MK_TPROBE
    unsigned long long tp_c = 0; const unsigned long long tp_c0 = __builtin_amdgcn_s_memtime(), tp_r0 = __builtin_amdgcn_s_memrealtime();
#endif
    if (!S.next(0, cur)) return;
#if MK_STAGGER
    {
        const unsigned long long t0 = __builtin_amdgcn_s_memrealtime(); const unsigned long long dly = (unsigned long long)(blockIdx.x & 7) * MK_STAGGER;
        while (__builtin_amdgcn_s_memrealtime() - t0 < dly) __builtin_amdgcn_s_sleep(8);
    }
#endif
    unsigned rA[2][2];
    AM.offsets(cur, tid, rA);
    const char* cB = Bbase + ((size_t)cur.e * Nb + (size_t)cur.pn * BM) * K * ES + (size_t)cur.sub * b_sub_stride;
    G_STAGE(G_SB(0, 0), cB, voffB); G_STAGE(G_SB(0, 1), cB + hstep, voffB); G_STAGE(G_SA(0, 0), Abase, rA[0]); G_STAGE(G_SA(0, 1), Abase, rA[1]);
    if (wr == 1) G_BAR;
    G_WAIT_V(2); G_BAR;
    G_STAGE(G_SB(1, 0), cB + kstep, voffB); G_STAGE(G_SA(1, 0), Abase + kstep, rA[0]); G_STAGE(G_SB(1, 1), cB + hstep + kstep, voffB);
    G_WAIT_V(6); G_BAR;
    f32x4 acc[2][2][4][2];
#pragma unroll
    for (int a = 0; a < 2; ++a)
#pragma unroll
        for (int b = 0; b < 2; ++b)
#pragma unroll
            for (int m = 0; m < 4; ++m)
#pragma unroll
                for (int n = 0; n < 2; ++n) acc[a][b][m][n] = (f32x4){0.f, 0.f, 0.f, 0.f};
    for (;;) {
        const bool has_next = S.next(ui + 1, nxt);
        const char* nB = has_next ? Bbase + ((size_t)nxt.e * Nb + (size_t)nxt.pn * BM) * K * ES + (size_t)nxt.sub * b_sub_stride : cB;
#if MK_TPROBE
        unsigned long long tp_a = 0; if (Epi::TPROBE && wid == 0) { tp_a = __builtin_amdgcn_s_memrealtime(); if (ui > 0 && lane == 0) { volatile LAS unsigned* M = (volatile LAS unsigned*)(lds + MISC_OFF); M[19] += (unsigned)(tp_a - tp_c); } }
#endif
        if (wid == 0) {
            int l16 = lane * 16; asm volatile("" : "+v"(l16));
#pragma unroll
            for (int k = 0; k < Epi::NSB; ++k) { const char* sp = E.sb_ptr(cur, k); if (l16 < 16 * E.sb_lanes(k)) __builtin_amdgcn_global_load_lds((const unsigned*)(sp + l16), (LAS unsigned*)(lds + SIDE_OFF + (ui & 1) * 4096 + 1024 * (k + 1)), 16, 0, 0); }
            if (AMap::GATHER && has_next) __builtin_amdgcn_global_load_lds((const unsigned*)(AM.tok_ptr(nxt) + l16), (LAS unsigned*)(lds + SIDE_OFF + ((ui + 1) & 1) * 4096), 16, 0, 0);
        }
#pragma nounroll
        for (int t = 0; t < nt; t += 2) {
            if constexpr (Epi::HAS_MID) { if (t == nt / 2) { int lz = lane; asm volatile("" : "+v"(lz)); E.mid(acc, cur, wr, wc, lz & 15, lz >> 4); } }
            bf16x8 At[4][2], B0[2][2], B1[2][2];
            v8i At8[4], B08[2], B18[2];
            const bool last = (t == nt - 2);
            constexpr bool fi = false;
            const char* b2 = last ? nB : cB + (size_t)(t + 2) * kstep; const char* b3 = b2 + kstep;
            if constexpr (FP8) { G_LDB8(B08, 0, 0); G_LDB8(B18, 0, 1); G_SCHED; G_LDA8(At8, 0, 0); } else { G_LDB(B0, 0, 0); G_LDB(B1, 0, 1); G_SCHED; G_LDA(At, 0, 0); }
            G_STAGE(G_SA(1, 1), Abase + (size_t)(t + 1) * kstep, rA[1]);
            G_WAIT_VS(); G_WAIT_L(0); G_BAR;
            if constexpr (FP8) { G_MMA8(0, 0, At8, B08); G_MMA8(0, 1, At8, B18); } else { G_MMA(0, 0, At, B0); G_MMA(0, 1, At, B1); }
            if constexpr (FP8) { G_PIN(0, 0); G_PIN(0, 1); }
            G_BAR; G_SCHED;
            if (last && has_next) { int tz = tid; asm volatile("" : "+v"(tz)); AM.next_offsets(nxt, tz, rA, (const LAS int*)(lds + SIDE_OFF + ((ui + 1) & 1) * 4096)); }
            const char* a2 = Abase + (last ? (size_t)0 : (size_t)(t + 2) * kstep);
            if constexpr (FP8) { G_LDA8(At8, 0, 1); } else { G_LDA(At, 0, 1); }
            G_STAGE(G_SB(0, 0), b2, voffB); G_STAGE(G_SB(0, 1), b2 + hstep, voffB); G_STAGE(G_SA(0, 0), a2, rA[0]);
            G_WAIT_VS(); G_WAIT_L(0); G_BAR;
            if constexpr (FP8) { G_MMA8(1, 0, At8, B08); G_MMA8(1, 1, At8, B18); } else { G_MMA(1, 0, At, B0); G_MMA(1, 1, At, B1); }
            if constexpr (FP8) { G_PIN(1, 0); G_PIN(1, 1); }
            G_BAR; G_SCHED;
            if constexpr (FP8) { G_LDB8(B08, 1, 0); G_LDB8(B18, 1, 1); G_SCHED; G_LDA8(At8, 1, 0); } else { G_LDB(B0, 1, 0); G_LDB(B1, 1, 1); G_SCHED; G_LDA(At, 1, 0); }
            G_STAGE(G_SA(0, 1), a2, rA[1]);
            G_WAIT_VS(); G_WAIT_L(0); G_BAR;
            if constexpr (FP8) { G_MMA8(0, 0, At8, B08); G_MMA8(0, 1, At8, B18); } else { G_MMA(0, 0, At, B0); G_MMA(0, 1, At, B1); }
            if constexpr (FP8) { G_PIN(0, 0); G_PIN(0, 1); }
            G_BAR; G_SCHED;
            if constexpr (FP8) { G_LDA8(At8, 1, 1); } else { G_LDA(At, 1, 1); }
            G_STAGE(G_SB(1, 0), b3, voffB); G_STAGE(G_SB(1, 1), b3 + hstep, voffB); G_STAGE(G_SA(1, 0), a2 + kstep, rA[0]);
            G_WAIT_VS(); G_WAIT_L(0); G_BAR;
            if constexpr (FP8) { G_MMA8(1, 0, At8, B08); G_MMA8(1, 1, At8, B18); } else { G_MMA(1, 0, At, B0); G_MMA(1, 1, At, B1); }
            if constexpr (FP8) { G_PIN(1, 0); G_PIN(1, 1); }
            G_BAR; G_SCHED;
        }
#if MK_TPROBE
        unsigned long long tp_b = 0; if (Epi::TPROBE && wid == 0) tp_b = __builtin_amdgcn_s_memrealtime();
#endif
        if (wr == 0) G_BAR;
        { int lz = lane; asm volatile("" : "+v"(lz));
          E(acc, cur, wr, wc, lz & 15, lz >> 4, (const LAS unsigned char*)(lds + SIDE_OFF + (ui & 1) * 4096 + 1024)); }
#if MK_TPROBE
        if (Epi::TPROBE && wid == 0) { tp_c = __builtin_amdgcn_s_memrealtime(); if (lane == 0) { volatile LAS unsigned* M = (volatile LAS unsigned*)(lds + MISC_OFF); M[16] += (unsigned)(tp_b - tp_a); M[17] += (unsigned)(tp_c - tp_b); M[18] += 1u; } }
#endif
        if (!has_next) break;
        if (!E.keep(cur)) {
#pragma unroll
            for (int a = 0; a < 2; ++a)
#pragma unroll
                for (int b = 0; b < 2; ++b)
#pragma unroll
                    for (int m = 0; m < 4; ++m)
#pragma unroll
                        for (int n = 0; n < 2; ++n) acc[a][b][m][n] = (f32x4){0.f, 0.f, 0.f, 0.f};
        }
        cur = nxt; cB = nB; ++ui;
        if (wr == 1) G_BAR;
    }
    G_WAIT_V(0);
    G_BAR;
#if MK_TPROBE
    if constexpr (Epi::TPROBE) if (wid == 0) { volatile LAS unsigned* M = (volatile LAS unsigned*)(lds + MISC_OFF);
        const unsigned long long t0 = __builtin_amdgcn_s_memrealtime();
        const unsigned long long d = MK_TPROBE == 4 ? 10000ull * (__builtin_amdgcn_s_memtime() - tp_c0) / (t0 - tp_r0)
                                   : 4ull * (unsigned long long)(MK_TPROBE == 1 ? M[16] : MK_TPROBE == 2 ? M[17] : M[19]);
        while (__builtin_amdgcn_s_memrealtime() - t0 < d) __builtin_amdgcn_s_sleep(8); }
#endif
#undef G_SA
#undef G_SB
#undef G_STAGE
#undef G_LDA
#undef G_LDB
#undef G_MMA
#undef G_LD8
#undef G_LDA8
#undef G_LDB8
#undef G_MMA8
#undef G_WAIT_V
#undef G_PIN
#undef G_WAIT_VS
#undef G_WAIT_L
#undef G_BAR
#undef G_SCHED
}

__device__ __forceinline__ u32x4 pack8(const f32x4& v0, const f32x4& v1) { u32x4 w; w.x = cvt_pk_bf16(v0[0], v0[1]); w.y = cvt_pk_bf16(v0[2], v0[3]); w.z = cvt_pk_bf16(v1[0], v1[1]); w.w = cvt_pk_bf16(v1[2], v1[3]); return w; }
__device__ __forceinline__ void unpack8(const u32x4& w, f32x4& v0, f32x4& v1) { v0 = (f32x4){bf_lo(w.x), bf_hi(w.x), bf_lo(w.y), bf_hi(w.y)}; v1 = (f32x4){bf_lo(w.z), bf_hi(w.z), bf_lo(w.w), bf_hi(w.w)}; }

template <bool F8>
struct EpiProjT {
    static constexpr bool HAS_MID = false;
    static constexpr float PSC = F8 ? (1.0f / 32.0f) : 1.0f;
    bf16_t* proj; bf16_t* gates; const float* lb;
    static constexpr int NSB = 0, NST = 16; static constexpr bool TPROBE = false;
    __device__ __forceinline__ const char* sb_ptr(const Unit&, int) const { return nullptr; }
    __device__ __forceinline__ int sb_lanes(int) const { return 0; }
    __device__ __forceinline__ bool keep(const Unit&) const { return false; }
    __device__ __forceinline__ void operator()(f32x4 (&acc)[2][2][4][2], const Unit& u, int wr, int wc, int fr, int fq, const LAS unsigned char* side) const {
        const int row0 = u.pm * BM + wr * 64 + fr, pn = F8 ? map8(u.pn) : map16(u.pn);
        if (pn >= 10) {
            const bool isg = pn >= 14; const int q = isg ? pn - 14 : pn - 10; const int c0 = q * HALF + wc * 32 + 8 * fq;
#pragma unroll
            for (int ai = 0; ai < 2; ++ai)
#pragma unroll
                for (int m = 0; m < 4; ++m) { const size_t r = (size_t)(row0 + ai * HALF + m * 16);
                    f32x4 a0 = acc[ai][0][m][0] * PSC, a1 = acc[ai][0][m][1] * PSC, b0 = acc[ai][1][m][0] * PSC, b1 = acc[ai][1][m][1] * PSC;
                    if (isg) {
#pragma unroll
                        for (int j = 0; j < 4; ++j) { b0[j] = sigmoidf_(b0[j]); b1[j] = sigmoidf_(b1[j]); a0[j] = sigmoidf_(a0[j]) * fast_rcp(fmaxf(b0[j], 1e-30f)); a1[j] = sigmoidf_(a1[j]) * fast_rcp(fmaxf(b1[j], 1e-30f)); }
                        *(u32x4*)(gates + r * GATE_LD + c0) = pack8(a0, a1); *(u32x4*)(gates + r * GATE_LD + 1024 + c0) = pack8(b0, b1);
                    } else {
                        *(u32x4*)(proj + r * PROJ_LD + 2560 + c0) = pack8(a0 * b0, a1 * b1);
                    } }
            return;
        }
        bf16_t* base = proj; const int ldc = PROJ_LD, colt = pn * BM, kind = (pn == 2 || pn == 3) ? 1 : 0;
        const int col0 = colt + wc * 32 + 8 * fq;
        f32x4 lbv[2][2];
        if (kind == 1) {
#pragma unroll
            for (int bj = 0; bj < 2; ++bj) { const float* lp = lb + (pn - 2) * BM + bj * HALF + wc * 32 + 8 * fq; lbv[bj][0] = *(const f32x4*)lp; lbv[bj][1] = *(const f32x4*)(lp + 4); }
        }
#pragma unroll
        for (int ai = 0; ai < 2; ++ai)
#pragma unroll
            for (int m = 0; m < 4; ++m) { bf16_t* rowp = base + (size_t)(row0 + ai * HALF + m * 16) * ldc + col0;
#pragma unroll
                for (int bj = 0; bj < 2; ++bj) { f32x4 v0 = acc[ai][bj][m][0] * PSC, v1 = acc[ai][bj][m][1] * PSC;
                    if (kind == 1) {
#pragma unroll
                        for (int j = 0; j < 4; ++j) { const float l0 = lbv[bj][0][j], l1 = lbv[bj][1][j];
                            v0[j] = fast_log(l0 + (1.0f - l0) * sigmoidf_(v0[j])); v1[j] = fast_log(l1 + (1.0f - l1) * sigmoidf_(v1[j])); }
                    }
                    *(u32x4*)(rowp + bj * HALF) = pack8(v0, v1); } }
    }
};
struct EpiMerge {
    static constexpr bool HAS_MID = true;
    const bf16_t* gates; bf16_t* out;
    static constexpr int NSB = 0, NST = 0; static constexpr bool TPROBE = false;
    __device__ __forceinline__ const char* sb_ptr(const Unit&, int) const { return nullptr; }
    __device__ __forceinline__ int sb_lanes(int) const { return 0; }
    __device__ __forceinline__ bool keep(const Unit&) const { return false; }
    __device__ __forceinline__ void mid(f32x4 (&acc)[2][2][4][2], const Unit& u, int wr, int wc, int fr, int fq) const {
        const int row0 = u.pm * BM + wr * 64 + fr, col0 = u.pn * BM + wc * 32 + 8 * fq;
#pragma unroll
        for (int ai = 0; ai < 2; ++ai) {
            u32x4 ga[4][2];
#pragma unroll
            for (int m = 0; m < 4; ++m) { const bf16_t* gp = gates + (size_t)(row0 + ai * HALF + m * 16) * GATE_LD + col0;
#pragma unroll
                for (int bj = 0; bj < 2; ++bj) ga[m][bj] = *(const u32x4*)(gp + bj * HALF); }
#pragma unroll
            for (int m = 0; m < 4; ++m)
#pragma unroll
                for (int bj = 0; bj < 2; ++bj) { f32x4 a0, a1; unpack8(ga[m][bj], a0, a1); acc[ai][bj][m][0] *= a0; acc[ai][bj][m][1] *= a1; }
            asm volatile("" ::: "memory"); }
    }
    __device__ __forceinline__ void operator()(f32x4 (&acc)[2][2][4][2], const Unit& u, int wr, int wc, int fr, int fq, const LAS unsigned char* side) const {
        const int row0 = u.pm * BM + wr * 64 + fr, col0 = u.pn * BM + wc * 32 + 8 * fq;
#pragma unroll
        for (int ai = 0; ai < 2; ++ai) {
            u32x4 gb[4][2];
#pragma unroll
            for (int m = 0; m < 4; ++m) { const bf16_t* gp = gates + (size_t)(row0 + ai * HALF + m * 16) * GATE_LD + col0;
#pragma unroll
                for (int bj = 0; bj < 2; ++bj) gb[m][bj] = *(const u32x4*)(gp + 1024 + bj * HALF); }
#pragma unroll
            for (int m = 0; m < 4; ++m) { const size_t r = (size_t)(row0 + ai * HALF + m * 16);
#pragma unroll
                for (int bj = 0; bj < 2; ++bj) { f32x4 b0, b1; unpack8(gb[m][bj], b0, b1); *(u32x4*)(out + r * D + col0 + bj * HALF) = pack8(acc[ai][bj][m][0] * b0, acc[ai][bj][m][1] * b1); } }
            asm volatile("" ::: "memory"); }
    }
};
struct EpiMix {
    static constexpr bool HAS_MID = false;
    const float* x; const float* mod; bf16_t* h;
    static constexpr int NSB = 0, NST = 0; static constexpr bool TPROBE = false;
    __device__ __forceinline__ const char* sb_ptr(const Unit&, int) const { return nullptr; }
    __device__ __forceinline__ int sb_lanes(int) const { return 0; }
    __device__ __forceinline__ bool keep(const Unit&) const { return false; }
    __device__ __forceinline__ void operator()(f32x4 (&acc)[2][2][4][2], const Unit& u, int wr, int wc, int fr, int fq, const LAS unsigned char* side) const {
        const int row0 = u.pm * BM + wr * 64 + fr, col0 = u.pn * BM + wc * 32 + 8 * fq, b = u.pm >> 3;
        f32x4 g[2][2];
#pragma unroll
        for (int bj = 0; bj < 2; ++bj) { const float* gp = mod + (size_t)b * 6144 + 2048 + col0 + bj * HALF; g[bj][0] = *(const f32x4*)gp; g[bj][1] = *(const f32x4*)(gp + 4); }
#pragma unroll
        for (int ai = 0; ai < 2; ++ai) {
            f32x4 xv[4][2][2];
#pragma unroll
            for (int m = 0; m < 4; ++m)
#pragma unroll
                for (int bj = 0; bj < 2; ++bj) { const float* xp = x + (size_t)(row0 + ai * HALF + m * 16) * D + col0 + bj * HALF; xv[m][bj][0] = *(const f32x4*)xp; xv[m][bj][1] = *(const f32x4*)(xp + 4); }
#pragma unroll
            for (int m = 0; m < 4; ++m) { const size_t r = (size_t)(row0 + ai * HALF + m * 16);
#pragma unroll
                for (int bj = 0; bj < 2; ++bj) *(u32x4*)(h + r * D + col0 + bj * HALF) = pack8(xv[m][bj][0] + g[bj][0] * acc[ai][bj][m][0], xv[m][bj][1] + g[bj][1] * acc[ai][bj][m][1]); }
            asm volatile("" ::: "memory"); }
    }
};
struct EpiSwiglu {
    static constexpr bool HAS_MID = false;
    static constexpr float WSC = 1.0f / 32.0f;
    const float* b1; unsigned char* act; unsigned* tpw;
    __device__ __forceinline__ unsigned* tp_words() const { return tpw; }
    static constexpr bool TPROBE = false;
    static constexpr int NSB = 2, NST = 8;
    __device__ __forceinline__ const char* sb_ptr(const Unit& u, int k) const { return (const char*)(b1 + (size_t)u.e * 2048 + k * 1024 + u.pn * HALF); }
    __device__ __forceinline__ int sb_lanes(int) const { return 32; }
    __device__ __forceinline__ bool keep(const Unit&) const { return false; }
    __device__ __forceinline__ void operator()(f32x4 (&acc)[2][2][4][2], const Unit& u, int wr, int wc, int fr, int fq, const LAS unsigned char* side) const {
        const int row0 = u.pm * BM + wr * 64 + fr, hc0 = u.pn * HALF + wc * 32 + 8 * fq;
        const LAS float* bp = (const LAS float*)side + wc * 32 + 8 * fq;
        const f32x4 bg[2] = {*(const LAS f32x4*)bp, *(const LAS f32x4*)(bp + 4)}; const f32x4 bl1[2] = {*(const LAS f32x4*)(bp + 256) + 1.0f, *(const LAS f32x4*)(bp + 260) + 1.0f};
#pragma unroll
        for (int ai = 0; ai < 2; ++ai)
#pragma unroll
            for (int m = 0; m < 4; ++m) { const size_t r = (size_t)(row0 + ai * HALF + m * 16);
                f32x4 o[2];
#pragma unroll
                for (int n = 0; n < 2; ++n) {
                    f32x4 g = acc[ai][0][m][n] * WSC + bg[n], l = acc[ai][1][m][n] * WSC + bl1[n];
#pragma unroll
                    for (int j = 0; j < 4; ++j) { g[j] = fminf(g[j], SW_LIMIT); l[j] = fminf(fmaxf(l[j], 1.0f - SW_LIMIT), 1.0f + SW_LIMIT); }
                    const f32x4 t = g * (-SW_ALPHA * 1.44269504089f); f32x4 e;
#pragma unroll
                    for (int j = 0; j < 4; ++j) e[j] = __builtin_amdgcn_exp2f(t[j]);
                    const f32x4 d = e + 1.0f; f32x4 rc;
#pragma unroll
                    for (int j = 0; j < 4; ++j) rc[j] = fast_rcp(d[j]);
                    o[n] = (g * rc) * l; }
                *(u32x2*)(act + r * DFF + hc0) = (u32x2){pk4_fp8_nc(o[0][0], o[0][1], o[0][2], o[0][3]), pk4_fp8_nc(o[1][0], o[1][1], o[1][2], o[1][3])}; }
    }
};
struct EpiMoeOut {
    static constexpr bool HAS_MID = false;
    const float* b2; const float* rw; unsigned char* ya;
    static constexpr bool TPROBE = false;
    static constexpr int NSB = 2, NST = 16;
    __device__ __forceinline__ const char* sb_ptr(const Unit& u, int k) const { return k == 0 ? (const char*)(b2 + (size_t)u.e * D + u.pn * BM) : (const char*)(rw + u.pm * BM); }
    __device__ __forceinline__ int sb_lanes(int) const { return 64; }
    __device__ __forceinline__ bool keep(const Unit&) const { return false; }
    __device__ __forceinline__ void operator()(f32x4 (&acc)[2][2][4][2], const Unit& u, int wr, int wc, int fr, int fq, const LAS unsigned char* side) const {
        const int lrow0 = wr * 64 + fr, col0 = u.pn * BM + wc * 32 + 8 * fq, row_t = u.pm * BM;
        unsigned char* tbase = ya + (size_t)row_t * D + col0;
        const LAS float* sb = (const LAS float*)side; const LAS float* srw = (const LAS float*)(side + 1024);
        f32x4 bv[2][2];
#pragma unroll
        for (int bj = 0; bj < 2; ++bj) { const LAS float* bp = sb + bj * HALF + wc * 32 + 8 * fq; bv[bj][0] = *(const LAS f32x4*)bp; bv[bj][1] = *(const LAS f32x4*)(bp + 4); }
#pragma unroll
        for (int ai = 0; ai < 2; ++ai)
#pragma unroll
            for (int m = 0; m < 4; ++m) { const int lr = lrow0 + ai * HALF + m * 16; const float w = srw[lr]; unsigned char* dst = tbase + (size_t)lr * D;
#pragma unroll
                for (int bj = 0; bj < 2; ++bj) { const f32x4 o0 = (acc[ai][bj][m][0] * (1.0f / 32.0f) + bv[bj][0]) * w, o1 = (acc[ai][bj][m][1] * (1.0f / 32.0f) + bv[bj][1]) * w;
                    *(u32x2*)(dst + bj * HALF) = (u32x2){pk4_fp8(o0[0], o0[1], o0[2], o0[3]), pk4_fp8(o1[0], o1[1], o1[2], o1[3])}; } }
    }
};
}

struct Args { const float* in[20]; float* out; unsigned char* ws; int ph_lo, ph_hi; };

__device__ __forceinline__ void transpose_item(const float* W, int N, bf16_t* WT, int ldwt, int k0, int n0, int dst_row0, LAS float* scr, int lane) {
    const int ks = lane >> 4, n4 = (lane & 15) * 4;
    f32x4 v[16];
#pragma unroll
    for (int i = 0; i < 16; ++i) v[i] = *(const f32x4*)(W + (size_t)(k0 + 4 * i + ks) * N + n0 + n4);
#pragma unroll
    for (int i = 0; i < 16; ++i) { LAS float* s = scr + (4 * i + ks) * 65 + n4; s[0] = v[i][0]; s[1] = v[i][1]; s[2] = v[i][2]; s[3] = v[i][3]; }
    LDS_WAIT(); asm volatile("" ::: "memory");
    const int kc = lane & 7;
#pragma unroll
    for (int p = 0; p < 8; ++p) { const int n = (lane >> 3) + 8 * p; const LAS float* s = scr + (8 * kc) * 65 + n;
        u32x4 o; o.x = cvt_pk_bf16(s[0], s[65]); o.y = cvt_pk_bf16(s[2 * 65], s[3 * 65]); o.z = cvt_pk_bf16(s[4 * 65], s[5 * 65]); o.w = cvt_pk_bf16(s[6 * 65], s[7 * 65]);
        *(u32x4*)(WT + (size_t)(dst_row0 + n) * ldwt + k0 + 8 * kc) = o; }
    LDS_WAIT(); asm volatile("" ::: "memory");
}

template <bool NT = false>
__device__ __forceinline__ void transpose_item_fp8(const float* W, int N, unsigned char* WT, int ldwt, int k0, int n0, int dst_row0, LAS float* scr, int lane) {
    const int ks = lane >> 3, n4 = (lane & 7) * 4;
    f32x4 v[16];
#pragma unroll
    for (int i = 0; i < 16; ++i) { const f32x4* p = (const f32x4*)(W + (size_t)(k0 + 8 * i + ks) * N + n0 + n4); v[i] = NT ? __builtin_nontemporal_load(p) : *p; }
#pragma unroll
    for (int i = 0; i < 16; ++i) { LAS float* s = scr + (8 * i + ks) * 33 + n4; s[0] = v[i][0]; s[1] = v[i][1]; s[2] = v[i][2]; s[3] = v[i][3]; }
    LDS_WAIT(); asm volatile("" ::: "memory");
    const int kc = lane & 7;
#pragma unroll
    for (int p = 0; p < 4; ++p) { const int n = (lane >> 3) + 8 * p; const LAS float* s = scr + (16 * kc) * 33 + n;
        u32x4 o;
        o.x = pk4_fp8(32.f * s[0], 32.f * s[33], 32.f * s[2 * 33], 32.f * s[3 * 33]); o.y = pk4_fp8(32.f * s[4 * 33], 32.f * s[5 * 33], 32.f * s[6 * 33], 32.f * s[7 * 33]);
        o.z = pk4_fp8(32.f * s[8 * 33], 32.f * s[9 * 33], 32.f * s[10 * 33], 32.f * s[11 * 33]); o.w = pk4_fp8(32.f * s[12 * 33], 32.f * s[13 * 33], 32.f * s[14 * 33], 32.f * s[15 * 33]);
        u32x4* q = (u32x4*)(WT + (size_t)(dst_row0 + n) * ldwt + k0 + 16 * kc); if (NT) __builtin_nontemporal_store(o, q); else *q = o; }
    LDS_WAIT(); asm volatile("" ::: "memory");
}

constexpr int BG_W1 = 32 * 8 * 64, BG_W2 = 32 * 8 * 32, BG_N = BG_W1 + BG_W2;
struct BgCtx { const float* w1; const float* w2; unsigned char* W1q; unsigned char* W2q; unsigned* qhead; };
__device__ __forceinline__ bool bg_item(const BgCtx& c, LAS float* scr, int lane) {
    unsigned it = 0; if (lane == 0) it = __hip_atomic_fetch_add(c.qhead, 1u, __ATOMIC_RELAXED, __HIP_MEMORY_SCOPE_AGENT);
    it = (unsigned)__builtin_amdgcn_readfirstlane((int)it);
    if (it >= (unsigned)BG_N) return false;
    if (it < (unsigned)BG_W1) { const int r = (int)it, e = r / 512, q = r % 512, kb = q / 64, nb = q % 64;
        const int pn = nb >> 3, wi = (nb & 7) * 32; const int src = wi < 128 ? pn * 128 + wi : 1024 + pn * 128 + (wi - 128);
        transpose_item_fp8<true>(c.w1 + (size_t)e * D * 2048, 2048, c.W1q + (size_t)e * 2048 * D, D, kb * 128, src, nb * 32, scr, lane); }
    else { const int r = (int)it - BG_W1, e = r / 256, q = r % 256, kb = q / 32, nb = q % 32;
        transpose_item_fp8<true>(c.w2 + (size_t)e * DFF * D, D, c.W2q + (size_t)e * D * DFF, DFF, kb * 128, nb * 32, nb * 32, scr, lane); }
    return true;
}
__device__ __forceinline__ void xcd_barrier_bg(const XcdBarrier& b, const BgCtx& c, LAS unsigned char* lds, int wave, int lane, bool drain) {
    volatile LAS unsigned* M = (volatile LAS unsigned*)(lds + MISC_OFF);
    LAS float* scr = (LAS float*)(lds + wave * 16896);
    if (drain) { while (bg_item(c, scr, lane)) { } }
    asm volatile("s_waitcnt vmcnt(0)" ::: "memory");
    __syncthreads();
    if (threadIdx.x == 0) {
        unsigned* bar = b.bar;
        __builtin_amdgcn_s_waitcnt(0);
        unsigned nloc = b.st[0], nx = b.st[1];
        if (nloc == 0u) { xcd_barrier_complete(bar, b.x, nloc, nx); b.st[0] = nloc; b.st[1] = nx; }
        const unsigned old = xb_add(&bar[XB_XSUB(b.x)], 1u);
        const unsigned gen = old / nloc;
        if (old + 1u == (gen + 1u) * nloc) {
            __builtin_amdgcn_fence(__ATOMIC_RELEASE, "agent");
            asm volatile("s_waitcnt vmcnt(0)" ::: "memory");
            const unsigned og = xb_add(&bar[XB_TOP], 1u);
            const unsigned tg = og / nx;
            if (og + 1u == (tg + 1u) * nx) { xb_add(&bar[XB_TOPGEN], 1u); M[10] = 2u; } else M[10] = 1u;
            M[11] = tg;
        } else { M[10] = 0u; M[11] = gen; }
    }
    unsigned spins = 0;
    for (;;) {
        if (threadIdx.x == 0) { const unsigned role = M[10], g = M[11]; unsigned* bar = b.bar;
            bool rel = role == 2u ? true : role == 1u ? (xb_ld(&bar[XB_TOPGEN]) != g) : (xb_ld(&bar[XB_XGEN(b.x)]) != g);
            if (!rel && (++spins & 255u) == 0u) { if (xb_ld(&bar[XB_TMO])) rel = true; else if (spins > XB_SPIN_CAP) { atomicAdd(&bar[XB_TMO], 1u); rel = true; } }
            M[12] = rel ? 1u : 0u; }
        asm volatile("s_waitcnt lgkmcnt(0)" ::: "memory"); __syncthreads();
        const bool rel = M[12] != 0u;
        asm volatile("s_waitcnt lgkmcnt(0)" ::: "memory"); __syncthreads();
        if (rel) break;
        if (M[13] != 0u || !bg_item(c, scr, lane)) { M[13] = 1u; __builtin_amdgcn_s_sleep(16); }
    }
    if (threadIdx.x == 0) {
        __builtin_amdgcn_fence(__ATOMIC_ACQUIRE, "agent");
        if (M[10] != 0u) xb_add(&b.bar[XB_XGEN(b.x)], 1u);
        asm volatile("s_waitcnt vmcnt(0)" ::: "memory");
    }
    __syncthreads();
}

__global__ void __launch_bounds__(NTHREADS, 2) fwd_kernel(Args args) {
    extern __shared__ __attribute__((aligned(16))) unsigned char lds_raw[];
    LAS unsigned char* lds = (LAS unsigned char*)lds_raw;
    volatile LAS unsigned* MISC = (volatile LAS unsigned*)(lds + MISC_OFF);
    const int G = gridDim.x, bid = blockIdx.x;
    const int wave_sg = __builtin_amdgcn_readfirstlane((int)threadIdx.x >> 6);
#define PHASE_IDS() int lane; asm volatile("v_mbcnt_lo_u32_b32 %0, -1, 0\n\tv_mbcnt_hi_u32_b32 %0, -1, %0" : "=v"(lane)); const int wave = wave_sg; const int tid = wave * 64 + lane; const int gw = bid * NWAVES + wave, NGW = G * NWAVES; (void)lane; (void)wave; (void)gw; (void)NGW
#define CAS __attribute__((address_space(4)))
#define PHASE_ARGS() const CAS Args* ap = (const CAS Args*)__builtin_amdgcn_kernarg_segment_ptr(); asm volatile("" : "+s"(ap)); unsigned char* const ws = ap->ws; unsigned* const ctl = (unsigned*)(ws + WS_CTL); (void)ctl
#define ARG(i) (ap->in[i])
#define WSP(T, off) ((T*)(ws + (off)))
    enum { I_X = 0, I_C, I_WADA, I_BADA, I_NMIX, I_WIN, I_LBT, I_HGNW, I_CONVW, I_WHG, I_WCV, I_WMIX, I_NFFN, I_WR, I_BR, I_W1, I_B1, I_W2, I_B2, I_NFIN };
    { PHASE_IDS(); for (int u = tid; u < 64; u += NTHREADS) MISC[u] = 0u; }
    __syncthreads();
    XcdBarrier bar; bar.bar = nullptr; bar.x = 0; bar.st = nullptr;
#if MK_ONE_LAUNCH
    { PHASE_ARGS(); bar = xcd_barrier_post(ctl + CW_BAR, MISC + 8); }
#if MK_BG
#define GRID_BAR_X(drain) do { PHASE_IDS(); PHASE_ARGS(); const BgCtx bgc{ARG(I_W1), ARG(I_W2), WSP(unsigned char, WS_W1), WSP(unsigned char, WS_W2), ctl + CW_Q}; xcd_barrier_bg(bar, bgc, lds, wave, lane, drain); } while (0)
#define GRID_BAR() GRID_BAR_X(false)
#else
#define GRID_BAR() xcd_barrier(bar)
#endif
#else
#define GRID_BAR() do { } while (0)
#endif
    const int lo = args.ph_lo, hi = args.ph_hi;
#if MK_PHT
    const unsigned long long pht0 = __builtin_amdgcn_s_memrealtime(); unsigned long long phtk = 0;
#endif
#ifndef PH_MASK
#define PH_MASK 0x7ff
#endif
#define IN(k) (((PH_MASK >> (k)) & 1) && lo <= (k) && (k) < hi)
#define BOTH(k) (IN(k) && IN((k) + 1))

    if (IN(0)) for (int rep_ = 0; rep_ < 1 + ((MK_REPEAT >> 0) & 1); ++rep_) { PHASE_IDS(); PHASE_ARGS();
        const float* cvec = ARG(I_C); const float* w_ada = ARG(I_WADA); const float* b_ada = ARG(I_BADA); const float* lbtab = ARG(I_LBT);
        const float* w_in = ARG(I_WIN); const float* w_hg = ARG(I_WHG); const float* w_cv = ARG(I_WCV); const float* w_mix = ARG(I_WMIX); const float* w1 = ARG(I_W1); const float* w2 = ARG(I_W2);
        float* MOD = WSP(float, WS_MOD); float* LB = WSP(float, WS_LB);
        bf16_t* Win_t = WSP(bf16_t, WS_WIN); bf16_t* Whg_t = WSP(bf16_t, WS_WHG); bf16_t* Wcv_t = WSP(bf16_t, WS_WHG) + 512;        bf16_t* Wmix_t = WSP(bf16_t, WS_WMIX); unsigned char* W1_t = WSP(unsigned char, WS_W1); unsigned char* W2_t = WSP(unsigned char, WS_W2);
        LAS float* scr = (LAS float*)(lds + wave * 16896);
        const int nmod_w = NGW >= 768 ? 384 : 0;
        for (int it = (nmod_w ? gw - (NGW - nmod_w) : gw); it >= 0 && it < 384; it += (nmod_w ? 384 : NGW)) {
            const int n0 = it * 16, cl = lane & 15, kq = lane >> 4;
            float acc[32];
#pragma unroll
            for (int b = 0; b < 32; ++b) acc[b] = 0.f;
            for (int ch = 0; ch < 16; ++ch) {
                { const int b = lane >> 1, part = lane & 1;
#pragma unroll
                    for (int q = 0; q < 4; ++q) {
                        const float* cp = cvec + (size_t)b * D + q * 256 + ch * 16 + part * 8;
                        const f32x4 c0 = *(const f32x4*)cp, c1 = *(const f32x4*)(cp + 4);
#pragma unroll
                        for (int j = 0; j < 4; ++j) { scr[(q * 16 + part * 8 + j) * 32 + b] = c0[j] * sigmoidf_(c0[j]); scr[(q * 16 + part * 8 + 4 + j) * 32 + b] = c1[j] * sigmoidf_(c1[j]); }
                    } }
                float wv[16];
#pragma unroll
                for (int kk = 0; kk < 16; ++kk) wv[kk] = w_ada[(size_t)(kq * 256 + ch * 16 + kk) * 6144 + n0 + cl];
                LDS_WAIT(); asm volatile("" ::: "memory");
#pragma unroll
                for (int kk = 0; kk < 16; ++kk) {
                    const LAS f32x4* sp = (const LAS f32x4*)(scr + (kq * 16 + kk) * 32);
#pragma unroll
                    for (int b4 = 0; b4 < 8; ++b4) { const f32x4 s = sp[b4]; acc[4 * b4] += wv[kk] * s[0]; acc[4 * b4 + 1] += wv[kk] * s[1]; acc[4 * b4 + 2] += wv[kk] * s[2]; acc[4 * b4 + 3] += wv[kk] * s[3]; }
                }
                LDS_WAIT(); asm volatile("" ::: "memory");
            }
            const float bias = b_ada[n0 + cl];
#pragma unroll
            for (int b = 0; b < 32; ++b) { float v = acc[b]; v += __shfl_xor(v, 16); v += __shfl_xor(v, 32); if (kq == 0) MOD[(size_t)b * 6144 + n0 + cl] = v + bias; }
        }
        if (bid == (G > 1 ? 1 : 0)) { const int k = tid; const float l0 = lbtab[k], l1 = lbtab[HW + k]; LB[k] = fast_rcp(1.0f + fast_exp(l1 - l0)); }
        {
            constexpr int I_IN = 16 * PN8 * 4, I_IN8 = 8 * NQ8 * 8, I_HG = 8 * 16, I_CV = 8 * 16, I_MIX = 16 * 16, I_W1 = 32 * 8 * 64, I_W2 = 32 * 8 * 32;
            constexpr int NITEMS = I_IN + I_IN8 + I_HG + I_CV + I_MIX + ((MK_BG && MK_ONE_LAUNCH) ? 0 : I_W1 + I_W2);
            const int n_nm = NGW - nmod_w, base2 = 2 * n_nm, nfull = (NITEMS - base2) / NGW, base3 = base2 + nfull * NGW;
            for (int rr = 0; rr < nfull + 3; ++rr) {
                int it;
                if (rr < 2) { if (gw >= n_nm) continue; it = rr * n_nm + gw; }
                else if (rr < 2 + nfull) it = base2 + (rr - 2) * NGW + gw;
                else { if (gw >= n_nm) continue; it = base3 + gw; }
                if (it >= NITEMS) continue;
                int r = it;
#if MK_P2FP8
                if (r < I_IN) { const int kb = r / 176, nb = r % 176; transpose_item_fp8(w_in, INC, (unsigned char*)Win_t, D, kb * 128, nb * 32, nb * 32, scr, lane); continue; } r -= I_IN;
#else
                if (r < I_IN) { const int kb = r / (PN8 * 4), nb = r % (PN8 * 4); const int pn = map16(nb >> 2), wi = (nb & 3) * 64;
                    const int src = pn < 10 ? pn * 256 + wi : pn < 14 ? (wi < 128 ? 2560 + (pn - 10) * 128 + wi : 3072 + (pn - 10) * 128 + (wi - 128)) : (wi < 128 ? 3584 + (pn - 14) * 128 + wi : 4608 + (pn - 14) * 128 + (wi - 128));
                    transpose_item(w_in, INC, Win_t, D, kb * 64, src, nb * 64, scr, lane); continue; } r -= I_IN;
                if (r < I_IN8) { const int kb = r / (NQ8 * 8), nb = r % (NQ8 * 8); const int pn = map8(nb >> 3), wi = (nb & 7) * 32;
                    const int src = pn < 10 ? pn * 256 + wi : pn < 14 ? (wi < 128 ? 2560 + (pn - 10) * 128 + wi : 3072 + (pn - 10) * 128 + (wi - 128)) : (wi < 128 ? 3584 + (pn - 14) * 128 + wi : 4608 + (pn - 14) * 128 + (wi - 128));
                    transpose_item_fp8(w_in, INC, WSP(unsigned char, WS_WIN8), D, kb * 128, src, nb * 32, scr, lane); continue; } r -= I_IN8;
#endif
                if (r < I_HG) { const int kb = r / 16, nb = r % 16; transpose_item(w_hg, D, Whg_t, D, kb * 64, nb * 64, nb * 64, scr, lane); continue; } r -= I_HG;
                if (r < I_CV) { const int kb = r / 16, nb = r % 16; transpose_item(w_cv, D, Wcv_t, D, kb * 64, nb * 64, nb * 64, scr, lane); continue; } r -= I_CV;
                if (r < I_MIX) { const int kb = r / 16, nb = r % 16; transpose_item(w_mix, D, Wmix_t, D, kb * 64, nb * 64, nb * 64, scr, lane); continue; } r -= I_MIX;
                if (r < I_W1) { const int e = r / 512, q = r % 512, kb = q / 64, nb = q % 64;
                    const int pn = nb >> 3, wi = (nb & 7) * 32; const int src = wi < 128 ? pn * 128 + wi : 1024 + pn * 128 + (wi - 128);
                    transpose_item_fp8(w1 + (size_t)e * D * 2048, 2048, W1_t + (size_t)e * 2048 * D, D, kb * 128, src, nb * 32, scr, lane); continue; } r -= I_W1;
                { const int e = r / 256, q = r % 256, kb = q / 32, nb = q % 32;
                    transpose_item_fp8(w2 + (size_t)e * DFF * D, D, W2_t + (size_t)e * D * DFF, DFF, kb * 128, nb * 32, nb * 32, scr, lane); }
            }
        }
        if (BOTH(0)) GRID_BAR();
#if MK_PHT
        if (MK_PHT == 1) phtk = __builtin_amdgcn_s_memrealtime() - pht0;
#endif
    }

    if (IN(1)) for (int rep_ = 0; rep_ < 1 + ((MK_REPEAT >> 1) & 1); ++rep_) { PHASE_IDS(); PHASE_ARGS();
        const float* x = ARG(I_X); const float* norm_mix_w = ARG(I_NMIX); const float* MOD = WSP(float, WS_MOD); bf16_t* U = WSP(bf16_t, WS_U); unsigned char* U8 = WSP(unsigned char, WS_U8);
        for (int m0 = gw * 32; m0 < NTOK; m0 += NGW * 32) {
            const int b = m0 >> 11;
            f32x4 A[4], Sh[4];
#pragma unroll
            for (int j = 0; j < 4; ++j) { const int k = 4 * lane + 256 * j; const f32x4 w = *(const f32x4*)(norm_mix_w + k), sc = *(const f32x4*)(MOD + (size_t)b * 6144 + 1024 + k);
                A[j] = w * (sc + 1.0f); Sh[j] = *(const f32x4*)(MOD + (size_t)b * 6144 + k); }
            for (int r = 0; r < 32; r += 4) {
                f32x4 v[4][4]; float ss[4];
#pragma unroll
                for (int q = 0; q < 4; ++q) { const float* xr = x + (size_t)(m0 + r + q) * D; ss[q] = 0.f;
#pragma unroll
                    for (int j = 0; j < 4; ++j) v[q][j] = *(const f32x4*)(xr + 4 * lane + 256 * j); }
#pragma unroll
                for (int q = 0; q < 4; ++q) {
#pragma unroll
                    for (int j = 0; j < 4; ++j) ss[q] += (v[q][j][0] * v[q][j][0] + v[q][j][1] * v[q][j][1]) + (v[q][j][2] * v[q][j][2] + v[q][j][3] * v[q][j][3]);
                    const float rs = __builtin_amdgcn_rsqf(wave_sum(ss[q]) * (1.0f / D) + EPS);
#if MK_P2FP8
                    unsigned char* ur = (unsigned char*)U + (size_t)(m0 + r + q) * D;
#pragma unroll
                    for (int j = 0; j < 4; ++j) { const f32x4 o = v[q][j] * rs * A[j] + Sh[j]; *(unsigned*)(ur + 4 * lane + 256 * j) = pk4_fp8(o[0], o[1], o[2], o[3]); }
#else
                    bf16_t* ur = U + (size_t)(m0 + r + q) * D; unsigned char* u8r = U8 + (size_t)(m0 + r + q) * D;
#pragma unroll
                    for (int j = 0; j < 4; ++j) { const f32x4 o = v[q][j] * rs * A[j] + Sh[j]; u32x2 w; w.x = cvt_pk_bf16(o[0], o[1]); w.y = cvt_pk_bf16(o[2], o[3]); *(u32x2*)(ur + 4 * lane + 256 * j) = w;
                        if (NQ8 > 0) *(unsigned*)(u8r + 4 * lane + 256 * j) = pk4_fp8(o[0], o[1], o[2], o[3]); }
#endif
                }
            }
        }
        if (BOTH(1)) GRID_BAR();
#if MK_PHT
        if (MK_PHT == 2) phtk = __builtin_amdgcn_s_memrealtime() - pht0;
#endif
    }

    if (IN(2)) for (int rep_ = 0; rep_ < 1 + ((MK_REPEAT >> 2) & 1); ++rep_) { PHASE_ARGS();
        if (PN8 > 0) { gm::DenseOrder S{NTOK / 256, PN8, G, bid, 1}; gm::DenseA AM{D, 0u, 2}; gm::EpiProjT<false> E{WSP(bf16_t, WS_PROJ), (bf16_t*)ap->out, WSP(float, WS_LB)};
            gm::gemm_phase<false>(wave_sg, lds, (const char*)WSP(bf16_t, WS_U), (const char*)WSP(bf16_t, WS_WIN), D, 0, 0u, S, E, AM); }
        if (NQ8 > 0) { gm::DenseOrder S{NTOK / 256, NQ8, G, bid, 1}; gm::DenseA AM{D, 0u, 1}; gm::EpiProjT<true> E{WSP(bf16_t, WS_PROJ), (bf16_t*)ap->out, WSP(float, WS_LB)};
            gm::gemm_phase<true>(wave_sg, lds, (const char*)WSP(unsigned char, WS_U8), (const char*)WSP(unsigned char, WS_WIN8), D, 0, 0u, S, E, AM); }
        if (BOTH(2)) GRID_BAR();
#if MK_PHT
        if (MK_PHT == 3) phtk = __builtin_amdgcn_s_memrealtime() - pht0;
#endif
    }

    if (IN(3)) for (int rep_ = 0; rep_ < 1 + ((MK_REPEAT >> 3) & 1); ++rep_) { PHASE_IDS(); PHASE_ARGS();
        const float* hg_norm_w = ARG(I_HGNW); const float* conv_w = ARG(I_CONVW); const bf16_t* PROJ = WSP(bf16_t, WS_PROJ); bf16_t* OB = WSP(bf16_t, WS_O); bf16_t* CVB = WSP(bf16_t, WS_O) + 512;
        const bool split = (G >= 256);
        bf16_t* RAWG = WSP(bf16_t, WS_RAW); bf16_t* QBG = WSP(bf16_t, WS_QBG); float* STATEG = WSP(float, WS_STATE); float* DECG = WSP(float, WS_DECG);
        constexpr int LDQ = 136, LDT = 72;
        if (!split || bid < 256) {
            LAS bf16_t* QT = (LAS bf16_t*)(lds);
            LAS bf16_t* KT = QT + 64 * LDQ;
            LAS bf16_t* QB = KT + 64 * LDQ;
            LAS bf16_t* KBT = QB + 64 * LDQ;
            LAS bf16_t* VT = KBT + 128 * LDT;
            LAS bf16_t* PM = VT + 128 * LDT;
            LAS bf16_t* ST = PM + 64 * LDT;
            LAS bf16_t* OS = ST + 128 * LDQ;
            LAS float* SEG = (LAS float*)(OS + 64 * LDQ);
            LAS float* DEC = SEG + 8 * 128;
            const int fr = lane & 15, fq = lane >> 4, w = wave;
            for (int chain = split ? (bid & 127) : bid; chain < BATCH * NHEAD; chain += split ? 128 : G) {
                const int b = chain >> 2, h = chain & 3;
                const int c0 = split ? (bid >> 7) * (NCHUNK / 2) : 0, c1 = split ? c0 + NCHUNK / 2 : NCHUNK; const bool rawm = split;
                __syncthreads();
                for (int i = tid; i < 128 * LDQ / 2; i += NTHREADS) ((LAS unsigned*)ST)[i] = 0u;
                f32x4 Sacc[8];
#pragma unroll
                for (int i = 0; i < 8; ++i) Sacc[i] = (f32x4){0.f, 0.f, 0.f, 0.f};
                const int ot = tid >> 3, ocg = tid & 7;
                f32x4 nwv[4];
#pragma unroll
                for (int q = 0; q < 2; ++q) { nwv[2 * q] = *(const f32x4*)(hg_norm_w + q * 64 + 8 * ocg); nwv[2 * q + 1] = *(const f32x4*)(hg_norm_w + q * 64 + 8 * ocg + 4); }
                const bf16_t* pbase = PROJ + (size_t)(b * SEQ) * PROJ_LD + h * DK;
                unsigned rq[8], rl[8], rv[8];
#pragma unroll
                for (int r = 0; r < 8; ++r) { const bf16_t* p = pbase + (size_t)(c0 * CHUNK + 8 * w + r) * PROJ_LD + 2 * lane; rq[r] = *(const unsigned*)p; rl[r] = *(const unsigned*)(p + 512); rv[r] = *(const unsigned*)(p + 1024); }
                for (int c = c0; c < c1; ++c) {
                    const int m0 = c * CHUNK;
                    float cs0[8], cs1[8]; { float a0 = 0.f, a1 = 0.f;
#pragma unroll
                        for (int r = 0; r < 8; ++r) { a0 += bf_lo(rl[r]); a1 += bf_hi(rl[r]); cs0[r] = a0; cs1[r] = a1; }
                        *(LAS f32x2*)(SEG + w * 128 + 2 * lane) = (f32x2){a0, a1}; }
                    LDS_WAIT(); __builtin_amdgcn_s_barrier(); asm volatile("" ::: "memory");
                    float pre0 = 0.f, pre1 = 0.f, bm0 = 0.f, bm1 = 0.f, bl0 = 0.f, bl1 = 0.f;
#pragma unroll
                    for (int s = 0; s < 8; ++s) { const f32x2 t2 = *(const LAS f32x2*)(SEG + s * 128 + 2 * lane); if (s < w) { pre0 += t2[0]; pre1 += t2[1]; } if (s < 4) { bm0 += t2[0]; bm1 += t2[1]; } bl0 += t2[0]; bl1 += t2[1]; }
                    const float em0 = fast_exp(fmaxf(bm0, -80.f)), em1 = fast_exp(fmaxf(bm1, -80.f));
                    const float el0 = fast_exp(fmaxf(bl0 - bm0, -80.f)), el1 = fast_exp(fmaxf(bl1 - bm1, -80.f));
                    if (w == 0) *(LAS f32x2*)(DEC + 2 * lane) = (f32x2){fast_exp(fmaxf(bl0, -80.f)), fast_exp(fmaxf(bl1, -80.f))};
                    unsigned kb0[4], kb1[4], vt0[4], vt1[4];
#pragma unroll
                    for (int r = 0; r < 8; ++r) {
                        const int t = 8 * w + r;
                        const float lf0 = bf_lo(rl[r]), lf1 = bf_hi(rl[r]);
                        const float d0 = fminf(fmaxf(pre0 + cs0[r] - bm0, -80.f), 80.f), d1 = fminf(fmaxf(pre1 + cs1[r] - bm1, -80.f), 80.f);
                        const float e0 = fast_exp(d0), e1 = fast_exp(d1), i0 = fast_exp(-d0), i1 = fast_exp(-d1);
                        const float kk0 = 1.0f - fast_exp(lf0), kk1 = 1.0f - fast_exp(lf1);
                        const float qt0 = bf_lo(rq[r]) * e0, qt1 = bf_hi(rq[r]) * e1, kt0 = kk0 * i0, kt1 = kk1 * i1;
                        *(LAS unsigned*)(QT + t * LDQ + 2 * lane) = cvt_pk_bf16(qt0, qt1);
                        *(LAS unsigned*)(KT + t * LDQ + 2 * lane) = cvt_pk_bf16(kt0, kt1);
                        *(LAS unsigned*)(QB + t * LDQ + 2 * lane) = cvt_pk_bf16(qt0 * em0, qt1 * em1);
                        const unsigned kbp = cvt_pk_bf16(kt0 * el0, kt1 * el1);
                        if (r & 1) { kb0[r >> 1] |= (kbp << 16); kb1[r >> 1] |= (kbp & 0xffff0000u); vt0[r >> 1] |= (rv[r] << 16); vt1[r >> 1] |= (rv[r] & 0xffff0000u); }
                        else { kb0[r >> 1] = kbp & 0xffffu; kb1[r >> 1] = kbp >> 16; vt0[r >> 1] = rv[r] & 0xffffu; vt1[r >> 1] = rv[r] >> 16; }
                    }
                    *(LAS u32x4*)(KBT + (2 * lane) * LDT + 8 * w) = (u32x4){kb0[0], kb0[1], kb0[2], kb0[3]};
                    *(LAS u32x4*)(KBT + (2 * lane + 1) * LDT + 8 * w) = (u32x4){kb1[0], kb1[1], kb1[2], kb1[3]};
                    *(LAS u32x4*)(VT + (2 * lane) * LDT + 8 * w) = (u32x4){vt0[0], vt0[1], vt0[2], vt0[3]};
                    *(LAS u32x4*)(VT + (2 * lane + 1) * LDT + 8 * w) = (u32x4){vt1[0], vt1[1], vt1[2], vt1[3]};
                    LDS_WAIT(); __builtin_amdgcn_s_barrier(); asm volatile("" ::: "memory");
                    u32x4 gg[2];
                    if (!rawm) { const bf16_t* gp = pbase + (size_t)(m0 + ot) * PROJ_LD + 1536 + 8 * ocg; gg[0] = *(const u32x4*)gp; gg[1] = *(const u32x4*)(gp + 64); }
                    if (c + 1 < c1) {
#pragma unroll
                        for (int r = 0; r < 8; ++r) { const bf16_t* p = pbase + (size_t)(m0 + CHUNK + 8 * w + r) * PROJ_LD + 2 * lane; rq[r] = *(const unsigned*)p; rl[r] = *(const unsigned*)(p + 512); rv[r] = *(const unsigned*)(p + 1024); }
                    }
#pragma unroll
                    for (int x2 = 0; x2 < 2; ++x2) { const int id = 2 * w + x2, si = id >> 2, ti = id & 3;
                        f32x4 sc = (f32x4){0.f, 0.f, 0.f, 0.f};
                        if (si <= ti) {
#pragma unroll
                            for (int ks = 0; ks < 4; ++ks) { const bf16x8 a = *(const LAS bf16x8*)(KT + (16 * si + fr) * LDQ + 32 * ks + 8 * fq), bb = *(const LAS bf16x8*)(QT + (16 * ti + fr) * LDQ + 32 * ks + 8 * fq);
                                sc = __builtin_amdgcn_mfma_f32_16x16x32_bf16(a, bb, sc, 0, 0, 0); }
                            const int t = 16 * ti + fr, s0 = 16 * si + 4 * fq;
#pragma unroll
                            for (int j = 0; j < 4; ++j) sc[j] = (s0 + j <= t) ? sc[j] : 0.f;
                        }
                        *(LAS u32x2*)(PM + (16 * ti + fr) * LDT + 16 * si + 4 * fq) = (u32x2){cvt_pk_bf16(sc[0], sc[1]), cvt_pk_bf16(sc[2], sc[3])};
                    }
                    f32x4 oacc[4];
                    { bf16x8 sa[4];
#pragma unroll
                        for (int ks = 0; ks < 4; ++ks) sa[ks] = *(const LAS bf16x8*)(ST + (16 * w + fr) * LDQ + 32 * ks + 8 * fq);
#pragma unroll
                        for (int ti = 0; ti < 4; ++ti) { oacc[ti] = (f32x4){0.f, 0.f, 0.f, 0.f};
#pragma unroll
                            for (int ks = 0; ks < 4; ++ks) { const bf16x8 bb = *(const LAS bf16x8*)(QB + (16 * ti + fr) * LDQ + 32 * ks + 8 * fq); oacc[ti] = __builtin_amdgcn_mfma_f32_16x16x32_bf16(sa[ks], bb, oacc[ti], 0, 0, 0); } } }
                    LDS_WAIT(); __builtin_amdgcn_s_barrier(); asm volatile("" ::: "memory");
                    { bf16x8 va[2];
#pragma unroll
                        for (int ks = 0; ks < 2; ++ks) va[ks] = *(const LAS bf16x8*)(VT + (16 * w + fr) * LDT + 32 * ks + 8 * fq);
#pragma unroll
                        for (int ti = 0; ti < 4; ++ti)
#pragma unroll
                            for (int ks = 0; ks < 2; ++ks) { const bf16x8 bb = *(const LAS bf16x8*)(PM + (16 * ti + fr) * LDT + 32 * ks + 8 * fq); oacc[ti] = __builtin_amdgcn_mfma_f32_16x16x32_bf16(va[ks], bb, oacc[ti], 0, 0, 0); }
#pragma unroll
                        for (int i = 0; i < 8; ++i) { const f32x4 dv = *(const LAS f32x4*)(DEC + 16 * i + 4 * fq); Sacc[i] = Sacc[i] * dv;
#pragma unroll
                            for (int ks = 0; ks < 2; ++ks) { const bf16x8 a = *(const LAS bf16x8*)(KBT + (16 * i + fr) * LDT + 32 * ks + 8 * fq); Sacc[i] = __builtin_amdgcn_mfma_f32_16x16x32_bf16(a, va[ks], Sacc[i], 0, 0, 0); } } }
#pragma unroll
                    for (int ti = 0; ti < 4; ++ti) *(LAS u32x2*)(OS + (16 * ti + fr) * LDQ + 16 * w + 4 * fq) = (u32x2){cvt_pk_bf16(oacc[ti][0], oacc[ti][1]), cvt_pk_bf16(oacc[ti][2], oacc[ti][3])};
#pragma unroll
                    for (int i = 0; i < 8; ++i) *(LAS u32x2*)(ST + (16 * w + fr) * LDQ + 16 * i + 4 * fq) = (u32x2){cvt_pk_bf16(Sacc[i][0], Sacc[i][1]), cvt_pk_bf16(Sacc[i][2], Sacc[i][3])};
                    LDS_WAIT(); __builtin_amdgcn_s_barrier(); asm volatile("" ::: "memory");
                    if (rawm) { const size_t ci = (size_t)(chain * (NCHUNK / 2) + (c - c0)), cr = ci + (size_t)(bid >> 7) * (128 * (NCHUNK / 2));
                        bf16_t* rp = RAWG + cr * (CHUNK * 128) + ot * 128 + 8 * ocg;
                        *(u32x4*)rp = *(const LAS u32x4*)(OS + ot * LDQ + 8 * ocg); *(u32x4*)(rp + 64) = *(const LAS u32x4*)(OS + ot * LDQ + 64 + 8 * ocg);
                        if (bid >= 128) { bf16_t* qp = QBG + ci * (CHUNK * 128) + ot * 128 + 8 * ocg;
                            *(u32x4*)qp = *(const LAS u32x4*)(QB + ot * LDQ + 8 * ocg); *(u32x4*)(qp + 64) = *(const LAS u32x4*)(QB + ot * LDQ + 64 + 8 * ocg);
                            if (tid < 32) *(f32x4*)(DECG + ci * 128 + 4 * tid) = *(const LAS f32x4*)(DEC + 4 * tid); }
                    } else
                    { f32x4 o[4]; const u32x4 ow0 = *(const LAS u32x4*)(OS + ot * LDQ + 8 * ocg), ow1 = *(const LAS u32x4*)(OS + ot * LDQ + 64 + 8 * ocg); gm::unpack8(ow0, o[0], o[1]); gm::unpack8(ow1, o[2], o[3]);
                        float ss = 0.f;
#pragma unroll
                        for (int q = 0; q < 4; ++q) ss += (o[q][0] * o[q][0] + o[q][1] * o[q][1]) + (o[q][2] * o[q][2] + o[q][3] * o[q][3]);
                        ss += __shfl_xor(ss, 1); ss += __shfl_xor(ss, 2); ss += __shfl_xor(ss, 4);
                        const float rn = __builtin_amdgcn_rsqf(ss * (1.0f / 128.0f) + EPS);
                        bf16_t* op = OB + (size_t)(b * SEQ + m0 + ot) * D + h * DK + 8 * ocg;
#pragma unroll
                        for (int q = 0; q < 2; ++q) { f32x4 g0, g1; gm::unpack8(gg[q], g0, g1);
#pragma unroll
                            for (int j = 0; j < 4; ++j) { g0[j] = g0[j] * sigmoidf_(g0[j]); g1[j] = g1[j] * sigmoidf_(g1[j]); }
                            *(u32x4*)(op + 64 * q) = gm::pack8(o[2 * q] * rn * nwv[2 * q] * g0, o[2 * q + 1] * rn * nwv[2 * q + 1] * g1); } }
                }
                if (split && bid < 128) {
                    GAS unsigned long long* sp = (GAS unsigned long long*)(STATEG + (size_t)chain * 16384 + (16 * w + fr) * 128 + 4 * fq);
#pragma unroll
                    for (int i = 0; i < 8; ++i) { const u32x4 sv = __builtin_bit_cast(u32x4, Sacc[i]);
                        __hip_atomic_store(sp + 8 * i, ((unsigned long long)sv.y << 32) | sv.x, __ATOMIC_RELAXED, __HIP_MEMORY_SCOPE_AGENT); __hip_atomic_store(sp + 8 * i + 1, ((unsigned long long)sv.w << 32) | sv.z, __ATOMIC_RELAXED, __HIP_MEMORY_SCOPE_AGENT); }
                    asm volatile("s_waitcnt vmcnt(0)" ::: "memory");
                    __syncthreads();
                    if (tid == 0) __hip_atomic_store((GAS unsigned*)(ctl + CW_ST + chain), 1u, __ATOMIC_RELAXED, __HIP_MEMORY_SCOPE_AGENT);
                }
            }
        }
        {
            f32x4 cw[3][2];
#pragma unroll
            for (int j = 0; j < 3; ++j) { cw[j][0] = *(const f32x4*)(conv_w + j * 512 + 8 * lane); cw[j][1] = *(const f32x4*)(conv_w + j * 512 + 8 * lane + 4); }
            constexpr int NPIECE = BATCH * (SEQ / 64), NA = MK_CONV_NA, NB = 8 - NA;
            const int p_lo = !split ? bid : bid < 128 ? bid * NA : bid < 256 ? 128 * NA + (bid - 128) * NB : NPIECE;
            const int p_hi = !split ? NPIECE : bid < 128 ? p_lo + NA : bid < 256 ? p_lo + NB : NPIECE, p_st = split ? 1 : G;
            for (int it = p_lo; it < p_hi; it += p_st) {
                const int b = it / (SEQ / 64), t0 = (it % (SEQ / 64)) * 64 + wave * 8;
                const bf16_t* pb = PROJ + (size_t)(b * SEQ) * PROJ_LD + 2048 + 8 * lane;
                u32x4 pr[10], gr[8];
#pragma unroll
                for (int r = 0; r < 10; ++r) { pr[r] = (u32x4){0u, 0u, 0u, 0u}; if (r >= 2 || t0 > 0) pr[r] = *(const u32x4*)(pb + (size_t)(t0 + r - 2) * PROJ_LD + 512); }
#pragma unroll
                for (int r = 0; r < 8; ++r) gr[r] = *(const u32x4*)(pb + (size_t)(t0 + r) * PROJ_LD);
                f32x4 p2[2], p1[2]; gm::unpack8(pr[0], p2[0], p2[1]); gm::unpack8(pr[1], p1[0], p1[1]);
#pragma unroll
                for (int r = 0; r < 8; ++r) { f32x4 q0, q1, g0, g1; gm::unpack8(pr[r + 2], q0, q1); gm::unpack8(gr[r], g0, g1);
                    const f32x4 y0 = g0 * (cw[0][0] * p2[0] + cw[1][0] * p1[0] + cw[2][0] * q0), y1 = g1 * (cw[0][1] * p2[1] + cw[1][1] * p1[1] + cw[2][1] * q1);
                    *(u32x4*)(CVB + (size_t)(b * SEQ + t0 + r) * D + 8 * lane) = gm::pack8(y0, y1);
                    p2[0] = p1[0]; p2[1] = p1[1]; p1[0] = q0; p1[1] = q1; }
            }
        }
        if (split && bid < 128) {
            const int chain = bid, b = chain >> 2, h = chain & 3, ot = tid >> 3, ocg = tid & 7;
            asm volatile("s_waitcnt vmcnt(0)" ::: "memory");
            __syncthreads();
            f32x4 nwv[4];
#pragma unroll
            for (int q = 0; q < 2; ++q) { nwv[2 * q] = *(const f32x4*)(hg_norm_w + q * 64 + 8 * ocg); nwv[2 * q + 1] = *(const f32x4*)(hg_norm_w + q * 64 + 8 * ocg + 4); }
            const bf16_t* pbase = PROJ + (size_t)(b * SEQ) * PROJ_LD + h * DK;
            for (int cc = 0; cc < NCHUNK / 2; cc += 2) {
                u32x4 rr[2][2], gq[2][2];
#pragma unroll
                for (int u = 0; u < 2; ++u) { const bf16_t* rp = RAWG + ((size_t)chain * (NCHUNK / 2) + cc + u) * (CHUNK * 128) + ot * 128 + 8 * ocg; rr[u][0] = *(const u32x4*)rp; rr[u][1] = *(const u32x4*)(rp + 64);
                    const bf16_t* gp = pbase + (size_t)((cc + u) * CHUNK + ot) * PROJ_LD + 1536 + 8 * ocg; gq[u][0] = *(const u32x4*)gp; gq[u][1] = *(const u32x4*)(gp + 64); }
#pragma unroll
                for (int u = 0; u < 2; ++u) { f32x4 o[4]; gm::unpack8(rr[u][0], o[0], o[1]); gm::unpack8(rr[u][1], o[2], o[3]);
                    float ss = 0.f;
#pragma unroll
                    for (int q = 0; q < 4; ++q) ss += (o[q][0] * o[q][0] + o[q][1] * o[q][1]) + (o[q][2] * o[q][2] + o[q][3] * o[q][3]);
                    ss += __shfl_xor(ss, 1); ss += __shfl_xor(ss, 2); ss += __shfl_xor(ss, 4);
                    const float rn = __builtin_amdgcn_rsqf(ss * (1.0f / 128.0f) + EPS);
                    bf16_t* op = OB + (size_t)(b * SEQ + (cc + u) * CHUNK + ot) * D + h * DK + 8 * ocg;
#pragma unroll
                    for (int q = 0; q < 2; ++q) { f32x4 g0, g1; gm::unpack8(gq[u][q], g0, g1);
#pragma unroll
                        for (int j = 0; j < 4; ++j) { g0[j] = g0[j] * sigmoidf_(g0[j]); g1[j] = g1[j] * sigmoidf_(g1[j]); }
                        *(u32x4*)(op + 64 * q) = gm::pack8(o[2 * q] * rn * nwv[2 * q] * g0, o[2 * q + 1] * rn * nwv[2 * q + 1] * g1); } }
            }
        }
        if (split && bid >= 128 && bid < 256) {
            LAS bf16_t* QB = (LAS bf16_t*)(lds) + 2 * 64 * LDQ;
            LAS bf16_t* ST = QB + 64 * LDQ + 2 * 128 * LDT + 64 * LDT;
            LAS bf16_t* OS = ST + 128 * LDQ;
            LAS float* DEC = (LAS float*)(OS + 64 * LDQ) + 8 * 128;
            const int chain = bid & 127, b = chain >> 2, h = chain & 3, fr = lane & 15, fq = lane >> 4, w = wave, ot = tid >> 3, ocg = tid & 7;
            asm volatile("s_waitcnt vmcnt(0)" ::: "memory");
            __syncthreads();
            if (wave == 0) { unsigned spins = 0;
                while ((unsigned)__builtin_amdgcn_readfirstlane((int)__hip_atomic_load((GAS unsigned*)(ctl + CW_ST + chain), __ATOMIC_RELAXED, __HIP_MEMORY_SCOPE_AGENT)) != 1u) { __builtin_amdgcn_s_sleep(2); if (++spins > (1u << 22)) break; }
                __builtin_amdgcn_fence(__ATOMIC_ACQUIRE, "agent"); }
            __syncthreads();
            f32x4 Sacc[8];
#pragma unroll
            for (int i = 0; i < 8; ++i) Sacc[i] = *(const f32x4*)(STATEG + (size_t)chain * 16384 + (16 * w + fr) * 128 + 16 * i + 4 * fq);
#pragma unroll
            for (int i = 0; i < 8; ++i) *(LAS u32x2*)(ST + (16 * w + fr) * LDQ + 16 * i + 4 * fq) = (u32x2){cvt_pk_bf16(Sacc[i][0], Sacc[i][1]), cvt_pk_bf16(Sacc[i][2], Sacc[i][3])};
            f32x4 nwv[4];
#pragma unroll
            for (int q = 0; q < 2; ++q) { nwv[2 * q] = *(const f32x4*)(hg_norm_w + q * 64 + 8 * ocg); nwv[2 * q + 1] = *(const f32x4*)(hg_norm_w + q * 64 + 8 * ocg + 4); }
            const bf16_t* pbase = PROJ + (size_t)(b * SEQ) * PROJ_LD + h * DK;
            const size_t cbase = (size_t)chain * (NCHUNK / 2);
#define P2_LOADQ(cix, Q, DV) do { const bf16_t* qp_ = QBG + (cbase + (cix)) * (CHUNK * 128) + ot * 128 + 8 * ocg; Q[0] = *(const u32x4*)qp_; Q[1] = *(const u32x4*)(qp_ + 64); \
                if (tid < 32) DV = *(const f32x4*)(DECG + (cbase + (cix)) * 128 + 4 * tid); } while (0)
#define P2_LOADR(cix, R, GGv) do { const bf16_t* rp_ = RAWG + (cbase + 128 * (NCHUNK / 2) + (cix)) * (CHUNK * 128) + ot * 128 + 8 * ocg; R[0] = *(const u32x4*)rp_; R[1] = *(const u32x4*)(rp_ + 64); \
                const bf16_t* gp_ = pbase + (size_t)((NCHUNK / 2 + (cix)) * CHUNK + ot) * PROJ_LD + 1536 + 8 * ocg; GGv[0] = *(const u32x4*)gp_; GGv[1] = *(const u32x4*)(gp_ + 64); } while (0)
#define P2_STEP(cix, Q, DV, R, GGv) do { \
                const int m0_ = (NCHUNK / 2 + (cix)) * CHUNK; \
                *(LAS u32x4*)(QB + ot * LDQ + 8 * ocg) = Q[0]; *(LAS u32x4*)(QB + ot * LDQ + 64 + 8 * ocg) = Q[1]; \
                if (tid < 32) *(LAS f32x4*)(DEC + 4 * tid) = DV; \
                LDS_WAIT(); __builtin_amdgcn_s_barrier(); asm volatile("" ::: "memory"); \
                if ((cix) + 2 < NCHUNK / 2) P2_LOADQ((cix) + 2, Q, DV); \
                f32x4 oacc[4]; \
                { bf16x8 sa[4]; \
                    _Pragma("unroll") for (int ks = 0; ks < 4; ++ks) sa[ks] = *(const LAS bf16x8*)(ST + (16 * w + fr) * LDQ + 32 * ks + 8 * fq); \
                    _Pragma("unroll") for (int ti = 0; ti < 4; ++ti) { oacc[ti] = (f32x4){0.f, 0.f, 0.f, 0.f}; \
                        _Pragma("unroll") for (int ks = 0; ks < 4; ++ks) { const bf16x8 bb = *(const LAS bf16x8*)(QB + (16 * ti + fr) * LDQ + 32 * ks + 8 * fq); oacc[ti] = __builtin_amdgcn_mfma_f32_16x16x32_bf16(sa[ks], bb, oacc[ti], 0, 0, 0); } } } \
                _Pragma("unroll") for (int ti = 0; ti < 4; ++ti) *(LAS u32x2*)(OS + (16 * ti + fr) * LDQ + 16 * w + 4 * fq) = (u32x2){cvt_pk_bf16(oacc[ti][0], oacc[ti][1]), cvt_pk_bf16(oacc[ti][2], oacc[ti][3])}; \
                _Pragma("unroll") for (int i = 0; i < 8; ++i) { const f32x4 dv = *(const LAS f32x4*)(DEC + 16 * i + 4 * fq); Sacc[i] = Sacc[i] * dv; \
                    *(LAS u32x2*)(ST + (16 * w + fr) * LDQ + 16 * i + 4 * fq) = (u32x2){cvt_pk_bf16(Sacc[i][0], Sacc[i][1]), cvt_pk_bf16(Sacc[i][2], Sacc[i][3])}; } \
                LDS_WAIT(); __builtin_amdgcn_s_barrier(); asm volatile("" ::: "memory"); \
                { f32x4 o[4], r4[4]; const u32x4 ow0 = *(const LAS u32x4*)(OS + ot * LDQ + 8 * ocg), ow1 = *(const LAS u32x4*)(OS + ot * LDQ + 64 + 8 * ocg); gm::unpack8(ow0, o[0], o[1]); gm::unpack8(ow1, o[2], o[3]); \
                    gm::unpack8(R[0], r4[0], r4[1]); gm::unpack8(R[1], r4[2], r4[3]); \
                    float ss = 0.f; \
                    _Pragma("unroll") for (int q = 0; q < 4; ++q) { o[q] = o[q] + r4[q]; ss += (o[q][0] * o[q][0] + o[q][1] * o[q][1]) + (o[q][2] * o[q][2] + o[q][3] * o[q][3]); } \
                    ss += __shfl_xor(ss, 1); ss += __shfl_xor(ss, 2); ss += __shfl_xor(ss, 4); \
                    const float rn = __builtin_amdgcn_rsqf(ss * (1.0f / 128.0f) + EPS); \
                    bf16_t* op = OB + (size_t)(b * SEQ + m0_ + ot) * D + h * DK + 8 * ocg; \
                    _Pragma("unroll") for (int q = 0; q < 2; ++q) { f32x4 g0, g1; gm::unpack8(GGv[q], g0, g1); \
                        _Pragma("unroll") for (int j = 0; j < 4; ++j) { g0[j] = g0[j] * sigmoidf_(g0[j]); g1[j] = g1[j] * sigmoidf_(g1[j]); } \
                        *(u32x4*)(op + 64 * q) = gm::pack8(o[2 * q] * rn * nwv[2 * q] * g0, o[2 * q + 1] * rn * nwv[2 * q + 1] * g1); } } \
                if ((cix) + 2 < NCHUNK / 2) P2_LOADR((cix) + 2, R, GGv); \
            } while (0)
            u32x4 qA[2], rA_[2], gA[2], qB_[2], rB_[2], gB[2]; f32x4 dA = (f32x4){0.f, 0.f, 0.f, 0.f}, dB = dA;
            P2_LOADQ(0, qA, dA); P2_LOADR(0, rA_, gA); P2_LOADQ(1, qB_, dB); P2_LOADR(1, rB_, gB);
            for (int cc = 0; cc < NCHUNK / 2; cc += 2) { P2_STEP(cc, qA, dA, rA_, gA); P2_STEP(cc + 1, qB_, dB, rB_, gB); }
#undef P2_STEP
#undef P2_LOADQ
#undef P2_LOADR
        }
        if (BOTH(3)) GRID_BAR();
#if MK_PHT
        if (MK_PHT == 4) phtk = __builtin_amdgcn_s_memrealtime() - pht0;
#endif
    }

    if (IN(4)) for (int rep_ = 0; rep_ < 1 + ((MK_REPEAT >> 4) & 1); ++rep_) { PHASE_ARGS();
        gm::DenseOrder S{NTOK / 256, D / 256, G, bid, 1}; gm::DenseA AM{D, 0u, 2}; gm::EpiMerge E{(const bf16_t*)ap->out, WSP(bf16_t, WS_U)};
        gm::gemm_phase<false>(wave_sg, lds, (const char*)WSP(bf16_t, WS_O), (const char*)WSP(bf16_t, WS_WHG), D, 0, 0u, S, E, AM);
        if (BOTH(4)) GRID_BAR();
#if MK_PHT
        if (MK_PHT == 5) phtk = __builtin_amdgcn_s_memrealtime() - pht0;
#endif
    }

    if (IN(5)) for (int rep_ = 0; rep_ < 1 + ((MK_REPEAT >> 5) & 1); ++rep_) { PHASE_ARGS();
        gm::DenseOrder S{NTOK / 256, D / 256, G, bid, 1}; gm::DenseA AM{D, 0u, 2}; gm::EpiMix E{ARG(I_X), WSP(float, WS_MOD), WSP(bf16_t, WS_H)};
        gm::gemm_phase<false>(wave_sg, lds, (const char*)WSP(bf16_t, WS_U), (const char*)WSP(bf16_t, WS_WMIX), D, 0, 0u, S, E, AM);
        if (BOTH(5)) GRID_BAR();
#if MK_PHT
        if (MK_PHT == 6) phtk = __builtin_amdgcn_s_memrealtime() - pht0;
#endif
    }

    if (IN(6)) { PHASE_IDS(); PHASE_ARGS();
        typedef float f32x16 __attribute__((ext_vector_type(16)));
        const float* norm_ffn_w = ARG(I_NFFN); const float* w_router = ARG(I_WR); const float* b_router = ARG(I_BR); const float* MOD = WSP(float, WS_MOD);
        const bf16_t* HB = WSP(bf16_t, WS_H); unsigned char* U2Q = WSP(unsigned char, WS_U2Q); int* TOPI = WSP(int, WS_TOPI); float* TOPP = WSP(float, WS_TOPP); int* POS = WSP(int, WS_POS);
        constexpr int WRS = 1032;
        LAS bf16_t* WRH = (LAS bf16_t*)lds; LAS bf16_t* WRL = WRH + 32 * WRS;
        LAS float* LG = (LAS float*)(lds + 132096) + wave * (16 * 36);
        LAS unsigned* LCNT = (LAS unsigned*)(lds + 150528);
        LAS unsigned* LBASE = LCNT + 32;
        LAS unsigned* LASS = LCNT + 64;
        LAS float* A2 = (LAS float*)(lds + 154880); LAS float* SH2 = A2 + 1024;
        for (int i = tid; i < 32 * 1024; i += NTHREADS) { const int e = i & 31, k = i >> 5; const float w = w_router[i];
            const unsigned hi = cvt_pk_bf16(w, 0.f) & 0xffffu; const unsigned lo = cvt_pk_bf16(w - bf_lo(hi), 0.f) & 0xffffu;
            WRH[e * WRS + k] = (bf16_t)hi; WRL[e * WRS + k] = (bf16_t)lo; }
        for (int tb = bid; tb < NTOK / 256; tb += G) {
            const int b = (tb * 256) >> 11;
            if (tid < 32) LCNT[tid] = 0u;
            for (int k = tid; k < 1024; k += NTHREADS) { A2[k] = norm_ffn_w[k] * (1.0f + MOD[(size_t)b * 6144 + 4096 + k]); SH2[k] = MOD[(size_t)b * 6144 + 3072 + k]; }
            LDS_WAIT(); __syncthreads();
            const int trow = lane & 31, half = lane >> 5, ltok0 = wave * 32, tok = tb * 256 + ltok0 + trow;
            const bf16_t* hrow = HB + (size_t)tok * D + 8 * half;
            float ssq = 0.f;
#pragma unroll 8
            for (int st = 0; st < 64; ++st) { const u32x4 hv = *(const u32x4*)(hrow + 16 * st); f32x4 x0, x1; gm::unpack8(hv, x0, x1);
                ssq += (x0[0] * x0[0] + x0[1] * x0[1]) + (x0[2] * x0[2] + x0[3] * x0[3]) + (x1[0] * x1[0] + x1[1] * x1[1]) + (x1[2] * x1[2] + x1[3] * x1[3]); }
            ssq += __shfl_xor(ssq, 32);
            const float rs = __builtin_amdgcn_rsqf(ssq * (1.0f / D) + EPS);
            f32x16 dacc;
#pragma unroll
            for (int q = 0; q < 16; ++q) dacc[q] = 0.f;
            unsigned char* urow = U2Q + (size_t)tok * D + 8 * half;
            const LAS bf16_t* wh = WRH + trow * WRS + 8 * half; const LAS bf16_t* wl = WRL + trow * WRS + 8 * half;
#pragma unroll 2
            for (int st = 0; st < 64; ++st) {
                const u32x4 hv = *(const u32x4*)(hrow + 16 * st); f32x4 x0, x1; gm::unpack8(hv, x0, x1);
                const int k0 = 16 * st + 8 * half;
                const f32x4 a0 = *(const LAS f32x4*)(A2 + k0), a1 = *(const LAS f32x4*)(A2 + k0 + 4), s0 = *(const LAS f32x4*)(SH2 + k0), s1 = *(const LAS f32x4*)(SH2 + k0 + 4);
                const f32x4 u0 = x0 * rs * a0 + s0, u1 = x1 * rs * a1 + s1;
                *(u32x2*)(urow + 16 * st) = (u32x2){pk4_fp8(u0[0], u0[1], u0[2], u0[3]), pk4_fp8(u1[0], u1[1], u1[2], u1[3])};
                u32x4 hh; hh.x = cvt_pk_bf16(u0[0], u0[1]); hh.y = cvt_pk_bf16(u0[2], u0[3]); hh.z = cvt_pk_bf16(u1[0], u1[1]); hh.w = cvt_pk_bf16(u1[2], u1[3]);
                u32x4 ll; ll.x = cvt_pk_bf16(u0[0] - bf_lo(hh.x), u0[1] - bf_hi(hh.x)); ll.y = cvt_pk_bf16(u0[2] - bf_lo(hh.y), u0[3] - bf_hi(hh.y));
                ll.z = cvt_pk_bf16(u1[0] - bf_lo(hh.z), u1[1] - bf_hi(hh.z)); ll.w = cvt_pk_bf16(u1[2] - bf_lo(hh.w), u1[3] - bf_hi(hh.w));
                const bf16x8 ah = __builtin_bit_cast(bf16x8, hh), al = __builtin_bit_cast(bf16x8, ll);
                const bf16x8 bh = *(const LAS bf16x8*)(wh + 16 * st), bl = *(const LAS bf16x8*)(wl + 16 * st);
                dacc = __builtin_amdgcn_mfma_f32_32x32x16_bf16(ah, bh, dacc, 0, 0, 0);
                dacc = __builtin_amdgcn_mfma_f32_32x32x16_bf16(ah, bl, dacc, 0, 0, 0);
                dacc = __builtin_amdgcn_mfma_f32_32x32x16_bf16(al, bh, dacc, 0, 0, 0);
            }
            const float br = b_router[trow];
#pragma unroll
            for (int g = 0; g < 2; ++g) {
#pragma unroll
                for (int q = 0; q < 8; ++q) { const int r16 = (q & 3) + 8 * (q >> 2) + 4 * half; LG[r16 * 36 + trow] = dacc[8 * g + q] + br; }
                LDS_WAIT(); asm volatile("" ::: "memory");
                if (lane < 16) {
                    float v0 = -3.0e38f, v1 = -3.0e38f, v2 = -3.0e38f, v3 = -3.0e38f; int i0 = 0, i1 = 0, i2 = 0, i3 = 0;
#pragma unroll
                    for (int e4 = 0; e4 < 8; ++e4) { const f32x4 lv = *(const LAS f32x4*)(LG + lane * 36 + 4 * e4);
#pragma unroll
                        for (int j = 0; j < 4; ++j) { const float x = lv[j]; const int e = 4 * e4 + j;
                            const bool c0 = x > v0, c1 = x > v1, c2 = x > v2, c3 = x > v3;
                            v3 = c2 ? v2 : (c3 ? x : v3); i3 = c2 ? i2 : (c3 ? e : i3);
                            v2 = c1 ? v1 : (c2 ? x : v2); i2 = c1 ? i1 : (c2 ? e : i2);
                            v1 = c0 ? v0 : (c1 ? x : v1); i1 = c0 ? i0 : (c1 ? e : i1);
                            v0 = c0 ? x : v0; i0 = c0 ? e : i0; } }
                    const float e1 = fast_exp(v1 - v0), e2 = fast_exp(v2 - v0), e3 = fast_exp(v3 - v0); const float inv = fast_rcp(1.0f + e1 + e2 + e3);
                    const int lt = ltok0 + 16 * g + lane; const size_t gt = (size_t)tb * 256 + lt;
                    typedef int i32x4 __attribute__((ext_vector_type(4)));
                    *(i32x4*)(TOPI + gt * 4) = (i32x4){i0, i1, i2, i3}; *(f32x4*)(TOPP + gt * 4) = (f32x4){inv, e1 * inv, e2 * inv, e3 * inv};
                    const unsigned r0 = __hip_atomic_fetch_add(LCNT + i0, 1u, __ATOMIC_RELAXED, __HIP_MEMORY_SCOPE_WORKGROUP), r1 = __hip_atomic_fetch_add(LCNT + i1, 1u, __ATOMIC_RELAXED, __HIP_MEMORY_SCOPE_WORKGROUP);
                    const unsigned r2 = __hip_atomic_fetch_add(LCNT + i2, 1u, __ATOMIC_RELAXED, __HIP_MEMORY_SCOPE_WORKGROUP), r3 = __hip_atomic_fetch_add(LCNT + i3, 1u, __ATOMIC_RELAXED, __HIP_MEMORY_SCOPE_WORKGROUP);
                    *(LAS u32x4*)(LASS + lt * 4) = (u32x4){((unsigned)i0 << 16) | r0, ((unsigned)i1 << 16) | r1, ((unsigned)i2 << 16) | r2, ((unsigned)i3 << 16) | r3};
                }
                LDS_WAIT(); asm volatile("" ::: "memory");
            }
            LDS_WAIT(); __syncthreads();
            if (tid < 32) LBASE[tid] = atomicAdd(ctl + CW_CNT + 64 * tid, (unsigned)LCNT[tid]);
            LDS_WAIT(); __syncthreads();
            for (int i = tid; i < 1024; i += NTHREADS) { const unsigned v = LASS[i]; POS[(size_t)tb * 1024 + i] = (int)(LBASE[v >> 16] + (v & 0xffffu)); }
            __syncthreads();
        }
        if (BOTH(6)) GRID_BAR();
#if MK_PHT
        if (MK_PHT == 7) phtk = __builtin_amdgcn_s_memrealtime() - pht0;
#endif
    }

    LAS int* PADSTART = (LAS int*)(lds + TBL_OFF); LAS int* TILE_E = PADSTART + 64;
    int ntiles = 0;
    {
        if (lo <= 9 && hi > 7) { PHASE_IDS(); PHASE_ARGS();
            __syncthreads();
            if (wave == 0) {
                const int cnt = lane < NE ? (int)__hip_atomic_load(ctl + CW_CNT + 64 * lane, __ATOMIC_RELAXED, __HIP_MEMORY_SCOPE_AGENT) : 0;
                const int padded = ((cnt + 255) >> 8) << 8; int incl = padded;
#pragma unroll
                for (int o = 1; o < 32; o <<= 1) { const int v = __shfl_up(incl, o); if ((lane & 31) >= o) incl += v; }
                if (lane < NE) PADSTART[lane] = incl - padded;
                if (lane == NE - 1) PADSTART[NE] = incl;
            }
            LDS_WAIT(); __syncthreads();
            for (int t = tid; t < (PADSTART[NE] >> 8); t += NTHREADS) { int e = 0;
#pragma unroll
                for (int q = 1; q < NE; ++q) e += ((PADSTART[q] >> 8) <= t) ? 1 : 0;
                TILE_E[t] = e; }
            LDS_WAIT(); __syncthreads();
            ntiles = PADSTART[NE] >> 8;
        }
    }

    if (IN(7)) for (int rep_ = 0; rep_ < 1 + ((MK_REPEAT >> 7) & 1); ++rep_) { PHASE_IDS(); PHASE_ARGS();
        const int* TOPI = WSP(int, WS_TOPI); const float* TOPP = WSP(float, WS_TOPP); int* POS = WSP(int, WS_POS); int* RTOK = WSP(int, WS_RTOK); int* RSLOT = WSP(int, WS_RSLOT); float* RW = WSP(float, WS_RW);
        for (int i = bid * NTHREADS + tid; i < NASSIGN; i += G * NTHREADS) { const int e = TOPI[i]; const int row = PADSTART[e] + POS[i]; RTOK[row] = i >> 2; RSLOT[row] = i; RW[row] = TOPP[i]; POS[i] = row; }
        for (int e = bid; e < NE; e += G) { const int cnt = (int)__hip_atomic_load(ctl + CW_CNT + 64 * e, __ATOMIC_RELAXED, __HIP_MEMORY_SCOPE_AGENT);
            for (int r = PADSTART[e] + cnt + tid; r < PADSTART[e + 1]; r += NTHREADS) { RTOK[r] = 0; RSLOT[r] = -1; RW[r] = 0.f; } }
#if MK_BG && MK_ONE_LAUNCH
        if (BOTH(7)) GRID_BAR_X(true);
#else
        if (BOTH(7)) GRID_BAR();
#endif
#if MK_PHT
        if (MK_PHT == 8) phtk = __builtin_amdgcn_s_memrealtime() - pht0;
#endif
    }

    if (IN(8)) for (int rep_ = 0; rep_ < 1 + ((MK_REPEAT >> 8) & 1); ++rep_) { PHASE_ARGS();
        gm::MoeOrder S{ntiles, 2048 / 256, G, bid, TILE_E}; gm::GatherA AM{D, WSP(int, WS_RTOK), 1}; gm::EpiSwiglu E{ARG(I_B1), WSP(unsigned char, WS_ACT), ctl + CW_TP};
        gm::gemm_phase<true>(wave_sg, lds, (const char*)WSP(char, WS_U2Q), (const char*)WSP(char, WS_W1), D, 2048, 0u, S, E, AM);
        if (BOTH(8)) GRID_BAR();
#if MK_PHT
        if (MK_PHT == 9) phtk = __builtin_amdgcn_s_memrealtime() - pht0;
#endif
    }

    if (IN(9)) for (int rep_ = 0; rep_ < 1 + ((MK_REPEAT >> 9) & 1); ++rep_) { PHASE_ARGS();
        gm::MoeOrder S{ntiles, D / 256, G, bid, TILE_E}; gm::DenseA AM{DFF, 0u, 1}; gm::EpiMoeOut E{ARG(I_B2), WSP(float, WS_RW), WSP(unsigned char, WS_YA)};
        gm::gemm_phase<true>(wave_sg, lds, (const char*)WSP(char, WS_ACT), (const char*)WSP(char, WS_W2), DFF, D, 0u, S, E, AM);
        if (BOTH(9)) GRID_BAR();
#if MK_PHT
        if (MK_PHT == 10) phtk = __builtin_amdgcn_s_memrealtime() - pht0;
#endif
    }

#if MK_PROBE
    if (lo == 100) { PHASE_IDS(); PHASE_ARGS();
        float* out = ap->out;
        const bf16_t* src = MK_PROBE == 1 ? WSP(bf16_t, WS_U) : MK_PROBE == 3 ? WSP(bf16_t, WS_O) : MK_PROBE == 4 ? WSP(bf16_t, WS_U) : MK_PROBE == 5 ? WSP(bf16_t, WS_H) : WSP(bf16_t, WS_U);
        for (size_t i = (size_t)bid * NTHREADS + tid; i < (size_t)NTOK * D; i += (size_t)G * NTHREADS) {
            float v;
            if (MK_PROBE == 3) { const size_t t = i >> 10, c = i & 1023; v = bf1(src[t * 1024 + c]); }
            else if (MK_PROBE == 2) { const size_t t = i >> 10, c = i & 1023; const bf16_t* P = WSP(bf16_t, WS_PROJ) + t * PROJ_LD; v = bf1(P[c]) + bf1(P[c + 1024]) + bf1(P[c + 2048]) + (c < 512 ? bf1(P[c + 3072]) : 0.f); }
            else if (MK_PROBE == 6) { const size_t t = i >> 10, c = i & 1023; v = bf1(src[i]) + (c < 4 ? (float)WSP(int, WS_TOPI)[t * 4 + c] : c < 8 ? WSP(float, WS_TOPP)[t * 4 + (c - 4)] : 0.f); }
            else v = bf1(src[i]);
            out[i] = v; }
    }
#endif
    if (IN(10)) { PHASE_IDS(); PHASE_ARGS();
#if MK_TPROBE
        const float tscale = 1.0f;
#elif MK_FP8TEST
        float tscale = 1.0f;
        {
            typedef int v8i __attribute__((ext_vector_type(8)));
            const int fr = lane & 15, fq = lane >> 4;
            v8i ta, tb;
#pragma unroll
            for (int d = 0; d < 8; ++d) { float av[4], bv[4];
#pragma unroll
                for (int e = 0; e < 4; ++e) { const int k = 32 * fq + 4 * d + e; av[e] = (float)(((fr * 7 + k * 3) % 5) - 2); bv[e] = (float)(((k * 5 + fr * 11) % 7) - 3); }
                int w = __builtin_amdgcn_cvt_pk_fp8_f32(av[0], av[1], 0, false); w = __builtin_amdgcn_cvt_pk_fp8_f32(av[2], av[3], w, true); ta[d] = w;
                w = __builtin_amdgcn_cvt_pk_fp8_f32(bv[0], bv[1], 0, false); w = __builtin_amdgcn_cvt_pk_fp8_f32(bv[2], bv[3], w, true); tb[d] = w; }
            f32x4 tc = {0.f, 0.f, 0.f, 0.f};
            tc = __builtin_amdgcn_mfma_scale_f32_16x16x128_f8f6f4(ta, tb, tc, 0, 0, 0, 0x7A7A7A7A, 0, 0x7F7F7F7F);
            bool bad = false;
#pragma unroll
            for (int r = 0; r < 4; ++r) { const int i = 4 * fq + r, j = fr; float ref = 0.f;
                for (int k = 0; k < 128; ++k) ref += (float)(((i * 7 + k * 3) % 5) - 2) * (float)(((k * 5 + j * 11) % 7) - 3);
                ref *= (1.0f / 32.0f); if (fabsf(tc[r] - ref) > 1e-3f) bad = true; }
            if (__any(bad)) tscale = 4.0f;
        }
#endif
        const float* norm_final_w = ARG(I_NFIN); const float* MOD = WSP(float, WS_MOD); const bf16_t* HB = WSP(bf16_t, WS_H); const unsigned char* YA = WSP(unsigned char, WS_YA); const int* ASROW = WSP(int, WS_POS); float* out = ap->out;
        for (int m0 = gw * 32; m0 < NTOK; m0 += NGW * 32) {
            const int b = m0 >> 11;
            f32x4 gf[4], nf[4];
#pragma unroll
            for (int j = 0; j < 4; ++j) { const int k = 4 * lane + 256 * j; gf[j] = *(const f32x4*)(MOD + (size_t)b * 6144 + 5120 + k); nf[j] = *(const f32x4*)(norm_final_w + k); }
            for (int r = 0; r < 32; ++r) {
                const size_t tok = (size_t)(m0 + r);
                const bf16_t* hr = HB + tok * D;
                typedef int i32x4 __attribute__((ext_vector_type(4)));
                const i32x4 rr = *(const i32x4*)(ASROW + tok * 4);
                const unsigned char* y0 = YA + (size_t)rr[0] * D; const unsigned char* y1 = YA + (size_t)rr[1] * D; const unsigned char* y2 = YA + (size_t)rr[2] * D; const unsigned char* y3 = YA + (size_t)rr[3] * D;
                f32x4 v[4]; float s = 0.f;
#pragma unroll
                for (int j = 0; j < 4; ++j) { const int k = 4 * lane + 256 * j;
                    const u32x2 hw = *(const u32x2*)(hr + k); const unsigned ya = *(const unsigned*)(y0 + k), yb = *(const unsigned*)(y1 + k), yc = *(const unsigned*)(y2 + k), yd = *(const unsigned*)(y3 + k);
                    f32x4 y = fp8x4_to_f32(ya); y += fp8x4_to_f32(yb); y += fp8x4_to_f32(yc); y += fp8x4_to_f32(yd);
                    v[j] = (f32x4){bf_lo(hw.x), bf_hi(hw.x), bf_lo(hw.y), bf_hi(hw.y)} + gf[j] * y;
                    s += (v[j][0] * v[j][0] + v[j][1] * v[j][1]) + (v[j][2] * v[j][2] + v[j][3] * v[j][3]); }
                const float rs = __builtin_amdgcn_rsqf(wave_sum(s) * (1.0f / D) + EPS);
                float* orow = out + tok * D;
#pragma unroll
                #if MK_FP8TEST || MK_TPROBE
                for (int j = 0; j < 4; ++j) *(f32x4*)(orow + 4 * lane + 256 * j) = v[j] * rs * nf[j] * tscale;
#else
                for (int j = 0; j < 4; ++j) *(f32x4*)(orow + 4 * lane + 256 * j) = v[j] * rs * nf[j];
#endif
            }
        }
    }
#if MK_PHT
    if (bid == 0) { const unsigned long long t1 = __builtin_amdgcn_s_memrealtime(); while (__builtin_amdgcn_s_memrealtime() - t1 < phtk) __builtin_amdgcn_s_sleep(8); }
#endif
#undef IN
#undef BOTH
}

extern "C" void kernel_launch(void* const* d_in, const int* in_sizes, int n_in, void* d_out, int out_size, void* d_ws, size_t ws_size, hipStream_t stream) {
    static int grid = 0;
    if (grid == 0) {
        if (n_in != 20 || out_size != NTOK * D || ws_size < WS_END) { fprintf(stderr, "kernel_launch: unexpected shapes (n_in %d out %d ws %zu)\n", n_in, out_size, ws_size); grid = -1; return; }
        if (hipFuncSetAttribute((const void*)fwd_kernel, hipFuncAttributeMaxDynamicSharedMemorySize, LDS_BYTES) != hipSuccess) { fprintf(stderr, "kernel_launch: hipFuncSetAttribute failed\n"); grid = -1; return; }
        int dev = 0, cus = 0, per_cu = 0;
        (void)hipGetDevice(&dev); (void)hipDeviceGetAttribute(&cus, hipDeviceAttributeMultiprocessorCount, dev);
        if (hipOccupancyMaxActiveBlocksPerMultiprocessor(&per_cu, (const void*)fwd_kernel, NTHREADS, LDS_BYTES) != hipSuccess || per_cu < 1) fprintf(stderr, "kernel_launch: occupancy query says %d\n", per_cu);
        (void)hipGetLastError();
        grid = cus > 0 ? cus : 256;
    }
    if (grid < 0) return;
    (void)hipMemsetAsync((char*)d_ws + WS_CTL, 0, CTL_ZERO_BYTES, stream);
    Args a{};
    for (int i = 0; i < 20; ++i) a.in[i] = (const float*)d_in[i];
    a.out = (float*)d_out; a.ws = (unsigned char*)d_ws;
#if MK_ONE_LAUNCH
    a.ph_lo = 0; a.ph_hi = NPHASE;
    hipLaunchKernelGGL(fwd_kernel, dim3(grid), dim3(NTHREADS), LDS_BYTES, stream, a);
#else
#if MK_PROBE
    for (int p = 0; p <= MK_PROBE; ++p) { a.ph_lo = p; a.ph_hi = p + 1; hipLaunchKernelGGL(fwd_kernel, dim3(grid), dim3(NTHREADS), LDS_BYTES, stream, a); }
    a.ph_lo = 100; a.ph_hi = 101; hipLaunchKernelGGL(fwd_kernel, dim3(grid), dim3(NTHREADS), LDS_BYTES, stream, a);
#else
    for (int p = 0; p < NPHASE; ++p) { a.ph_lo = p; a.ph_hi = p + 1; hipLaunchKernelGGL(fwd_kernel, dim3(grid), dim3(NTHREADS), LDS_BYTES, stream, a); }
#endif
#endif
}
```

```cpp
#include <hip/hip_runtime.h>
#include <cstdio>
#include <cstdint>

#ifndef MK_PROBE
#define MK_PROBE 0
#endif
#ifndef MK_REPEAT
#define MK_REPEAT 0
#endif
#ifndef MK_FP8TEST
#define MK_FP8TEST 0
#endif
#ifndef MK_STAGGER
#define MK_STAGGER 0
#endif
#ifndef MK_TPROBE
#define MK_TPROBE 0
#endif
#ifndef MK_PHT
#define MK_PHT 0
#endif
#ifndef MK_PN8
#define MK_PN8 14
#endif
#ifndef MK_GO8
#define MK_GO8 4
#endif
#ifndef MK_S08
#define MK_S08 4
#endif
#ifndef MK_Q8
#define MK_Q8 1
#endif
#ifndef MK_CONV_NA
#define MK_CONV_NA 6
#endif
#ifndef MK_WGM8
#define MK_WGM8 2
#endif
#ifndef MK_WGM9
#define MK_WGM9 8
#endif
#ifndef MK_P2FP8
#define MK_P2FP8 0
#endif
#ifndef MK_BG
#define MK_BG 0
#endif
#ifndef MK_ONE_LAUNCH
#define MK_ONE_LAUNCH 1
#endif

#define LAS __attribute__((address_space(3)))
#define GAS __attribute__((address_space(1)))
typedef unsigned short bf16_t;
typedef short bf16x8 __attribute__((ext_vector_type(8)));
typedef float f32x4 __attribute__((ext_vector_type(4)));
typedef float f32x2 __attribute__((ext_vector_type(2)));
typedef unsigned u32x4 __attribute__((ext_vector_type(4)));
typedef unsigned u32x2 __attribute__((ext_vector_type(2)));
typedef int v8i __attribute__((ext_vector_type(8)));

constexpr int D = 1024, BATCH = 32, SEQ = 2048, NTOK = BATCH * SEQ;
constexpr int HW = 512, NHEAD = 4, DK = 128, CHUNK = 64, NCHUNK = SEQ / CHUNK;
constexpr int INC = 5632, PROJ_LD = 3584, GATE_LD = 2048;
constexpr int NE = 32, TOPK = 4, DFF = 1024, NASSIGN = NTOK * TOPK;
constexpr int MAXTILES = NASSIGN / 256 + NE;
constexpr int MAXROWS = MAXTILES * 256;
constexpr float EPS = 1e-6f, SW_LIMIT = 7.0f, SW_ALPHA = 1.702f;
constexpr int NWAVES = 8, NTHREADS = 512;
constexpr int NPHASE = 11;

constexpr size_t MiB = 1u << 20;
constexpr size_t WS_CTL = 0, CTL_ZERO_BYTES = 65536;
constexpr size_t WS_MOD = 1 * MiB;
constexpr size_t WS_LB = WS_MOD + 32 * 6144 * 4;
constexpr size_t WS_WIN = 2 * MiB;
constexpr size_t WS_WHG = 13 * MiB, WS_WCV = 14 * MiB, WS_WMIX = 15 * MiB;
constexpr size_t WS_W2 = 18 * MiB;
constexpr size_t WS_W1 = 50 * MiB;
constexpr size_t WS_U2Q = 114 * MiB;
constexpr size_t WS_U = 210 * MiB;
constexpr size_t WS_PROJ = 338 * MiB;
constexpr size_t WS_O = 786 * MiB;
constexpr size_t WS_CV = 850 * MiB;
constexpr size_t WS_H = 338 * MiB;
constexpr size_t WS_ACT = 466 * MiB;
constexpr size_t WS_TOPI = 994 * MiB, WS_TOPP = 995 * MiB, WS_POS = 996 * MiB;
constexpr size_t WS_RTOK = 997 * MiB, WS_RSLOT = 997 * MiB + 1081344 + 0, WS_RW = WS_RSLOT + 1081344;
constexpr size_t WS_YA = 50 * MiB, WS_YB = 730 * MiB; constexpr int YSPLIT = 147456;
constexpr size_t WS_YO23_UNUSED = 730 * MiB;
constexpr int PN8 = MK_PN8 - MK_GO8 - (MK_Q8 ? 2 : 0), NQ8 = 22 - PN8;
__host__ __device__ constexpr int map16(int j) { return MK_Q8 ? (j < 2 ? 2 + j : 2 + MK_GO8 + j) : (j >= MK_S08 ? j + MK_GO8 : j); }
__host__ __device__ constexpr int map8(int j) { return MK_Q8 ? (j < 2 ? j : j < 2 + MK_GO8 ? j + 2 : j + 12 - MK_GO8) : (j < MK_GO8 ? MK_S08 + j : MK_PN8 - MK_GO8 + j); }
constexpr size_t WS_WIN8 = 914 * MiB;
constexpr size_t WS_U8 = 920 * MiB;
constexpr size_t WS_RAW = WS_U, WS_QBG = WS_U + 64 * MiB, WS_STATE = WS_U + 96 * MiB, WS_DECG = WS_U + 104 * MiB;
constexpr size_t WS_WRI = 984 * MiB;
constexpr size_t WS_SSQ = 986 * MiB;
constexpr size_t WS_END = 1001 * MiB;
static_assert(WS_RW + 1081344 <= WS_END && MAXROWS * 4 == 1081344, "tables");
static_assert(WS_ACT + (size_t)MAXROWS * 1024 <= WS_YB && WS_YB + (size_t)(MAXROWS - YSPLIT) * 2048 <= WS_TOPI && WS_YA + (size_t)YSPLIT * 2048 <= WS_H && YSPLIT % 256 == 0, "expert output map");
constexpr int CW_TMO = 0, CW_BAR = 4096, CW_CNT = 8192, CW_TP = 12288, CW_Q = 12544, CW_ST = 14336;

constexpr int LDS_BYTES = 163840;
constexpr int MISC_OFF = LDS_BYTES - 256;
constexpr int TBL_OFF = 135168;
constexpr int SIDE_OFF = TBL_OFF + 8192;

#define LDS_WAIT() asm volatile("s_waitcnt lgkmcnt(0)" ::: "memory")
#define VM_WAIT() asm volatile("s_waitcnt vmcnt(0)" ::: "memory")
typedef __bf16 bf16x2_t __attribute__((ext_vector_type(2)));
__device__ __forceinline__ unsigned cvt_pk_bf16(float lo, float hi) { const f32x2 v = {lo, hi}; const bf16x2_t b = __builtin_convertvector(v, bf16x2_t); return __builtin_bit_cast(unsigned, b); }
__device__ __forceinline__ unsigned pk4_fp8(float a, float b, float c, float d) {
    a = fminf(fmaxf(a, -448.f), 448.f); b = fminf(fmaxf(b, -448.f), 448.f); c = fminf(fmaxf(c, -448.f), 448.f); d = fminf(fmaxf(d, -448.f), 448.f);
    int w = __builtin_amdgcn_cvt_pk_fp8_f32(a, b, 0, false); w = __builtin_amdgcn_cvt_pk_fp8_f32(c, d, w, true); return (unsigned)w; }
__device__ __forceinline__ f32x4 fp8x4_to_f32(unsigned w) {
    const f32x2 lo = __builtin_amdgcn_cvt_pk_f32_fp8((int)w, false), hi = __builtin_amdgcn_cvt_pk_f32_fp8((int)w, true); return (f32x4){lo[0], lo[1], hi[0], hi[1]}; }
__device__ __forceinline__ unsigned pk4_fp8_nc(float a, float b, float c, float d) {
    int w = __builtin_amdgcn_cvt_pk_fp8_f32(a, b, 0, false); w = __builtin_amdgcn_cvt_pk_fp8_f32(c, d, w, true); return (unsigned)w; }
__device__ __forceinline__ float bf_lo(unsigned u) { return __uint_as_float(u << 16); }
__device__ __forceinline__ float bf_hi(unsigned u) { return __uint_as_float(u & 0xffff0000u); }
__device__ __forceinline__ float bf1(bf16_t u) { return __uint_as_float(((unsigned)u) << 16); }
__device__ __forceinline__ float fast_rcp(float x) { return __builtin_amdgcn_rcpf(x); }
__device__ __forceinline__ float fast_exp(float x) { return __builtin_amdgcn_exp2f(x * 1.44269504089f); }
__device__ __forceinline__ float fast_log(float x) { return __builtin_amdgcn_logf(x) * 0.69314718056f; }
__device__ __forceinline__ float sigmoidf_(float x) { return fast_rcp(1.0f + fast_exp(-x)); }
__device__ __forceinline__ float wave_sum(float v) {
#pragma unroll
    for (int o = 1; o < 64; o <<= 1) v += __shfl_xor(v, o);
    return v;
}

#define XB_TMO      128
#define XB_XCNT(j)  (256  + 64 * (j))
#define XB_XSUB(j)  (1280 + 64 * (j))
#define XB_XGEN(j)  (2304 + 64 * (j))
#define XB_TOP      3328
#define XB_TOPGEN   3392
#define XCD_BAR_WORDS 3456
#define XB_SPIN_CAP (1u << 20)
__device__ __forceinline__ unsigned xb_ld(unsigned* p)              { return __hip_atomic_load(p, __ATOMIC_RELAXED, __HIP_MEMORY_SCOPE_AGENT); }
__device__ __forceinline__ unsigned xb_add(unsigned* p, unsigned v) { return __hip_atomic_fetch_add(p, v, __ATOMIC_RELAXED, __HIP_MEMORY_SCOPE_AGENT); }
__device__ __forceinline__ unsigned xb_xcc_id() { return (unsigned)__builtin_amdgcn_s_getreg((3 << 11) | 20) & 0xFu; }
#define XB_SPIN(cond, bar) do { unsigned _sp = 0; while (cond) { __builtin_amdgcn_s_sleep(1); \
    if ((++_sp & 255u) == 0u) { if (xb_ld(&(bar)[XB_TMO])) break; if (_sp > XB_SPIN_CAP) { atomicAdd(&(bar)[XB_TMO], 1u); break; } } } } while (0)
struct XcdBarrier { unsigned* bar; unsigned x; volatile LAS unsigned* st; };
__device__ __forceinline__ XcdBarrier xcd_barrier_post(unsigned* bar, volatile LAS unsigned* st) {
    XcdBarrier b; b.bar = bar; b.x = xb_xcc_id(); b.st = st;
    if (threadIdx.x == 0) (void)xb_add(&bar[XB_XCNT(b.x)], 1u);
    return b;
}
__device__ __forceinline__ void xcd_barrier_complete(unsigned* bar, unsigned x, unsigned& nloc, unsigned& nx) {
    const unsigned G = gridDim.x * gridDim.y * gridDim.z;
    unsigned sum, cnt, mine, sp = 0u;
    for (;;) {
        sum = 0u; cnt = 0u; mine = 0u;
#pragma unroll
        for (unsigned j = 0; j < 16; ++j) { const unsigned c = xb_ld(&bar[XB_XCNT(j)]); sum += c; cnt += (c > 0u) ? 1u : 0u; mine = (j == x) ? c : mine; }
        if (sum == G) break;
        __builtin_amdgcn_s_sleep(1);
        if ((++sp & 255u) == 0u) { if (xb_ld(&bar[XB_TMO])) break; if (sp > XB_SPIN_CAP) { atomicAdd(&bar[XB_TMO], 1u); break; } }
    }
    nloc = mine > 0u ? mine : 1u; nx = cnt > 0u ? cnt : 1u;
}
__device__ __forceinline__ void xcd_barrier(const XcdBarrier& b) {
    asm volatile("s_waitcnt vmcnt(0)" ::: "memory");
    __syncthreads();
    if (threadIdx.x == 0) {
        unsigned* bar = b.bar;
        __builtin_amdgcn_s_waitcnt(0);
        unsigned nloc = b.st[0], nx = b.st[1];
        if (nloc == 0u) { xcd_barrier_complete(bar, b.x, nloc, nx); b.st[0] = nloc; b.st[1] = nx; }
        const unsigned old = xb_add(&bar[XB_XSUB(b.x)], 1u);
        const unsigned gen = old / nloc;
        if (old + 1u == (gen + 1u) * nloc) {
            __builtin_amdgcn_fence(__ATOMIC_RELEASE, "agent");
            asm volatile("s_waitcnt vmcnt(0)" ::: "memory");
            const unsigned og = xb_add(&bar[XB_TOP], 1u);
            const unsigned tg = og / nx;
            if (og + 1u == (tg + 1u) * nx) xb_add(&bar[XB_TOPGEN], 1u);
            else XB_SPIN(xb_ld(&bar[XB_TOPGEN]) == tg, bar);
            __builtin_amdgcn_fence(__ATOMIC_ACQUIRE, "agent");
            xb_add(&bar[XB_XGEN(b.x)], 1u);
            asm volatile("s_waitcnt vmcnt(0)" ::: "memory");
        } else {
            XB_SPIN(xb_ld(&bar[XB_XGEN(b.x)]) == gen, bar);
            __builtin_amdgcn_fence(__ATOMIC_ACQUIRE, "agent");
            asm volatile("s_waitcnt vmcnt(0)" ::: "memory");
        }
    }
    __syncthreads();
}

namespace gm {
constexpr int BM = 256, BK = 64, HALF = 128, HTB = HALF * BK * 2, STAGE_BYTES = 8 * HTB, NXCD = 8, WGM = 8;
__device__ __forceinline__ int lds_byte(int r, int c) { const int st = (r >> 4) * 2 + (c >> 5), rr = r & 15, cc = c & 31, ob = rr * 64 + cc * 2; return st * 1024 + (ob ^ (((ob >> 9) & 1) << 5)); }
__device__ __forceinline__ void stage_rc(int b, int& R, int& C) { const int st = b / 1024, sb = b % 1024, swz = sb ^ (((sb >> 9) & 1) << 5); R = (st >> 1) * 16 + swz / 64; C = (st & 1) * 32 + (swz % 64) / 2; }
__device__ __forceinline__ int perm32(int rho) { const int n = rho >> 4, i = rho & 15; return 8 * (i >> 2) + 4 * n + (i & 3); }

struct Unit { int pm, pn, e, sub; };

__device__ __forceinline__ bool tile_order(int nM, int nN, int L, int& pm, int& pn, int wgm = WGM) {
    const int nwg = nM * nN; if (L >= nwg) return false;
    int wgid = (int)L; { const int q = nwg / NXCD, r = nwg % NXCD, xcd = wgid % NXCD, off = wgid / NXCD; wgid = (xcd < r ? xcd * (q + 1) : r * (q + 1) + (xcd - r) * q) + off; }
    const int nig = wgm * nN, gid = wgid / nig, fm = gid * wgm, gsz = (nM - fm) < wgm ? (nM - fm) : wgm;
    pm = fm + ((wgid % nig) % gsz); pn = (wgid % nig) / gsz; return true;
}
struct DenseOrder {
    int nM, nN, G, c, nsub; bool rev = false;
    __device__ __forceinline__ bool next(int i, Unit& u) const { const int ti = i / nsub; u.sub = i - ti * nsub; u.e = 0; const int L0 = ti * G + c, nwg = nM * nN; if (L0 >= nwg) return false; return tile_order(nM, nN, rev ? nwg - 1 - L0 : L0, u.pm, u.pn); }
};
struct MoeOrder {
    int nM, nN, G, c; const LAS int* tile_e; int wgm = WGM; bool rev = false;
    __device__ __forceinline__ bool next(int i, Unit& u) const { u.sub = 0; const int L0 = i * G + c, nwg = nM * nN; if (L0 >= nwg) return false; if (!tile_order(nM, nN, rev ? nwg - 1 - L0 : L0, u.pm, u.pn, wgm)) return false; u.e = tile_e[u.pm]; return true; }
};
struct DenseA { int K; unsigned sub_stride; int ES;
    __device__ __forceinline__ void offsets(const Unit& u, int tid, unsigned (&o)[2][2]) const {
#pragma unroll
        for (int i = 0; i < 2; ++i) { int R, C; stage_rc(tid * 16 + i * 8192, R, C);
#pragma unroll
            for (int h = 0; h < 2; ++h) o[h][i] = (unsigned)((u.pm * BM + h * HALF + R) * K * ES + C * 2) + (unsigned)u.sub * sub_stride; } }
    static constexpr bool GATHER = false;
    __device__ __forceinline__ const char* tok_ptr(const Unit&) const { return nullptr; }
    __device__ __forceinline__ void next_offsets(const Unit& u, int tid, unsigned (&o)[2][2], const LAS int*) const { offsets(u, tid, o); } };
struct GatherA { int K; const int* row_tok; int ES;
    __device__ __forceinline__ void offsets(const Unit& u, int tid, unsigned (&o)[2][2]) const {
#pragma unroll
        for (int i = 0; i < 2; ++i) { int R, C; stage_rc(tid * 16 + i * 8192, R, C);
#pragma unroll
            for (int h = 0; h < 2; ++h) { const int tok = row_tok[u.pm * BM + h * HALF + R]; o[h][i] = (unsigned)(tok * K * ES + C * 2); } } }
    static constexpr bool GATHER = true;
    __device__ __forceinline__ const char* tok_ptr(const Unit& u) const { return (const char*)(row_tok + u.pm * BM); }
    __device__ __forceinline__ void next_offsets(const Unit&, int tid, unsigned (&o)[2][2], const LAS int* stok) const {
#pragma unroll
        for (int i = 0; i < 2; ++i) { int R, C; stage_rc(tid * 16 + i * 8192, R, C);
#pragma unroll
            for (int h = 0; h < 2; ++h) { const int tok = stok[h * HALF + R]; o[h][i] = (unsigned)(tok * K * ES + C * 2); } } } };

template <bool FP8, class Epi, class Sched, class AMap>
__device__ __forceinline__ void gemm_phase(int wave_sg, LAS unsigned char* lds, const char* Abase, const char* Bbase, int K, int Nb, unsigned b_sub_stride, const Sched& S, const Epi& E, const AMap& AM) {
    int lane; asm volatile("v_mbcnt_lo_u32_b32 %0, -1, 0\n\tv_mbcnt_hi_u32_b32 %0, -1, %0" : "=v"(lane));
    const int wid = wave_sg, tid = wid * 64 + lane, wr = wid >> 2, wc = wid & 3, fr = lane & 15, fq = lane >> 4;
    constexpr int ES = FP8 ? 1 : 2;
    const int nt = K * ES / (BK * 2);
    unsigned voffB[2];
#pragma unroll
    for (int i = 0; i < 2; ++i) { int R, C; stage_rc(tid * 16 + i * 8192, R, C); const int Rb = (R & ~31) + perm32(R & 31); voffB[i] = (unsigned)(Rb * K * ES + C * 2); }
    const size_t kstep = (size_t)(BK * 2);
    const size_t hstep = (size_t)HALF * K * ES;
    const unsigned ldsw = (unsigned)wid * 1024u;
    const int aoff = lds_byte(wr * 64 + fr, fq * 8), boff = lds_byte(wc * 32 + fr, fq * 8);
#define G_SA(b, h) (((b) * 2 + (h)) * HTB)
#define G_SB(b, h) ((4 + (b) * 2 + (h)) * HTB)
#define G_STAGE(bufoff, gbase, voff) do { _Pragma("unroll") for (int _i = 0; _i < 2; ++_i) \
        __builtin_amdgcn_global_load_lds((const unsigned*)((const char*)(gbase) + (voff)[_i]), (LAS unsigned*)(lds + (bufoff) + ldsw + _i * 8192), 16, 0, 0); } while (0)
#define G_LDA(dst, b, h) do { _Pragma("unroll") for (int m = 0; m < 4; ++m) _Pragma("unroll") for (int k = 0; k < 2; ++k) dst[m][k] = *(const LAS bf16x8*)(lds + G_SA(b, h) + aoff + m * 2048 + k * 1024); } while (0)
#define G_LDB(dst, b, h) do { _Pragma("unroll") for (int n = 0; n < 2; ++n) _Pragma("unroll") for (int k = 0; k < 2; ++k) dst[n][k] = *(const LAS bf16x8*)(lds + G_SB(b, h) + boff + n * 2048 + k * 1024); } while (0)
#define G_MMA(ai, bj, At, Bt) do { __builtin_amdgcn_s_setprio(1); _Pragma("unroll") for (int m = 0; m < 4; ++m) _Pragma("unroll") for (int n = 0; n < 2; ++n) _Pragma("unroll") for (int k = 0; k < 2; ++k) \
        acc[ai][bj][m][n] = __builtin_amdgcn_mfma_f32_16x16x32_bf16(Bt[n][k], At[m][k], acc[ai][bj][m][n], 0, 0, 0); __builtin_amdgcn_s_setprio(0); } while (0)
#define G_LD8(dst, off) do { const u32x4 _l = *(const LAS u32x4*)(lds + (off)), _h = *(const LAS u32x4*)(lds + (off) + 1024); dst = (v8i){(int)_l.x, (int)_l.y, (int)_l.z, (int)_l.w, (int)_h.x, (int)_h.y, (int)_h.z, (int)_h.w}; } while (0)
#define G_LDA8(dst, b, h) do { _Pragma("unroll") for (int m = 0; m < 4; ++m) G_LD8(dst[m], G_SA(b, h) + aoff + m * 2048); } while (0)
#define G_LDB8(dst, b, h) do { _Pragma("unroll") for (int n = 0; n < 2; ++n) G_LD8(dst[n], G_SB(b, h) + boff + n * 2048); } while (0)
#define G_MMA8(ai, bj, At, Bt) do { __builtin_amdgcn_s_setprio(1); _Pragma("unroll") for (int m = 0; m < 4; ++m) _Pragma("unroll") for (int n = 0; n < 2; ++n) \
        acc[ai][bj][m][n] = __builtin_amdgcn_mfma_scale_f32_16x16x128_f8f6f4(Bt[n], At[m], acc[ai][bj][m][n], 0, 0, 0, 0x7F7F7F7F, 0, 0x7F7F7F7F); __builtin_amdgcn_s_setprio(0); } while (0)
#define G_PIN(ai, bj) asm volatile("" :: "v"(acc[ai][bj][0][0][0]), "v"(acc[ai][bj][0][1][0]), "v"(acc[ai][bj][1][0][0]), "v"(acc[ai][bj][1][1][0]), "v"(acc[ai][bj][2][0][0]), "v"(acc[ai][bj][2][1][0]), "v"(acc[ai][bj][3][0][0]), "v"(acc[ai][bj][3][1][0]) : "memory")
#define G_WAIT_V(n) asm volatile("s_waitcnt vmcnt(" #n ")" ::: "memory")
#define G_WAIT_L(n) asm volatile("s_waitcnt lgkmcnt(" #n ")" ::: "memory")
#define G_WAIT_VS() do { if (fi) { if (Epi::NST == 16) G_WAIT_V(24); else if (Epi::NST == 8) G_WAIT_V(16); else G_WAIT_V(8); } else G_WAIT_V(8); } while (0)
#define G_BAR __builtin_amdgcn_s_barrier()
#define G_SCHED __builtin_amdgcn_sched_barrier(0)
    Unit cur, nxt; int ui = 0;
#if MK_TPROBE
    unsigned long long tp_c = 0; const unsigned long long tp_c0 = __builtin_amdgcn_s_memtime(), tp_r0 = __builtin_amdgcn_s_memrealtime();
#endif
    if (!S.next(0, cur)) return;
#if MK_STAGGER
    {
        const unsigned long long t0 = __builtin_amdgcn_s_memrealtime(); const unsigned long long dly = (unsigned long long)(blockIdx.x & 7) * MK_STAGGER;
        while (__builtin_amdgcn_s_memrealtime() - t0 < dly) __builtin_amdgcn_s_sleep(8);
    }
#endif
    unsigned rA[2][2];
    AM.offsets(cur, tid, rA);
    const char* cB = Bbase + ((size_t)cur.e * Nb + (size_t)cur.pn * BM) * K * ES + (size_t)cur.sub * b_sub_stride;
    G_STAGE(G_SB(0, 0), cB, voffB); G_STAGE(G_SB(0, 1), cB + hstep, voffB); G_STAGE(G_SA(0, 0), Abase, rA[0]); G_STAGE(G_SA(0, 1), Abase, rA[1]);
    if (wr == 1) G_BAR;
    G_WAIT_V(2); G_BAR;
    G_STAGE(G_SB(1, 0), cB + kstep, voffB); G_STAGE(G_SA(1, 0), Abase + kstep, rA[0]); G_STAGE(G_SB(1, 1), cB + hstep + kstep, voffB);
    G_WAIT_V(6); G_BAR;
    f32x4 acc[2][2][4][2];
#pragma unroll
    for (int a = 0; a < 2; ++a)
#pragma unroll
        for (int b = 0; b < 2; ++b)
#pragma unroll
            for (int m = 0; m < 4; ++m)
#pragma unroll
                for (int n = 0; n < 2; ++n) acc[a][b][m][n] = (f32x4){0.f, 0.f, 0.f, 0.f};
    for (;;) {
        const bool has_next = S.next(ui + 1, nxt);
        const char* nB = has_next ? Bbase + ((size_t)nxt.e * Nb + (size_t)nxt.pn * BM) * K * ES + (size_t)nxt.sub * b_sub_stride : cB;
#if MK_TPROBE
        unsigned long long tp_a = 0; if (Epi::TPROBE && wid == 0) { tp_a = __builtin_amdgcn_s_memrealtime(); if (ui > 0 && lane == 0) { volatile LAS unsigned* M = (volatile LAS unsigned*)(lds + MISC_OFF); M[19] += (unsigned)(tp_a - tp_c); } }
#endif
        if (wid == 0) {
            int l16 = lane * 16; asm volatile("" : "+v"(l16));
#pragma unroll
            for (int k = 0; k < Epi::NSB; ++k) { const char* sp = E.sb_ptr(cur, k); if (l16 < 16 * E.sb_lanes(k)) __builtin_amdgcn_global_load_lds((const unsigned*)(sp + l16), (LAS unsigned*)(lds + SIDE_OFF + (ui & 1) * 4096 + 1024 * (k + 1)), 16, 0, 0); }
            if (AMap::GATHER && has_next) __builtin_amdgcn_global_load_lds((const unsigned*)(AM.tok_ptr(nxt) + l16), (LAS unsigned*)(lds + SIDE_OFF + ((ui + 1) & 1) * 4096), 16, 0, 0);
        }
#pragma nounroll
        for (int t = 0; t < nt; t += 2) {
            if constexpr (Epi::HAS_MID) { if (t == nt / 2) { int lz = lane; asm volatile("" : "+v"(lz)); E.mid(acc, cur, wr, wc, lz & 15, lz >> 4); } }
            bf16x8 At[4][2], B0[2][2], B1[2][2];
            v8i At8[4], B08[2], B18[2];
            const bool last = (t == nt - 2);
            constexpr bool fi = false;
            const char* b2 = last ? nB : cB + (size_t)(t + 2) * kstep; const char* b3 = b2 + kstep;
            if constexpr (FP8) { G_LDB8(B08, 0, 0); G_LDB8(B18, 0, 1); G_SCHED; G_LDA8(At8, 0, 0); } else { G_LDB(B0, 0, 0); G_LDB(B1, 0, 1); G_SCHED; G_LDA(At, 0, 0); }
            G_STAGE(G_SA(1, 1), Abase + (size_t)(t + 1) * kstep, rA[1]);
            G_WAIT_VS(); G_WAIT_L(0); G_BAR;
            if constexpr (FP8) { G_MMA8(0, 0, At8, B08); G_MMA8(0, 1, At8, B18); } else { G_MMA(0, 0, At, B0); G_MMA(0, 1, At, B1); }
            if constexpr (FP8) { G_PIN(0, 0); G_PIN(0, 1); }
            G_BAR; G_SCHED;
            if (last && has_next) { int tz = tid; asm volatile("" : "+v"(tz)); AM.next_offsets(nxt, tz, rA, (const LAS int*)(lds + SIDE_OFF + ((ui + 1) & 1) * 4096)); }
            const char* a2 = Abase + (last ? (size_t)0 : (size_t)(t + 2) * kstep);
            if constexpr (FP8) { G_LDA8(At8, 0, 1); } else { G_LDA(At, 0, 1); }
            G_STAGE(G_SB(0, 0), b2, voffB); G_STAGE(G_SB(0, 1), b2 + hstep, voffB); G_STAGE(G_SA(0, 0), a2, rA[0]);
            G_WAIT_VS(); G_WAIT_L(0); G_BAR;
            if constexpr (FP8) { G_MMA8(1, 0, At8, B08); G_MMA8(1, 1, At8, B18); } else { G_MMA(1, 0, At, B0); G_MMA(1, 1, At, B1); }
            if constexpr (FP8) { G_PIN(1, 0); G_PIN(1, 1); }
            G_BAR; G_SCHED;
            if constexpr (FP8) { G_LDB8(B08, 1, 0); G_LDB8(B18, 1, 1); G_SCHED; G_LDA8(At8, 1, 0); } else { G_LDB(B0, 1, 0); G_LDB(B1, 1, 1); G_SCHED; G_LDA(At, 1, 0); }
            G_STAGE(G_SA(0, 1), a2, rA[1]);
            G_WAIT_VS(); G_WAIT_L(0); G_BAR;
            if constexpr (FP8) { G_MMA8(0, 0, At8, B08); G_MMA8(0, 1, At8, B18); } else { G_MMA(0, 0, At, B0); G_MMA(0, 1, At, B1); }
            if constexpr (FP8) { G_PIN(0, 0); G_PIN(0, 1); }
            G_BAR; G_SCHED;
            if constexpr (FP8) { G_LDA8(At8, 1, 1); } else { G_LDA(At, 1, 1); }
            G_STAGE(G_SB(1, 0), b3, voffB); G_STAGE(G_SB(1, 1), b3 + hstep, voffB); G_STAGE(G_SA(1, 0), a2 + kstep, rA[0]);
            G_WAIT_VS(); G_WAIT_L(0); G_BAR;
            if constexpr (FP8) { G_MMA8(1, 0, At8, B08); G_MMA8(1, 1, At8, B18); } else { G_MMA(1, 0, At, B0); G_MMA(1, 1, At, B1); }
            if constexpr (FP8) { G_PIN(1, 0); G_PIN(1, 1); }
            G_BAR; G_SCHED;
        }
#if MK_TPROBE
        unsigned long long tp_b = 0; if (Epi::TPROBE && wid == 0) tp_b = __builtin_amdgcn_s_memrealtime();
#endif
        if (wr == 0) G_BAR;
        { int lz = lane; asm volatile("" : "+v"(lz));
          E(acc, cur, wr, wc, lz & 15, lz >> 4, (const LAS unsigned char*)(lds + SIDE_OFF + (ui & 1) * 4096 + 1024)); }
#if MK_TPROBE
        if (Epi::TPROBE && wid == 0) { tp_c = __builtin_amdgcn_s_memrealtime(); if (lane == 0) { volatile LAS unsigned* M = (volatile LAS unsigned*)(lds + MISC_OFF); M[16] += (unsigned)(tp_b - tp_a); M[17] += (unsigned)(tp_c - tp_b); M[18] += 1u; } }
#endif
        if (!has_next) break;
        if (!E.keep(cur)) {
#pragma unroll
            for (int a = 0; a < 2; ++a)
#pragma unroll
                for (int b = 0; b < 2; ++b)
#pragma unroll
                    for (int m = 0; m < 4; ++m)
#pragma unroll
                        for (int n = 0; n < 2; ++n) acc[a][b][m][n] = (f32x4){0.f, 0.f, 0.f, 0.f};
        }
        cur = nxt; cB = nB; ++ui;
        if (wr == 1) G_BAR;
    }
    G_WAIT_V(0);
    G_BAR;
#if MK_TPROBE
    if constexpr (Epi::TPROBE) if (wid == 0) { volatile LAS unsigned* M = (volatile LAS unsigned*)(lds + MISC_OFF);
        const unsigned long long t0 = __builtin_amdgcn_s_memrealtime();
        const unsigned long long d = MK_TPROBE == 4 ? 10000ull * (__builtin_amdgcn_s_memtime() - tp_c0) / (t0 - tp_r0)
                                   : 4ull * (unsigned long long)(MK_TPROBE == 1 ? M[16] : MK_TPROBE == 2 ? M[17] : M[19]);
        while (__builtin_amdgcn_s_memrealtime() - t0 < d) __builtin_amdgcn_s_sleep(8); }
#endif
#undef G_SA
#undef G_SB
#undef G_STAGE
#undef G_LDA
#undef G_LDB
#undef G_MMA
#undef G_LD8
#undef G_LDA8
#undef G_LDB8
#undef G_MMA8
#undef G_WAIT_V
#undef G_PIN
#undef G_WAIT_VS
#undef G_WAIT_L
#undef G_BAR
#undef G_SCHED
}

__device__ __forceinline__ u32x4 pack8(const f32x4& v0, const f32x4& v1) { u32x4 w; w.x = cvt_pk_bf16(v0[0], v0[1]); w.y = cvt_pk_bf16(v0[2], v0[3]); w.z = cvt_pk_bf16(v1[0], v1[1]); w.w = cvt_pk_bf16(v1[2], v1[3]); return w; }
__device__ __forceinline__ void unpack8(const u32x4& w, f32x4& v0, f32x4& v1) { v0 = (f32x4){bf_lo(w.x), bf_hi(w.x), bf_lo(w.y), bf_hi(w.y)}; v1 = (f32x4){bf_lo(w.z), bf_hi(w.z), bf_lo(w.w), bf_hi(w.w)}; }

template <bool F8>
struct EpiProjT {
    static constexpr bool HAS_MID = false;
    static constexpr float PSC = F8 ? (1.0f / 32.0f) : 1.0f;
    bf16_t* proj; bf16_t* gates; const float* lb;
    static constexpr int NSB = 0, NST = 16; static constexpr bool TPROBE = false;
    __device__ __forceinline__ const char* sb_ptr(const Unit&, int) const { return nullptr; }
    __device__ __forceinline__ int sb_lanes(int) const { return 0; }
    __device__ __forceinline__ bool keep(const Unit&) const { return false; }
    __device__ __forceinline__ void operator()(f32x4 (&acc)[2][2][4][2], const Unit& u, int wr, int wc, int fr, int fq, const LAS unsigned char* side) const {
        const int row0 = u.pm * BM + wr * 64 + fr, pn = F8 ? map8(u.pn) : map16(u.pn);
        if (pn >= 10) {
            const bool isg = pn >= 14; const int q = isg ? pn - 14 : pn - 10; const int c0 = q * HALF + wc * 32 + 8 * fq;
#pragma unroll
            for (int ai = 0; ai < 2; ++ai)
#pragma unroll
                for (int m = 0; m < 4; ++m) { const size_t r = (size_t)(row0 + ai * HALF + m * 16);
                    f32x4 a0 = acc[ai][0][m][0] * PSC, a1 = acc[ai][0][m][1] * PSC, b0 = acc[ai][1][m][0] * PSC, b1 = acc[ai][1][m][1] * PSC;
                    if (isg) {
#pragma unroll
                        for (int j = 0; j < 4; ++j) {
                            const float ea0 = fast_exp(-a0[j]), ea1 = fast_exp(-a1[j]), eb0 = 1.0f + fast_exp(fminf(-b0[j], 60.f)), eb1 = 1.0f + fast_exp(fminf(-b1[j], 60.f));
                            a0[j] = eb0 * fast_rcp(1.0f + ea0); a1[j] = eb1 * fast_rcp(1.0f + ea1); b0[j] = fast_rcp(eb0); b1[j] = fast_rcp(eb1); }
                        *(u32x4*)(gates + r * GATE_LD + c0) = pack8(a0, a1); *(u32x4*)(gates + r * GATE_LD + 1024 + c0) = pack8(b0, b1);
                    } else {
                        *(u32x4*)(proj + r * PROJ_LD + 2560 + c0) = pack8(a0 * b0, a1 * b1);
                    } }
            return;
        }
        bf16_t* base = proj; const int ldc = PROJ_LD, colt = pn * BM, kind = (pn == 2 || pn == 3) ? 1 : 0;
        const int col0 = colt + wc * 32 + 8 * fq;
        f32x4 lbv[2][2];
        if (kind == 1) {
#pragma unroll
            for (int bj = 0; bj < 2; ++bj) { const float* lp = lb + (pn - 2) * BM + bj * HALF + wc * 32 + 8 * fq; lbv[bj][0] = *(const f32x4*)lp; lbv[bj][1] = *(const f32x4*)(lp + 4); }
        }
#pragma unroll
        for (int ai = 0; ai < 2; ++ai)
#pragma unroll
            for (int m = 0; m < 4; ++m) { bf16_t* rowp = base + (size_t)(row0 + ai * HALF + m * 16) * ldc + col0;
#pragma unroll
                for (int bj = 0; bj < 2; ++bj) { f32x4 v0 = acc[ai][bj][m][0] * PSC, v1 = acc[ai][bj][m][1] * PSC;
                    if (kind == 1) {
#pragma unroll
                        for (int j = 0; j < 4; ++j) { const float l0 = lbv[bj][0][j], l1 = lbv[bj][1][j];
                            v0[j] = fast_log(l0 + (1.0f - l0) * sigmoidf_(v0[j])); v1[j] = fast_log(l1 + (1.0f - l1) * sigmoidf_(v1[j])); }
                    }
                    *(u32x4*)(rowp + bj * HALF) = pack8(v0, v1); } }
    }
};
struct EpiMerge {
    static constexpr bool HAS_MID = true;
    const bf16_t* gates; bf16_t* out;
    static constexpr int NSB = 0, NST = 0; static constexpr bool TPROBE = false;
    __device__ __forceinline__ const char* sb_ptr(const Unit&, int) const { return nullptr; }
    __device__ __forceinline__ int sb_lanes(int) const { return 0; }
    __device__ __forceinline__ bool keep(const Unit&) const { return false; }
    __device__ __forceinline__ void mid(f32x4 (&acc)[2][2][4][2], const Unit& u, int wr, int wc, int fr, int fq) const {
        const int row0 = u.pm * BM + wr * 64 + fr, col0 = u.pn * BM + wc * 32 + 8 * fq;
#pragma unroll
        for (int ai = 0; ai < 2; ++ai) {
            u32x4 ga[4][2];
#pragma unroll
            for (int m = 0; m < 4; ++m) { const bf16_t* gp = gates + (size_t)(row0 + ai * HALF + m * 16) * GATE_LD + col0;
#pragma unroll
                for (int bj = 0; bj < 2; ++bj) ga[m][bj] = *(const u32x4*)(gp + bj * HALF); }
#pragma unroll
            for (int m = 0; m < 4; ++m)
#pragma unroll
                for (int bj = 0; bj < 2; ++bj) { f32x4 a0, a1; unpack8(ga[m][bj], a0, a1); acc[ai][bj][m][0] *= a0; acc[ai][bj][m][1] *= a1; }
            asm volatile("" ::: "memory"); }
    }
    __device__ __forceinline__ void operator()(f32x4 (&acc)[2][2][4][2], const Unit& u, int wr, int wc, int fr, int fq, const LAS unsigned char* side) const {
        const int row0 = u.pm * BM + wr * 64 + fr, col0 = u.pn * BM + wc * 32 + 8 * fq;
#pragma unroll
        for (int ai = 0; ai < 2; ++ai) {
            u32x4 gb[4][2];
#pragma unroll
            for (int m = 0; m < 4; ++m) { const bf16_t* gp = gates + (size_t)(row0 + ai * HALF + m * 16) * GATE_LD + col0;
#pragma unroll
                for (int bj = 0; bj < 2; ++bj) gb[m][bj] = *(const u32x4*)(gp + 1024 + bj * HALF); }
#pragma unroll
            for (int m = 0; m < 4; ++m) { const size_t r = (size_t)(row0 + ai * HALF + m * 16);
#pragma unroll
                for (int bj = 0; bj < 2; ++bj) { f32x4 b0, b1; unpack8(gb[m][bj], b0, b1); *(u32x4*)(out + r * D + col0 + bj * HALF) = pack8(acc[ai][bj][m][0] * b0, acc[ai][bj][m][1] * b1); } }
            asm volatile("" ::: "memory"); }
    }
};
struct EpiMix {
    static constexpr bool HAS_MID = false;
    const float* x; const float* mod; bf16_t* h; float* ssqp;
    static constexpr int NSB = 0, NST = 0; static constexpr bool TPROBE = false;
    __device__ __forceinline__ const char* sb_ptr(const Unit&, int) const { return nullptr; }
    __device__ __forceinline__ int sb_lanes(int) const { return 0; }
    __device__ __forceinline__ bool keep(const Unit&) const { return false; }
    __device__ __forceinline__ void operator()(f32x4 (&acc)[2][2][4][2], const Unit& u, int wr, int wc, int fr, int fq, const LAS unsigned char* side) const {
        const int row0 = u.pm * BM + wr * 64 + fr, col0 = u.pn * BM + wc * 32 + 8 * fq, b = u.pm >> 3;
        f32x4 g[2][2];
#pragma unroll
        for (int bj = 0; bj < 2; ++bj) { const float* gp = mod + (size_t)b * 6144 + 2048 + col0 + bj * HALF; g[bj][0] = *(const f32x4*)gp; g[bj][1] = *(const f32x4*)(gp + 4); }
#pragma unroll
        for (int ai = 0; ai < 2; ++ai) {
            f32x4 xv[4][2][2];
#pragma unroll
            for (int m = 0; m < 4; ++m)
#pragma unroll
                for (int bj = 0; bj < 2; ++bj) { const float* xp = x + (size_t)(row0 + ai * HALF + m * 16) * D + col0 + bj * HALF; xv[m][bj][0] = *(const f32x4*)xp; xv[m][bj][1] = *(const f32x4*)(xp + 4); }
#pragma unroll
            for (int m = 0; m < 4; ++m) { const size_t r = (size_t)(row0 + ai * HALF + m * 16);
                float sq = 0.f;
#pragma unroll
                for (int bj = 0; bj < 2; ++bj) { const f32x4 v0 = xv[m][bj][0] + g[bj][0] * acc[ai][bj][m][0], v1 = xv[m][bj][1] + g[bj][1] * acc[ai][bj][m][1];
                    *(u32x4*)(h + r * D + col0 + bj * HALF) = pack8(v0, v1);
                    sq += (v0[0] * v0[0] + v0[1] * v0[1]) + (v0[2] * v0[2] + v0[3] * v0[3]) + (v1[0] * v1[0] + v1[1] * v1[1]) + (v1[2] * v1[2] + v1[3] * v1[3]); }
                sq += __shfl_xor(sq, 16); sq += __shfl_xor(sq, 32);
                if (fq == 0) ssqp[r * 16 + u.pn * 4 + wc] = sq; }
            asm volatile("" ::: "memory"); }
    }
};
struct EpiSwiglu {
    static constexpr bool HAS_MID = false;
    static constexpr float WSC = 1.0f / 32.0f;
    const float* b1; unsigned char* act; unsigned* tpw;
    __device__ __forceinline__ unsigned* tp_words() const { return tpw; }
    static constexpr bool TPROBE = false;
    static constexpr int NSB = 2, NST = 4;
    __device__ __forceinline__ const char* sb_ptr(const Unit& u, int k) const { return (const char*)(b1 + (size_t)u.e * 2048 + k * 1024 + u.pn * HALF); }
    __device__ __forceinline__ int sb_lanes(int) const { return 32; }
    __device__ __forceinline__ bool keep(const Unit&) const { return false; }
    __device__ __forceinline__ void operator()(f32x4 (&acc)[2][2][4][2], const Unit& u, int wr, int wc, int fr, int fq, const LAS unsigned char* side) const {
        const int row0 = u.pm * BM + wr * 64 + fr, hc0 = u.pn * HALF + wc * 32 + 8 * fq;
        const LAS float* bp = (const LAS float*)side + wc * 32 + 8 * fq;
        const f32x4 bg[2] = {*(const LAS f32x4*)bp, *(const LAS f32x4*)(bp + 4)}; const f32x4 bl1[2] = {*(const LAS f32x4*)(bp + 256) + 1.0f, *(const LAS f32x4*)(bp + 260) + 1.0f};
        const int odd = fq & 1; unsigned px = 0u, py = 0u;
#pragma unroll
        for (int ai = 0; ai < 2; ++ai)
#pragma unroll
            for (int m = 0; m < 4; ++m) { const size_t r = (size_t)(row0 + ai * HALF + m * 16);
                f32x4 o[2];
#pragma unroll
                for (int n = 0; n < 2; ++n) {
                    f32x4 g = acc[ai][0][m][n] * WSC + bg[n], l = acc[ai][1][m][n] * WSC + bl1[n];
#pragma unroll
                    for (int j = 0; j < 4; ++j) { g[j] = fminf(g[j], SW_LIMIT); l[j] = fminf(fmaxf(l[j], 1.0f - SW_LIMIT), 1.0f + SW_LIMIT); }
                    const f32x4 t = g * (-SW_ALPHA * 1.44269504089f); f32x4 e;
#pragma unroll
                    for (int j = 0; j < 4; ++j) e[j] = __builtin_amdgcn_exp2f(t[j]);
                    const f32x4 d = e + 1.0f; f32x4 rc;
#pragma unroll
                    for (int j = 0; j < 4; ++j) rc[j] = fast_rcp(d[j]);
                    o[n] = (g * rc) * l; }
                const unsigned cx = pk4_fp8_nc(o[0][0], o[0][1], o[0][2], o[0][3]), cy = pk4_fp8_nc(o[1][0], o[1][1], o[1][2], o[1][3]);
                if ((m & 1) == 0) { px = cx; py = cy; }
                else { unsigned ax = px, ay = py, bx = cx, by = cy;
                    { auto rr = __builtin_amdgcn_permlane16_swap(ax, bx, false, false); ax = rr[0]; bx = rr[1]; }
                    { auto rr = __builtin_amdgcn_permlane16_swap(ay, by, false, false); ay = rr[0]; by = rr[1]; }
                    *(u32x4*)(act + (r - (odd ? 0 : 16)) * DFF + hc0 - 8 * odd) = (u32x4){ax, ay, bx, by}; } }
    }
};
struct EpiMoeOut {
    static constexpr bool HAS_MID = false;
    const float* b2; const float* rw; unsigned char* ya;
    static constexpr bool TPROBE = false;
    static constexpr int NSB = 2, NST = 8;
    __device__ __forceinline__ const char* sb_ptr(const Unit& u, int k) const { return k == 0 ? (const char*)(b2 + (size_t)u.e * D + u.pn * BM) : (const char*)(rw + u.pm * BM); }
    __device__ __forceinline__ int sb_lanes(int) const { return 64; }
    __device__ __forceinline__ bool keep(const Unit&) const { return false; }
    __device__ __forceinline__ void operator()(f32x4 (&acc)[2][2][4][2], const Unit& u, int wr, int wc, int fr, int fq, const LAS unsigned char* side) const {
        const int lrow0 = wr * 64 + fr, col0 = u.pn * BM + wc * 32 + 8 * fq, row_t = u.pm * BM;
        unsigned char* tbase = ya + (size_t)row_t * D + col0;
        const LAS float* sb = (const LAS float*)side; const LAS float* srw = (const LAS float*)(side + 1024);
        f32x4 bv[2][2];
#pragma unroll
        for (int bj = 0; bj < 2; ++bj) { const LAS float* bp = sb + bj * HALF + wc * 32 + 8 * fq; bv[bj][0] = *(const LAS f32x4*)bp; bv[bj][1] = *(const LAS f32x4*)(bp + 4); }
        const int odd = fq & 1;
#pragma unroll
        for (int ai = 0; ai < 2; ++ai)
#pragma unroll
            for (int mp = 0; mp < 2; ++mp) { const int lr0 = lrow0 + ai * HALF + (2 * mp) * 16, lr1 = lr0 + 16; const float w0 = srw[lr0], w1 = srw[lr1];
                unsigned char* dst = tbase - 8 * odd + (size_t)(odd ? lr1 : lr0) * D;
#pragma unroll
                for (int bj = 0; bj < 2; ++bj) {
                    const f32x4 p0 = (acc[ai][bj][2 * mp][0] * (1.0f / 32.0f) + bv[bj][0]) * w0, p1 = (acc[ai][bj][2 * mp][1] * (1.0f / 32.0f) + bv[bj][1]) * w0;
                    const f32x4 q0 = (acc[ai][bj][2 * mp + 1][0] * (1.0f / 32.0f) + bv[bj][0]) * w1, q1 = (acc[ai][bj][2 * mp + 1][1] * (1.0f / 32.0f) + bv[bj][1]) * w1;
                    unsigned ax = pk4_fp8(p0[0], p0[1], p0[2], p0[3]), ay = pk4_fp8(p1[0], p1[1], p1[2], p1[3]), bx = pk4_fp8(q0[0], q0[1], q0[2], q0[3]), by = pk4_fp8(q1[0], q1[1], q1[2], q1[3]);
                    { auto r = __builtin_amdgcn_permlane16_swap(ax, bx, false, false); ax = r[0]; bx = r[1]; }
                    { auto r = __builtin_amdgcn_permlane16_swap(ay, by, false, false); ay = r[0]; by = r[1]; }
                    *(u32x4*)(dst + bj * HALF) = (u32x4){ax, ay, bx, by}; } }
    }
};
}

struct Args { const float* in[20]; float* out; unsigned char* ws; int ph_lo, ph_hi; };

__device__ __forceinline__ void transpose_item(const float* W, int N, bf16_t* WT, int ldwt, int k0, int n0, int dst_row0, LAS float* scr, int lane) {
    const int ks = lane >> 4, n4 = (lane & 15) * 4;
    f32x4 v[16];
#pragma unroll
    for (int i = 0; i < 16; ++i) v[i] = *(const f32x4*)(W + (size_t)(k0 + 4 * i + ks) * N + n0 + n4);
#pragma unroll
    for (int i = 0; i < 16; ++i) { LAS float* s = scr + (4 * i + ks) * 65 + n4; s[0] = v[i][0]; s[1] = v[i][1]; s[2] = v[i][2]; s[3] = v[i][3]; }
    LDS_WAIT(); asm volatile("" ::: "memory");
    const int kc = lane & 7;
#pragma unroll
    for (int p = 0; p < 8; ++p) { const int n = (lane >> 3) + 8 * p; const LAS float* s = scr + (8 * kc) * 65 + n;
        u32x4 o; o.x = cvt_pk_bf16(s[0], s[65]); o.y = cvt_pk_bf16(s[2 * 65], s[3 * 65]); o.z = cvt_pk_bf16(s[4 * 65], s[5 * 65]); o.w = cvt_pk_bf16(s[6 * 65], s[7 * 65]);
        *(u32x4*)(WT + (size_t)(dst_row0 + n) * ldwt + k0 + 8 * kc) = o; }
    LDS_WAIT(); asm volatile("" ::: "memory");
}

template <bool NT = false>
__device__ __forceinline__ void transpose_item_fp8(const float* W, int N, unsigned char* WT, int ldwt, int k0, int n0, int dst_row0, LAS float* scr, int lane) {
    const int ks = lane >> 3, n4 = (lane & 7) * 4;
    f32x4 v[16];
#pragma unroll
    for (int i = 0; i < 16; ++i) { const f32x4* p = (const f32x4*)(W + (size_t)(k0 + 8 * i + ks) * N + n0 + n4); v[i] = NT ? __builtin_nontemporal_load(p) : *p; }
#pragma unroll
    for (int i = 0; i < 16; ++i) { LAS float* s = scr + (8 * i + ks) * 33 + n4; s[0] = v[i][0]; s[1] = v[i][1]; s[2] = v[i][2]; s[3] = v[i][3]; }
    LDS_WAIT(); asm volatile("" ::: "memory");
    const int kc = lane & 7;
#pragma unroll
    for (int p = 0; p < 4; ++p) { const int n = (lane >> 3) + 8 * p; const LAS float* s = scr + (16 * kc) * 33 + n;
        u32x4 o;
        o.x = pk4_fp8(32.f * s[0], 32.f * s[33], 32.f * s[2 * 33], 32.f * s[3 * 33]); o.y = pk4_fp8(32.f * s[4 * 33], 32.f * s[5 * 33], 32.f * s[6 * 33], 32.f * s[7 * 33]);
        o.z = pk4_fp8(32.f * s[8 * 33], 32.f * s[9 * 33], 32.f * s[10 * 33], 32.f * s[11 * 33]); o.w = pk4_fp8(32.f * s[12 * 33], 32.f * s[13 * 33], 32.f * s[14 * 33], 32.f * s[15 * 33]);
        u32x4* q = (u32x4*)(WT + (size_t)(dst_row0 + n) * ldwt + k0 + 16 * kc); if (NT) __builtin_nontemporal_store(o, q); else *q = o; }
    LDS_WAIT(); asm volatile("" ::: "memory");
}

constexpr int BG_W1 = 32 * 8 * 64, BG_W2 = 32 * 8 * 32, BG_N = BG_W1 + BG_W2;
struct BgCtx { const float* w1; const float* w2; unsigned char* W1q; unsigned char* W2q; unsigned* qhead; };
__device__ __forceinline__ bool bg_item(const BgCtx& c, LAS float* scr, int lane) {
    unsigned it = 0; if (lane == 0) it = __hip_atomic_fetch_add(c.qhead, 1u, __ATOMIC_RELAXED, __HIP_MEMORY_SCOPE_AGENT);
    it = (unsigned)__builtin_amdgcn_readfirstlane((int)it);
    if (it >= (unsigned)BG_N) return false;
    if (it < (unsigned)BG_W1) { const int r = (int)it, e = r / 512, q = r % 512, kb = q / 64, nb = q % 64;
        const int pn = nb >> 3, wi = (nb & 7) * 32; const int src = wi < 128 ? pn * 128 + wi : 1024 + pn * 128 + (wi - 128);
        transpose_item_fp8<true>(c.w1 + (size_t)e * D * 2048, 2048, c.W1q + (size_t)e * 2048 * D, D, kb * 128, src, nb * 32, scr, lane); }
    else { const int r = (int)it - BG_W1, e = r / 256, q = r % 256, kb = q / 32, nb = q % 32;
        transpose_item_fp8<true>(c.w2 + (size_t)e * DFF * D, D, c.W2q + (size_t)e * D * DFF, DFF, kb * 128, nb * 32, nb * 32, scr, lane); }
    return true;
}
__device__ __forceinline__ void xcd_barrier_bg(const XcdBarrier& b, const BgCtx& c, LAS unsigned char* lds, int wave, int lane, bool drain) {
    volatile LAS unsigned* M = (volatile LAS unsigned*)(lds + MISC_OFF);
    LAS float* scr = (LAS float*)(lds + wave * 16896);
    if (drain) { while (bg_item(c, scr, lane)) { } }
    asm volatile("s_waitcnt vmcnt(0)" ::: "memory");
    __syncthreads();
    if (threadIdx.x == 0) {
        unsigned* bar = b.bar;
        __builtin_amdgcn_s_waitcnt(0);
        unsigned nloc = b.st[0], nx = b.st[1];
        if (nloc == 0u) { xcd_barrier_complete(bar, b.x, nloc, nx); b.st[0] = nloc; b.st[1] = nx; }
        const unsigned old = xb_add(&bar[XB_XSUB(b.x)], 1u);
        const unsigned gen = old / nloc;
        if (old + 1u == (gen + 1u) * nloc) {
            __builtin_amdgcn_fence(__ATOMIC_RELEASE, "agent");
            asm volatile("s_waitcnt vmcnt(0)" ::: "memory");
            const unsigned og = xb_add(&bar[XB_TOP], 1u);
            const unsigned tg = og / nx;
            if (og + 1u == (tg + 1u) * nx) { xb_add(&bar[XB_TOPGEN], 1u); M[10] = 2u; } else M[10] = 1u;
            M[11] = tg;
        } else { M[10] = 0u; M[11] = gen; }
    }
    unsigned spins = 0;
    for (;;) {
        if (threadIdx.x == 0) { const unsigned role = M[10], g = M[11]; unsigned* bar = b.bar;
            bool rel = role == 2u ? true : role == 1u ? (xb_ld(&bar[XB_TOPGEN]) != g) : (xb_ld(&bar[XB_XGEN(b.x)]) != g);
            if (!rel && (++spins & 255u) == 0u) { if (xb_ld(&bar[XB_TMO])) rel = true; else if (spins > XB_SPIN_CAP) { atomicAdd(&bar[XB_TMO], 1u); rel = true; } }
            M[12] = rel ? 1u : 0u; }
        asm volatile("s_waitcnt lgkmcnt(0)" ::: "memory"); __syncthreads();
        const bool rel = M[12] != 0u;
        asm volatile("s_waitcnt lgkmcnt(0)" ::: "memory"); __syncthreads();
        if (rel) break;
        if (M[13] != 0u || !bg_item(c, scr, lane)) { M[13] = 1u; __builtin_amdgcn_s_sleep(16); }
    }
    if (threadIdx.x == 0) {
        __builtin_amdgcn_fence(__ATOMIC_ACQUIRE, "agent");
        if (M[10] != 0u) xb_add(&b.bar[XB_XGEN(b.x)], 1u);
        asm volatile("s_waitcnt vmcnt(0)" ::: "memory");
    }
    __syncthreads();
}

__global__ void __launch_bounds__(NTHREADS, 2) fwd_kernel(Args args) {
    extern __shared__ __attribute__((aligned(16))) unsigned char lds_raw[];
    LAS unsigned char* lds = (LAS unsigned char*)lds_raw;
    volatile LAS unsigned* MISC = (volatile LAS unsigned*)(lds + MISC_OFF);
    const int G = gridDim.x, bid = blockIdx.x;
    const int wave_sg = __builtin_amdgcn_readfirstlane((int)threadIdx.x >> 6);
#define PHASE_IDS() int lane; asm volatile("v_mbcnt_lo_u32_b32 %0, -1, 0\n\tv_mbcnt_hi_u32_b32 %0, -1, %0" : "=v"(lane)); const int wave = wave_sg; const int tid = wave * 64 + lane; const int gw = bid * NWAVES + wave, NGW = G * NWAVES; (void)lane; (void)wave; (void)gw; (void)NGW
#define CAS __attribute__((address_space(4)))
#define PHASE_ARGS() const CAS Args* ap = (const CAS Args*)__builtin_amdgcn_kernarg_segment_ptr(); asm volatile("" : "+s"(ap)); unsigned char* const ws = ap->ws; unsigned* const ctl = (unsigned*)(ws + WS_CTL); (void)ctl
#define ARG(i) (ap->in[i])
#define WSP(T, off) ((T*)(ws + (off)))
    enum { I_X = 0, I_C, I_WADA, I_BADA, I_NMIX, I_WIN, I_LBT, I_HGNW, I_CONVW, I_WHG, I_WCV, I_WMIX, I_NFFN, I_WR, I_BR, I_W1, I_B1, I_W2, I_B2, I_NFIN };
    { PHASE_IDS(); for (int u = tid; u < 64; u += NTHREADS) MISC[u] = 0u; }
    __syncthreads();
    XcdBarrier bar; bar.bar = nullptr; bar.x = 0; bar.st = nullptr;
#if MK_ONE_LAUNCH
    { PHASE_ARGS(); bar = xcd_barrier_post(ctl + CW_BAR, MISC + 8); }
#if MK_BG
#define GRID_BAR_X(drain) do { PHASE_IDS(); PHASE_ARGS(); const BgCtx bgc{ARG(I_W1), ARG(I_W2), WSP(unsigned char, WS_W1), WSP(unsigned char, WS_W2), ctl + CW_Q}; xcd_barrier_bg(bar, bgc, lds, wave, lane, drain); } while (0)
#define GRID_BAR() GRID_BAR_X(false)
#else
#define GRID_BAR() xcd_barrier(bar)
#endif
#else
#define GRID_BAR() do { } while (0)
#endif
    const int lo = args.ph_lo, hi = args.ph_hi;
#if MK_PHT
    const unsigned long long pht0 = __builtin_amdgcn_s_memrealtime(); unsigned long long phtk = 0;
#endif
#ifndef PH_MASK
#define PH_MASK 0x7ff
#endif
#define IN(k) (((PH_MASK >> (k)) & 1) && lo <= (k) && (k) < hi)
#define BOTH(k) (IN(k) && IN((k) + 1))

    if (IN(0)) for (int rep_ = 0; rep_ < 1 + ((MK_REPEAT >> 0) & 1); ++rep_) { PHASE_IDS(); PHASE_ARGS();
        const float* cvec = ARG(I_C); const float* w_ada = ARG(I_WADA); const float* b_ada = ARG(I_BADA); const float* lbtab = ARG(I_LBT);
        const float* w_in = ARG(I_WIN); const float* w_hg = ARG(I_WHG); const float* w_cv = ARG(I_WCV); const float* w_mix = ARG(I_WMIX); const float* w1 = ARG(I_W1); const float* w2 = ARG(I_W2);
        float* MOD = WSP(float, WS_MOD); float* LB = WSP(float, WS_LB);
        bf16_t* Win_t = WSP(bf16_t, WS_WIN); bf16_t* Whg_t = WSP(bf16_t, WS_WHG); bf16_t* Wcv_t = WSP(bf16_t, WS_WHG) + 512;        bf16_t* Wmix_t = WSP(bf16_t, WS_WMIX); unsigned char* W1_t = WSP(unsigned char, WS_W1); unsigned char* W2_t = WSP(unsigned char, WS_W2);
        LAS float* scr = (LAS float*)(lds + wave * 16896);
        const int nmod_w = NGW >= 768 ? 384 : 0;
        for (int it = (nmod_w ? gw - (NGW - nmod_w) : gw); it >= 0 && it < 384; it += (nmod_w ? 384 : NGW)) {
            const int n0 = it * 16, cl = lane & 15, kq = lane >> 4;
            float acc[32];
#pragma unroll
            for (int b = 0; b < 32; ++b) acc[b] = 0.f;
            for (int ch = 0; ch < 16; ++ch) {
                { const int b = lane >> 1, part = lane & 1;
#pragma unroll
                    for (int q = 0; q < 4; ++q) {
                        const float* cp = cvec + (size_t)b * D + q * 256 + ch * 16 + part * 8;
                        const f32x4 c0 = *(const f32x4*)cp, c1 = *(const f32x4*)(cp + 4);
#pragma unroll
                        for (int j = 0; j < 4; ++j) { scr[(q * 16 + part * 8 + j) * 32 + b] = c0[j] * sigmoidf_(c0[j]); scr[(q * 16 + part * 8 + 4 + j) * 32 + b] = c1[j] * sigmoidf_(c1[j]); }
                    } }
                float wv[16];
#pragma unroll
                for (int kk = 0; kk < 16; ++kk) wv[kk] = w_ada[(size_t)(kq * 256 + ch * 16 + kk) * 6144 + n0 + cl];
                LDS_WAIT(); asm volatile("" ::: "memory");
#pragma unroll
                for (int kk = 0; kk < 16; ++kk) {
                    const LAS f32x4* sp = (const LAS f32x4*)(scr + (kq * 16 + kk) * 32);
#pragma unroll
                    for (int b4 = 0; b4 < 8; ++b4) { const f32x4 s = sp[b4]; acc[4 * b4] += wv[kk] * s[0]; acc[4 * b4 + 1] += wv[kk] * s[1]; acc[4 * b4 + 2] += wv[kk] * s[2]; acc[4 * b4 + 3] += wv[kk] * s[3]; }
                }
                LDS_WAIT(); asm volatile("" ::: "memory");
            }
            const float bias = b_ada[n0 + cl];
#pragma unroll
            for (int b = 0; b < 32; ++b) { float v = acc[b]; v += __shfl_xor(v, 16); v += __shfl_xor(v, 32); if (kq == 0) MOD[(size_t)b * 6144 + n0 + cl] = v + bias; }
        }
        if (bid == (G > 1 ? 1 : 0)) { const int k = tid; const float l0 = lbtab[k], l1 = lbtab[HW + k]; LB[k] = fast_rcp(1.0f + fast_exp(l1 - l0)); }
        {
            constexpr int I_IN = 16 * PN8 * 4, I_IN8 = 8 * NQ8 * 8, I_HG = 8 * 16, I_CV = 8 * 16, I_MIX = 16 * 16, I_W1 = 32 * 8 * 64, I_W2 = 32 * 8 * 32;
            constexpr int I_RT = 32;
            constexpr int NITEMS = I_RT + I_IN + I_IN8 + I_HG + I_CV + I_MIX + ((MK_BG && MK_ONE_LAUNCH) ? 0 : I_W1 + I_W2);
            const int n_nm = NGW - nmod_w, base2 = 2 * n_nm, nfull = (NITEMS - base2) / NGW, base3 = base2 + nfull * NGW;
            for (int rr = 0; rr < nfull + 3; ++rr) {
                int it;
                if (rr < 2) { if (gw >= n_nm) continue; it = rr * n_nm + gw; }
                else if (rr < 2 + nfull) it = base2 + (rr - 2) * NGW + gw;
                else { if (gw >= n_nm) continue; it = base3 + gw; }
                if (it >= NITEMS) continue;
                int r = it;
                if (r < I_RT) { const float* w_router = ARG(I_WR); bf16_t* WI = WSP(bf16_t, WS_WRI);
                    for (int k = lane; k < 1024; k += 64) { const float w = w_router[k * 32 + r]; const unsigned hi = cvt_pk_bf16(w, 0.f) & 0xffffu; const unsigned lo = cvt_pk_bf16(w - bf_lo(hi), 0.f) & 0xffffu;
                        WI[r * 1032 + k] = (bf16_t)hi; WI[32 * 1032 + r * 1032 + k] = (bf16_t)lo; }
                    continue; } r -= I_RT;
#if MK_P2FP8
                if (r < I_IN) { const int kb = r / 176, nb = r % 176; transpose_item_fp8(w_in, INC, (unsigned char*)Win_t, D, kb * 128, nb * 32, nb * 32, scr, lane); continue; } r -= I_IN;
#else
                if (r < I_IN) { const int kb = r / (PN8 * 4), nb = r % (PN8 * 4); const int pn = map16(nb >> 2), wi = (nb & 3) * 64;
                    const int src = pn < 10 ? pn * 256 + wi : pn < 14 ? (wi < 128 ? 2560 + (pn - 10) * 128 + wi : 3072 + (pn - 10) * 128 + (wi - 128)) : (wi < 128 ? 3584 + (pn - 14) * 128 + wi : 4608 + (pn - 14) * 128 + (wi - 128));
                    transpose_item(w_in, INC, Win_t, D, kb * 64, src, nb * 64, scr, lane); continue; } r -= I_IN;
                if (r < I_IN8) { const int kb = r / (NQ8 * 8), nb = r % (NQ8 * 8); const int pn = map8(nb >> 3), wi = (nb & 7) * 32;
                    const int src = pn < 10 ? pn * 256 + wi : pn < 14 ? (wi < 128 ? 2560 + (pn - 10) * 128 + wi : 3072 + (pn - 10) * 128 + (wi - 128)) : (wi < 128 ? 3584 + (pn - 14) * 128 + wi : 4608 + (pn - 14) * 128 + (wi - 128));
                    transpose_item_fp8(w_in, INC, WSP(unsigned char, WS_WIN8), D, kb * 128, src, nb * 32, scr, lane); continue; } r -= I_IN8;
#endif
                if (r < I_HG) { const int kb = r / 16, nb = r % 16; transpose_item(w_hg, D, Whg_t, D, kb * 64, nb * 64, nb * 64, scr, lane); continue; } r -= I_HG;
                if (r < I_CV) { const int kb = r / 16, nb = r % 16; transpose_item(w_cv, D, Wcv_t, D, kb * 64, nb * 64, nb * 64, scr, lane); continue; } r -= I_CV;
                if (r < I_MIX) { const int kb = r / 16, nb = r % 16; transpose_item(w_mix, D, Wmix_t, D, kb * 64, nb * 64, nb * 64, scr, lane); continue; } r -= I_MIX;
                if (r < I_W1) { const int e = r / 512, q = r % 512, kb = q / 64, nb = q % 64;
                    const int pn = nb >> 3, wi = (nb & 7) * 32; const int src = wi < 128 ? pn * 128 + wi : 1024 + pn * 128 + (wi - 128);
                    transpose_item_fp8(w1 + (size_t)e * D * 2048, 2048, W1_t + (size_t)e * 2048 * D, D, kb * 128, src, nb * 32, scr, lane); continue; } r -= I_W1;
                { const int e = r / 256, q = r % 256, kb = q / 32, nb = q % 32;
                    transpose_item_fp8(w2 + (size_t)e * DFF * D, D, W2_t + (size_t)e * D * DFF, DFF, kb * 128, nb * 32, nb * 32, scr, lane); }
            }
        }
        if (BOTH(0)) GRID_BAR();
#if MK_PHT
        if (MK_PHT == 1) phtk = __builtin_amdgcn_s_memrealtime() - pht0;
#endif
    }

    if (IN(1)) for (int rep_ = 0; rep_ < 1 + ((MK_REPEAT >> 1) & 1); ++rep_) { PHASE_IDS(); PHASE_ARGS();
        const float* x = ARG(I_X); const float* norm_mix_w = ARG(I_NMIX); const float* MOD = WSP(float, WS_MOD); bf16_t* U = WSP(bf16_t, WS_U); unsigned char* U8 = WSP(unsigned char, WS_U8);
        for (int m0 = gw * 32; m0 < NTOK; m0 += NGW * 32) {
            const int b = m0 >> 11;
            f32x4 A[4], Sh[4];
#pragma unroll
            for (int j = 0; j < 4; ++j) { const int k = 4 * lane + 256 * j; const f32x4 w = *(const f32x4*)(norm_mix_w + k), sc = *(const f32x4*)(MOD + (size_t)b * 6144 + 1024 + k);
                A[j] = w * (sc + 1.0f); Sh[j] = *(const f32x4*)(MOD + (size_t)b * 6144 + k); }
            for (int r = 0; r < 32; r += 4) {
                f32x4 v[4][4]; float ss[4];
#pragma unroll
                for (int q = 0; q < 4; ++q) { const float* xr = x + (size_t)(m0 + r + q) * D; ss[q] = 0.f;
#pragma unroll
                    for (int j = 0; j < 4; ++j) v[q][j] = *(const f32x4*)(xr + 4 * lane + 256 * j); }
#pragma unroll
                for (int q = 0; q < 4; ++q) {
#pragma unroll
                    for (int j = 0; j < 4; ++j) ss[q] += (v[q][j][0] * v[q][j][0] + v[q][j][1] * v[q][j][1]) + (v[q][j][2] * v[q][j][2] + v[q][j][3] * v[q][j][3]);
                    const float rs = __builtin_amdgcn_rsqf(wave_sum(ss[q]) * (1.0f / D) + EPS);
#if MK_P2FP8
                    unsigned char* ur = (unsigned char*)U + (size_t)(m0 + r + q) * D;
#pragma unroll
                    for (int j = 0; j < 4; ++j) { const f32x4 o = v[q][j] * rs * A[j] + Sh[j]; *(unsigned*)(ur + 4 * lane + 256 * j) = pk4_fp8(o[0], o[1], o[2], o[3]); }
#else
                    bf16_t* ur = U + (size_t)(m0 + r + q) * D; unsigned char* u8r = U8 + (size_t)(m0 + r + q) * D;
#pragma unroll
                    for (int j = 0; j < 4; ++j) { const f32x4 o = v[q][j] * rs * A[j] + Sh[j]; u32x2 w; w.x = cvt_pk_bf16(o[0], o[1]); w.y = cvt_pk_bf16(o[2], o[3]); *(u32x2*)(ur + 4 * lane + 256 * j) = w;
                        if (NQ8 > 0) *(unsigned*)(u8r + 4 * lane + 256 * j) = pk4_fp8(o[0], o[1], o[2], o[3]); }
#endif
                }
            }
        }
        if (BOTH(1)) GRID_BAR();
#if MK_PHT
        if (MK_PHT == 2) phtk = __builtin_amdgcn_s_memrealtime() - pht0;
#endif
    }

    if (IN(2)) for (int rep_ = 0; rep_ < 1 + ((MK_REPEAT >> 2) & 1); ++rep_) { PHASE_ARGS();
        if (PN8 > 0) { gm::DenseOrder S{NTOK / 256, PN8, G, bid, 1}; gm::DenseA AM{D, 0u, 2}; gm::EpiProjT<false> E{WSP(bf16_t, WS_PROJ), (bf16_t*)ap->out, WSP(float, WS_LB)};
            gm::gemm_phase<false>(wave_sg, lds, (const char*)WSP(bf16_t, WS_U), (const char*)WSP(bf16_t, WS_WIN), D, 0, 0u, S, E, AM); }
        if (NQ8 > 0) { gm::DenseOrder S{NTOK / 256, NQ8, G, bid, 1}; gm::DenseA AM{D, 0u, 1}; gm::EpiProjT<true> E{WSP(bf16_t, WS_PROJ), (bf16_t*)ap->out, WSP(float, WS_LB)};
            gm::gemm_phase<true>(wave_sg, lds, (const char*)WSP(unsigned char, WS_U8), (const char*)WSP(unsigned char, WS_WIN8), D, 0, 0u, S, E, AM); }
        if (BOTH(2)) GRID_BAR();
#if MK_PHT
        if (MK_PHT == 3) phtk = __builtin_amdgcn_s_memrealtime() - pht0;
#endif
    }

    if (IN(3)) for (int rep_ = 0; rep_ < 1 + ((MK_REPEAT >> 3) & 1); ++rep_) { PHASE_IDS(); PHASE_ARGS();
        const float* hg_norm_w = ARG(I_HGNW); const float* conv_w = ARG(I_CONVW); const bf16_t* PROJ = WSP(bf16_t, WS_PROJ); bf16_t* OB = WSP(bf16_t, WS_O); bf16_t* CVB = WSP(bf16_t, WS_O) + 512;
        const bool split = (G >= 256);
        bf16_t* RAWG = WSP(bf16_t, WS_RAW); bf16_t* QBG = WSP(bf16_t, WS_QBG); float* STATEG = WSP(float, WS_STATE); float* DECG = WSP(float, WS_DECG);
        constexpr int LDQ = 136, LDT = 72;
        if (!split || bid < 256) {
            LAS bf16_t* QT = (LAS bf16_t*)(lds);
            LAS bf16_t* KT = QT + 64 * LDQ;
            LAS bf16_t* QB = KT + 64 * LDQ;
            LAS bf16_t* KBT = QB + 64 * LDQ;
            LAS bf16_t* VT = KBT + 128 * LDT;
            LAS bf16_t* PM = VT + 128 * LDT;
            LAS bf16_t* ST = PM + 64 * LDT;
            LAS bf16_t* OS = ST + 128 * LDQ;
            LAS float* SEG = (LAS float*)(OS + 64 * LDQ);
            LAS float* DEC = SEG + 8 * 128;
            const int fr = lane & 15, fq = lane >> 4, w = wave;
            for (int chain = split ? (bid & 127) : bid; chain < BATCH * NHEAD; chain += split ? 128 : G) {
                const int b = chain >> 2, h = chain & 3;
                const int c0 = split ? (bid >> 7) * (NCHUNK / 2) : 0, c1 = split ? c0 + NCHUNK / 2 : NCHUNK; const bool rawm = split;
                __syncthreads();
                for (int i = tid; i < 128 * LDQ / 2; i += NTHREADS) ((LAS unsigned*)ST)[i] = 0u;
                f32x4 Sacc[8];
#pragma unroll
                for (int i = 0; i < 8; ++i) Sacc[i] = (f32x4){0.f, 0.f, 0.f, 0.f};
                const int ot = tid >> 3, ocg = tid & 7;
                f32x4 nwv[4];
#pragma unroll
                for (int q = 0; q < 2; ++q) { nwv[2 * q] = *(const f32x4*)(hg_norm_w + q * 64 + 8 * ocg); nwv[2 * q + 1] = *(const f32x4*)(hg_norm_w + q * 64 + 8 * ocg + 4); }
                const bf16_t* pbase = PROJ + (size_t)(b * SEQ) * PROJ_LD + h * DK;
                unsigned rq[8], rl[8], rv[8];
#pragma unroll
                for (int r = 0; r < 8; ++r) { const bf16_t* p = pbase + (size_t)(c0 * CHUNK + 8 * w + r) * PROJ_LD + 2 * lane; rq[r] = *(const unsigned*)p; rl[r] = *(const unsigned*)(p + 512); rv[r] = *(const unsigned*)(p + 1024); }
                for (int c = c0; c < c1; ++c) {
                    const int m0 = c * CHUNK;
                    float cs0[8], cs1[8]; { float a0 = 0.f, a1 = 0.f;
#pragma unroll
                        for (int r = 0; r < 8; ++r) { a0 += bf_lo(rl[r]); a1 += bf_hi(rl[r]); cs0[r] = a0; cs1[r] = a1; }
                        *(LAS f32x2*)(SEG + w * 128 + 2 * lane) = (f32x2){a0, a1}; }
                    LDS_WAIT(); __builtin_amdgcn_s_barrier(); asm volatile("" ::: "memory");
                    float pre0 = 0.f, pre1 = 0.f, bm0 = 0.f, bm1 = 0.f, bl0 = 0.f, bl1 = 0.f;
#pragma unroll
                    for (int s = 0; s < 8; ++s) { const f32x2 t2 = *(const LAS f32x2*)(SEG + s * 128 + 2 * lane); if (s < w) { pre0 += t2[0]; pre1 += t2[1]; } if (s < 4) { bm0 += t2[0]; bm1 += t2[1]; } bl0 += t2[0]; bl1 += t2[1]; }
                    const float em0 = fast_exp(fmaxf(bm0, -80.f)), em1 = fast_exp(fmaxf(bm1, -80.f));
                    const float el0 = fast_exp(fmaxf(bl0 - bm0, -80.f)), el1 = fast_exp(fmaxf(bl1 - bm1, -80.f));
                    if (w == 0) *(LAS f32x2*)(DEC + 2 * lane) = (f32x2){fast_exp(fmaxf(bl0, -80.f)), fast_exp(fmaxf(bl1, -80.f))};
                    unsigned kb0[4], kb1[4], vt0[4], vt1[4];
#pragma unroll
                    for (int r = 0; r < 8; ++r) {
                        const int t = 8 * w + r;
                        const float lf0 = bf_lo(rl[r]), lf1 = bf_hi(rl[r]);
                        const float d0 = fminf(fmaxf(pre0 + cs0[r] - bm0, -80.f), 80.f), d1 = fminf(fmaxf(pre1 + cs1[r] - bm1, -80.f), 80.f);
                        const float e0 = fast_exp(d0), e1 = fast_exp(d1), i0 = fast_exp(-d0), i1 = fast_exp(-d1);
                        const float kk0 = 1.0f - fast_exp(lf0), kk1 = 1.0f - fast_exp(lf1);
                        const float qt0 = bf_lo(rq[r]) * e0, qt1 = bf_hi(rq[r]) * e1, kt0 = kk0 * i0, kt1 = kk1 * i1;
                        *(LAS unsigned*)(QT + t * LDQ + 2 * lane) = cvt_pk_bf16(qt0, qt1);
                        *(LAS unsigned*)(KT + t * LDQ + 2 * lane) = cvt_pk_bf16(kt0, kt1);
                        *(LAS unsigned*)(QB + t * LDQ + 2 * lane) = cvt_pk_bf16(qt0 * em0, qt1 * em1);
                        const unsigned kbp = cvt_pk_bf16(kt0 * el0, kt1 * el1);
                        if (r & 1) { kb0[r >> 1] |= (kbp << 16); kb1[r >> 1] |= (kbp & 0xffff0000u); vt0[r >> 1] |= (rv[r] << 16); vt1[r >> 1] |= (rv[r] & 0xffff0000u); }
                        else { kb0[r >> 1] = kbp & 0xffffu; kb1[r >> 1] = kbp >> 16; vt0[r >> 1] = rv[r] & 0xffffu; vt1[r >> 1] = rv[r] >> 16; }
                    }
                    *(LAS u32x4*)(KBT + (2 * lane) * LDT + 8 * w) = (u32x4){kb0[0], kb0[1], kb0[2], kb0[3]};
                    *(LAS u32x4*)(KBT + (2 * lane + 1) * LDT + 8 * w) = (u32x4){kb1[0], kb1[1], kb1[2], kb1[3]};
                    *(LAS u32x4*)(VT + (2 * lane) * LDT + 8 * w) = (u32x4){vt0[0], vt0[1], vt0[2], vt0[3]};
                    *(LAS u32x4*)(VT + (2 * lane + 1) * LDT + 8 * w) = (u32x4){vt1[0], vt1[1], vt1[2], vt1[3]};
                    LDS_WAIT(); __builtin_amdgcn_s_barrier(); asm volatile("" ::: "memory");
                    u32x4 gg[2];
                    if (!rawm) { const bf16_t* gp = pbase + (size_t)(m0 + ot) * PROJ_LD + 1536 + 8 * ocg; gg[0] = *(const u32x4*)gp; gg[1] = *(const u32x4*)(gp + 64); }
                    if (c + 1 < c1) {
#pragma unroll
                        for (int r = 0; r < 8; ++r) { const bf16_t* p = pbase + (size_t)(m0 + CHUNK + 8 * w + r) * PROJ_LD + 2 * lane; rq[r] = *(const unsigned*)p; rl[r] = *(const unsigned*)(p + 512); rv[r] = *(const unsigned*)(p + 1024); }
                    }
#pragma unroll
                    for (int x2 = 0; x2 < 2; ++x2) { const int id = 2 * w + x2, si = id >> 2, ti = id & 3;
                        f32x4 sc = (f32x4){0.f, 0.f, 0.f, 0.f};
                        if (si <= ti) {
#pragma unroll
                            for (int ks = 0; ks < 4; ++ks) { const bf16x8 a = *(const LAS bf16x8*)(KT + (16 * si + fr) * LDQ + 32 * ks + 8 * fq), bb = *(const LAS bf16x8*)(QT + (16 * ti + fr) * LDQ + 32 * ks + 8 * fq);
                                sc = __builtin_amdgcn_mfma_f32_16x16x32_bf16(a, bb, sc, 0, 0, 0); }
                            const int t = 16 * ti + fr, s0 = 16 * si + 4 * fq;
#pragma unroll
                            for (int j = 0; j < 4; ++j) sc[j] = (s0 + j <= t) ? sc[j] : 0.f;
                        }
                        *(LAS u32x2*)(PM + (16 * ti + fr) * LDT + 16 * si + 4 * fq) = (u32x2){cvt_pk_bf16(sc[0], sc[1]), cvt_pk_bf16(sc[2], sc[3])};
                    }
                    f32x4 oacc[4];
                    { bf16x8 sa[4];
#pragma unroll
                        for (int ks = 0; ks < 4; ++ks) sa[ks] = *(const LAS bf16x8*)(ST + (16 * w + fr) * LDQ + 32 * ks + 8 * fq);
#pragma unroll
                        for (int ti = 0; ti < 4; ++ti) { oacc[ti] = (f32x4){0.f, 0.f, 0.f, 0.f};
#pragma unroll
                            for (int ks = 0; ks < 4; ++ks) { const bf16x8 bb = *(const LAS bf16x8*)(QB + (16 * ti + fr) * LDQ + 32 * ks + 8 * fq); oacc[ti] = __builtin_amdgcn_mfma_f32_16x16x32_bf16(sa[ks], bb, oacc[ti], 0, 0, 0); } } }
                    LDS_WAIT(); __builtin_amdgcn_s_barrier(); asm volatile("" ::: "memory");
                    { bf16x8 va[2];
#pragma unroll
                        for (int ks = 0; ks < 2; ++ks) va[ks] = *(const LAS bf16x8*)(VT + (16 * w + fr) * LDT + 32 * ks + 8 * fq);
#pragma unroll
                        for (int ti = 0; ti < 4; ++ti)
#pragma unroll
                            for (int ks = 0; ks < 2; ++ks) { const bf16x8 bb = *(const LAS bf16x8*)(PM + (16 * ti + fr) * LDT + 32 * ks + 8 * fq); oacc[ti] = __builtin_amdgcn_mfma_f32_16x16x32_bf16(va[ks], bb, oacc[ti], 0, 0, 0); }
#pragma unroll
                        for (int i = 0; i < 8; ++i) { const f32x4 dv = *(const LAS f32x4*)(DEC + 16 * i + 4 * fq); Sacc[i] = Sacc[i] * dv;
#pragma unroll
                            for (int ks = 0; ks < 2; ++ks) { const bf16x8 a = *(const LAS bf16x8*)(KBT + (16 * i + fr) * LDT + 32 * ks + 8 * fq); Sacc[i] = __builtin_amdgcn_mfma_f32_16x16x32_bf16(a, va[ks], Sacc[i], 0, 0, 0); } } }
#pragma unroll
                    for (int ti = 0; ti < 4; ++ti) *(LAS u32x2*)(OS + (16 * ti + fr) * LDQ + 16 * w + 4 * fq) = (u32x2){cvt_pk_bf16(oacc[ti][0], oacc[ti][1]), cvt_pk_bf16(oacc[ti][2], oacc[ti][3])};
#pragma unroll
                    for (int i = 0; i < 8; ++i) *(LAS u32x2*)(ST + (16 * w + fr) * LDQ + 16 * i + 4 * fq) = (u32x2){cvt_pk_bf16(Sacc[i][0], Sacc[i][1]), cvt_pk_bf16(Sacc[i][2], Sacc[i][3])};
                    LDS_WAIT(); __builtin_amdgcn_s_barrier(); asm volatile("" ::: "memory");
                    if (rawm) { const size_t ci = (size_t)(chain * (NCHUNK / 2) + (c - c0)), cr = ci + (size_t)(bid >> 7) * (128 * (NCHUNK / 2));
                        bf16_t* rp = RAWG + cr * (CHUNK * 128) + ot * 128 + 8 * ocg;
                        *(u32x4*)rp = *(const LAS u32x4*)(OS + ot * LDQ + 8 * ocg); *(u32x4*)(rp + 64) = *(const LAS u32x4*)(OS + ot * LDQ + 64 + 8 * ocg);
                        if (bid >= 128) { bf16_t* qp = QBG + ci * (CHUNK * 128) + ot * 128 + 8 * ocg;
                            *(u32x4*)qp = *(const LAS u32x4*)(QB + ot * LDQ + 8 * ocg); *(u32x4*)(qp + 64) = *(const LAS u32x4*)(QB + ot * LDQ + 64 + 8 * ocg);
                            if (tid < 32) *(f32x4*)(DECG + ci * 128 + 4 * tid) = *(const LAS f32x4*)(DEC + 4 * tid); }
                    } else
                    { f32x4 o[4]; const u32x4 ow0 = *(const LAS u32x4*)(OS + ot * LDQ + 8 * ocg), ow1 = *(const LAS u32x4*)(OS + ot * LDQ + 64 + 8 * ocg); gm::unpack8(ow0, o[0], o[1]); gm::unpack8(ow1, o[2], o[3]);
                        float ss = 0.f;
#pragma unroll
                        for (int q = 0; q < 4; ++q) ss += (o[q][0] * o[q][0] + o[q][1] * o[q][1]) + (o[q][2] * o[q][2] + o[q][3] * o[q][3]);
                        ss += __shfl_xor(ss, 1); ss += __shfl_xor(ss, 2); ss += __shfl_xor(ss, 4);
                        const float rn = __builtin_amdgcn_rsqf(ss * (1.0f / 128.0f) + EPS);
                        bf16_t* op = OB + (size_t)(b * SEQ + m0 + ot) * D + h * DK + 8 * ocg;
#pragma unroll
                        for (int q = 0; q < 2; ++q) { f32x4 g0, g1; gm::unpack8(gg[q], g0, g1);
#pragma unroll
                            for (int j = 0; j < 4; ++j) { g0[j] = g0[j] * sigmoidf_(g0[j]); g1[j] = g1[j] * sigmoidf_(g1[j]); }
                            *(u32x4*)(op + 64 * q) = gm::pack8(o[2 * q] * rn * nwv[2 * q] * g0, o[2 * q + 1] * rn * nwv[2 * q + 1] * g1); } }
                }
                if (split && bid < 128) {
                    GAS unsigned long long* sp = (GAS unsigned long long*)(STATEG + (size_t)chain * 16384 + (16 * w + fr) * 128 + 4 * fq);
#pragma unroll
                    for (int i = 0; i < 8; ++i) { const u32x4 sv = __builtin_bit_cast(u32x4, Sacc[i]);
                        __hip_atomic_store(sp + 8 * i, ((unsigned long long)sv.y << 32) | sv.x, __ATOMIC_RELAXED, __HIP_MEMORY_SCOPE_AGENT); __hip_atomic_store(sp + 8 * i + 1, ((unsigned long long)sv.w << 32) | sv.z, __ATOMIC_RELAXED, __HIP_MEMORY_SCOPE_AGENT); }
                    asm volatile("s_waitcnt vmcnt(0)" ::: "memory");
                    __syncthreads();
                    if (tid == 0) __hip_atomic_store((GAS unsigned*)(ctl + CW_ST + chain), 1u, __ATOMIC_RELAXED, __HIP_MEMORY_SCOPE_AGENT);
                }
            }
        }
        {
            f32x4 cw[3][2];
#pragma unroll
            for (int j = 0; j < 3; ++j) { cw[j][0] = *(const f32x4*)(conv_w + j * 512 + 8 * lane); cw[j][1] = *(const f32x4*)(conv_w + j * 512 + 8 * lane + 4); }
            constexpr int NPIECE = BATCH * (SEQ / 64), NA = MK_CONV_NA, NB = 8 - NA;
            const int p_lo = !split ? bid : bid < 128 ? bid * NA : bid < 256 ? 128 * NA + (bid - 128) * NB : NPIECE;
            const int p_hi = !split ? NPIECE : bid < 128 ? p_lo + NA : bid < 256 ? p_lo + NB : NPIECE, p_st = split ? 1 : G;
            for (int it = p_lo; it < p_hi; it += p_st) {
                const int b = it / (SEQ / 64), t0 = (it % (SEQ / 64)) * 64 + wave * 8;
                const bf16_t* pb = PROJ + (size_t)(b * SEQ) * PROJ_LD + 2048 + 8 * lane;
                u32x4 pr[10], gr[8];
#pragma unroll
                for (int r = 0; r < 10; ++r) { pr[r] = (u32x4){0u, 0u, 0u, 0u}; if (r >= 2 || t0 > 0) pr[r] = *(const u32x4*)(pb + (size_t)(t0 + r - 2) * PROJ_LD + 512); }
#pragma unroll
                for (int r = 0; r < 8; ++r) gr[r] = *(const u32x4*)(pb + (size_t)(t0 + r) * PROJ_LD);
                f32x4 p2[2], p1[2]; gm::unpack8(pr[0], p2[0], p2[1]); gm::unpack8(pr[1], p1[0], p1[1]);
#pragma unroll
                for (int r = 0; r < 8; ++r) { f32x4 q0, q1, g0, g1; gm::unpack8(pr[r + 2], q0, q1); gm::unpack8(gr[r], g0, g1);
                    const f32x4 y0 = g0 * (cw[0][0] * p2[0] + cw[1][0] * p1[0] + cw[2][0] * q0), y1 = g1 * (cw[0][1] * p2[1] + cw[1][1] * p1[1] + cw[2][1] * q1);
                    *(u32x4*)(CVB + (size_t)(b * SEQ + t0 + r) * D + 8 * lane) = gm::pack8(y0, y1);
                    p2[0] = p1[0]; p2[1] = p1[1]; p1[0] = q0; p1[1] = q1; }
            }
        }
        if (split && bid < 128) {
            const int chain = bid, b = chain >> 2, h = chain & 3, ot = tid >> 3, ocg = tid & 7;
            asm volatile("s_waitcnt vmcnt(0)" ::: "memory");
            __syncthreads();
            f32x4 nwv[4];
#pragma unroll
            for (int q = 0; q < 2; ++q) { nwv[2 * q] = *(const f32x4*)(hg_norm_w + q * 64 + 8 * ocg); nwv[2 * q + 1] = *(const f32x4*)(hg_norm_w + q * 64 + 8 * ocg + 4); }
            const bf16_t* pbase = PROJ + (size_t)(b * SEQ) * PROJ_LD + h * DK;
            for (int cc = 0; cc < NCHUNK / 2; cc += 2) {
                u32x4 rr[2][2], gq[2][2];
#pragma unroll
                for (int u = 0; u < 2; ++u) { const bf16_t* rp = RAWG + ((size_t)chain * (NCHUNK / 2) + cc + u) * (CHUNK * 128) + ot * 128 + 8 * ocg; rr[u][0] = *(const u32x4*)rp; rr[u][1] = *(const u32x4*)(rp + 64);
                    const bf16_t* gp = pbase + (size_t)((cc + u) * CHUNK + ot) * PROJ_LD + 1536 + 8 * ocg; gq[u][0] = *(const u32x4*)gp; gq[u][1] = *(const u32x4*)(gp + 64); }
#pragma unroll
                for (int u = 0; u < 2; ++u) { f32x4 o[4]; gm::unpack8(rr[u][0], o[0], o[1]); gm::unpack8(rr[u][1], o[2], o[3]);
                    float ss = 0.f;
#pragma unroll
                    for (int q = 0; q < 4; ++q) ss += (o[q][0] * o[q][0] + o[q][1] * o[q][1]) + (o[q][2] * o[q][2] + o[q][3] * o[q][3]);
                    ss += __shfl_xor(ss, 1); ss += __shfl_xor(ss, 2); ss += __shfl_xor(ss, 4);
                    const float rn = __builtin_amdgcn_rsqf(ss * (1.0f / 128.0f) + EPS);
                    bf16_t* op = OB + (size_t)(b * SEQ + (cc + u) * CHUNK + ot) * D + h * DK + 8 * ocg;
#pragma unroll
                    for (int q = 0; q < 2; ++q) { f32x4 g0, g1; gm::unpack8(gq[u][q], g0, g1);
#pragma unroll
                        for (int j = 0; j < 4; ++j) { g0[j] = g0[j] * sigmoidf_(g0[j]); g1[j] = g1[j] * sigmoidf_(g1[j]); }
                        *(u32x4*)(op + 64 * q) = gm::pack8(o[2 * q] * rn * nwv[2 * q] * g0, o[2 * q + 1] * rn * nwv[2 * q + 1] * g1); } }
            }
        }
        if (split && bid >= 128 && bid < 256) {
            LAS bf16_t* QB = (LAS bf16_t*)(lds) + 2 * 64 * LDQ;
            LAS bf16_t* ST = QB + 64 * LDQ + 2 * 128 * LDT + 64 * LDT;
            LAS bf16_t* OS = ST + 128 * LDQ;
            LAS float* DEC = (LAS float*)(OS + 64 * LDQ) + 8 * 128;
            const int chain = bid & 127, b = chain >> 2, h = chain & 3, fr = lane & 15, fq = lane >> 4, w = wave, ot = tid >> 3, ocg = tid & 7;
            asm volatile("s_waitcnt vmcnt(0)" ::: "memory");
            __syncthreads();
            if (wave == 0) { unsigned spins = 0;
                while ((unsigned)__builtin_amdgcn_readfirstlane((int)__hip_atomic_load((GAS unsigned*)(ctl + CW_ST + chain), __ATOMIC_RELAXED, __HIP_MEMORY_SCOPE_AGENT)) != 1u) { __builtin_amdgcn_s_sleep(2); if (++spins > (1u << 22)) break; }
                __builtin_amdgcn_fence(__ATOMIC_ACQUIRE, "agent"); }
            __syncthreads();
            f32x4 Sacc[8];
#pragma unroll
            for (int i = 0; i < 8; ++i) Sacc[i] = *(const f32x4*)(STATEG + (size_t)chain * 16384 + (16 * w + fr) * 128 + 16 * i + 4 * fq);
#pragma unroll
            for (int i = 0; i < 8; ++i) *(LAS u32x2*)(ST + (16 * w + fr) * LDQ + 16 * i + 4 * fq) = (u32x2){cvt_pk_bf16(Sacc[i][0], Sacc[i][1]), cvt_pk_bf16(Sacc[i][2], Sacc[i][3])};
            f32x4 nwv[4];
#pragma unroll
            for (int q = 0; q < 2; ++q) { nwv[2 * q] = *(const f32x4*)(hg_norm_w + q * 64 + 8 * ocg); nwv[2 * q + 1] = *(const f32x4*)(hg_norm_w + q * 64 + 8 * ocg + 4); }
            const bf16_t* pbase = PROJ + (size_t)(b * SEQ) * PROJ_LD + h * DK;
            const size_t cbase = (size_t)chain * (NCHUNK / 2);
#define P2_LOADQ(cix, Q, DV) do { const bf16_t* qp_ = QBG + (cbase + (cix)) * (CHUNK * 128) + ot * 128 + 8 * ocg; Q[0] = *(const u32x4*)qp_; Q[1] = *(const u32x4*)(qp_ + 64); \
                if (tid < 32) DV = *(const f32x4*)(DECG + (cbase + (cix)) * 128 + 4 * tid); } while (0)
#define P2_LOADR(cix, R, GGv) do { const bf16_t* rp_ = RAWG + (cbase + 128 * (NCHUNK / 2) + (cix)) * (CHUNK * 128) + ot * 128 + 8 * ocg; R[0] = *(const u32x4*)rp_; R[1] = *(const u32x4*)(rp_ + 64); \
                const bf16_t* gp_ = pbase + (size_t)((NCHUNK / 2 + (cix)) * CHUNK + ot) * PROJ_LD + 1536 + 8 * ocg; GGv[0] = *(const u32x4*)gp_; GGv[1] = *(const u32x4*)(gp_ + 64); } while (0)
#define P2_STEP(cix, Q, DV, R, GGv) do { \
                const int m0_ = (NCHUNK / 2 + (cix)) * CHUNK; \
                *(LAS u32x4*)(QB + ot * LDQ + 8 * ocg) = Q[0]; *(LAS u32x4*)(QB + ot * LDQ + 64 + 8 * ocg) = Q[1]; \
                if (tid < 32) *(LAS f32x4*)(DEC + 4 * tid) = DV; \
                LDS_WAIT(); __builtin_amdgcn_s_barrier(); asm volatile("" ::: "memory"); \
                if ((cix) + 2 < NCHUNK / 2) P2_LOADQ((cix) + 2, Q, DV); \
                f32x4 oacc[4]; \
                { bf16x8 sa[4]; \
                    _Pragma("unroll") for (int ks = 0; ks < 4; ++ks) sa[ks] = *(const LAS bf16x8*)(ST + (16 * w + fr) * LDQ + 32 * ks + 8 * fq); \
                    _Pragma("unroll") for (int ti = 0; ti < 4; ++ti) { oacc[ti] = (f32x4){0.f, 0.f, 0.f, 0.f}; \
                        _Pragma("unroll") for (int ks = 0; ks < 4; ++ks) { const bf16x8 bb = *(const LAS bf16x8*)(QB + (16 * ti + fr) * LDQ + 32 * ks + 8 * fq); oacc[ti] = __builtin_amdgcn_mfma_f32_16x16x32_bf16(sa[ks], bb, oacc[ti], 0, 0, 0); } } } \
                _Pragma("unroll") for (int ti = 0; ti < 4; ++ti) *(LAS u32x2*)(OS + (16 * ti + fr) * LDQ + 16 * w + 4 * fq) = (u32x2){cvt_pk_bf16(oacc[ti][0], oacc[ti][1]), cvt_pk_bf16(oacc[ti][2], oacc[ti][3])}; \
                _Pragma("unroll") for (int i = 0; i < 8; ++i) { const f32x4 dv = *(const LAS f32x4*)(DEC + 16 * i + 4 * fq); Sacc[i] = Sacc[i] * dv; \
                    *(LAS u32x2*)(ST + (16 * w + fr) * LDQ + 16 * i + 4 * fq) = (u32x2){cvt_pk_bf16(Sacc[i][0], Sacc[i][1]), cvt_pk_bf16(Sacc[i][2], Sacc[i][3])}; } \
                LDS_WAIT(); __builtin_amdgcn_s_barrier(); asm volatile("" ::: "memory"); \
                { f32x4 o[4], r4[4]; const u32x4 ow0 = *(const LAS u32x4*)(OS + ot * LDQ + 8 * ocg), ow1 = *(const LAS u32x4*)(OS + ot * LDQ + 64 + 8 * ocg); gm::unpack8(ow0, o[0], o[1]); gm::unpack8(ow1, o[2], o[3]); \
                    gm::unpack8(R[0], r4[0], r4[1]); gm::unpack8(R[1], r4[2], r4[3]); \
                    float ss = 0.f; \
                    _Pragma("unroll") for (int q = 0; q < 4; ++q) { o[q] = o[q] + r4[q]; ss += (o[q][0] * o[q][0] + o[q][1] * o[q][1]) + (o[q][2] * o[q][2] + o[q][3] * o[q][3]); } \
                    ss += __shfl_xor(ss, 1); ss += __shfl_xor(ss, 2); ss += __shfl_xor(ss, 4); \
                    const float rn = __builtin_amdgcn_rsqf(ss * (1.0f / 128.0f) + EPS); \
                    bf16_t* op = OB + (size_t)(b * SEQ + m0_ + ot) * D + h * DK + 8 * ocg; \
                    _Pragma("unroll") for (int q = 0; q < 2; ++q) { f32x4 g0, g1; gm::unpack8(GGv[q], g0, g1); \
                        _Pragma("unroll") for (int j = 0; j < 4; ++j) { g0[j] = g0[j] * sigmoidf_(g0[j]); g1[j] = g1[j] * sigmoidf_(g1[j]); } \
                        *(u32x4*)(op + 64 * q) = gm::pack8(o[2 * q] * rn * nwv[2 * q] * g0, o[2 * q + 1] * rn * nwv[2 * q + 1] * g1); } } \
                if ((cix) + 2 < NCHUNK / 2) P2_LOADR((cix) + 2, R, GGv); \
            } while (0)
            u32x4 qA[2], rA_[2], gA[2], qB_[2], rB_[2], gB[2]; f32x4 dA = (f32x4){0.f, 0.f, 0.f, 0.f}, dB = dA;
            P2_LOADQ(0, qA, dA); P2_LOADR(0, rA_, gA); P2_LOADQ(1, qB_, dB); P2_LOADR(1, rB_, gB);
            for (int cc = 0; cc < NCHUNK / 2; cc += 2) { P2_STEP(cc, qA, dA, rA_, gA); P2_STEP(cc + 1, qB_, dB, rB_, gB); }
#undef P2_STEP
#undef P2_LOADQ
#undef P2_LOADR
        }
        if (BOTH(3)) GRID_BAR();
#if MK_PHT
        if (MK_PHT == 4) phtk = __builtin_amdgcn_s_memrealtime() - pht0;
#endif
    }

    if (IN(4)) for (int rep_ = 0; rep_ < 1 + ((MK_REPEAT >> 4) & 1); ++rep_) { PHASE_ARGS();
        gm::DenseOrder S{NTOK / 256, D / 256, G, bid, 1}; gm::DenseA AM{D, 0u, 2}; gm::EpiMerge E{(const bf16_t*)ap->out, WSP(bf16_t, WS_U)};
        gm::gemm_phase<false>(wave_sg, lds, (const char*)WSP(bf16_t, WS_O), (const char*)WSP(bf16_t, WS_WHG), D, 0, 0u, S, E, AM);
        if (BOTH(4)) GRID_BAR();
#if MK_PHT
        if (MK_PHT == 5) phtk = __builtin_amdgcn_s_memrealtime() - pht0;
#endif
    }

    if (IN(5)) for (int rep_ = 0; rep_ < 1 + ((MK_REPEAT >> 5) & 1); ++rep_) { PHASE_ARGS();
        gm::DenseOrder S{NTOK / 256, D / 256, G, bid, 1, true}; gm::DenseA AM{D, 0u, 2}; gm::EpiMix E{ARG(I_X), WSP(float, WS_MOD), WSP(bf16_t, WS_H), WSP(float, WS_SSQ)};
        gm::gemm_phase<false>(wave_sg, lds, (const char*)WSP(bf16_t, WS_U), (const char*)WSP(bf16_t, WS_WMIX), D, 0, 0u, S, E, AM);
        if (BOTH(5)) GRID_BAR();
#if MK_PHT
        if (MK_PHT == 6) phtk = __builtin_amdgcn_s_memrealtime() - pht0;
#endif
    }

    if (IN(6)) { PHASE_IDS(); PHASE_ARGS();
        typedef float f32x16 __attribute__((ext_vector_type(16)));
        const float* norm_ffn_w = ARG(I_NFFN); const float* w_router = ARG(I_WR); const float* b_router = ARG(I_BR); const float* MOD = WSP(float, WS_MOD);
        const bf16_t* HB = WSP(bf16_t, WS_H); const float* SSQP = WSP(float, WS_SSQ); unsigned char* U2Q = WSP(unsigned char, WS_U2Q); int* TOPI = WSP(int, WS_TOPI); float* TOPP = WSP(float, WS_TOPP); int* POS = WSP(int, WS_POS);
        constexpr int WRS = 1032;
        LAS bf16_t* WRH = (LAS bf16_t*)lds; LAS bf16_t* WRL = WRH + 32 * WRS;
        LAS float* LG = (LAS float*)(lds + 132096) + wave * (16 * 36);
        LAS unsigned* LCNT = (LAS unsigned*)(lds + 150528);
        LAS unsigned* LBASE = LCNT + 32;
        LAS unsigned* LASS = LCNT + 64;
        LAS float* A2 = (LAS float*)(lds + 154880); LAS float* SH2 = A2 + 1024;
        { const u32x4* wi = (const u32x4*)WSP(bf16_t, WS_WRI);
            for (int i = tid; i < 2 * 32 * WRS * 2 / 16; i += NTHREADS) *(LAS u32x4*)(lds + 16 * i) = wi[i]; }
        for (int tb = bid; tb < NTOK / 256; tb += G) {
            const int b = (tb * 256) >> 11;
            if (tid < 32) LCNT[tid] = 0u;
            for (int k = tid; k < 1024; k += NTHREADS) { A2[k] = norm_ffn_w[k] * (1.0f + MOD[(size_t)b * 6144 + 4096 + k]); SH2[k] = MOD[(size_t)b * 6144 + 3072 + k]; }
            LDS_WAIT(); __syncthreads();
            const int trow = lane & 31, half = lane >> 5, ltok0 = wave * 32, tok = tb * 256 + ltok0 + trow;
            const bf16_t* hrow = HB + (size_t)tok * D + 8 * half;
            float ssq; { const float* sp = SSQP + (size_t)tok * 16 + 8 * half; const f32x4 p0 = *(const f32x4*)sp, p1 = *(const f32x4*)(sp + 4); ssq = ((p0[0] + p0[1]) + (p0[2] + p0[3])) + ((p1[0] + p1[1]) + (p1[2] + p1[3])); }
            ssq += __shfl_xor(ssq, 32);
            const float rs = __builtin_amdgcn_rsqf(ssq * (1.0f / D) + EPS);
            f32x16 dacc, dacx;
#pragma unroll
            for (int q = 0; q < 16; ++q) { dacc[q] = 0.f; dacx[q] = 0.f; }
            unsigned char* urow0 = U2Q + (size_t)tok * D; unsigned upx = 0u, upy = 0u;
            const LAS bf16_t* wh = WRH + trow * WRS + 8 * half; const LAS bf16_t* wl = WRL + trow * WRS + 8 * half;
            u32x4 hq[2][8];
#pragma unroll
            for (int j = 0; j < 8; ++j) hq[0][j] = *(const u32x4*)(hrow + 16 * j);
#pragma unroll 1
            for (int s16 = 0; s16 < 64; s16 += 16)
#pragma unroll
            for (int s8 = 0; s8 < 16; s8 += 8) {
                const int pb_ = (s8 >> 3) & 1;
                if (s16 + s8 + 8 < 64) {
#pragma unroll
                    for (int j = 0; j < 8; ++j) hq[pb_ ^ 1][j] = *(const u32x4*)(hrow + 16 * (s16 + s8 + 8 + j));
                }
#pragma unroll
            for (int sj = 0; sj < 8; ++sj) { const int st = s16 + s8 + sj;
                const u32x4 hv = hq[pb_][sj]; f32x4 x0, x1; gm::unpack8(hv, x0, x1);
                const int k0 = 16 * st + 8 * half;
                const f32x4 a0 = *(const LAS f32x4*)(A2 + k0), a1 = *(const LAS f32x4*)(A2 + k0 + 4), s0 = *(const LAS f32x4*)(SH2 + k0), s1 = *(const LAS f32x4*)(SH2 + k0 + 4);
                const f32x4 u0 = x0 * rs * a0 + s0, u1 = x1 * rs * a1 + s1;
                {
                    const unsigned cx = pk4_fp8(u0[0], u0[1], u0[2], u0[3]), cy = pk4_fp8(u1[0], u1[1], u1[2], u1[3]);
                    if ((sj & 1) == 0) { upx = cx; upy = cy; }
                    else { unsigned ax = upx, ay = upy, bx = cx, by = cy;
                        { auto rr = __builtin_amdgcn_permlane32_swap(ax, bx, false, false); ax = rr[0]; bx = rr[1]; }
                        { auto rr = __builtin_amdgcn_permlane32_swap(ay, by, false, false); ay = rr[0]; by = rr[1]; }
                        *(u32x4*)(urow0 + 16 * (st - 1 + half)) = (u32x4){ax, ay, bx, by}; } }
                u32x4 hh; hh.x = cvt_pk_bf16(u0[0], u0[1]); hh.y = cvt_pk_bf16(u0[2], u0[3]); hh.z = cvt_pk_bf16(u1[0], u1[1]); hh.w = cvt_pk_bf16(u1[2], u1[3]);
                u32x4 ll; ll.x = cvt_pk_bf16(u0[0] - bf_lo(hh.x), u0[1] - bf_hi(hh.x)); ll.y = cvt_pk_bf16(u0[2] - bf_lo(hh.y), u0[3] - bf_hi(hh.y));
                ll.z = cvt_pk_bf16(u1[0] - bf_lo(hh.z), u1[1] - bf_hi(hh.z)); ll.w = cvt_pk_bf16(u1[2] - bf_lo(hh.w), u1[3] - bf_hi(hh.w));
                const bf16x8 ah = __builtin_bit_cast(bf16x8, hh), al = __builtin_bit_cast(bf16x8, ll);
                const bf16x8 bh = *(const LAS bf16x8*)(wh + 16 * st), bl = *(const LAS bf16x8*)(wl + 16 * st);
                dacc = __builtin_amdgcn_mfma_f32_32x32x16_bf16(ah, bh, dacc, 0, 0, 0);
                dacx = __builtin_amdgcn_mfma_f32_32x32x16_bf16(ah, bl, dacx, 0, 0, 0);
                dacx = __builtin_amdgcn_mfma_f32_32x32x16_bf16(al, bh, dacx, 0, 0, 0);
            } }
#pragma unroll
            for (int q = 0; q < 16; ++q) dacc[q] += dacx[q];
            const float br = b_router[trow];
#pragma unroll
            for (int g = 0; g < 2; ++g) {
#pragma unroll
                for (int q = 0; q < 8; ++q) { const int r16 = (q & 3) + 8 * (q >> 2) + 4 * half; LG[r16 * 36 + trow] = dacc[8 * g + q] + br; }
                LDS_WAIT(); asm volatile("" ::: "memory");
                if (lane < 16) {
                    float v0 = -3.0e38f, v1 = -3.0e38f, v2 = -3.0e38f, v3 = -3.0e38f; int i0 = 0, i1 = 0, i2 = 0, i3 = 0;
#pragma unroll
                    for (int e4 = 0; e4 < 8; ++e4) { const f32x4 lv = *(const LAS f32x4*)(LG + lane * 36 + 4 * e4);
#pragma unroll
                        for (int j = 0; j < 4; ++j) { const float x = lv[j]; const int e = 4 * e4 + j;
                            const bool c0 = x > v0, c1 = x > v1, c2 = x > v2, c3 = x > v3;
                            v3 = c2 ? v2 : (c3 ? x : v3); i3 = c2 ? i2 : (c3 ? e : i3);
                            v2 = c1 ? v1 : (c2 ? x : v2); i2 = c1 ? i1 : (c2 ? e : i2);
                            v1 = c0 ? v0 : (c1 ? x : v1); i1 = c0 ? i0 : (c1 ? e : i1);
                            v0 = c0 ? x : v0; i0 = c0 ? e : i0; } }
                    const float e1 = fast_exp(v1 - v0), e2 = fast_exp(v2 - v0), e3 = fast_exp(v3 - v0); const float inv = fast_rcp(1.0f + e1 + e2 + e3);
                    const int lt = ltok0 + 16 * g + lane; const size_t gt = (size_t)tb * 256 + lt;
                    typedef int i32x4 __attribute__((ext_vector_type(4)));
                    *(i32x4*)(TOPI + gt * 4) = (i32x4){i0, i1, i2, i3}; *(f32x4*)(TOPP + gt * 4) = (f32x4){inv, e1 * inv, e2 * inv, e3 * inv};
                    const unsigned r0 = __hip_atomic_fetch_add(LCNT + i0, 1u, __ATOMIC_RELAXED, __HIP_MEMORY_SCOPE_WORKGROUP), r1 = __hip_atomic_fetch_add(LCNT + i1, 1u, __ATOMIC_RELAXED, __HIP_MEMORY_SCOPE_WORKGROUP);
                    const unsigned r2 = __hip_atomic_fetch_add(LCNT + i2, 1u, __ATOMIC_RELAXED, __HIP_MEMORY_SCOPE_WORKGROUP), r3 = __hip_atomic_fetch_add(LCNT + i3, 1u, __ATOMIC_RELAXED, __HIP_MEMORY_SCOPE_WORKGROUP);
                    *(LAS u32x4*)(LASS + lt * 4) = (u32x4){((unsigned)i0 << 16) | r0, ((unsigned)i1 << 16) | r1, ((unsigned)i2 << 16) | r2, ((unsigned)i3 << 16) | r3};
                }
                LDS_WAIT(); asm volatile("" ::: "memory");
            }
            LDS_WAIT(); __syncthreads();
            if (tid < 32) LBASE[tid] = atomicAdd(ctl + CW_CNT + 64 * tid, (unsigned)LCNT[tid]);
            LDS_WAIT(); __syncthreads();
            for (int i = tid; i < 1024; i += NTHREADS) { const unsigned v = LASS[i]; POS[(size_t)tb * 1024 + i] = (int)(LBASE[v >> 16] + (v & 0xffffu)); }
            __syncthreads();
        }
        if (BOTH(6)) GRID_BAR();
#if MK_PHT
        if (MK_PHT == 7) phtk = __builtin_amdgcn_s_memrealtime() - pht0;
#endif
    }

    LAS int* PADSTART = (LAS int*)(lds + TBL_OFF); LAS int* TILE_E = PADSTART + 64;
    int ntiles = 0;
    {
        if (lo <= 9 && hi > 7) { PHASE_IDS(); PHASE_ARGS();
            __syncthreads();
            if (wave == 0) {
                const int cnt = lane < NE ? (int)__hip_atomic_load(ctl + CW_CNT + 64 * lane, __ATOMIC_RELAXED, __HIP_MEMORY_SCOPE_AGENT) : 0;
                const int padded = ((cnt + 255) >> 8) << 8; int incl = padded;
#pragma unroll
                for (int o = 1; o < 32; o <<= 1) { const int v = __shfl_up(incl, o); if ((lane & 31) >= o) incl += v; }
                if (lane < NE) PADSTART[lane] = incl - padded;
                if (lane == NE - 1) PADSTART[NE] = incl;
            }
            LDS_WAIT(); __syncthreads();
            for (int t = tid; t < (PADSTART[NE] >> 8); t += NTHREADS) { int e = 0;
#pragma unroll
                for (int q = 1; q < NE; ++q) e += ((PADSTART[q] >> 8) <= t) ? 1 : 0;
                TILE_E[t] = e; }
            LDS_WAIT(); __syncthreads();
            ntiles = PADSTART[NE] >> 8;
        }
    }

    if (IN(7)) for (int rep_ = 0; rep_ < 1 + ((MK_REPEAT >> 7) & 1); ++rep_) { PHASE_IDS(); PHASE_ARGS();
        const int* TOPI = WSP(int, WS_TOPI); const float* TOPP = WSP(float, WS_TOPP); int* POS = WSP(int, WS_POS); int* RTOK = WSP(int, WS_RTOK); int* RSLOT = WSP(int, WS_RSLOT); float* RW = WSP(float, WS_RW);
        for (int i = bid * NTHREADS + tid; i < NASSIGN; i += G * NTHREADS) { const int e = TOPI[i]; const int row = PADSTART[e] + POS[i]; RTOK[row] = i >> 2; RSLOT[row] = i; RW[row] = TOPP[i]; POS[i] = row; }
        for (int e = bid; e < NE; e += G) { const int cnt = (int)__hip_atomic_load(ctl + CW_CNT + 64 * e, __ATOMIC_RELAXED, __HIP_MEMORY_SCOPE_AGENT);
            for (int r = PADSTART[e] + cnt + tid; r < PADSTART[e + 1]; r += NTHREADS) { RTOK[r] = 0; RSLOT[r] = -1; RW[r] = 0.f; } }
#if MK_BG && MK_ONE_LAUNCH
        if (BOTH(7)) GRID_BAR_X(true);
#else
        if (BOTH(7)) GRID_BAR();
#endif
#if MK_PHT
        if (MK_PHT == 8) phtk = __builtin_amdgcn_s_memrealtime() - pht0;
#endif
    }

    if (IN(8)) for (int rep_ = 0; rep_ < 1 + ((MK_REPEAT >> 8) & 1); ++rep_) { PHASE_ARGS();
        gm::MoeOrder S{ntiles, 2048 / 256, G, bid, TILE_E, MK_WGM8}; gm::GatherA AM{D, WSP(int, WS_RTOK), 1}; gm::EpiSwiglu E{ARG(I_B1), WSP(unsigned char, WS_ACT), ctl + CW_TP};
        gm::gemm_phase<true>(wave_sg, lds, (const char*)WSP(char, WS_U2Q), (const char*)WSP(char, WS_W1), D, 2048, 0u, S, E, AM);
        if (BOTH(8)) GRID_BAR();
#if MK_PHT
        if (MK_PHT == 9) phtk = __builtin_amdgcn_s_memrealtime() - pht0;
#endif
    }

    if (IN(9)) for (int rep_ = 0; rep_ < 1 + ((MK_REPEAT >> 9) & 1); ++rep_) { PHASE_ARGS();
        gm::MoeOrder S{ntiles, D / 256, G, bid, TILE_E, MK_WGM9, true}; gm::DenseA AM{DFF, 0u, 1}; gm::EpiMoeOut E{ARG(I_B2), WSP(float, WS_RW), WSP(unsigned char, WS_YA)};
        gm::gemm_phase<true>(wave_sg, lds, (const char*)WSP(char, WS_ACT), (const char*)WSP(char, WS_W2), DFF, D, 0u, S, E, AM);
        if (BOTH(9)) GRID_BAR();
#if MK_PHT
        if (MK_PHT == 10) phtk = __builtin_amdgcn_s_memrealtime() - pht0;
#endif
    }

#if MK_PROBE
    if (lo == 100) { PHASE_IDS(); PHASE_ARGS();
        float* out = ap->out;
        const bf16_t* src = MK_PROBE == 1 ? WSP(bf16_t, WS_U) : MK_PROBE == 3 ? WSP(bf16_t, WS_O) : MK_PROBE == 4 ? WSP(bf16_t, WS_U) : MK_PROBE == 5 ? WSP(bf16_t, WS_H) : WSP(bf16_t, WS_U);
        for (size_t i = (size_t)bid * NTHREADS + tid; i < (size_t)NTOK * D; i += (size_t)G * NTHREADS) {
            float v;
            if (MK_PROBE == 3) { const size_t t = i >> 10, c = i & 1023; v = bf1(src[t * 1024 + c]); }
            else if (MK_PROBE == 2) { const size_t t = i >> 10, c = i & 1023; const bf16_t* P = WSP(bf16_t, WS_PROJ) + t * PROJ_LD; v = bf1(P[c]) + bf1(P[c + 1024]) + bf1(P[c + 2048]) + (c < 512 ? bf1(P[c + 3072]) : 0.f); }
            else if (MK_PROBE == 6) { const size_t t = i >> 10, c = i & 1023; v = bf1(src[i]) + (c < 4 ? (float)WSP(int, WS_TOPI)[t * 4 + c] : c < 8 ? WSP(float, WS_TOPP)[t * 4 + (c - 4)] : 0.f); }
            else v = bf1(src[i]);
            out[i] = v; }
    }
#endif
    if (IN(10)) { PHASE_IDS(); PHASE_ARGS();
#if MK_TPROBE
        const float tscale = 1.0f;
#elif MK_FP8TEST
        float tscale = 1.0f;
        {
            typedef int v8i __attribute__((ext_vector_type(8)));
            const int fr = lane & 15, fq = lane >> 4;
            v8i ta, tb;
#pragma unroll
            for (int d = 0; d < 8; ++d) { float av[4], bv[4];
#pragma unroll
                for (int e = 0; e < 4; ++e) { const int k = 32 * fq + 4 * d + e; av[e] = (float)(((fr * 7 + k * 3) % 5) - 2); bv[e] = (float)(((k * 5 + fr * 11) % 7) - 3); }
                int w = __builtin_amdgcn_cvt_pk_fp8_f32(av[0], av[1], 0, false); w = __builtin_amdgcn_cvt_pk_fp8_f32(av[2], av[3], w, true); ta[d] = w;
                w = __builtin_amdgcn_cvt_pk_fp8_f32(bv[0], bv[1], 0, false); w = __builtin_amdgcn_cvt_pk_fp8_f32(bv[2], bv[3], w, true); tb[d] = w; }
            f32x4 tc = {0.f, 0.f, 0.f, 0.f};
            tc = __builtin_amdgcn_mfma_scale_f32_16x16x128_f8f6f4(ta, tb, tc, 0, 0, 0, 0x7A7A7A7A, 0, 0x7F7F7F7F);
            bool bad = false;
#pragma unroll
            for (int r = 0; r < 4; ++r) { const int i = 4 * fq + r, j = fr; float ref = 0.f;
                for (int k = 0; k < 128; ++k) ref += (float)(((i * 7 + k * 3) % 5) - 2) * (float)(((k * 5 + j * 11) % 7) - 3);
                ref *= (1.0f / 32.0f); if (fabsf(tc[r] - ref) > 1e-3f) bad = true; }
            if (__any(bad)) tscale = 4.0f;
        }
#endif
        const float* norm_final_w = ARG(I_NFIN); const float* MOD = WSP(float, WS_MOD); const bf16_t* HB = WSP(bf16_t, WS_H); const unsigned char* YA = WSP(unsigned char, WS_YA); const int* ASROW = WSP(int, WS_POS); float* out = ap->out;
#if !MK_FP8TEST && !MK_TPROBE
        for (int m0 = gw * 32; m0 < NTOK; m0 += NGW * 32) {
            const int b = m0 >> 11;
            f32x4 gf[4], nf[4];
#pragma unroll
            for (int j = 0; j < 4; ++j) { const int k = 4 * lane + 256 * j; gf[j] = *(const f32x4*)(MOD + (size_t)b * 6144 + 5120 + k); nf[j] = *(const f32x4*)(norm_final_w + k); }
            const u32x2 rws = *(const u32x2*)(ASROW + (size_t)m0 * 4 + 2 * lane);
#define P10_LOAD(r_, HW, YR) { const int r__ = (r_); const bf16_t* hr = HB + (size_t)(m0 + r__) * D; \
                const unsigned q0 = (unsigned)__builtin_amdgcn_readlane((int)rws.x, 2 * r__), q1 = (unsigned)__builtin_amdgcn_readlane((int)rws.y, 2 * r__), q2 = (unsigned)__builtin_amdgcn_readlane((int)rws.x, 2 * r__ + 1), q3 = (unsigned)__builtin_amdgcn_readlane((int)rws.y, 2 * r__ + 1); \
                const unsigned char* y0 = YA + (size_t)q0 * D; const unsigned char* y1 = YA + (size_t)q1 * D; const unsigned char* y2 = YA + (size_t)q2 * D; const unsigned char* y3 = YA + (size_t)q3 * D; \
                _Pragma("unroll") for (int j = 0; j < 4; ++j) { const int k = 4 * lane + 256 * j; HW[j] = *(const u32x2*)(hr + k); \
                    YR[j] = (u32x4){*(const unsigned*)(y0 + k), *(const unsigned*)(y1 + k), *(const unsigned*)(y2 + k), *(const unsigned*)(y3 + k)}; } }
#define P10_FIN(r_, HW, YR) { f32x4 v[4]; float s = 0.f; \
                _Pragma("unroll") for (int j = 0; j < 4; ++j) { \
                    f32x4 y = fp8x4_to_f32(YR[j].x); y += fp8x4_to_f32(YR[j].y); y += fp8x4_to_f32(YR[j].z); y += fp8x4_to_f32(YR[j].w); \
                    v[j] = (f32x4){bf_lo(HW[j].x), bf_hi(HW[j].x), bf_lo(HW[j].y), bf_hi(HW[j].y)} + gf[j] * y; \
                    s += (v[j][0] * v[j][0] + v[j][1] * v[j][1]) + (v[j][2] * v[j][2] + v[j][3] * v[j][3]); } \
                const float rs = __builtin_amdgcn_rsqf(wave_sum(s) * (1.0f / D) + EPS); \
                float* orow = out + (size_t)(m0 + (r_)) * D; \
                _Pragma("unroll") for (int j = 0; j < 4; ++j) *(f32x4*)(orow + 4 * lane + 256 * j) = v[j] * rs * nf[j]; }
            u32x2 hwA[4], hwB[4]; u32x4 yrA[4], yrB[4];
            P10_LOAD(0, hwA, yrA);
#pragma unroll 1
            for (int r = 0; r < 32; r += 2) {
                P10_LOAD(r + 1, hwB, yrB);
                asm volatile("" ::: "memory");
                P10_FIN(r, hwA, yrA);
                if (r + 2 < 32) P10_LOAD(r + 2, hwA, yrA);
                asm volatile("" ::: "memory");
                P10_FIN(r + 1, hwB, yrB);
            }
#undef P10_LOAD
#undef P10_FIN
        }
#else
        for (int m0 = gw * 32; m0 < NTOK; m0 += NGW * 32) {
            const int b = m0 >> 11;
            f32x4 gf[4], nf[4];
#pragma unroll
            for (int j = 0; j < 4; ++j) { const int k = 4 * lane + 256 * j; gf[j] = *(const f32x4*)(MOD + (size_t)b * 6144 + 5120 + k); nf[j] = *(const f32x4*)(norm_final_w + k); }
            for (int r = 0; r < 32; ++r) {
                const size_t tok = (size_t)(m0 + r);
                const bf16_t* hr = HB + tok * D;
                typedef int i32x4 __attribute__((ext_vector_type(4)));
                const i32x4 rr = *(const i32x4*)(ASROW + tok * 4);
                const unsigned char* y0 = YA + (size_t)rr[0] * D; const unsigned char* y1 = YA + (size_t)rr[1] * D; const unsigned char* y2 = YA + (size_t)rr[2] * D; const unsigned char* y3 = YA + (size_t)rr[3] * D;
                f32x4 v[4]; float s = 0.f;
#pragma unroll
                for (int j = 0; j < 4; ++j) { const int k = 4 * lane + 256 * j;
                    const u32x2 hw = *(const u32x2*)(hr + k); const unsigned ya = *(const unsigned*)(y0 + k), yb = *(const unsigned*)(y1 + k), yc = *(const unsigned*)(y2 + k), yd = *(const unsigned*)(y3 + k);
                    f32x4 y = fp8x4_to_f32(ya); y += fp8x4_to_f32(yb); y += fp8x4_to_f32(yc); y += fp8x4_to_f32(yd);
                    v[j] = (f32x4){bf_lo(hw.x), bf_hi(hw.x), bf_lo(hw.y), bf_hi(hw.y)} + gf[j] * y;
                    s += (v[j][0] * v[j][0] + v[j][1] * v[j][1]) + (v[j][2] * v[j][2] + v[j][3] * v[j][3]); }
                const float rs = __builtin_amdgcn_rsqf(wave_sum(s) * (1.0f / D) + EPS);
                float* orow = out + tok * D;
#pragma unroll
                #if MK_FP8TEST || MK_TPROBE
                for (int j = 0; j < 4; ++j) *(f32x4*)(orow + 4 * lane + 256 * j) = v[j] * rs * nf[j] * tscale;
#else
                for (int j = 0; j < 4; ++j) *(f32x4*)(orow + 4 * lane + 256 * j) = v[j] * rs * nf[j];
#endif
            }
        }
#endif
    }
#if MK_PHT
    if (bid == 0) { const unsigned long long t1 = __builtin_amdgcn_s_memrealtime(); while (__builtin_amdgcn_s_memrealtime() - t1 < phtk) __builtin_amdgcn_s_sleep(8); }
#endif
#undef IN
#undef BOTH
}

extern "C" void kernel_launch(void* const* d_in, const int* in_sizes, int n_in, void* d_out, int out_size, void* d_ws, size_t ws_size, hipStream_t stream) {
    static int grid = 0;
    if (grid == 0) {
        if (n_in != 20 || out_size != NTOK * D || ws_size < WS_END) { fprintf(stderr, "kernel_launch: unexpected shapes (n_in %d out %d ws %zu)\n", n_in, out_size, ws_size); grid = -1; return; }
        if (hipFuncSetAttribute((const void*)fwd_kernel, hipFuncAttributeMaxDynamicSharedMemorySize, LDS_BYTES) != hipSuccess) { fprintf(stderr, "kernel_launch: hipFuncSetAttribute failed\n"); grid = -1; return; }
        int dev = 0, cus = 0, per_cu = 0;
        (void)hipGetDevice(&dev); (void)hipDeviceGetAttribute(&cus, hipDeviceAttributeMultiprocessorCount, dev);
        if (hipOccupancyMaxActiveBlocksPerMultiprocessor(&per_cu, (const void*)fwd_kernel, NTHREADS, LDS_BYTES) != hipSuccess || per_cu < 1) fprintf(stderr, "kernel_launch: occupancy query says %d\n", per_cu);
        (void)hipGetLastError();
        grid = cus > 0 ? cus : 256;
    }
    if (grid < 0) return;
    (void)hipMemsetAsync((char*)d_ws + WS_CTL, 0, CTL_ZERO_BYTES, stream);
    Args a{};
    for (int i = 0; i < 20; ++i) a.in[i] = (const float*)d_in[i];
    a.out = (float*)d_out; a.ws = (unsigned char*)d_ws;
#if MK_ONE_LAUNCH
    a.ph_lo = 0; a.ph_hi = NPHASE;
    hipLaunchKernelGGL(fwd_kernel, dim3(grid), dim3(NTHREADS), LDS_BYTES, stream, a);
#else
#if MK_PROBE
    for (int p = 0; p <= MK_PROBE; ++p) { a.ph_lo = p; a.ph_hi = p + 1; hipLaunchKernelGGL(fwd_kernel, dim3(grid), dim3(NTHREADS), LDS_BYTES, stream, a); }
    a.ph_lo = 100; a.ph_hi = 101; hipLaunchKernelGGL(fwd_kernel, dim3(grid), dim3(NTHREADS), LDS_BYTES, stream, a);
#else
    for (int p = 0; p < NPHASE; ++p) { a.ph_lo = p; a.ph_hi = p + 1; hipLaunchKernelGGL(fwd_kernel, dim3(grid), dim3(NTHREADS), LDS_BYTES, stream, a); }
#endif
#endif
}
```
